# Optimizing an MI355X kernel written in HIP

```python
import jax, jax.numpy as jnp
from jax import lax
import numpy as np


D_MODEL = 1024
BATCH = 4
SEQ = 8192
DEPTH = 1

GRID_W = 64
N_MEM = 256
EPS = 1e-6

ATT_HEADS = 8
ATT_KV_HEADS = 2
ATT_HEAD_DIM = 64
ATT_WIDTH = ATT_HEADS * ATT_HEAD_DIM
KV_WIDTH = ATT_KV_HEADS * ATT_HEAD_DIM
ROPE_THETA = 10000.0
Q_BLOCK = 128

SGU_GROUPS = 4
SGU_WIDTH = 512
SGU_GROUP_CH = SGU_WIDTH // SGU_GROUPS
SGU_CHUNK = 128

IN_COLS = ATT_WIDTH + 2 * KV_WIDTH + 2 * SGU_WIDTH + 2 * D_MODEL

X_HEADS = 4
X_HEAD_DIM = 128
X_WIDTH = X_HEADS * X_HEAD_DIM

N_GROUPS = 4
EXPERTS_PER_GROUP = 4
N_EXPERTS = N_GROUPS * EXPERTS_PER_GROUP
TOP_K = 2
D_EXPERT = 512

kernel_name = "hybrid_gated_gqa_gmlp_hmoe_encoder"


def rms_norm(x, g):
    xf = x.astype(jnp.float32)
    y = xf * lax.rsqrt(jnp.mean(xf * xf, axis=-1, keepdims=True) + EPS)
    return y.astype(x.dtype) * g


def layer_norm(x, g, b):
    xf = x.astype(jnp.float32)
    mu = jnp.mean(xf, axis=-1, keepdims=True)
    xc = xf - mu
    var = jnp.mean(xc * xc, axis=-1, keepdims=True)
    return (xc * lax.rsqrt(var + EPS)).astype(x.dtype) * g + b


def axial_rope_tables(seq_len):
    rows = seq_len // GRID_W
    row_ids = jnp.repeat(jnp.arange(rows), GRID_W).astype(jnp.float32)
    col_ids = jnp.tile(jnp.arange(GRID_W), rows).astype(jnp.float32)
    pairs_per_axis = ATT_HEAD_DIM // 4
    inv_freq = ROPE_THETA ** (-jnp.arange(pairs_per_axis, dtype=jnp.float32) / pairs_per_axis)
    ang = jnp.concatenate([row_ids[:, None] * inv_freq[None, :],
                           col_ids[:, None] * inv_freq[None, :]], axis=-1)
    return jnp.cos(ang), jnp.sin(ang)


def apply_rope(x, cos, sin):
    xf = x.astype(jnp.float32).reshape(*x.shape[:-1], x.shape[-1] // 2, 2)
    x0, x1 = xf[..., 0], xf[..., 1]
    c = cos[None, :, None, :]
    s = sin[None, :, None, :]
    out = jnp.stack([x0 * c - x1 * s, x0 * s + x1 * c], axis=-1).reshape(x.shape)
    return out.astype(x.dtype)


def gqa_attention(q, k, v):
    B, S, _, HD = q.shape
    G = ATT_HEADS // ATT_KV_HEADS
    nb = S // Q_BLOCK
    qb = q.reshape(B, nb, Q_BLOCK, ATT_KV_HEADS, G, HD).transpose(1, 0, 2, 3, 4, 5)
    scale = HD ** -0.5

    def block(q_blk):
        s = jnp.einsum('bqhgd,bkhd->bhgqk', q_blk, k, preferred_element_type=jnp.float32) * scale
        p = jax.nn.softmax(s, axis=-1).astype(v.dtype)
        return jnp.einsum('bhgqk,bkhd->bqhgd', p, v)

    o = lax.map(block, qb)
    return o.transpose(1, 0, 2, 3, 4, 5).reshape(B, S, ATT_WIDTH)


def spatial_gating(u, v, w_s, b_s, ln_g, ln_b):
    B, S, _ = v.shape
    nc = S // SGU_CHUNK
    vn = layer_norm(v, ln_g, ln_b).reshape(B, nc, SGU_CHUNK, SGU_GROUPS, SGU_GROUP_CH)
    vm = jnp.einsum('gpq,bnqgc->bnpgc', w_s, vn) + b_s.T[:, :, None]
    return u * vm.reshape(B, S, SGU_WIDTH)


def memory_cross_attention(h, mem_n, w_cq, w_ckv, w_co):
    B, S, _ = h.shape
    M = mem_n.shape[1]
    q = (h @ w_cq).reshape(B, S, X_HEADS, X_HEAD_DIM)
    kv = mem_n @ w_ckv
    k = kv[..., :X_WIDTH].reshape(B, M, X_HEADS, X_HEAD_DIM)
    v = kv[..., X_WIDTH:].reshape(B, M, X_HEADS, X_HEAD_DIM)
    s = jnp.einsum('bshd,bmhd->bhsm', q, k, preferred_element_type=jnp.float32) * (X_HEAD_DIM ** -0.5)
    p = jax.nn.softmax(s, axis=-1).astype(v.dtype)
    o = jnp.einsum('bhsm,bmhd->bshd', p, v).reshape(B, S, X_WIDTH)
    return o @ w_co


def hierarchical_moe(h, w_rg, b_rg, w_re, b_re, w_gate, w_up, w_down):
    B, S, D = h.shape
    t = h.reshape(B * S, D)
    glog = (t @ w_rg + b_rg).astype(jnp.float32)
    gprob = jax.nn.softmax(glog, axis=-1)
    gval, gidx = lax.top_k(gprob, 1)
    elog = (t @ w_re + b_re).astype(jnp.float32).reshape(-1, N_GROUPS, EXPERTS_PER_GROUP)
    elog_sel = jnp.take_along_axis(elog, gidx[:, :, None], axis=1)[:, 0]
    evals, eidx = lax.top_k(elog_sel, TOP_K)
    ew = jax.nn.softmax(evals, axis=-1) * gval
    expert_id = gidx * EXPERTS_PER_GROUP + eidx
    combine = jnp.sum(jax.nn.one_hot(expert_id, N_EXPERTS, dtype=jnp.float32) * ew[..., None], axis=1)
    combine = combine.astype(t.dtype)
    y = jnp.zeros_like(t)
    for e in range(N_EXPERTS):
        he = jax.nn.silu(t @ w_gate[e]) * (t @ w_up[e])
        y = y + combine[:, e:e + 1] * (he @ w_down[e])
    return y.reshape(B, S, D)


def setup_inputs(seed: int = 0) -> dict:
    key = jax.random.key(seed)
    ks = iter(jax.random.split(key, 40))
    L = DEPTH
    f32 = jnp.float32

    def nrm(shape, scale):
        return jax.random.normal(next(ks), shape, f32) * scale

    def gain(shape):
        return 1.0 + 0.1 * jax.random.normal(next(ks), shape, f32)

    return {
        'x': nrm((BATCH, SEQ, D_MODEL), 1.0),
        'mem': nrm((BATCH, N_MEM, D_MODEL), 1.0),
        'g_mix': gain((L, D_MODEL)),
        'w_in': nrm((L, D_MODEL, IN_COLS), D_MODEL ** -0.5),
        'g_q': gain((L, ATT_HEAD_DIM)),
        'g_k': gain((L, ATT_HEAD_DIM)),
        'w_att_out': nrm((L, ATT_WIDTH, D_MODEL), ATT_WIDTH ** -0.5),
        'sgu_ln_g': gain((L, SGU_WIDTH)),
        'sgu_ln_b': nrm((L, SGU_WIDTH), 0.02),
        'w_s': nrm((L, SGU_GROUPS, SGU_CHUNK, SGU_CHUNK), 0.5 * SGU_CHUNK ** -0.5),
        'b_s': 1.0 + nrm((L, SGU_GROUPS, SGU_CHUNK), 0.1),
        'w_sgu_out': nrm((L, SGU_WIDTH, D_MODEL), SGU_WIDTH ** -0.5),
        'w_out': nrm((L, D_MODEL, D_MODEL), D_MODEL ** -0.5),
        'g_cross': gain((L, D_MODEL)),
        'g_mem': gain((L, D_MODEL)),
        'w_cq': nrm((L, D_MODEL, X_WIDTH), D_MODEL ** -0.5),
        'w_ckv': nrm((L, D_MODEL, 2 * X_WIDTH), D_MODEL ** -0.5),
        'w_co': nrm((L, X_WIDTH, D_MODEL), X_WIDTH ** -0.5),
        'g_moe': gain((L, D_MODEL)),
        'w_rg': nrm((L, D_MODEL, N_GROUPS), D_MODEL ** -0.5),
        'b_rg': nrm((L, N_GROUPS), 0.01),
        'w_re': nrm((L, D_MODEL, N_EXPERTS), D_MODEL ** -0.5),
        'b_re': nrm((L, N_EXPERTS), 0.01),
        'w_gate': nrm((L, N_EXPERTS, D_MODEL, D_EXPERT), D_MODEL ** -0.5),
        'w_up': nrm((L, N_EXPERTS, D_MODEL, D_EXPERT), D_MODEL ** -0.5),
        'w_down': nrm((L, N_EXPERTS, D_EXPERT, D_MODEL), D_EXPERT ** -0.5),
        'g_final': gain((D_MODEL,)),
    }


def reference(x, mem, g_mix, w_in, g_q, g_k, w_att_out, sgu_ln_g, sgu_ln_b, w_s, b_s,
              w_sgu_out, w_out, g_cross, g_mem, w_cq, w_ckv, w_co, g_moe, w_rg, b_rg,
              w_re, b_re, w_gate, w_up, w_down, g_final):
    B, S, _ = x.shape
    cos, sin = axial_rope_tables(S)
    splits = [ATT_WIDTH,
              ATT_WIDTH + KV_WIDTH,
              ATT_WIDTH + 2 * KV_WIDTH,
              ATT_WIDTH + 2 * KV_WIDTH + SGU_WIDTH,
              ATT_WIDTH + 2 * KV_WIDTH + 2 * SGU_WIDTH,
              ATT_WIDTH + 2 * KV_WIDTH + 2 * SGU_WIDTH + D_MODEL]
    for l in range(DEPTH):
        h = rms_norm(x, g_mix[l])
        z = h @ w_in[l]
        q, k, v, su, sv, ga, gb = jnp.split(z, splits, axis=-1)
        q = rms_norm(q.reshape(B, S, ATT_HEADS, ATT_HEAD_DIM), g_q[l])
        k = rms_norm(k.reshape(B, S, ATT_KV_HEADS, ATT_HEAD_DIM), g_k[l])
        q = apply_rope(q, cos, sin)
        k = apply_rope(k, cos, sin)
        v = v.reshape(B, S, ATT_KV_HEADS, ATT_HEAD_DIM)
        y_att = gqa_attention(q, k, v) @ w_att_out[l]
        y_sgu = spatial_gating(jax.nn.gelu(su), jax.nn.gelu(sv), w_s[l], b_s[l],
                               sgu_ln_g[l], sgu_ln_b[l]) @ w_sgu_out[l]
        merged = jax.nn.sigmoid(ga) * y_att + jax.nn.sigmoid(gb) * y_sgu
        x = x + merged @ w_out[l]
        x = x + memory_cross_attention(rms_norm(x, g_cross[l]), rms_norm(mem, g_mem[l]),
                                       w_cq[l], w_ckv[l], w_co[l])
        x = x + hierarchical_moe(rms_norm(x, g_moe[l]), w_rg[l], b_rg[l], w_re[l], b_re[l],
                                 w_gate[l], w_up[l], w_down[l])
    return rms_norm(x, g_final)
```

```cpp
#include <hip/hip_runtime.h>
#include <cstdio>
#include <cstdint>
#include <cmath>

typedef unsigned short bf16_t;
typedef float f32x4 __attribute__((ext_vector_type(4)));
typedef unsigned u32x4 __attribute__((ext_vector_type(4)));
typedef unsigned u32x2 __attribute__((ext_vector_type(2)));

constexpr int BATCH = 4, SEQ = 8192, D = 1024, M = BATCH * SEQ;
constexpr int NMEM = 256, MMEM = BATCH * NMEM;
constexpr int NZ = 3840;
constexpr int ZQ = 0, ZK = 512, ZV = 640, ZSU = 768, ZSV = 1280, ZGA = 1792, ZGB = 2816;
constexpr int NE = 16, DE = 512;
constexpr float EPS = 1e-6f;
constexpr float LOG2E = 1.4426950408889634f;
constexpr float C2_SELF = 0.125f * LOG2E;
constexpr float C2_CROSS = 0.08838834764831845f * LOG2E;
constexpr int LIST_CAP = 32768;

constexpr size_t MiB = 1u << 20;
constexpr size_t WS_CTL = 0, CTL_ZERO_BYTES = 64 * 1024;
constexpr size_t WS_TAB = 512 * 1024;
constexpr size_t WS_WZ = 1 * MiB;
constexpr size_t WS_WATT = 11 * MiB, WS_WSGU = 12 * MiB, WS_WOUT = 13 * MiB, WS_WCQ = 15 * MiB, WS_WCO = 16 * MiB, WS_WSS = 17 * MiB;
constexpr size_t WS_WGU = 18 * MiB;
constexpr size_t WS_WD = 50 * MiB;
constexpr size_t WS_XN = 68 * MiB;
constexpr size_t WS_MERGED = 68 * MiB;
constexpr size_t WS_XN3 = 68 * MiB;
constexpr size_t WS_KVC = 134 * MiB;
constexpr size_t WS_Q = 136 * MiB, WS_K = 168 * MiB, WS_V = 176 * MiB, WS_U = 184 * MiB, WS_GV = 216 * MiB, WS_GA = 248 * MiB, WS_GB = 312 * MiB;
constexpr size_t WS_ATT = 376 * MiB, WS_SG = 408 * MiB;
constexpr size_t WS_XN1 = 136 * MiB;
constexpr size_t WS_QC = 376 * MiB, WS_OC = 408 * MiB;
constexpr size_t WS_LIST = 200 * MiB;
constexpr size_t WS_TOKINFO = 204 * MiB;
constexpr size_t WS_YS = 208 * MiB;
constexpr size_t WS_H = 336 * MiB;
constexpr size_t WS_SCR = 440 * MiB;
constexpr size_t WS_END = 504 * MiB;
constexpr int CW_TMO = 0, CW_BAR = 4096, CW_ECNT = 8192;

__host__ __device__ __forceinline__ float bf2f(bf16_t b) { union { unsigned u; float f; } c; c.u = ((unsigned)b) << 16; return c.f; }
__host__ __device__ __forceinline__ unsigned f2bf(float f) { union { unsigned u; float f; } c; c.f = f; unsigned u = c.u; return (u + 0x7fffu + ((u >> 16) & 1u)) >> 16; }
__device__ __forceinline__ unsigned pk2(float lo, float hi) { return f2bf(lo) | (f2bf(hi) << 16); }
__device__ __forceinline__ float wave_sum(float v) {
#pragma unroll
    for (int o = 1; o < 64; o <<= 1) v += __shfl_xor(v, o);
    return v;
}
__device__ __forceinline__ float wave_max(float v) {
#pragma unroll
    for (int o = 1; o < 64; o <<= 1) v = fmaxf(v, __shfl_xor(v, o));
    return v;
}
__device__ __forceinline__ float gelu_tanh(float x) { const float u = 0.7978845608028654f * (x + 0.044715f * x * x * x); return x / (1.0f + __builtin_amdgcn_exp2f(-2.0f * LOG2E * u)); }
__device__ __forceinline__ float sigmoidf_(float x) { return 1.0f / (1.0f + __builtin_amdgcn_exp2f(-LOG2E * x)); }

__host__ __device__ __forceinline__ int z_phys(int c) {
    if (c < 512) { const int h = c >> 6, d = c & 63; return (h >> 2) * 256 + (d >> 5) * 128 + (h & 3) * 32 + (d & 31); }
    if (c < 768) { const int cc = c - 512, w = cc >> 6, d = cc & 63; return 512 + (d >> 5) * 128 + w * 32 + (d & 31); }
    return c;
}

#define LAS __attribute__((address_space(3)))
__device__ __forceinline__ void p0_transpose_item(const float* W, int K, int N, bf16_t* WT, int mode, int row_off, LAS float* scr, int item, int lane) {
    const int nblk = N / 32, kb = item / nblk, nb = item % nblk, k0 = 64 * kb, n0 = 32 * nb;
#pragma unroll 8
    for (int i = 0; i < 32; ++i) { const int kk = 2 * i + (lane >> 5); scr[kk * 33 + (lane & 31)] = W[(size_t)(k0 + kk) * N + n0 + (lane & 31)]; }
    __builtin_amdgcn_s_waitcnt(0xC07F); asm volatile("" ::: "memory");
    const int c = lane & 7;
#pragma unroll
    for (int j = 0; j < 4; ++j) { const int n = (lane >> 3) + 8 * j; const LAS float* s = scr + (8 * c) * 33 + n;
        u32x4 o; o.x = pk2(s[0 * 33], s[1 * 33]); o.y = pk2(s[2 * 33], s[3 * 33]); o.z = pk2(s[4 * 33], s[5 * 33]); o.w = pk2(s[6 * 33], s[7 * 33]);
        const int nl = n0 + n; int row;
        if (mode == 0) row = row_off + nl; else if (mode == 1) row = z_phys(nl); else if (mode == 2) row = 256 * (nl >> 7) + (nl & 127); else row = 256 * (nl >> 7) + 128 + (nl & 127);
        *(u32x4*)(WT + (size_t)row * K + k0 + 8 * c) = o; }
    __builtin_amdgcn_s_waitcnt(0xC07F); asm volatile("" ::: "memory");
}
struct PtrsIn { const float* in[27]; };
constexpr int IT_WIN = 16 * 120, IT_CKV = 16 * 32, IT_ATT = 8 * 32, IT_SGU = 8 * 32, IT_OUT = 16 * 32, IT_CQ = 16 * 16, IT_CO = 8 * 32, IT_G = 16 * 16, IT_DN = 8 * 32;
constexpr int IT_TOTAL = IT_WIN + IT_CKV + IT_ATT + IT_SGU + IT_OUT + IT_CQ + IT_CO + NE * (2 * IT_G + IT_DN);
__device__ __forceinline__ void p0_weight_item(const PtrsIn& P, unsigned char* ws, LAS float* scr, int it, int lane) {
    int r = it;
    bf16_t* WZ = (bf16_t*)(ws + WS_WZ);
    if (r < IT_WIN) { p0_transpose_item(P.in[3], 1024, NZ, WZ, 1, 0, scr, r, lane); return; } r -= IT_WIN;
    if (r < IT_CKV) { p0_transpose_item(P.in[16], 1024, 1024, WZ, 0, NZ, scr, r, lane); return; } r -= IT_CKV;
    if (r < IT_ATT) { p0_transpose_item(P.in[6], 512, 1024, (bf16_t*)(ws + WS_WATT), 0, 0, scr, r, lane); return; } r -= IT_ATT;
    if (r < IT_SGU) { p0_transpose_item(P.in[11], 512, 1024, (bf16_t*)(ws + WS_WSGU), 0, 0, scr, r, lane); return; } r -= IT_SGU;
    if (r < IT_OUT) { p0_transpose_item(P.in[12], 1024, 1024, (bf16_t*)(ws + WS_WOUT), 0, 0, scr, r, lane); return; } r -= IT_OUT;
    if (r < IT_CQ) { p0_transpose_item(P.in[15], 1024, 512, (bf16_t*)(ws + WS_WCQ), 0, 0, scr, r, lane); return; } r -= IT_CQ;
    if (r < IT_CO) { p0_transpose_item(P.in[17], 512, 1024, (bf16_t*)(ws + WS_WCO), 0, 0, scr, r, lane); return; } r -= IT_CO;
    const int per = 2 * IT_G + IT_DN, e = r / per; r -= e * per;
    if (r < IT_G) { p0_transpose_item(P.in[23] + (size_t)e * 1024 * 512, 1024, 512, (bf16_t*)(ws + WS_WGU) + (size_t)e * 1024 * 1024, 2, 0, scr, r, lane); return; } r -= IT_G;
    if (r < IT_G) { p0_transpose_item(P.in[24] + (size_t)e * 1024 * 512, 1024, 512, (bf16_t*)(ws + WS_WGU) + (size_t)e * 1024 * 1024, 3, 0, scr, r, lane); return; } r -= IT_G;
    p0_transpose_item(P.in[25] + (size_t)e * 512 * 1024, 512, 1024, (bf16_t*)(ws + WS_WD) + (size_t)e * 1024 * 512, 0, 0, scr, r, lane);
}
__device__ __forceinline__ void rms_row_to_bf16(const float* xrow, const float* g, bf16_t* orow, int lane) {
    const f32x4* xr = (const f32x4*)xrow + lane; const f32x4* gr = (const f32x4*)g + lane;
    f32x4 v[4]; float s = 0.f;
#pragma unroll
    for (int j = 0; j < 4; ++j) { v[j] = xr[64 * j]; s += (v[j].x * v[j].x + v[j].y * v[j].y) + (v[j].z * v[j].z + v[j].w * v[j].w); }
    const float rs = 1.0f / sqrtf(wave_sum(s) * (1.f / 1024.f) + EPS);
    unsigned long long* o8 = (unsigned long long*)orow + lane;
#pragma unroll
    for (int j = 0; j < 4; ++j) { const f32x4 gg = gr[64 * j]; o8[64 * j] = (unsigned long long)pk2(v[j].x * rs * gg.x, v[j].y * rs * gg.y) | ((unsigned long long)pk2(v[j].z * rs * gg.z, v[j].w * rs * gg.w) << 32); }
}
__device__ __forceinline__ void rope_table_entry(float* tab, int idx) {
    const int pos = idx >> 4, i = idx & 15;
    const float inv = (float)pow(10000.0, -(double)i / 16.0);
    const float ang = (float)pos * inv;
    const float c = (float)cos((double)ang), s = (float)sin((double)ang);
    tab[0 * 2048 + idx] = c; tab[1 * 2048 + idx] = s; tab[2 * 2048 + idx] = c; tab[3 * 2048 + idx] = s;
}

template <class RW> __device__ __forceinline__ void route_token(const float* xrow, const float* gmoe, RW rw, const float* b_rg, const float* b_re, bf16_t* orow, int lane, int& e0, int& e1, float& w0, float& w1) {
    const f32x4* xr = (const f32x4*)xrow + lane; const f32x4* gr = (const f32x4*)gmoe + lane;
    f32x4 v[4]; float s = 0.f;
#pragma unroll
    for (int j = 0; j < 4; ++j) { v[j] = xr[64 * j]; s += (v[j].x * v[j].x + v[j].y * v[j].y) + (v[j].z * v[j].z + v[j].w * v[j].w); }
    const float rs = 1.0f / sqrtf(wave_sum(s) * (1.f / 1024.f) + EPS);
    unsigned long long* o8 = (unsigned long long*)orow + lane;
#pragma unroll
    for (int j = 0; j < 4; ++j) { const f32x4 gg = gr[64 * j]; v[j].x *= rs * gg.x; v[j].y *= rs * gg.y; v[j].z *= rs * gg.z; v[j].w *= rs * gg.w;
        o8[64 * j] = (unsigned long long)pk2(v[j].x, v[j].y) | ((unsigned long long)pk2(v[j].z, v[j].w) << 32); }
    float lg[20];
#pragma unroll
    for (int o = 0; o < 20; ++o) { auto wr = rw + o * 1024 + 4 * lane; float a = 0.f;
#pragma unroll
        for (int j = 0; j < 4; ++j) { const float w0_ = wr[256 * j], w1_ = wr[256 * j + 1], w2_ = wr[256 * j + 2], w3_ = wr[256 * j + 3]; a += (v[j].x * w0_ + v[j].y * w1_) + (v[j].z * w2_ + v[j].w * w3_); }
        lg[o] = wave_sum(a); }
    float g0 = lg[0] + b_rg[0], g1 = lg[1] + b_rg[1], g2 = lg[2] + b_rg[2], g3 = lg[3] + b_rg[3];
    int gi = 0; float gm = g0; if (g1 > gm) { gm = g1; gi = 1; } if (g2 > gm) { gm = g2; gi = 2; } if (g3 > gm) { gm = g3; gi = 3; }
    const float gval = 1.0f / (expf(g0 - gm) + expf(g1 - gm) + expf(g2 - gm) + expf(g3 - gm));
    float ev[4];
#pragma unroll
    for (int j = 0; j < 4; ++j) { float t = 0.f;
#pragma unroll
        for (int g = 0; g < 4; ++g) t = (gi == g) ? (lg[4 + 4 * g + j] + b_re[4 * g + j]) : t;
        ev[j] = t; }
    int i0 = 0; float m0 = ev[0];
#pragma unroll
    for (int j = 1; j < 4; ++j) if (ev[j] > m0) { m0 = ev[j]; i0 = j; }
    int i1 = -1; float m1 = -INFINITY;
#pragma unroll
    for (int j = 0; j < 4; ++j) if (j != i0 && ev[j] > m1) { m1 = ev[j]; i1 = j; }
    const float p1 = expf(m1 - m0), den = 1.0f / (1.0f + p1);
    e0 = gi * 4 + i0; e1 = gi * 4 + i1; w0 = den * gval; w1 = p1 * den * gval;
}
__device__ __forceinline__ void final_row(float* orow, const bf16_t* ys2, const float* g, int lane) {
    f32x4* xr = (f32x4*)orow + lane; const f32x4* gr = (const f32x4*)g + lane;
    const u32x2* y0 = (const u32x2*)ys2 + lane; const u32x2* y1 = (const u32x2*)(ys2 + 1024) + lane;
    f32x4 v[4]; float s = 0.f;
#pragma unroll
    for (int j = 0; j < 4; ++j) { v[j] = xr[64 * j]; const u32x2 a = y0[64 * j], b = y1[64 * j];
        v[j].x += bf2f((bf16_t)(a.x & 0xffff)) + bf2f((bf16_t)(b.x & 0xffff)); v[j].y += bf2f((bf16_t)(a.x >> 16)) + bf2f((bf16_t)(b.x >> 16));
        v[j].z += bf2f((bf16_t)(a.y & 0xffff)) + bf2f((bf16_t)(b.y & 0xffff)); v[j].w += bf2f((bf16_t)(a.y >> 16)) + bf2f((bf16_t)(b.y >> 16));
        s += (v[j].x * v[j].x + v[j].y * v[j].y) + (v[j].z * v[j].z + v[j].w * v[j].w); }
    const float rs = 1.0f / sqrtf(wave_sum(s) * (1.f / 1024.f) + EPS);
#pragma unroll
    for (int j = 0; j < 4; ++j) { const f32x4 gg = gr[64 * j]; f32x4 o; o.x = v[j].x * rs * gg.x; o.y = v[j].y * rs * gg.y; o.z = v[j].z * rs * gg.z; o.w = v[j].w * rs * gg.w; xr[64 * j] = o; }
}

__global__ void __launch_bounds__(512) k_prologue(PtrsIn P, unsigned char* ws) {
    extern __shared__ __attribute__((aligned(16))) unsigned char dyn[];
    const int tid = threadIdx.x, lane = tid & 63, wave = tid >> 6;
    const int gw = blockIdx.x * 8 + wave, NGW = gridDim.x * 8;
    LAS float* scr = (LAS float*)dyn + wave * 64 * 33;
    for (int it = gw; it < IT_TOTAL; it += NGW) p0_weight_item(P, ws, scr, it, lane);
    { const float* wsrc = P.in[9]; bf16_t* wd = (bf16_t*)(ws + WS_WSS);
      for (int i = blockIdx.x * 512 + tid; i < 4 * 128 * 128; i += gridDim.x * 512) wd[i] = (bf16_t)f2bf(wsrc[i]); }
    for (int i = blockIdx.x * 512 + tid; i < 2048; i += gridDim.x * 512) rope_table_entry((float*)(ws + WS_TAB), i);
    bf16_t* XN = (bf16_t*)(ws + WS_XN);
    for (int m = gw; m < M; m += NGW) rms_row_to_bf16(P.in[0] + (size_t)m * D, P.in[2], XN + (size_t)m * D, lane);
    for (int m = gw; m < MMEM; m += NGW) rms_row_to_bf16(P.in[1] + (size_t)m * D, P.in[14], XN + (size_t)(M + m) * D, lane);
}
__global__ void __launch_bounds__(512) k_norm_rows(const float* x, const float* g, bf16_t* o, int rows) {
    const int lane = threadIdx.x & 63, gw = blockIdx.x * 8 + (threadIdx.x >> 6), NGW = gridDim.x * 8;
    for (int m = gw; m < rows; m += NGW) rms_row_to_bf16(x + (size_t)m * D, g, o + (size_t)m * D, lane);
}
__global__ void __launch_bounds__(512) k_route(PtrsIn P, const float* x2, unsigned char* ws) {
    extern __shared__ __attribute__((aligned(16))) unsigned char dyn[];
    float* rw = (float*)dyn;
    int* te = (int*)(dyn + 20 * 1024 * 4);
    float* tw = (float*)(te + 256);
    int* tp = (int*)(tw + 256);
    int* ebase = tp + 256;
    const int tid = threadIdx.x, lane = tid & 63, wave = tid >> 6;
    for (int i = tid; i < 1024 * 4; i += 512) { const int k = i >> 2, o = i & 3; rw[o * 1024 + k] = P.in[19][i]; }
    for (int i = tid; i < 1024 * 16; i += 512) { const int k = i >> 4, o = i & 15; rw[(4 + o) * 1024 + k] = P.in[21][i]; }
    __syncthreads();
    bf16_t* XN3 = (bf16_t*)(ws + WS_XN3);
    const int t0 = blockIdx.x * 128;
    for (int i = 0; i < 16; ++i) { const int tl = wave * 16 + i, t = t0 + tl; int e0, e1; float w0, w1;
        route_token(x2 + (size_t)t * D, P.in[18], rw, P.in[20], P.in[22], XN3 + (size_t)t * D, lane, e0, e1, w0, w1);
        if (lane == 0) { te[2 * tl] = e0; te[2 * tl + 1] = e1; tw[2 * tl] = w0; tw[2 * tl + 1] = w1; } }
    __syncthreads();
    if (wave == 0) {
        int cnt = 0;
        int mye[4]; for (int j = 0; j < 4; ++j) mye[j] = te[j * 64 + lane];
        int pos[4] = {0, 0, 0, 0};
        for (int e = 0; e < 16; ++e) { int run = 0;
            for (int j = 0; j < 4; ++j) { const unsigned long long mk = __ballot(mye[j] == e); const int before = __popcll(mk & ((1ull << lane) - 1ull));
                if (mye[j] == e) pos[j] = run + before; run += __popcll(mk); }
            if (lane == e) cnt = run; }
        for (int j = 0; j < 4; ++j) tp[j * 64 + lane] = pos[j];
        if (lane < 16) { unsigned* ec = (unsigned*)(ws + WS_CTL) + CW_ECNT + 64 * lane; ebase[lane] = (int)atomicAdd(ec, (unsigned)cnt); }
    }
    __syncthreads();
    if (tid < 256) { const int e = te[tid], slot = ebase[e] + tp[tid], dest = (t0 * 2) + tid; const float w = tw[tid];
        int* lst = (int*)(ws + WS_LIST) + ((size_t)e * LIST_CAP + slot) * 2; lst[0] = dest; lst[1] = __float_as_int(w);
        int* ti = (int*)(ws + WS_TOKINFO) + (size_t)dest * 2; ti[0] = e; ti[1] = __float_as_int(w); }
}
__global__ void __launch_bounds__(512) k_final(float* out, const bf16_t* ys, const float* g) {
    const int lane = threadIdx.x & 63, gw = blockIdx.x * 8 + (threadIdx.x >> 6), NGW = gridDim.x * 8;
    for (int m = gw; m < M; m += NGW) final_row(out + (size_t)m * D, ys + (size_t)m * 2048, g, lane);
}

__global__ void __launch_bounds__(256) nv_gemm(const bf16_t* A, int lda, const bf16_t* Bt, int ldb, int K, float* C, int ldc) {
    __shared__ __attribute__((aligned(16))) float As[16][68], Bs[16][68];
    const int tid = threadIdx.x, tx = tid & 15, ty = tid >> 4, r0 = blockIdx.y * 64, n0 = blockIdx.x * 64, lr = tid >> 2, lk = (tid & 3) * 4;
    float acc[4][4];
#pragma unroll
    for (int i = 0; i < 4; ++i)
#pragma unroll
        for (int j = 0; j < 4; ++j) acc[i][j] = 0.f;
    for (int k0 = 0; k0 < K; k0 += 16) {
        const u32x2 av = *(const u32x2*)(A + (size_t)(r0 + lr) * lda + k0 + lk), bv = *(const u32x2*)(Bt + (size_t)(n0 + lr) * ldb + k0 + lk);
        As[lk + 0][lr] = bf2f((bf16_t)(av.x & 0xffff)); As[lk + 1][lr] = bf2f((bf16_t)(av.x >> 16)); As[lk + 2][lr] = bf2f((bf16_t)(av.y & 0xffff)); As[lk + 3][lr] = bf2f((bf16_t)(av.y >> 16));
        Bs[lk + 0][lr] = bf2f((bf16_t)(bv.x & 0xffff)); Bs[lk + 1][lr] = bf2f((bf16_t)(bv.x >> 16)); Bs[lk + 2][lr] = bf2f((bf16_t)(bv.y & 0xffff)); Bs[lk + 3][lr] = bf2f((bf16_t)(bv.y >> 16));
        __syncthreads();
#pragma unroll
        for (int kk = 0; kk < 16; ++kk) { const f32x4 a = *(const f32x4*)&As[kk][ty * 4], b = *(const f32x4*)&Bs[kk][tx * 4];
#pragma unroll
            for (int i = 0; i < 4; ++i)
#pragma unroll
                for (int j = 0; j < 4; ++j) acc[i][j] += a[i] * b[j]; }
        __syncthreads();
    }
#pragma unroll
    for (int i = 0; i < 4; ++i) { f32x4 o = {acc[i][0], acc[i][1], acc[i][2], acc[i][3]}; *(f32x4*)(C + (size_t)(r0 + ty * 4 + i) * ldc + n0 + tx * 4) = o; }
}
__global__ void __launch_bounds__(256) nv_z_epi(const float* Cz, int row0, PtrsIn P, unsigned char* ws) {
    const int tid = threadIdx.x, lane = tid & 63, wave = tid >> 6;
    const int rl = blockIdx.x, row = row0 + rl, t = row % SEQ, rid = t >> 6, cid = t & 63;
    const float* z = Cz + (size_t)rl * NZ; const float* tab = (const float*)(ws + WS_TAB);
    if (wave == 0) {
        for (int hh = 0; hh < 10; ++hh) {
            const int c = (hh < 8) ? hh * 64 + lane : 512 + (hh - 8) * 64 + lane;
            const float v = z[z_phys(c)]; const float ss = wave_sum(v * v); const float rs = 1.0f / sqrtf(ss * (1.f / 64.f) + EPS);
            const float g = (hh < 8) ? P.in[4][lane] : P.in[5][lane];
            const float y = v * rs * g, yp = __shfl_xor(y, 1);
            const int i = lane >> 1; const float cs = (i < 16) ? tab[0 * 2048 + rid * 16 + i] : tab[2 * 2048 + cid * 16 + (i - 16)], sn = (i < 16) ? tab[1 * 2048 + rid * 16 + i] : tab[3 * 2048 + cid * 16 + (i - 16)];
            const float o = (lane & 1) ? (yp * sn + y * cs) : (y * cs - yp * sn);
            if (hh < 8) ((bf16_t*)(ws + WS_Q))[(size_t)row * 512 + hh * 64 + lane] = (bf16_t)f2bf(o * C2_SELF);
            else ((bf16_t*)(ws + WS_K))[(size_t)row * 128 + (hh - 8) * 64 + lane] = (bf16_t)f2bf(o);
        }
        for (int c = lane; c < 128; c += 64) ((bf16_t*)(ws + WS_V))[(size_t)row * 128 + c] = (bf16_t)f2bf(z[z_phys(ZV + c)]);
    } else {
        for (int c = tid - 64; c < 512; c += 192) { ((bf16_t*)(ws + WS_U))[(size_t)row * 512 + c] = (bf16_t)f2bf(gelu_tanh(z[ZSU + c])); ((bf16_t*)(ws + WS_GV))[(size_t)row * 512 + c] = (bf16_t)f2bf(gelu_tanh(z[ZSV + c])); }
        for (int c = tid - 64; c < 1024; c += 192) { ((bf16_t*)(ws + WS_GA))[(size_t)row * 1024 + c] = (bf16_t)f2bf(sigmoidf_(z[ZGA + c])); ((bf16_t*)(ws + WS_GB))[(size_t)row * 1024 + c] = (bf16_t)f2bf(sigmoidf_(z[ZGB + c])); }
    }
}
__global__ void __launch_bounds__(256) nv_store_bf16(const float* C, bf16_t* O, size_t n, float scale) {
    for (size_t i = (size_t)blockIdx.x * 256 + threadIdx.x; i < n; i += (size_t)gridDim.x * 256) O[i] = (bf16_t)f2bf(C[i] * scale);
}
__global__ void __launch_bounds__(256) nv_attn(const bf16_t* Q, const bf16_t* Kb, const bf16_t* Vb, bf16_t* O) {
    extern __shared__ __attribute__((aligned(16))) unsigned char dyn[];
    float (*Qs)[65] = (float (*)[65])dyn; float (*Ks)[65] = Qs + 64; float (*Vs)[65] = Ks + 64; float (*Ps)[65] = Vs + 64;
    const int tid = threadIdx.x, tx = tid & 15, ty = tid >> 4, qb = blockIdx.x, h = blockIdx.y, b = blockIdx.z, kvh = h >> 2;
    const int lr = tid >> 2, lc = (tid & 3) * 16;
    { const bf16_t* src = Q + ((size_t)(b * SEQ + qb * 64 + lr)) * 512 + h * 64 + lc;
      for (int j = 0; j < 16; ++j) Qs[lr][lc + j] = bf2f(src[j]); }
    float m[4], l[4], o[4][4];
    for (int i = 0; i < 4; ++i) { m[i] = -1e30f; l[i] = 0.f; for (int j = 0; j < 4; ++j) o[i][j] = 0.f; }
    for (int kt = 0; kt < SEQ / 64; ++kt) {
        __syncthreads();
        { const bf16_t* ks = Kb + ((size_t)(b * SEQ + kt * 64 + lr)) * 128 + kvh * 64 + lc; const bf16_t* vs = Vb + ((size_t)(b * SEQ + kt * 64 + lr)) * 128 + kvh * 64 + lc;
          for (int j = 0; j < 16; ++j) { Ks[lr][lc + j] = bf2f(ks[j]); Vs[lr][lc + j] = bf2f(vs[j]); } }
        __syncthreads();
        float s[4][4];
        for (int i = 0; i < 4; ++i) for (int j = 0; j < 4; ++j) s[i][j] = 0.f;
        for (int d = 0; d < 64; ++d) { float a[4], bb[4];
            for (int i = 0; i < 4; ++i) { a[i] = Qs[ty * 4 + i][d]; bb[i] = Ks[tx * 4 + i][d]; }
            for (int i = 0; i < 4; ++i) for (int j = 0; j < 4; ++j) s[i][j] += a[i] * bb[j]; }
        for (int i = 0; i < 4; ++i) {
            float rm = fmaxf(fmaxf(s[i][0], s[i][1]), fmaxf(s[i][2], s[i][3]));
            for (int x = 1; x < 16; x <<= 1) rm = fmaxf(rm, __shfl_xor(rm, x));
            const float mn = fmaxf(m[i], rm), al = __builtin_amdgcn_exp2f(m[i] - mn);
            float rsum = 0.f;
            for (int j = 0; j < 4; ++j) { const float p = __builtin_amdgcn_exp2f(s[i][j] - mn); Ps[ty * 4 + i][tx * 4 + j] = p; rsum += p; }
            for (int x = 1; x < 16; x <<= 1) rsum += __shfl_xor(rsum, x);
            l[i] = l[i] * al + rsum; m[i] = mn;
            for (int j = 0; j < 4; ++j) o[i][j] *= al;
        }
        __syncthreads();
        for (int c = 0; c < 64; ++c) { float p[4], v[4];
            for (int i = 0; i < 4; ++i) { p[i] = Ps[ty * 4 + i][c]; v[i] = Vs[c][tx * 4 + i]; }
            for (int i = 0; i < 4; ++i) for (int j = 0; j < 4; ++j) o[i][j] += p[i] * v[j]; }
    }
    for (int i = 0; i < 4; ++i) { const float il = 1.0f / l[i]; bf16_t* dst = O + ((size_t)(b * SEQ + qb * 64 + ty * 4 + i)) * 512 + h * 64 + tx * 4;
        for (int j = 0; j < 4; ++j) dst[j] = (bf16_t)f2bf(o[i][j] * il); }
}
__global__ void __launch_bounds__(256) nv_sgu(PtrsIn P, unsigned char* ws) {
    extern __shared__ __attribute__((aligned(16))) unsigned char dyn[];
    float* vn = (float*)dyn;
    float* mu = vn + 128 * 129; float* rstd = mu + 128;
    const int tid = threadIdx.x, lane = tid & 63, wave = tid >> 6, ch = blockIdx.x, g = blockIdx.y;
    const bf16_t* GV = (const bf16_t*)(ws + WS_GV) + (size_t)ch * 128 * 512;
    for (int r = wave * 32; r < wave * 32 + 32; ++r) { float s = 0.f;
        float xv[8]; for (int j = 0; j < 8; ++j) { xv[j] = bf2f(GV[(size_t)r * 512 + j * 64 + lane]); s += xv[j]; }
        const float mean = wave_sum(s) * (1.f / 512.f); float q = 0.f;
        for (int j = 0; j < 8; ++j) { const float d = xv[j] - mean; q += d * d; }
        const float var = wave_sum(q) * (1.f / 512.f);
        if (lane == 0) { mu[r] = mean; rstd[r] = 1.0f / sqrtf(var + EPS); } }
    __syncthreads();
    for (int i = tid; i < 128 * 128; i += 256) { const int q = i >> 7, c = i & 127, cg = g * 128 + c;
        vn[q * 129 + c] = (bf2f(GV[(size_t)q * 512 + cg]) - mu[q]) * rstd[q] * P.in[7][cg] + P.in[8][cg]; }
    __syncthreads();
    const bf16_t* W = (const bf16_t*)(ws + WS_WSS) + (size_t)g * 128 * 128;
    const bf16_t* U = (const bf16_t*)(ws + WS_U) + (size_t)ch * 128 * 512; bf16_t* SG = (bf16_t*)(ws + WS_SG) + (size_t)ch * 128 * 512;
    const int c = tid & 127;
    for (int p = tid >> 7; p < 128; p += 2) { float a = 0.f;
        for (int q = 0; q < 128; ++q) a += bf2f(W[p * 128 + q]) * vn[q * 129 + c];
        a += P.in[10][g * 128 + p];
        SG[(size_t)p * 512 + g * 128 + c] = (bf16_t)f2bf(bf2f(U[(size_t)p * 512 + g * 128 + c]) * a); }
}
__global__ void __launch_bounds__(256) nv_merge(const float* C1, const float* C2, const bf16_t* GA, const bf16_t* GB, bf16_t* Mg, size_t n) {
    for (size_t i = (size_t)blockIdx.x * 256 + threadIdx.x; i < n; i += (size_t)gridDim.x * 256) Mg[i] = (bf16_t)f2bf(bf2f(GA[i]) * C1[i] + bf2f(GB[i]) * C2[i]);
}
__global__ void __launch_bounds__(256) nv_resid(const float* base, const float* C, float* out, size_t n) {
    for (size_t i = (size_t)blockIdx.x * 256 + threadIdx.x; i < n; i += (size_t)gridDim.x * 256) out[i] = base[i] + C[i];
}
__global__ void __launch_bounds__(256) nv_cross(const bf16_t* QC, const bf16_t* KVC, bf16_t* OC) {
    __shared__ float qs[512]; __shared__ float ps[4][256];
    const int tid = threadIdx.x, lane = tid & 63, h = tid >> 6, tok = blockIdx.x, b = tok / SEQ;
    for (int i = tid; i < 512; i += 256) qs[i] = bf2f(QC[(size_t)tok * 512 + i]);
    __syncthreads();
    float sc[4]; float mx = -1e30f;
    for (int j = 0; j < 4; ++j) { const int mrow = b * NMEM + j * 64 + lane; const bf16_t* kr = KVC + (size_t)mrow * 1024 + h * 128; float a = 0.f;
        for (int d = 0; d < 128; ++d) a += qs[h * 128 + d] * bf2f(kr[d]);
        sc[j] = a; mx = fmaxf(mx, a); }
    mx = wave_max(mx); float sum = 0.f;
    for (int j = 0; j < 4; ++j) { const float p = __builtin_amdgcn_exp2f(sc[j] - mx); ps[h][j * 64 + lane] = p; sum += p; }
    sum = wave_sum(sum);
    __syncthreads();
    for (int dd = 0; dd < 2; ++dd) { const int d = dd * 64 + lane; float a = 0.f;
        for (int mm = 0; mm < 256; ++mm) a += ps[h][mm] * bf2f(KVC[(size_t)(b * NMEM + mm) * 1024 + 512 + h * 128 + d]);
        OC[(size_t)tok * 512 + h * 128 + d] = (bf16_t)f2bf(a / sum); }
}
__global__ void __launch_bounds__(256) nv_moe_a(const bf16_t* XN3, unsigned char* ws) {
    __shared__ float xs[1024];
    const int tid = threadIdx.x, dest = blockIdx.x, tok = dest >> 1;
    const int e = ((const int*)(ws + WS_TOKINFO))[(size_t)dest * 2];
    for (int i = tid; i < 1024; i += 256) xs[i] = bf2f(XN3[(size_t)tok * 1024 + i]);
    __syncthreads();
    const bf16_t* W = (const bf16_t*)(ws + WS_WGU) + (size_t)e * 1024 * 1024; bf16_t* Hh = (bf16_t*)(ws + WS_H) + (size_t)dest * 512;
    for (int n = tid; n < 512; n += 256) { const bf16_t* wg = W + (size_t)(256 * (n >> 7) + (n & 127)) * 1024; const bf16_t* wu = wg + 128 * 1024; float a = 0.f, b = 0.f;
        for (int k = 0; k < 1024; k += 8) { const u32x4 g4 = *(const u32x4*)(wg + k), u4 = *(const u32x4*)(wu + k);
            const unsigned gg[4] = {g4.x, g4.y, g4.z, g4.w}, uu[4] = {u4.x, u4.y, u4.z, u4.w};
            for (int j = 0; j < 4; ++j) { a += xs[k + 2 * j] * bf2f((bf16_t)(gg[j] & 0xffff)) + xs[k + 2 * j + 1] * bf2f((bf16_t)(gg[j] >> 16)); b += xs[k + 2 * j] * bf2f((bf16_t)(uu[j] & 0xffff)) + xs[k + 2 * j + 1] * bf2f((bf16_t)(uu[j] >> 16)); } }
        Hh[n] = (bf16_t)f2bf(a * sigmoidf_(a) * b); }
}
__global__ void __launch_bounds__(256) nv_moe_b(unsigned char* ws) {
    __shared__ float hs[512];
    const int tid = threadIdx.x, dest = blockIdx.x;
    const int* ti = (const int*)(ws + WS_TOKINFO) + (size_t)dest * 2; const int e = ti[0]; const float w = __int_as_float(ti[1]);
    const bf16_t* Hh = (const bf16_t*)(ws + WS_H) + (size_t)dest * 512;
    for (int i = tid; i < 512; i += 256) hs[i] = bf2f(Hh[i]);
    __syncthreads();
    const bf16_t* W = (const bf16_t*)(ws + WS_WD) + (size_t)e * 1024 * 512; bf16_t* Y = (bf16_t*)(ws + WS_YS) + (size_t)dest * 1024;
    for (int n = tid; n < 1024; n += 256) { const bf16_t* wr = W + (size_t)n * 512; float a = 0.f;
        for (int k = 0; k < 512; k += 8) { const u32x4 g4 = *(const u32x4*)(wr + k); const unsigned gg[4] = {g4.x, g4.y, g4.z, g4.w};
            for (int j = 0; j < 4; ++j) a += hs[k + 2 * j] * bf2f((bf16_t)(gg[j] & 0xffff)) + hs[k + 2 * j + 1] * bf2f((bf16_t)(gg[j] >> 16)); }
        Y[n] = (bf16_t)f2bf(a * w); }
}

namespace pg8 {
typedef short bf16x8 __attribute__((ext_vector_type(8)));
constexpr int BM = 256, BK = 64, HALF = 128, HTB = HALF * BK * 2, STAGE_BYTES = 8 * HTB, NXCD = 8, WGM = 8;
__host__ __device__ __forceinline__ int lds_byte(int r, int c) { const int st = (r >> 4) * 2 + (c >> 5), rr = r & 15, cc = c & 31, ob = rr * 64 + cc * 2; return st * 1024 + (ob ^ (((ob >> 9) & 1) << 5)); }
__host__ __device__ __forceinline__ void stage_rc(int b, int& R, int& C) { const int st = b / 1024, sb = b % 1024, swz = sb ^ (((sb >> 9) & 1) << 5); R = (st >> 1) * 16 + swz / 64; C = (st & 1) * 32 + (swz % 64) / 2; }
__host__ __device__ __forceinline__ int perm32(int rho) { const int n = rho >> 4, i = rho & 15; return 8 * (i >> 2) + 4 * n + (i & 3); }
struct Unit { int pm, pn, kind; };
__device__ __forceinline__ void tile_of(int L, int nM, int nN, int& pm, int& pn) {
    const int nwg = nM * nN; int wgid = L; { const int q = nwg / NXCD, r = nwg % NXCD, xcd = wgid % NXCD, off = wgid / NXCD; wgid = (xcd < r ? xcd * (q + 1) : r * (q + 1) + (xcd - r) * q) + off; }
    const int nig = WGM * nN, gid = wgid / nig, fm = gid * WGM, gsz = (nM - fm) < WGM ? (nM - fm) : WGM;
    pm = fm + ((wgid % nig) % gsz); pn = (wgid % nig) / gsz;
}
__device__ __forceinline__ unsigned cvt_pk_bf16(float lo, float hi) { unsigned r; asm volatile("v_cvt_pk_bf16_f32 %0, %1, %2" : "=v"(r) : "v"(lo), "v"(hi)); return r; }

template <class Epi, class Sched, bool ALIGN_EPI, bool GATHER>
__device__ __forceinline__ void gemm_phase(LAS unsigned char* lds, const int K, const Sched& S, const Epi& E) {
    const int tid = threadIdx.x, wid = __builtin_amdgcn_readfirstlane(tid >> 6), lane = tid & 63, wr = wid >> 2, wc = wid & 3, fr = lane & 15, fq = lane >> 4;
    const int nt = K / BK;
    unsigned voffA[2], voffB[2]; int RA[2], CA2[2];
#pragma unroll
    for (int i = 0; i < 2; ++i) { int R, C; stage_rc(tid * 16 + i * 8192, R, C); const int Rb = Epi::PERM ? ((R & ~31) + perm32(R & 31)) : R;
        voffA[i] = (unsigned)(R * K + C) * 2u; voffB[i] = (unsigned)(Rb * K + C) * 2u; RA[i] = R; CA2[i] = C * 2; }
    const size_t kstep = (size_t)(BK * 2);
    const size_t hstep = (size_t)HALF * K * 2;
    const unsigned ldsw = (unsigned)wid * 1024u;
    const int aoff = lds_byte(wr * 64 + fr, fq * 8), boff = lds_byte(wc * 32 + fr, fq * 8);
    unsigned vA[2][2] = {{0u, 0u}, {0u, 0u}}, vN[2][2] = {{0u, 0u}, {0u, 0u}};
#define PG8_SA(b, h) (((b) * 2 + (h)) * HTB)
#define PG8_SB(b, h) ((4 + (b) * 2 + (h)) * HTB)
#define PG8_STAGE(bufoff, gbase, voff) do { _Pragma("unroll") for (int _i = 0; _i < 2; ++_i) \
        __builtin_amdgcn_global_load_lds((const unsigned*)((const char*)(gbase) + (voff)[_i]), (LAS unsigned*)(lds + (bufoff) + ldsw + _i * 8192), 16, 0, 0); } while (0)
#define PG8_STAGEA(bufoff, gbase, h, nx) do { _Pragma("unroll") for (int _i = 0; _i < 2; ++_i) { \
        const unsigned _o = GATHER ? ((nx) ? vN[h][_i] : vA[h][_i]) : voffA[_i]; \
        __builtin_amdgcn_global_load_lds((const unsigned*)((const char*)(gbase) + (GATHER ? (size_t)0 : (size_t)(h) * hstep) + _o), (LAS unsigned*)(lds + (bufoff) + ldsw + _i * 8192), 16, 0, 0); } } while (0)
#define PG8_LDA(dst, b, h) do { _Pragma("unroll") for (int m = 0; m < 4; ++m) _Pragma("unroll") for (int k = 0; k < 2; ++k) dst[m][k] = *(const LAS bf16x8*)(lds + PG8_SA(b, h) + aoff + m * 2048 + k * 1024); } while (0)
#define PG8_LDB(dst, b, h) do { _Pragma("unroll") for (int n = 0; n < 2; ++n) _Pragma("unroll") for (int k = 0; k < 2; ++k) dst[n][k] = *(const LAS bf16x8*)(lds + PG8_SB(b, h) + boff + n * 2048 + k * 1024); } while (0)
#define PG8_MMA(ai, bj, At, Bt) do { __builtin_amdgcn_s_setprio(1); _Pragma("unroll") for (int m = 0; m < 4; ++m) _Pragma("unroll") for (int n = 0; n < 2; ++n) _Pragma("unroll") for (int k = 0; k < 2; ++k) \
        acc[ai][bj][m][n] = __builtin_amdgcn_mfma_f32_16x16x32_bf16(Bt[n][k], At[m][k], acc[ai][bj][m][n], 0, 0, 0); __builtin_amdgcn_s_setprio(0); } while (0)
#define PG8_WAIT_V(n) asm volatile("s_waitcnt vmcnt(" #n ")" ::: "memory")
#define PG8_WAIT_L(n) asm volatile("s_waitcnt lgkmcnt(" #n ")" ::: "memory")
#define PG8_BAR __builtin_amdgcn_s_barrier()
#define PG8_SCHED __builtin_amdgcn_sched_barrier(0)
#define PG8_GOFF(dst, ui_) do { if (GATHER) { _Pragma("unroll") for (int _h = 0; _h < 2; ++_h) _Pragma("unroll") for (int _i = 0; _i < 2; ++_i) dst[_h][_i] = S.goff((ui_), _h * HALF + RA[_i]) + (unsigned)CA2[_i]; } } while (0)
    Unit cur, nxt; int ui = 0;
    if (!S.next(0, cur)) return;
    f32x4 acc[2][2][4][2];
#pragma unroll
    for (int a = 0; a < 2; ++a)
#pragma unroll
        for (int b = 0; b < 2; ++b)
#pragma unroll
            for (int m = 0; m < 4; ++m)
#pragma unroll
                for (int n = 0; n < 2; ++n) acc[a][b][m][n] = (f32x4){0.f, 0.f, 0.f, 0.f};
    bf16x8 At[4][2], B0[2][2], B1[2][2];
    const char* cA = S.a_ptr(cur); const char* cB = S.b_ptr(cur);
    PG8_GOFF(vA, 0);
    PG8_STAGE(PG8_SB(0, 0), cB, voffB); PG8_STAGE(PG8_SB(0, 1), cB + hstep, voffB); PG8_STAGEA(PG8_SA(0, 0), cA, 0, false); PG8_STAGEA(PG8_SA(0, 1), cA, 1, false);
    if (wr == 1) PG8_BAR;
    PG8_WAIT_V(2); PG8_BAR;
    PG8_STAGE(PG8_SB(1, 0), cB + kstep, voffB); PG8_STAGEA(PG8_SA(1, 0), cA + kstep, 0, false); PG8_STAGE(PG8_SB(1, 1), cB + hstep + kstep, voffB);
    PG8_WAIT_V(6); PG8_BAR;
    for (;;) {
        const bool has_next = S.next(ui + 1, nxt);
        const char* nA = has_next ? S.a_ptr(nxt) : cA; const char* nB = has_next ? S.b_ptr(nxt) : cB;
        for (int t = 0; t < nt; t += 2) {
            const bool last = (t == nt - 2);
            const char* a1 = cA + (size_t)(t + 1) * kstep;
            const char* a2 = last ? nA : cA + (size_t)(t + 2) * kstep; const char* b2 = last ? nB : cB + (size_t)(t + 2) * kstep;
            const char* a3 = a2 + kstep; const char* b3 = b2 + kstep;
            if (GATHER && last) { if (has_next) { PG8_GOFF(vN, ui + 1); } else {
#pragma unroll
                for (int _h = 0; _h < 2; ++_h)
#pragma unroll
                    for (int _i = 0; _i < 2; ++_i) vN[_h][_i] = vA[_h][_i]; } }
            PG8_LDB(B0, 0, 0); PG8_LDB(B1, 0, 1); PG8_SCHED; PG8_LDA(At, 0, 0); PG8_STAGEA(PG8_SA(1, 1), a1, 1, false);
            PG8_WAIT_V(8); PG8_WAIT_L(0); PG8_BAR; PG8_MMA(0, 0, At, B0); PG8_MMA(0, 1, At, B1); PG8_BAR; PG8_SCHED;
            PG8_LDA(At, 0, 1); PG8_STAGE(PG8_SB(0, 0), b2, voffB); PG8_STAGE(PG8_SB(0, 1), b2 + hstep, voffB); PG8_STAGEA(PG8_SA(0, 0), a2, 0, last);
            PG8_WAIT_V(8); PG8_WAIT_L(0); PG8_BAR; PG8_MMA(1, 0, At, B0); PG8_MMA(1, 1, At, B1); PG8_BAR; PG8_SCHED;
            PG8_LDB(B0, 1, 0); PG8_LDB(B1, 1, 1); PG8_SCHED; PG8_LDA(At, 1, 0); PG8_STAGEA(PG8_SA(0, 1), a2, 1, last);
            PG8_WAIT_V(8); PG8_WAIT_L(0); PG8_BAR; PG8_MMA(0, 0, At, B0); PG8_MMA(0, 1, At, B1); PG8_BAR; PG8_SCHED;
            PG8_LDA(At, 1, 1); PG8_STAGE(PG8_SB(1, 0), b3, voffB); PG8_STAGE(PG8_SB(1, 1), b3 + hstep, voffB); PG8_STAGEA(PG8_SA(1, 0), a3, 0, last);
            PG8_WAIT_V(8); PG8_WAIT_L(0); PG8_BAR; PG8_MMA(1, 0, At, B0); PG8_MMA(1, 1, At, B1); PG8_BAR; PG8_SCHED;
        }
        if constexpr (ALIGN_EPI) { if (wr == 0) PG8_BAR; }
        E(acc, cur, ui, wr, wc, fr, fq);
        if (!has_next) break;
#pragma unroll
        for (int a = 0; a < 2; ++a)
#pragma unroll
            for (int b = 0; b < 2; ++b)
#pragma unroll
                for (int m = 0; m < 4; ++m)
#pragma unroll
                    for (int n = 0; n < 2; ++n) acc[a][b][m][n] = (f32x4){0.f, 0.f, 0.f, 0.f};
        cur = nxt; cA = nA; cB = nB; ++ui;
        if (GATHER) {
#pragma unroll
            for (int _h = 0; _h < 2; ++_h)
#pragma unroll
                for (int _i = 0; _i < 2; ++_i) vA[_h][_i] = vN[_h][_i]; }
        if constexpr (ALIGN_EPI) { if (wr == 1) PG8_BAR; }
    }
    PG8_WAIT_V(0);
    if constexpr (!ALIGN_EPI) { if (wr == 0) PG8_BAR; }
    PG8_BAR;
#undef PG8_SA
#undef PG8_SB
#undef PG8_STAGE
#undef PG8_STAGEA
#undef PG8_LDA
#undef PG8_LDB
#undef PG8_MMA
#undef PG8_WAIT_V
#undef PG8_WAIT_L
#undef PG8_BAR
#undef PG8_SCHED
#undef PG8_GOFF
}
}
namespace attn_body {
using bf16=unsigned short;
using bf16x8=__attribute__((ext_vector_type(8)))short;
using s16x4=__attribute__((ext_vector_type(4)))short;
using f32x16=__attribute__((ext_vector_type(16)))float;
constexpr int SEQA=8192,D=64,QP=512,KP=128;
constexpr int NW=8,QBLK=32,QB=QBLK*NW,KVBLK=64,NQB=SEQA/QB;
__device__ __forceinline__ int crow(int r,int hi){return (r&3)+8*(r>>2)+4*hi;}
#define SBAR() __builtin_amdgcn_sched_barrier(0)
__device__ __forceinline__ void cmask(f32x16&p0,f32x16&p1,int jb,int qrel,int hi){
  const float NEG=-INFINITY; int kb=64*jb+4*hi;
  #pragma unroll
  for(int r=0;r<16;++r){int kv=kb+(r&3)+8*(r>>2); if(kv>qrel)p0[r]=NEG; if(kv+32>qrel)p1[r]=NEG;}
}

constexpr int NSLOT=3, SLOTB=8192;
constexpr int LDS_K=0, LDS_V=NSLOT*SLOTB, LDS_WS=2*NSLOT*SLOTB, LDS_OST=LDS_WS+NW*64*4, LDS_BYTES=LDS_OST+NW*4096;
constexpr float C2=0.125f*1.4426950408889634f;
__device__ __forceinline__ void glds16(const void*gsrc,unsigned lds_dst){unsigned keep;
  asm volatile("s_mov_b32 %0, m0\n\ts_mov_b32 m0, %2\n\ts_nop 0\n\tglobal_load_lds_dwordx4 %1, off\n\ts_mov_b32 m0, %0":"=&s"(keep):"v"(gsrc),"s"(lds_dst):"memory");}
__device__ __forceinline__ float max3f(float a,float b,float c){float r;asm("v_max3_f32 %0, %1, %2, %3":"=v"(r):"v"(a),"v"(b),"v"(c));return r;}
__device__ __forceinline__ float max2f(float a,float b){float r;asm("v_max_f32_e32 %0, %1, %2":"=v"(r):"v"(a),"v"(b));return r;}
__device__ __forceinline__ float fadd_s(float a,float b){float r;asm("v_add_f32_e32 %0, %1, %2":"=v"(r):"v"(a),"v"(b));return r;}
__device__ __forceinline__ float fsub_s(float a,float b){float r;asm("v_sub_f32_e32 %0, %1, %2":"=v"(r):"v"(a),"v"(b));return r;}
typedef float f32x2_t __attribute__((ext_vector_type(2))); typedef __bf16 bf16x2_t __attribute__((ext_vector_type(2)));
__device__ __forceinline__ unsigned cvtpk_s(float lo,float hi){f32x2_t v={lo,hi};bf16x2_t b=__builtin_convertvector(v,bf16x2_t);return __builtin_bit_cast(unsigned,b);}
#define WAIT_BAR(N) asm volatile("s_waitcnt vmcnt(" #N ") lgkmcnt(0)\n\ts_barrier":::"memory")

__device__ __forceinline__ void qkt(f32x16&p0,f32x16&p1,const char*Kslot,const bf16x8*qr,const f32x16&negm,int r32,int hi){
  const char*kb=Kslot+hi*1024+r32*16;
  #pragma unroll
  for(int d0=0;d0<4;++d0){
    const bf16x8 b0=*reinterpret_cast<const bf16x8*>(kb+d0*2048);
    const bf16x8 b1=*reinterpret_cast<const bf16x8*>(kb+d0*2048+512);
    if(d0==0){p0=__builtin_amdgcn_mfma_f32_32x32x16_bf16(b0,qr[0],negm,0,0,0);p1=__builtin_amdgcn_mfma_f32_32x32x16_bf16(b1,qr[0],negm,0,0,0);}
    else{p0=__builtin_amdgcn_mfma_f32_32x32x16_bf16(b0,qr[d0],p0,0,0,0);p1=__builtin_amdgcn_mfma_f32_32x32x16_bf16(b1,qr[d0],p1,0,0,0);}}
}
typedef __attribute__((address_space(3))) const char* lds_cptr;
typedef short v4i16_t __attribute__((ext_vector_type(4)));
__device__ __forceinline__ void kload8(bf16x8*kf,lds_cptr kp){
  kf[0]=*(const __attribute__((address_space(3))) bf16x8*)(kp);      kf[1]=*(const __attribute__((address_space(3))) bf16x8*)(kp+512);
  kf[2]=*(const __attribute__((address_space(3))) bf16x8*)(kp+2048); kf[3]=*(const __attribute__((address_space(3))) bf16x8*)(kp+2560);
  kf[4]=*(const __attribute__((address_space(3))) bf16x8*)(kp+4096); kf[5]=*(const __attribute__((address_space(3))) bf16x8*)(kp+4608);
  kf[6]=*(const __attribute__((address_space(3))) bf16x8*)(kp+6144); kf[7]=*(const __attribute__((address_space(3))) bf16x8*)(kp+6656);
}
__device__ __forceinline__ void kload2(bf16x8*kf,lds_cptr kp,int j){ kf[2*j]=*(const __attribute__((address_space(3))) bf16x8*)(kp+j*2048); kf[2*j+1]=*(const __attribute__((address_space(3))) bf16x8*)(kp+j*2048+512); }
__device__ __forceinline__ s16x4 vtr(lds_cptr p){ return __builtin_bit_cast(s16x4,__builtin_amdgcn_ds_read_tr16_b64_v4i16((__attribute__((address_space(3))) v4i16_t*)p)); }
__device__ __forceinline__ float rowmax(const f32x16&p0,const f32x16&p1){
  float a=max3f(p0[0],p0[1],p1[0]),b=max3f(p0[2],p0[3],p1[1]);a=max3f(a,p1[2],p1[3]);
  #pragma unroll
  for(int r=4;r<16;r+=4){a=max3f(a,p0[r],p0[r+1]);b=max3f(b,p0[r+2],p0[r+3]);a=max3f(a,p1[r],p1[r+1]);b=max3f(b,p1[r+2],p1[r+3]);}
  const float m=max2f(a,b);
  auto rr=__builtin_amdgcn_permlane32_swap(__float_as_uint(m),__float_as_uint(m),false,false);
  return max2f(__uint_as_float(rr[0]),__uint_as_float(rr[1]));
}
__device__ __forceinline__ void pv(f32x16*o,int vb,bf16x8 pa0,bf16x8 pa1,bf16x8 pa2,bf16x8 pa3){
  #pragma unroll
  for(int d0=0;d0<2;++d0){s16x4 lo[4],hi[4];
    #pragma unroll
    for(int ks=0;ks<4;++ks){
      asm volatile("ds_read_b64_tr_b16 %0,%1 offset:%c2":"=&v"(lo[ks]):"v"(vb),"i"(d0*4096+ks*1024):"memory");
      asm volatile("ds_read_b64_tr_b16 %0,%1 offset:%c2":"=&v"(hi[ks]):"v"(vb),"i"(d0*4096+ks*1024+512):"memory");}
    asm volatile("s_waitcnt lgkmcnt(0)":::"memory");SBAR();
    #define PK(k) (bf16x8){lo[k][0],lo[k][1],lo[k][2],lo[k][3],hi[k][0],hi[k][1],hi[k][2],hi[k][3]}
    o[d0]=__builtin_amdgcn_mfma_f32_32x32x16_bf16(pa0,PK(0),o[d0],0,0,0);
    o[d0]=__builtin_amdgcn_mfma_f32_32x32x16_bf16(pa1,PK(1),o[d0],0,0,0);
    o[d0]=__builtin_amdgcn_mfma_f32_32x32x16_bf16(pa2,PK(2),o[d0],0,0,0);
    o[d0]=__builtin_amdgcn_mfma_f32_32x32x16_bf16(pa3,PK(3),o[d0],0,0,0);
    #undef PK
  }
}

#ifndef ATTN_STORE16
#define ATTN_STORE16(p,v) (*(u32x4*)(p)=(v))
#endif
template<int THRL> __device__ __forceinline__ void attn_unit(int b,int h,int kvh,int qb,const bf16*Q,const bf16*__restrict__ K,const bf16*__restrict__ V,bf16*O,char*shm){
  const int tid=threadIdx.x,lane=tid&63,r32=lane&31,hi=lane>>5; const int wid=__builtin_amdgcn_readfirstlane(tid>>6);
  const long rowbase=(long)b*SEQA; const int q0=qb*QB;
  const bf16*Qw=Q+(rowbase+q0+wid*QBLK)*QP+h*D;
  const bf16*Kh=K+rowbase*KP+kvh*D,*Vh=V+rowbase*KP+kvh*D;
  const unsigned lds0=(unsigned)(uintptr_t)shm;
  float*wsf=(float*)(shm+LDS_WS)+wid*64;
  const bf16*ksrc=Kh+(long)lane*KP+wid*8;
  const bf16*vsrc=Vh+(long)(16*(wid&3)+(lane>>2))*KP+(wid>>2)*32+(lane&3)*8;
  const unsigned kdst=lds0+LDS_K+wid*1024, vdst=lds0+LDS_V+wid*1024;
  #define DMA_K(t,slot) glds16(ksrc+(long)(t)*KVBLK*KP,(unsigned)__builtin_amdgcn_readfirstlane(kdst+(slot)))
  #define DMA_V(t,slot) glds16(vsrc+(long)(t)*KVBLK*KP,(unsigned)__builtin_amdgcn_readfirstlane(vdst+(slot)))
  const int vb0=(int)(lds0+LDS_V)+((lane>>4)&1)*32+(lane&3)*8+(4*hi+((lane&15)>>2))*64;
  const char*Kbase=shm+LDS_K; bf16x8 kf[8];
  const lds_cptr shm3=(lds_cptr)shm; const lds_cptr kp0=shm3+LDS_K+hi*1024+r32*16; const lds_cptr vp0=shm3+LDS_V+((lane>>4)&1)*32+(lane&3)*8+(4*hi+((lane&15)>>2))*64;
  const int NT=SEQA/KVBLK;
  DMA_K(0,0);DMA_V(0,0);DMA_K(1,SLOTB);
  bf16x8 qr[4];
  #pragma unroll
  for(int d0=0;d0<4;++d0)qr[d0]=*reinterpret_cast<const bf16x8*>(&Qw[(long)r32*QP+d0*16+hi*8]);
  float mhat=0.f,l_reg=0.f;f32x16 o[2];o[0]=f32x16{};o[1]=f32x16{};f32x16 negm=f32x16{};asm volatile("":"+v"(negm));
  const int qrel=wid*QBLK+r32;
  #define CMASK(P0,P1,t) do{}while(0)
  bool resc=false;
  #define START(P0,P1) do{ const float rm=rowmax(P0,P1); resc=false; \
    { const float dl=rm; mhat=fadd_s(mhat,dl); \
      _Pragma("unroll") for(int r=0;r<16;++r){P0[r]=fsub_s(P0[r],dl);P1[r]=fsub_s(P1[r],dl);} \
      _Pragma("unroll") for(int r=0;r<16;++r)negm[r]=-mhat; asm volatile("":"+v"(negm)); } \
    _Pragma("unroll") for(int r=0;r<16;++r)P0[r]=__builtin_amdgcn_exp2f(P0[r]); }while(0)
  #define RESC() do{ if(resc){ asm volatile("s_waitcnt lgkmcnt(0)":::"memory"); \
      _Pragma("unroll") for(int d_=0;d_<2;++d_) _Pragma("unroll") for(int r=0;r<16;++r)o[d_][r]*=wsf[crow(r,hi)]; } }while(0)
  f32x16 pA0,pA1,pB0,pB1;
  int sl_prev=0,sl_cur=0,sl_next=SLOTB;
  #define ROT() do{sl_prev=sl_cur;sl_cur=sl_next;sl_next=(sl_next==(NSLOT-1)*SLOTB)?0:sl_next+SLOTB;}while(0)
  DMA_K(2,2*SLOTB);
  WAIT_BAR(3);
  qkt(pA0,pA1,Kbase,qr,negm,r32,hi);asm volatile("s_nop 15\n\ts_nop 7":"+v"(pA0),"+v"(pA1));CMASK(pA0,pA1,0);
  START(pA0,pA1);
  _Pragma("unroll") for(int r=0;r<16;++r)pA1[r]=__builtin_amdgcn_exp2f(pA1[r]);
  WAIT_BAR(0);
  DMA_K(3,0);DMA_V(1,SLOTB);
  ROT();
  kload8(kf,kp0+sl_cur);
  WAIT_BAR(2);
  s16x4 vlo[8],vhi[8]; u32x4 pw0,pw1,pw2,pw3;
  #define PKW(P,B) cvtpk_s(P[B],P[B+1])
  #define PAF(k) __builtin_bit_cast(bf16x8,pw##k)
  #define VFR(i) (bf16x8){vlo[i][0],vlo[i][1],vlo[i][2],vlo[i][3],vhi[i][0],vhi[i][1],vhi[i][2],vhi[i][3]}
  #define PIN(x) asm volatile("":"+v"(x))
  #define MX3(a,b,c) __builtin_fmaxf(__builtin_fmaxf((a),(b)),(c))
  #define GAPA(MF,A0,A1,A2,A3,W0,W1,PW) do{ MF; sacc+=A0; sacc+=A1; sacc+=A2; sacc+=A3; PIN(sacc); W0; W1; PIN(PW); SBAR(); }while(0)
  #define EX(v) __builtin_amdgcn_exp2f(v)
  #define GAPB(MF,X,B) do{ MF; X[B]=EX(X[B]); X[B+1]=EX(X[B+1]); X[B+2]=EX(X[B+2]); X[B+3]=EX(X[B+3]); PIN(X); SBAR(); }while(0)
  #define VRD(i) do{ vlo[i]=vtr(vp_+(((i)>>2)*4096+((i)&3)*1024)); vhi[i]=vtr(vp_+(((i)>>2)*4096+((i)&3)*1024+512)); }while(0)
  #define KRD(G,j) do{ if(G){ kload2(kf,kp0+sl_next,j); SBAR(); } }while(0)
  #define STEP(C0,C1,P0,P1,t,GK,GV,GL) do{ SBAR(); \
    const lds_cptr vp_=vp0+sl_prev; \
    VRD(0); SBAR(); float sacc=(P0[0]+P0[1]); \
    GAPA(C0=__builtin_amdgcn_mfma_f32_32x32x16_bf16(kf[0],qr[0],negm,0,0,0), P0[2],P0[3],P0[4],P0[5],     pw0[0]=PKW(P0,0), pw0[1]=PKW(P0,2), pw0); \
    VRD(4); SBAR(); GAPA(C1=__builtin_amdgcn_mfma_f32_32x32x16_bf16(kf[1],qr[0],negm,0,0,0), P0[6],P0[7],P0[8],P0[9],     pw0[2]=PKW(P0,4), pw0[3]=PKW(P0,6), pw0); \
    VRD(1); SBAR(); GAPA(C0=__builtin_amdgcn_mfma_f32_32x32x16_bf16(kf[2],qr[1],C0,0,0,0),   P0[10],P0[11],P0[12],P0[13], pw1[0]=PKW(P0,8), pw1[1]=PKW(P0,10), pw1); \
    VRD(5); SBAR(); GAPA(C1=__builtin_amdgcn_mfma_f32_32x32x16_bf16(kf[3],qr[1],C1,0,0,0),   P0[14],P0[15],P1[0],P1[1],   pw1[2]=PKW(P0,12),pw1[3]=PKW(P0,14), pw1); \
    VRD(2); SBAR(); GAPA(C0=__builtin_amdgcn_mfma_f32_32x32x16_bf16(kf[4],qr[2],C0,0,0,0),   P1[2],P1[3],P1[4],P1[5],     pw2[0]=PKW(P1,0), pw2[1]=PKW(P1,2), pw2); \
    VRD(6); SBAR(); GAPA(C1=__builtin_amdgcn_mfma_f32_32x32x16_bf16(kf[5],qr[2],C1,0,0,0),   P1[6],P1[7],P1[8],P1[9],     pw2[2]=PKW(P1,4), pw2[3]=PKW(P1,6), pw2); \
    VRD(3); SBAR(); GAPA(C0=__builtin_amdgcn_mfma_f32_32x32x16_bf16(kf[6],qr[3],C0,0,0,0),   P1[10],P1[11],P1[12],P1[13], pw3[0]=PKW(P1,8), pw3[1]=PKW(P1,10), pw3); \
    VRD(7); SBAR(); GAPA(C1=__builtin_amdgcn_mfma_f32_32x32x16_bf16(kf[7],qr[3],C1,0,0,0),   P1[14],P1[15],0.f,0.f,       pw3[2]=PKW(P1,12),pw3[3]=PKW(P1,14), pw3); \
    l_reg+=sacc; \
    if(GK){DMA_K((t)+3,sl_cur);} if(GV){DMA_V((t)+1,sl_next);} \
    CMASK(C0,C1,t); \
    { float a=MX3(C0[0],C0[1],C1[0]),b=MX3(C0[2],C0[3],C1[1]); a=MX3(a,C1[2],C1[3]); \
      _Pragma("unroll") for(int r=4;r<16;r+=4){a=MX3(a,C0[r],C0[r+1]);b=MX3(b,C0[r+2],C0[r+3]);a=MX3(a,C1[r],C1[r+1]);b=MX3(b,C1[r+2],C1[r+3]);} \
      float rm=__builtin_fmaxf(a,b); { auto rr=__builtin_amdgcn_permlane32_swap(__float_as_uint(rm),__float_as_uint(rm),false,false); rm=__builtin_fmaxf(__uint_as_float(rr[0]),__uint_as_float(rr[1])); } \
      resc=false; \
      if(__builtin_expect(__any(rm>(float)THRL),0)){ const float dl=__builtin_fmaxf(rm,0.f); mhat+=dl; \
        _Pragma("unroll") for(int r=0;r<16;++r){C0[r]-=dl;C1[r]-=dl;} \
        _Pragma("unroll") for(int r=0;r<16;++r)negm[r]=-mhat; asm volatile("":"+v"(negm)); \
        const float f=__builtin_amdgcn_exp2f(-dl); l_reg*=f; if(hi==0)wsf[r32]=f; resc=true; } } \
    SBAR(); \
    GAPB(o[0]=__builtin_amdgcn_mfma_f32_32x32x16_bf16(PAF(0),VFR(0),o[0],0,0,0), C0,0); \
    GAPB(o[1]=__builtin_amdgcn_mfma_f32_32x32x16_bf16(PAF(0),VFR(4),o[1],0,0,0), C0,4); \
    KRD(GL,0); GAPB(o[0]=__builtin_amdgcn_mfma_f32_32x32x16_bf16(PAF(1),VFR(1),o[0],0,0,0), C0,8); \
    KRD(GL,1); GAPB(o[1]=__builtin_amdgcn_mfma_f32_32x32x16_bf16(PAF(1),VFR(5),o[1],0,0,0), C0,12); \
    KRD(GL,2); GAPB(o[0]=__builtin_amdgcn_mfma_f32_32x32x16_bf16(PAF(2),VFR(2),o[0],0,0,0), C1,0); \
    KRD(GL,3); GAPB(o[1]=__builtin_amdgcn_mfma_f32_32x32x16_bf16(PAF(2),VFR(6),o[1],0,0,0), C1,4); \
    GAPB(o[0]=__builtin_amdgcn_mfma_f32_32x32x16_bf16(PAF(3),VFR(3),o[0],0,0,0), C1,8); \
    GAPB(o[1]=__builtin_amdgcn_mfma_f32_32x32x16_bf16(PAF(3),VFR(7),o[1],0,0,0), C1,12); \
    }while(0)
  int t=1;
  #undef CMASK
  #define CMASK(P0,P1,t) do{}while(0)
  for(;t+5<NT;t+=2){
    STEP(pB0,pB1,pA0,pA1,t,true,true,true);     WAIT_BAR(2); RESC(); ROT();
    STEP(pA0,pA1,pB0,pB1,t+1,true,true,true);   WAIT_BAR(2); RESC(); ROT();
  }
  #undef CMASK
  #define CMASK(P0,P1,t) do{}while(0)
  #define ENDW(tt) do{ if((tt)+3<NT){WAIT_BAR(2);} else if((tt)+2<NT){WAIT_BAR(1);} else {WAIT_BAR(0);} }while(0)
  for(;t+1<NT;t+=2){
    STEP(pB0,pB1,pA0,pA1,t,(t+3<NT),(t+1<NT),(t+1<NT));       ENDW(t);   RESC(); ROT();
    STEP(pA0,pA1,pB0,pB1,t+1,(t+4<NT),(t+2<NT),(t+2<NT));     ENDW(t+1); RESC(); ROT();
  }
  STEP(pB0,pB1,pA0,pA1,NT-1,false,false,false); RESC();
  { float sacc=pB0[0]+pB0[1]; _Pragma("unroll") for(int r=2;r<16;++r)sacc+=pB0[r]; _Pragma("unroll") for(int r=0;r<16;++r)sacc+=pB1[r]; l_reg+=sacc;
    pw0=(u32x4){PKW(pB0,0),PKW(pB0,2),PKW(pB0,4),PKW(pB0,6)};pw1=(u32x4){PKW(pB0,8),PKW(pB0,10),PKW(pB0,12),PKW(pB0,14)};pw2=(u32x4){PKW(pB1,0),PKW(pB1,2),PKW(pB1,4),PKW(pB1,6)};pw3=(u32x4){PKW(pB1,8),PKW(pB1,10),PKW(pB1,12),PKW(pB1,14)};
    SBAR(); pv(o,vb0+sl_cur,PAF(0),PAF(1),PAF(2),PAF(3)); }
  #undef PKW
  #undef PAF
  #undef VFR
  #undef PIN
  #undef MX3
  #undef GAPA
  #undef GAPB
  #undef EX
  #undef VRD
  #undef KRD
  #undef STEP
  #undef ENDW
  {auto rr=__builtin_amdgcn_permlane32_swap(__float_as_uint(l_reg),__float_as_uint(l_reg),false,false);l_reg=__uint_as_float(rr[0])+__uint_as_float(rr[1]);}
  if(hi==0)wsf[32+r32]=l_reg;asm volatile("s_waitcnt lgkmcnt(0)":::"memory");
  float rli[16];
  #pragma unroll
  for(int r=0;r<16;++r)rli[r]=__builtin_amdgcn_rcpf(wsf[32+crow(r,hi)]);
  bf16*Ow=O+(rowbase+q0+wid*QBLK)*QP+h*D;
  { bf16*stg=(bf16*)(shm+LDS_OST)+wid*2048;
    #pragma unroll
    for(int r=0;r<16;++r){const int orow=crow(r,hi);
      #pragma unroll
      for(int d0=0;d0<2;++d0)stg[orow*64+d0*32+r32]=(bf16)f2bf(o[d0][r]*rli[r]);}
    asm volatile("s_waitcnt lgkmcnt(0)":::"memory");
    #pragma unroll
    for(int i=0;i<4;++i){const int row=i*8+(lane>>3),ch=lane&7; const u32x4 v=*(const u32x4*)(stg+row*64+ch*8); ATTN_STORE16(Ow+(long)row*QP+ch*8,v);} }
  asm volatile("s_waitcnt lgkmcnt(0)\n\ts_barrier":::"memory");
  #undef DMA_K
  #undef DMA_V
  #undef CMASK
  #undef START
  #undef RESC
  #undef ROT
}
constexpr int ATTN_LDS_BYTES=LDS_BYTES;
#undef SBAR
#undef WAIT_BAR
}
constexpr int NWAVES = 8;
constexpr int RING_OFF = 0, RING_BYTES = 131072;
constexpr int SGU_ROWB = 1040, SGU_TILE_BYTES = 128 * SGU_ROWB;
constexpr int TBL_OFF = 133120;
constexpr int UREC_OFF = TBL_OFF + 8192;
constexpr int MISC_OFF = UREC_OFF + 256;
constexpr int LDS_BYTES = 147456;
static_assert(MISC_OFF + 128 <= LDS_BYTES, "LDS map");
constexpr int NPHASE = 13;

#define GAS __attribute__((address_space(1)))
typedef GAS unsigned gu32;
#define RLX_AGENT __ATOMIC_RELAXED, __HIP_MEMORY_SCOPE_AGENT

#define XB_TMO      128
#define XB_XCNT(j)  (256  + 64 * (j))
#define XB_XSUB(j)  (1280 + 64 * (j))
#define XB_XGEN(j)  (2304 + 64 * (j))
#define XB_TOP      3328
#define XB_TOPGEN   3392
#define XCD_BAR_WORDS 3456
#define XB_SPIN_CAP (1u << 18)
__device__ __forceinline__ unsigned xb_ld(unsigned* p)              { return __hip_atomic_load(p, __ATOMIC_RELAXED, __HIP_MEMORY_SCOPE_AGENT); }
__device__ __forceinline__ unsigned xb_add(unsigned* p, unsigned v) { return __hip_atomic_fetch_add(p, v, __ATOMIC_RELAXED, __HIP_MEMORY_SCOPE_AGENT); }
__device__ __forceinline__ unsigned xb_xcc_id() { return (unsigned)__builtin_amdgcn_s_getreg((3 << 11) | 20) & 0xFu; }
#define XB_SPIN(cond, bar) do { unsigned _sp = 0; while (cond) { __builtin_amdgcn_s_sleep(1); \
    if ((++_sp & 255u) == 0u) { if (xb_ld(&(bar)[XB_TMO])) break; if (_sp > XB_SPIN_CAP) { atomicAdd(&(bar)[XB_TMO], 1u); break; } } } } while (0)
struct XcdBarrier { unsigned* bar; unsigned x; volatile LAS unsigned* st; };
__device__ __forceinline__ XcdBarrier xcd_barrier_post(unsigned* bar, volatile LAS unsigned* st) {
    XcdBarrier b; b.bar = bar; b.x = xb_xcc_id(); b.st = st;
    if (threadIdx.x == 0) (void)xb_add(&bar[XB_XCNT(b.x)], 1u);
    return b;
}
__device__ __forceinline__ void xcd_barrier_complete(unsigned* bar, unsigned x, unsigned& nloc, unsigned& nx) {
    const unsigned G = gridDim.x * gridDim.y * gridDim.z;
    unsigned sum, cnt, mine, sp = 0u;
    for (;;) {
        sum = 0u; cnt = 0u; mine = 0u;
#pragma unroll
        for (unsigned j = 0; j < 16; ++j) { const unsigned c = xb_ld(&bar[XB_XCNT(j)]); sum += c; cnt += (c > 0u) ? 1u : 0u; mine = (j == x) ? c : mine; }
        if (sum == G) break;
        __builtin_amdgcn_s_sleep(1);
        if ((++sp & 255u) == 0u) { if (xb_ld(&bar[XB_TMO])) break; if (sp > XB_SPIN_CAP) { atomicAdd(&bar[XB_TMO], 1u); break; } }
    }
    nloc = mine > 0u ? mine : 1u; nx = cnt > 0u ? cnt : 1u;
}
__device__ __forceinline__ void xcd_barrier(const XcdBarrier& b) {
    asm volatile("s_waitcnt vmcnt(0)" ::: "memory");
    __syncthreads();
    if (threadIdx.x == 0) {
        unsigned* bar = b.bar;
        __builtin_amdgcn_s_waitcnt(0);
        unsigned nloc = b.st[0], nx = b.st[1];
        if (nloc == 0u) { xcd_barrier_complete(bar, b.x, nloc, nx); b.st[0] = nloc; b.st[1] = nx; }
        const unsigned old = xb_add(&bar[XB_XSUB(b.x)], 1u);
        const unsigned gen = old / nloc;
        if (old + 1u == (gen + 1u) * nloc) {
            __builtin_amdgcn_fence(__ATOMIC_RELEASE, "agent");
            asm volatile("s_waitcnt vmcnt(0)" ::: "memory");
            const unsigned og = xb_add(&bar[XB_TOP], 1u);
            const unsigned tg = og / nx;
            if (og + 1u == (tg + 1u) * nx) xb_add(&bar[XB_TOPGEN], 1u);
            else XB_SPIN(xb_ld(&bar[XB_TOPGEN]) == tg, bar);
            __builtin_amdgcn_fence(__ATOMIC_ACQUIRE, "agent");
            xb_add(&bar[XB_XGEN(b.x)], 1u);
            asm volatile("s_waitcnt vmcnt(0)" ::: "memory");
        } else {
            XB_SPIN(xb_ld(&bar[XB_XGEN(b.x)]) == gen, bar);
            __builtin_amdgcn_fence(__ATOMIC_ACQUIRE, "agent");
            asm volatile("s_waitcnt vmcnt(0)" ::: "memory");
        }
    }
    __syncthreads();
}

using pg8::Unit;
struct SchedPlain {
    const char* A; const char* Bt; int nM, nN, G, c, K;
    __device__ __forceinline__ bool next(int i, Unit& u) const { const long L = (long)i * G + c; if (L >= (long)nM * nN) return false; pg8::tile_of((int)L, nM, nN, u.pm, u.pn); u.kind = 0; return true; }
    __device__ __forceinline__ const char* a_ptr(const Unit& u) const { return A + (size_t)u.pm * 256 * K * 2; }
    __device__ __forceinline__ const char* b_ptr(const Unit& u) const { return Bt + (size_t)u.pn * 256 * K * 2; }
    __device__ __forceinline__ unsigned goff(int, int) const { return 0u; }
};
struct SchedZ {
    const char* A; const char* Bt; int G, c;
    __device__ __forceinline__ bool next(int i, Unit& u) const { const long L = (long)i * G + c; if (L >= 1936) return false;
        if (L < 1920) pg8::tile_of((int)L, 128, 15, u.pm, u.pn); else { const int j = (int)L - 1920; u.pm = 128 + (j >> 2); u.pn = 15 + (j & 3); } u.kind = 0; return true; }
    __device__ __forceinline__ const char* a_ptr(const Unit& u) const { return A + (size_t)u.pm * 256 * 2048; }
    __device__ __forceinline__ const char* b_ptr(const Unit& u) const { return Bt + (size_t)u.pn * 256 * 2048; }
    __device__ __forceinline__ unsigned goff(int, int) const { return 0u; }
};
struct SchedY {
    const char* A0; const char* A1; const char* B0; const char* B1; int G, c;
    __device__ __forceinline__ bool next(int i, Unit& u) const { const long L = (long)(i >> 1) * G + c; if (L >= 512) return false; pg8::tile_of((int)L, 128, 4, u.pm, u.pn); u.kind = i & 1; return true; }
    __device__ __forceinline__ const char* a_ptr(const Unit& u) const { return (u.kind ? A1 : A0) + (size_t)u.pm * 256 * 1024; }
    __device__ __forceinline__ const char* b_ptr(const Unit& u) const { return (u.kind ? B1 : B0) + (size_t)u.pn * 256 * 1024; }
    __device__ __forceinline__ unsigned goff(int, int) const { return 0u; }
};
struct SchedMoe {
    const LAS int* rec; const LAS unsigned* tbl; const char* A; const char* Bt; size_t a_panel_bytes, b_expert_bytes, b_tile_bytes; bool gather;
    __device__ __forceinline__ bool next(int i, Unit& u) const { if (i >= 8 || rec[i * 8] == 0) return false; u.pm = rec[i * 8 + 1]; u.pn = rec[i * 8 + 2]; u.kind = rec[i * 8 + 3]; return true; }
    __device__ __forceinline__ const char* a_ptr(const Unit& u) const { return gather ? A : A + (size_t)u.pm * a_panel_bytes; }
    __device__ __forceinline__ const char* b_ptr(const Unit& u) const { return Bt + (size_t)u.kind * b_expert_bytes + (size_t)u.pn * b_tile_bytes; }
    __device__ __forceinline__ unsigned goff(int ui, int row) const { return tbl[ui * 256 + row]; }
};

typedef const f32x4 (&AccRef)[2][2][4][2];
struct EpiZ {
    static constexpr bool PERM = true;
    unsigned char* ws; const float* gq; const float* gk; const float* tab;
    __device__ __forceinline__ void operator()(AccRef acc, const Unit& u, int, int wr, int wc, int fr, int fq) const {
        const int pn = u.pn;
        if (pn <= 2) {
            const bool isv = (pn == 2 && wc >= 2), isq = (pn < 2);
            bf16_t* dst; int ldc;
            if (isq) { dst = (bf16_t*)(ws + WS_Q) + (4 * pn + wc) * 64; ldc = 512; }
            else if (!isv) { dst = (bf16_t*)(ws + WS_K) + wc * 64; ldc = 128; }
            else { dst = (bf16_t*)(ws + WS_V) + (wc - 2) * 64; ldc = 128; }
            const float* g = isq ? gq : gk;
            f32x4 gv[2][2];
#pragma unroll
            for (int bj = 0; bj < 2; ++bj)
#pragma unroll
                for (int n = 0; n < 2; ++n) gv[bj][n] = *(const f32x4*)(g + 32 * bj + 8 * fq + 4 * n);
            const float osc = isq ? C2_SELF : 1.0f;
#pragma unroll
            for (int ai = 0; ai < 2; ++ai)
#pragma unroll
                for (int m = 0; m < 4; ++m) {
                    const int row = u.pm * 256 + ai * 128 + wr * 64 + m * 16 + fr;
                    bf16_t* rowp = dst + (size_t)row * ldc + 8 * fq;
                    if (isv) {
#pragma unroll
                        for (int bj = 0; bj < 2; ++bj) { const f32x4 v0 = acc[ai][bj][m][0], v1 = acc[ai][bj][m][1];
                            u32x4 w; w.x = pg8::cvt_pk_bf16(v0[0], v0[1]); w.y = pg8::cvt_pk_bf16(v0[2], v0[3]); w.z = pg8::cvt_pk_bf16(v1[0], v1[1]); w.w = pg8::cvt_pk_bf16(v1[2], v1[3]);
                            *(u32x4*)(rowp + 32 * bj) = w; }
                    } else {
                        float ss = 0.f;
#pragma unroll
                        for (int bj = 0; bj < 2; ++bj)
#pragma unroll
                            for (int n = 0; n < 2; ++n) { const f32x4 x = acc[ai][bj][m][n]; ss += (x[0] * x[0] + x[1] * x[1]) + (x[2] * x[2] + x[3] * x[3]); }
                        ss += __shfl_xor(ss, 16); ss += __shfl_xor(ss, 32);
                        const float rs = osc / sqrtf(ss * (1.f / 64.f) + EPS);
                        const int t = row & (SEQ - 1), rid = t >> 6, cid = t & 63;
#pragma unroll
                        for (int bj = 0; bj < 2; ++bj) {
                            const float* tb = tab + (bj ? (2 * 2048 + cid * 16) : (rid * 16)) + 4 * fq;
                            const f32x4 cs = *(const f32x4*)tb, sn = *(const f32x4*)(tb + 2048);
                            float o[8];
#pragma unroll
                            for (int n = 0; n < 2; ++n) { const f32x4 x = acc[ai][bj][m][n], gg = gv[bj][n];
                                const float y0 = x[0] * rs * gg[0], y1 = x[1] * rs * gg[1], y2 = x[2] * rs * gg[2], y3 = x[3] * rs * gg[3];
                                const float c0 = cs[2 * n], s0 = sn[2 * n], c1 = cs[2 * n + 1], s1 = sn[2 * n + 1];
                                o[4 * n + 0] = y0 * c0 - y1 * s0; o[4 * n + 1] = y0 * s0 + y1 * c0; o[4 * n + 2] = y2 * c1 - y3 * s1; o[4 * n + 3] = y2 * s1 + y3 * c1; }
                            u32x4 w; w.x = pg8::cvt_pk_bf16(o[0], o[1]); w.y = pg8::cvt_pk_bf16(o[2], o[3]); w.z = pg8::cvt_pk_bf16(o[4], o[5]); w.w = pg8::cvt_pk_bf16(o[6], o[7]);
                            *(u32x4*)(rowp + 32 * bj) = w; }
                    }
                }
        } else {
            bf16_t* dst; int ldc, row0; int act;
            if (pn < 5) { dst = (bf16_t*)(ws + WS_U) + (pn - 3) * 256; ldc = 512; act = 1; row0 = u.pm * 256; }
            else if (pn < 7) { dst = (bf16_t*)(ws + WS_GV) + (pn - 5) * 256; ldc = 512; act = 1; row0 = u.pm * 256; }
            else if (pn < 11) { dst = (bf16_t*)(ws + WS_GA) + (pn - 7) * 256; ldc = 1024; act = 2; row0 = u.pm * 256; }
            else if (pn < 15) { dst = (bf16_t*)(ws + WS_GB) + (pn - 11) * 256; ldc = 1024; act = 2; row0 = u.pm * 256; }
            else { dst = (bf16_t*)(ws + WS_KVC) + (pn - 15) * 256; ldc = 1024; act = 0; row0 = (u.pm - 128) * 256; }
            const bool isg = (act == 1);
            const float k1 = isg ? 2.0f * LOG2E * 0.7978845608028654f : LOG2E, k3 = isg ? 2.0f * LOG2E * 0.7978845608028654f * 0.044715f : 0.f;
#pragma unroll
            for (int ai = 0; ai < 2; ++ai)
#pragma unroll
                for (int m = 0; m < 4; ++m) { bf16_t* rowp = dst + (size_t)(row0 + ai * 128 + wr * 64 + m * 16 + fr) * ldc + wc * 32 + 8 * fq;
#pragma unroll
                    for (int bj = 0; bj < 2; ++bj) { float o[8];
#pragma unroll
                        for (int n = 0; n < 2; ++n)
#pragma unroll
                            for (int j = 0; j < 4; ++j) { const float x = acc[ai][bj][m][n][j];
                                if (act == 0) o[4 * n + j] = x;
                                else { const float tt = x * (k1 + k3 * x * x); const float r = __builtin_amdgcn_rcpf(1.0f + __builtin_amdgcn_exp2f(-tt)); o[4 * n + j] = isg ? x * r : r; } }
                        u32x4 w; w.x = pg8::cvt_pk_bf16(o[0], o[1]); w.y = pg8::cvt_pk_bf16(o[2], o[3]); w.z = pg8::cvt_pk_bf16(o[4], o[5]); w.w = pg8::cvt_pk_bf16(o[6], o[7]);
                        *(u32x4*)(rowp + bj * 128) = w; } }
        }
    }
};
__device__ __forceinline__ void unpack8(const u32x4 g, float (&f)[8]) {
    f[0] = __uint_as_float(g.x << 16); f[1] = __uint_as_float(g.x & 0xffff0000u); f[2] = __uint_as_float(g.y << 16); f[3] = __uint_as_float(g.y & 0xffff0000u);
    f[4] = __uint_as_float(g.z << 16); f[5] = __uint_as_float(g.z & 0xffff0000u); f[6] = __uint_as_float(g.w << 16); f[7] = __uint_as_float(g.w & 0xffff0000u);
}
struct EpiY {
    static constexpr bool PERM = true;
    const bf16_t* GA; const bf16_t* GB; bf16_t* MG;
    __device__ __forceinline__ void operator()(AccRef acc, const Unit& u, int, int wr, int wc, int fr, int fq) const {
        const bf16_t* G = u.kind ? GB : GA; const bool add = (u.kind != 0);
#pragma unroll
        for (int ai = 0; ai < 2; ++ai)
#pragma unroll
            for (int m = 0; m < 4; ++m) { const size_t off = (size_t)(u.pm * 256 + ai * 128 + wr * 64 + m * 16 + fr) * 1024 + u.pn * 256 + wc * 32 + 8 * fq;
#pragma unroll
                for (int bj = 0; bj < 2; ++bj) { float g[8], p[8]; unpack8(*(const u32x4*)(G + off + bj * 128), g);
                    if (add) unpack8(*(const u32x4*)(MG + off + bj * 128), p); else {
#pragma unroll
                        for (int j = 0; j < 8; ++j) p[j] = 0.f; }
                    float o[8];
#pragma unroll
                    for (int n = 0; n < 2; ++n)
#pragma unroll
                        for (int j = 0; j < 4; ++j) o[4 * n + j] = p[4 * n + j] + g[4 * n + j] * acc[ai][bj][m][n][j];
                    u32x4 w; w.x = pg8::cvt_pk_bf16(o[0], o[1]); w.y = pg8::cvt_pk_bf16(o[2], o[3]); w.z = pg8::cvt_pk_bf16(o[4], o[5]); w.w = pg8::cvt_pk_bf16(o[6], o[7]);
                    *(u32x4*)(MG + off + bj * 128) = w; } }
    }
};
struct EpiRes {
    static constexpr bool PERM = false;
    const float* base; float* out;
    __device__ __forceinline__ void operator()(AccRef acc, const Unit& u, int, int wr, int wc, int fr, int fq) const {
#pragma unroll
        for (int ai = 0; ai < 2; ++ai)
#pragma unroll
            for (int m = 0; m < 4; ++m) { const size_t off = (size_t)(u.pm * 256 + ai * 128 + wr * 64 + m * 16 + fr) * 1024 + u.pn * 256 + wc * 32 + 4 * fq;
#pragma unroll
                for (int bj = 0; bj < 2; ++bj)
#pragma unroll
                    for (int n = 0; n < 2; ++n) { const f32x4 b = *(const f32x4*)(base + off + bj * 128 + n * 16); *(f32x4*)(out + off + bj * 128 + n * 16) = b + acc[ai][bj][m][n]; } }
    }
};
struct EpiBf16s {
    static constexpr bool PERM = true;
    bf16_t* O; int ldc; float scale;
    __device__ __forceinline__ void operator()(AccRef acc, const Unit& u, int, int wr, int wc, int fr, int fq) const {
#pragma unroll
        for (int ai = 0; ai < 2; ++ai)
#pragma unroll
            for (int m = 0; m < 4; ++m) { bf16_t* rowp = O + (size_t)(u.pm * 256 + ai * 128 + wr * 64 + m * 16 + fr) * ldc + u.pn * 256 + wc * 32 + 8 * fq;
#pragma unroll
                for (int bj = 0; bj < 2; ++bj) { const f32x4 v0 = acc[ai][bj][m][0] * scale, v1 = acc[ai][bj][m][1] * scale;
                    u32x4 w; w.x = pg8::cvt_pk_bf16(v0[0], v0[1]); w.y = pg8::cvt_pk_bf16(v0[2], v0[3]); w.z = pg8::cvt_pk_bf16(v1[0], v1[1]); w.w = pg8::cvt_pk_bf16(v1[2], v1[3]);
                    *(u32x4*)(rowp + bj * 128) = w; } }
    }
};
struct EpiMoeA {
    static constexpr bool PERM = true;
    bf16_t* H;
    __device__ __forceinline__ void operator()(AccRef acc, const Unit& u, int, int wr, int wc, int fr, int fq) const {
#pragma unroll
        for (int ai = 0; ai < 2; ++ai)
#pragma unroll
            for (int m = 0; m < 4; ++m) { bf16_t* rowp = H + (size_t)(u.pm * 256 + ai * 128 + wr * 64 + m * 16 + fr) * 512 + u.pn * 128 + wc * 32 + 8 * fq; float o[8];
#pragma unroll
                for (int n = 0; n < 2; ++n)
#pragma unroll
                    for (int j = 0; j < 4; ++j) { const float g = acc[ai][0][m][n][j], up = acc[ai][1][m][n][j]; o[4 * n + j] = g * __builtin_amdgcn_rcpf(1.0f + __builtin_amdgcn_exp2f(-LOG2E * g)) * up; }
                u32x4 w; w.x = pg8::cvt_pk_bf16(o[0], o[1]); w.y = pg8::cvt_pk_bf16(o[2], o[3]); w.z = pg8::cvt_pk_bf16(o[4], o[5]); w.w = pg8::cvt_pk_bf16(o[6], o[7]);
                *(u32x4*)rowp = w; }
    }
};
struct EpiMoeB {
    static constexpr bool PERM = true;
    const LAS int* rec; const int* list; bf16_t* YS;
    __device__ __forceinline__ void operator()(AccRef acc, const Unit& u, int ui, int wr, int wc, int fr, int fq) const {
        const int e = u.kind, r0 = rec[ui * 8 + 4], ne = rec[ui * 8 + 5];
#pragma unroll
        for (int ai = 0; ai < 2; ++ai)
#pragma unroll
            for (int m = 0; m < 4; ++m) { const int idx = r0 + ai * 128 + wr * 64 + m * 16 + fr;
                if (idx < ne) { const int* ent = list + ((size_t)e * LIST_CAP + idx) * 2; const int dest = ent[0]; const float w = __int_as_float(ent[1]);
                    bf16_t* rowp = YS + (size_t)dest * 1024 + u.pn * 256 + wc * 32 + 8 * fq;
#pragma unroll
                    for (int bj = 0; bj < 2; ++bj) { const f32x4 v0 = acc[ai][bj][m][0] * w, v1 = acc[ai][bj][m][1] * w;
                        u32x4 wv; wv.x = pg8::cvt_pk_bf16(v0[0], v0[1]); wv.y = pg8::cvt_pk_bf16(v0[2], v0[3]); wv.z = pg8::cvt_pk_bf16(v1[0], v1[1]); wv.w = pg8::cvt_pk_bf16(v1[2], v1[3]);
                        *(u32x4*)(rowp + bj * 128) = wv; } } }
    }
};
typedef short v4i16_t __attribute__((ext_vector_type(4)));
typedef short bf16x8_t __attribute__((ext_vector_type(8)));
typedef float f32x16_t __attribute__((ext_vector_type(16)));
__device__ __forceinline__ v4i16_t lds_tr16(LAS unsigned char* p) { return __builtin_amdgcn_ds_read_tr16_b64_v4i16((LAS v4i16_t*)p); }

__device__ __forceinline__ void sgu_unit(LAS unsigned char* lds, unsigned char* ws, const PtrsIn& P, int ch) {
    const int tid = threadIdx.x, lane = tid & 63, wave = __builtin_amdgcn_readfirstlane(tid >> 6), fr = lane & 15, fq = lane >> 4;
    {
        const int row = tid >> 2, q4 = tid & 3;
        const u32x4* src = (const u32x4*)((const bf16_t*)(ws + WS_GV) + ((size_t)ch * 128 + row) * 512 + q4 * 128);
        u32x4 raw[16];
#pragma unroll
        for (int j = 0; j < 16; ++j) raw[j] = src[j];
        float s = 0.f;
#pragma unroll
        for (int j = 0; j < 16; ++j) { float f[8]; unpack8(raw[j], f);
#pragma unroll
            for (int k = 0; k < 8; ++k) s += f[k]; }
        s += __shfl_xor(s, 1); s += __shfl_xor(s, 2);
        const float mean = s * (1.f / 512.f); float q = 0.f;
#pragma unroll
        for (int j = 0; j < 16; ++j) { float f[8]; unpack8(raw[j], f);
#pragma unroll
            for (int k = 0; k < 8; ++k) { const float d = f[k] - mean; q += d * d; } }
        q += __shfl_xor(q, 1); q += __shfl_xor(q, 2);
        const float rstd = 1.0f / sqrtf(q * (1.f / 512.f) + EPS);
        const float* lg = P.in[7] + q4 * 128; const float* lb = P.in[8] + q4 * 128;
        LAS unsigned char* dst = lds + row * SGU_ROWB + q4 * 256;
#pragma unroll
        for (int j = 0; j < 16; ++j) { float f[8]; unpack8(raw[j], f);
            const f32x4 g0 = *(const f32x4*)(lg + 8 * j), g1 = *(const f32x4*)(lg + 8 * j + 4), b0 = *(const f32x4*)(lb + 8 * j), b1 = *(const f32x4*)(lb + 8 * j + 4);
            u32x4 w; w.x = pg8::cvt_pk_bf16((f[0] - mean) * rstd * g0[0] + b0[0], (f[1] - mean) * rstd * g0[1] + b0[1]); w.y = pg8::cvt_pk_bf16((f[2] - mean) * rstd * g0[2] + b0[2], (f[3] - mean) * rstd * g0[3] + b0[3]);
            w.z = pg8::cvt_pk_bf16((f[4] - mean) * rstd * g1[0] + b1[0], (f[5] - mean) * rstd * g1[1] + b1[1]); w.w = pg8::cvt_pk_bf16((f[6] - mean) * rstd * g1[2] + b1[2], (f[7] - mean) * rstd * g1[3] + b1[3]);
            *(LAS u32x4*)(dst + j * 16) = w; }
    }
    __syncthreads();
    const int i16 = lane & 15;
    LAS unsigned char* trb = lds + (8 * fq + (i16 >> 2)) * SGU_ROWB + (i16 & 3) * 8;
    const int p = 16 * wave + fr; const size_t tok = (size_t)ch * 128 + p;
    for (int g = 0; g < 4; ++g) {
        const bf16_t* W = (const bf16_t*)(ws + WS_WSS) + ((size_t)g * 128 + p) * 128 + 8 * fq;
        bf16x8_t af[4];
#pragma unroll
        for (int ks = 0; ks < 4; ++ks) af[ks] = *(const bf16x8_t*)(W + 32 * ks);
        const float bs = P.in[10][g * 128 + p];
        f32x4 acc[8];
#pragma unroll
        for (int nt = 0; nt < 8; ++nt) { acc[nt] = (f32x4){0.f, 0.f, 0.f, 0.f};
#pragma unroll
            for (int ks = 0; ks < 4; ++ks) { LAS unsigned char* a = trb + ks * 32 * SGU_ROWB + (g * 128 + 16 * nt) * 2;
                const v4i16_t lo = lds_tr16(a), hi = lds_tr16(a + 4 * SGU_ROWB);
                const bf16x8_t bfr = (bf16x8_t){lo[0], lo[1], lo[2], lo[3], hi[0], hi[1], hi[2], hi[3]};
                acc[nt] = __builtin_amdgcn_mfma_f32_16x16x32_bf16(bfr, af[ks], acc[nt], 0, 0, 0); } }
        const bf16_t* U = (const bf16_t*)(ws + WS_U) + tok * 512 + g * 128 + 4 * fq; bf16_t* SG = (bf16_t*)(ws + WS_SG) + tok * 512 + g * 128 + 4 * fq;
#pragma unroll
        for (int nt = 0; nt < 8; ++nt) { const u32x2 uu = *(const u32x2*)(U + 16 * nt);
            const float u0 = __uint_as_float(uu.x << 16), u1 = __uint_as_float(uu.x & 0xffff0000u), u2 = __uint_as_float(uu.y << 16), u3 = __uint_as_float(uu.y & 0xffff0000u);
            u32x2 o; o.x = pg8::cvt_pk_bf16(u0 * (acc[nt][0] + bs), u1 * (acc[nt][1] + bs)); o.y = pg8::cvt_pk_bf16(u2 * (acc[nt][2] + bs), u3 * (acc[nt][3] + bs));
            *(u32x2*)(SG + 16 * nt) = o; }
    }
    __syncthreads();
}

__device__ __forceinline__ void phase2_sgu_attn(LAS unsigned char* lds, unsigned char* lds_generic, unsigned char* ws, const PtrsIn& P, int vcu, int G) {
    for (int ch = vcu; ch < M / 128; ch += G) sgu_unit(lds, ws, P, ch);
    const int upc = (1024 + G - 1) / G;
    for (int i = 0; i < upc; ++i) { const int U = vcu * upc + i; if (U >= 1024) break;
        const int bkv = U >> 7, jj = U & 127, hl = jj >> 5, qb = jj & 31, b = bkv >> 1, kvh = bkv & 1;
        attn_body::attn_unit<8>(b, kvh * 4 + hl, kvh, qb, (const bf16_t*)(ws + WS_Q), (const bf16_t*)(ws + WS_K), (const bf16_t*)(ws + WS_V), (bf16_t*)(ws + WS_ATT), (char*)lds_generic + RING_OFF); }
}

__device__ __forceinline__ void cross_stage_kv(unsigned lds0, const bf16_t* KVC, int b, int h, int wave, int lane) {
#pragma unroll
    for (int j = 0; j < 8; ++j) { const int c = 2 * wave + (j >> 2), rb = j & 3;
        attn_body::glds16(KVC + (size_t)(b * NMEM + rb * 64 + lane) * 1024 + h * 128 + c * 8, (unsigned)__builtin_amdgcn_readfirstlane(lds0 + c * 4096 + rb * 1024)); }
#pragma unroll
    for (int j = 0; j < 8; ++j) { const int pc = wave * 8 + j, db = pc >> 4, r0 = (pc & 15) * 16;
        attn_body::glds16(KVC + (size_t)(b * NMEM + r0 + (lane >> 2)) * 1024 + 512 + h * 128 + db * 32 + (lane & 3) * 8, (unsigned)__builtin_amdgcn_readfirstlane(lds0 + 65536 + db * 16384 + r0 * 64)); }
}
__device__ __forceinline__ void cross_unit(LAS unsigned char* lds, const bf16_t* QC, bf16_t* OC, int row0, int h) {
    const int tid = threadIdx.x, lane = tid & 63, wave = __builtin_amdgcn_readfirstlane(tid >> 6), r32 = lane & 31, hi = lane >> 5;
    const bf16_t* Qw = QC + (size_t)(row0 + 32 * wave + r32) * 512 + h * 128 + 8 * hi;
    bf16x8_t qr[8];
#pragma unroll
    for (int ds = 0; ds < 8; ++ds) qr[ds] = *(const bf16x8_t*)(Qw + 16 * ds);
    f32x16_t p[8];
    const LAS unsigned char* kb0 = lds + hi * 4096 + r32 * 16;
#pragma unroll
    for (int kb = 0; kb < 8; ++kb) { p[kb] = f32x16_t{};
#pragma unroll
        for (int ds = 0; ds < 8; ++ds) { const bf16x8_t kf = *(const LAS bf16x8_t*)(kb0 + ds * 8192 + kb * 512); p[kb] = __builtin_amdgcn_mfma_f32_32x32x16_bf16(kf, qr[ds], p[kb], 0, 0, 0); }
        __builtin_amdgcn_sched_barrier(0); }
    float mx = -1e30f;
#pragma unroll
    for (int kb = 0; kb < 8; ++kb)
#pragma unroll
        for (int r = 0; r < 16; ++r) mx = fmaxf(mx, p[kb][r]);
    { auto rr = __builtin_amdgcn_permlane32_swap(__float_as_uint(mx), __float_as_uint(mx), false, false); mx = fmaxf(__uint_as_float(rr[0]), __uint_as_float(rr[1])); }
    float l = 0.f;
    u32x4 pw[16];
#pragma unroll
    for (int kb = 0; kb < 8; ++kb) {
#pragma unroll
        for (int r = 0; r < 16; ++r) { p[kb][r] = __builtin_amdgcn_exp2f(p[kb][r] - mx); l += p[kb][r]; }
#pragma unroll
        for (int s = 0; s < 2; ++s) { pw[2 * kb + s].x = pg8::cvt_pk_bf16(p[kb][8 * s + 0], p[kb][8 * s + 1]); pw[2 * kb + s].y = pg8::cvt_pk_bf16(p[kb][8 * s + 2], p[kb][8 * s + 3]);
            pw[2 * kb + s].z = pg8::cvt_pk_bf16(p[kb][8 * s + 4], p[kb][8 * s + 5]); pw[2 * kb + s].w = pg8::cvt_pk_bf16(p[kb][8 * s + 6], p[kb][8 * s + 7]); }
        __builtin_amdgcn_sched_barrier(0); }
    { auto rr = __builtin_amdgcn_permlane32_swap(__float_as_uint(l), __float_as_uint(l), false, false); l = __uint_as_float(rr[0]) + __uint_as_float(rr[1]); }
    const float il = 1.0f / l;
    f32x16_t o[4];
#pragma unroll
    for (int db = 0; db < 4; ++db) o[db] = f32x16_t{};
    const int i16 = lane & 15;
    LAS unsigned char* vb = lds + 65536 + (4 * hi + (i16 >> 2)) * 64 + ((lane >> 4) & 1) * 32 + (i16 & 3) * 8;
#pragma unroll
    for (int ks = 0; ks < 16; ++ks) {
        const bf16x8_t pa = __builtin_bit_cast(bf16x8_t, pw[ks]);
#pragma unroll
        for (int db = 0; db < 4; ++db) { LAS unsigned char* a = vb + db * 16384 + (16 * ks) * 64;
            const v4i16_t lo = lds_tr16(a), hh = lds_tr16(a + 512);
            const bf16x8_t vf = (bf16x8_t){lo[0], lo[1], lo[2], lo[3], hh[0], hh[1], hh[2], hh[3]};
            o[db] = __builtin_amdgcn_mfma_f32_32x32x16_bf16(vf, pa, o[db], 0, 0, 0); }
        __builtin_amdgcn_sched_barrier(0); }
    bf16_t* Ow = OC + (size_t)(row0 + 32 * wave + r32) * 512 + h * 128 + 4 * hi;
#pragma unroll
    for (int db = 0; db < 4; ++db)
#pragma unroll
        for (int rg = 0; rg < 4; ++rg) { u32x2 w; w.x = pg8::cvt_pk_bf16(o[db][4 * rg + 0] * il, o[db][4 * rg + 1] * il); w.y = pg8::cvt_pk_bf16(o[db][4 * rg + 2] * il, o[db][4 * rg + 3] * il);
            *(u32x2*)(Ow + 32 * db + 8 * rg) = w; }
}
__device__ __forceinline__ void phase7_cross(LAS unsigned char* lds, unsigned char* lds_generic, unsigned char* ws, int vcu, int G) {
    const int tid = threadIdx.x, lane = tid & 63, wave = __builtin_amdgcn_readfirstlane(tid >> 6);
    const unsigned lds0 = (unsigned)(uintptr_t)(lds_generic + RING_OFF);
    for (int j = vcu; j < 256; j += G) { const int h = j & 3, pp = j >> 2, b = pp >> 4;
        cross_stage_kv(lds0, (const bf16_t*)(ws + WS_KVC), b, h, wave, lane);
        asm volatile("s_waitcnt vmcnt(0)" ::: "memory"); __syncthreads();
        cross_unit(lds, (const bf16_t*)(ws + WS_QC), (bf16_t*)(ws + WS_OC), (2 * pp) * 256, h);
        cross_unit(lds, (const bf16_t*)(ws + WS_QC), (bf16_t*)(ws + WS_OC), (2 * pp + 1) * 256, h);
        __syncthreads(); }
}
struct Args { PtrsIn P; float* out; unsigned char* ws; int ph_lo, ph_hi; };
static_assert(sizeof(Args) == 27 * 8 + 24, "Args has no holes");

__device__ __forceinline__ void moe_setup(LAS unsigned char* lds, unsigned char* ws, int vcu, int G, bool with_gather) {
    LAS int* rec = (LAS int*)(lds + UREC_OFF); LAS unsigned* tbl = (LAS unsigned*)(lds + TBL_OFF);
    const int tid = threadIdx.x;
    const unsigned* ec = (const unsigned*)(ws + WS_CTL) + CW_ECNT;
    int cnt[16], pb[17]; pb[0] = 0;
#pragma unroll
    for (int e = 0; e < 16; ++e) { cnt[e] = (int)__hip_atomic_load(ec + 64 * e, __ATOMIC_RELAXED, __HIP_MEMORY_SCOPE_AGENT); pb[e + 1] = pb[e] + ((cnt[e] + 255) >> 8); }
    const int NP = pb[16];
    for (int i = 0; i < 8; ++i) {
        const int L = i * G + vcu; const bool valid = (L < 4 * NP);
        int panel = 0, pn = 0, e = 0, r0 = 0, ne = 0;
        if (valid) { panel = L >> 2; pn = L & 3;
#pragma unroll
            for (int j = 1; j < 16; ++j) if (panel >= pb[j]) e = j;
#pragma unroll
            for (int j = 0; j < 16; ++j) if (j == e) { r0 = (panel - pb[j]) * 256; ne = cnt[j]; } }
        if (tid == 0) { rec[i * 8 + 0] = valid ? 1 : 0; rec[i * 8 + 1] = panel; rec[i * 8 + 2] = pn; rec[i * 8 + 3] = e; rec[i * 8 + 4] = r0; rec[i * 8 + 5] = ne; }
        if (with_gather && tid < 256) { unsigned off = 0u;
            if (valid && r0 + tid < ne) { const int dest = ((const int*)(ws + WS_LIST))[((size_t)e * LIST_CAP + r0 + tid) * 2]; off = (unsigned)(dest >> 1) * 2048u; }
            tbl[i * 256 + tid] = off; }
    }
    __syncthreads();
}

__global__ void __launch_bounds__(NWAVES * 64, 2) mega(Args args) {
    extern __shared__ __attribute__((aligned(16))) unsigned char lds_raw[];
    LAS unsigned char* lds = (LAS unsigned char*)lds_raw;
    volatile LAS unsigned* MISC = (volatile LAS unsigned*)(lds + MISC_OFF);
    const int tid = threadIdx.x, lane = tid & 63, wave = __builtin_amdgcn_readfirstlane(tid >> 6);
    const int G = gridDim.x, bx = blockIdx.x, vcu = (G % 8 == 0) ? (bx % 8) * (G / 8) + bx / 8 : bx;
    unsigned char* ws = args.ws; const PtrsIn& P = args.P; float* out = args.out;
    for (int u = tid; u < (LDS_BYTES - MISC_OFF) / 4; u += NWAVES * 64) ((LAS unsigned*)(lds + MISC_OFF))[u] = 0u;
    __syncthreads();
    const int lo = args.ph_lo, hi = args.ph_hi;
    const bool fusedrun = (hi - lo) > 1;
    XcdBarrier bar; bar.bar = (unsigned*)(ws + WS_CTL) + CW_BAR; bar.x = 0; bar.st = nullptr;
    if (fusedrun) bar = xcd_barrier_post((unsigned*)(ws + WS_CTL) + CW_BAR, MISC + 8);
#ifndef PH_EN
#define PH_EN 0x1FFF
#endif
#define IN(k) ((((PH_EN) >> (k)) & 1) && lo <= (k) && (k) < hi)
#define SEAM(k) do { if (IN(k) && IN((k) + 1)) xcd_barrier(bar); } while (0)
    const int gw = vcu * NWAVES + wave, NGW = G * NWAVES;

    if (IN(0)) {
        LAS float* scr = (LAS float*)(lds + RING_OFF + wave * 16384);
        for (int it = gw; it < IT_TOTAL; it += NGW) p0_weight_item(P, ws, scr, it, lane);
        { const float* wsrc = P.in[9]; bf16_t* wd = (bf16_t*)(ws + WS_WSS);
          for (int i = bx * 512 + tid; i < 4 * 128 * 128; i += G * 512) wd[i] = (bf16_t)f2bf(wsrc[i]); }
        for (int i = bx * 512 + tid; i < 2048; i += G * 512) rope_table_entry((float*)(ws + WS_TAB), i);
        bf16_t* XN = (bf16_t*)(ws + WS_XN);
        for (int m = gw; m < M; m += NGW) rms_row_to_bf16(P.in[0] + (size_t)m * D, P.in[2], XN + (size_t)m * D, lane);
        for (int m = gw; m < MMEM; m += NGW) rms_row_to_bf16(P.in[1] + (size_t)m * D, P.in[14], XN + (size_t)(M + m) * D, lane);
    }
    SEAM(0);
    if (IN(1)) {
        SchedZ S{(const char*)(ws + WS_XN), (const char*)(ws + WS_WZ), G, bx};
        EpiZ E{ws, P.in[4], P.in[5], (const float*)(ws + WS_TAB)};
        pg8::gemm_phase<EpiZ, SchedZ, true, false>(lds + RING_OFF, 1024, S, E);
    }
    SEAM(1);
    if (IN(2)) {
        phase2_sgu_attn(lds, lds_raw, ws, P, vcu, G);
    }
    SEAM(2);
    if (IN(3)) {
        SchedY S{(const char*)(ws + WS_ATT), (const char*)(ws + WS_SG), (const char*)(ws + WS_WATT), (const char*)(ws + WS_WSGU), G, bx};
        EpiY E{(const bf16_t*)(ws + WS_GA), (const bf16_t*)(ws + WS_GB), (bf16_t*)(ws + WS_MERGED)};
        pg8::gemm_phase<EpiY, SchedY, true, false>(lds + RING_OFF, 512, S, E);
    }
    SEAM(3);
    if (IN(4)) {
        SchedPlain S{(const char*)(ws + WS_MERGED), (const char*)(ws + WS_WOUT), 128, 4, G, bx, 1024};
        EpiRes E{P.in[0], out};
        pg8::gemm_phase<EpiRes, SchedPlain, true, false>(lds + RING_OFF, 1024, S, E);
    }
    SEAM(4);
    if (IN(5)) {
        bf16_t* XN1 = (bf16_t*)(ws + WS_XN1);
        for (int m = gw; m < M; m += NGW) rms_row_to_bf16(out + (size_t)m * D, P.in[13], XN1 + (size_t)m * D, lane);
    }
    SEAM(5);
    if (IN(6)) {
        SchedPlain S{(const char*)(ws + WS_XN1), (const char*)(ws + WS_WCQ), 128, 2, G, bx, 1024};
        EpiBf16s E{(bf16_t*)(ws + WS_QC), 512, C2_CROSS};
        pg8::gemm_phase<EpiBf16s, SchedPlain, true, false>(lds + RING_OFF, 1024, S, E);
    }
    SEAM(6);
    if (IN(7)) {
        phase7_cross(lds, lds_raw, ws, vcu, G);
    }
    SEAM(7);
    if (IN(8)) {
        SchedPlain S{(const char*)(ws + WS_OC), (const char*)(ws + WS_WCO), 128, 4, G, bx, 512};
        EpiRes E{out, out};
        pg8::gemm_phase<EpiRes, SchedPlain, true, false>(lds + RING_OFF, 512, S, E);
    }
    SEAM(8);
    if (IN(9)) {
        LAS float* rw = (LAS float*)(lds + RING_OFF);
        LAS int* te = (LAS int*)(lds + RING_OFF + 20 * 1024 * 4); LAS float* tw = (LAS float*)(te + 256); LAS int* tp = (LAS int*)(tw + 256); LAS int* ebase = tp + 256;
        for (int i = tid; i < 1024 * 4; i += 512) { const int k = i >> 2, o = i & 3; rw[o * 1024 + k] = P.in[19][i]; }
        for (int i = tid; i < 1024 * 16; i += 512) { const int k = i >> 4, o = i & 15; rw[(4 + o) * 1024 + k] = P.in[21][i]; }
        __syncthreads();
        bf16_t* XN3 = (bf16_t*)(ws + WS_XN3);
        for (int tb = vcu; tb < M / 128; tb += G) {
            const int t0 = tb * 128;
            for (int i = 0; i < 16; ++i) { const int tl = wave * 16 + i, t = t0 + tl; int e0, e1; float w0, w1;
                route_token(out + (size_t)t * D, P.in[18], rw, P.in[20], P.in[22], XN3 + (size_t)t * D, lane, e0, e1, w0, w1);
                if (lane == 0) { te[2 * tl] = e0; te[2 * tl + 1] = e1; tw[2 * tl] = w0; tw[2 * tl + 1] = w1; } }
            __syncthreads();
            if (wave == 0) {
                int cnt = 0; int mye[4];
#pragma unroll
                for (int j = 0; j < 4; ++j) mye[j] = te[j * 64 + lane];
                int pos[4] = {0, 0, 0, 0};
                for (int e = 0; e < 16; ++e) { int run = 0;
#pragma unroll
                    for (int j = 0; j < 4; ++j) { const unsigned long long mk = __ballot(mye[j] == e); const int before = __popcll(mk & ((1ull << lane) - 1ull));
                        if (mye[j] == e) pos[j] = run + before; run += __popcll(mk); }
                    if (lane == e) cnt = run; }
#pragma unroll
                for (int j = 0; j < 4; ++j) tp[j * 64 + lane] = pos[j];
                if (lane < 16) { unsigned* ec = (unsigned*)(ws + WS_CTL) + CW_ECNT + 64 * lane; ebase[lane] = (int)atomicAdd(ec, (unsigned)cnt); }
            }
            __syncthreads();
            if (tid < 256) { const int e = te[tid], slot = ebase[e] + tp[tid], dest = (t0 * 2) + tid; const float w = tw[tid];
                int* lst = (int*)(ws + WS_LIST) + ((size_t)e * LIST_CAP + slot) * 2; lst[0] = dest; lst[1] = __float_as_int(w);
                int* ti = (int*)(ws + WS_TOKINFO) + (size_t)dest * 2; ti[0] = e; ti[1] = __float_as_int(w); }
            __syncthreads();
        }
    }
    SEAM(9);
    if (IN(10)) {
        moe_setup(lds, ws, vcu, G, true);
        SchedMoe S{(const LAS int*)(lds + UREC_OFF), (const LAS unsigned*)(lds + TBL_OFF), (const char*)(ws + WS_XN3), (const char*)(ws + WS_WGU), 0, (size_t)1024 * 1024 * 2, (size_t)256 * 1024 * 2, true};
        EpiMoeA E{(bf16_t*)(ws + WS_H)};
        pg8::gemm_phase<EpiMoeA, SchedMoe, true, true>(lds + RING_OFF, 1024, S, E);
    }
    SEAM(10);
    if (IN(11)) {
        moe_setup(lds, ws, vcu, G, false);
        SchedMoe S{(const LAS int*)(lds + UREC_OFF), (const LAS unsigned*)(lds + TBL_OFF), (const char*)(ws + WS_H), (const char*)(ws + WS_WD), (size_t)256 * 512 * 2, (size_t)1024 * 512 * 2, (size_t)256 * 512 * 2, false};
        EpiMoeB E{(const LAS int*)(lds + UREC_OFF), (const int*)(ws + WS_LIST), (bf16_t*)(ws + WS_YS)};
        pg8::gemm_phase<EpiMoeB, SchedMoe, true, false>(lds + RING_OFF, 512, S, E);
    }
    SEAM(11);
    if (IN(12)) {
        const bf16_t* ys = (const bf16_t*)(ws + WS_YS);
        for (int m = gw; m < M; m += NGW) final_row(out + (size_t)m * D, ys + (size_t)m * 2048, P.in[26], lane);
    }
#undef IN
#undef SEAM
}
#ifndef OPT_MASK
#define OPT_MASK 0x1FFF
#endif
#ifndef FUSED
#define FUSED 1
#endif
static void launch_mega(const Args& a0, int lo, int hi, int grid, hipStream_t stream) {
    Args a = a0; a.ph_lo = lo; a.ph_hi = hi;
    hipLaunchKernelGGL(mega, dim3(grid), dim3(NWAVES * 64), LDS_BYTES, stream, a);
    const hipError_t le = hipPeekAtLastError();
    if (le != hipSuccess) fprintf(stderr, "kernel_launch: launch [%d,%d) failed: %s\n", lo, hi, hipGetErrorName(le));
}
extern "C" void kernel_launch(void* const* d_in, const int* in_sizes, int n_in, void* d_out, int out_size, void* d_ws, size_t ws_size, hipStream_t stream) {
    static int grid = 0;
    if (grid == 0) {
        if (n_in != 27 || in_sizes[0] != M * D || out_size != M * D || ws_size < WS_END) { fprintf(stderr, "kernel_launch: unexpected problem (n_in %d, in0 %d, out %d, ws %zu)\n", n_in, n_in > 0 ? in_sizes[0] : -1, out_size, ws_size); grid = -1; return; }
        (void)hipFuncSetAttribute((const void*)k_route, hipFuncAttributeMaxDynamicSharedMemorySize, 20 * 1024 * 4 + 4096);
        (void)hipFuncSetAttribute((const void*)nv_sgu, hipFuncAttributeMaxDynamicSharedMemorySize, 128 * 129 * 4 + 1024);
        (void)hipFuncSetAttribute((const void*)nv_attn, hipFuncAttributeMaxDynamicSharedMemorySize, 4 * 64 * 65 * 4);
        (void)hipFuncSetAttribute((const void*)k_prologue, hipFuncAttributeMaxDynamicSharedMemorySize, 8 * 64 * 33 * 4);
        if (hipFuncSetAttribute((const void*)mega, hipFuncAttributeMaxDynamicSharedMemorySize, LDS_BYTES) != hipSuccess) { fprintf(stderr, "kernel_launch: hipFuncSetAttribute(mega) failed\n"); grid = -1; return; }
        int dev = 0, cus = 0, per_cu = 0;
        if (hipGetDevice(&dev) != hipSuccess || hipDeviceGetAttribute(&cus, hipDeviceAttributeMultiprocessorCount, dev) != hipSuccess) { grid = -1; return; }
        if (hipOccupancyMaxActiveBlocksPerMultiprocessor(&per_cu, (const void*)mega, NWAVES * 64, LDS_BYTES) != hipSuccess || per_cu < 1) fprintf(stderr, "kernel_launch: occupancy query says %d blocks per CU\n", per_cu);
        (void)hipGetLastError();
        grid = cus;
    }
    if (grid < 0) return;
    unsigned char* ws = (unsigned char*)d_ws; float* out = (float*)d_out;
    Args a{}; for (int i = 0; i < 27; ++i) a.P.in[i] = (const float*)d_in[i];
    a.out = out; a.ws = ws; a.ph_lo = 0; a.ph_hi = NPHASE;
    const PtrsIn& P = a.P;
    (void)hipMemsetAsync(ws + WS_CTL, 0, CTL_ZERO_BYTES, stream);
#if FUSED
    launch_mega(a, 0, NPHASE, grid, stream);
#else
    float* scr = (float*)(ws + WS_SCR);
    bf16_t* XN = (bf16_t*)(ws + WS_XN);
    for (int ph = 0; ph < NPHASE; ++ph) {
        if ((OPT_MASK >> ph) & 1) { launch_mega(a, ph, ph + 1, grid, stream); continue; }
        switch (ph) {
        case 0: hipLaunchKernelGGL(k_prologue, dim3(256), dim3(512), 8 * 64 * 33 * 4, stream, P, ws); break;
        case 1:
            for (int c = 0; c < M / 4096; ++c) {
                hipLaunchKernelGGL(nv_gemm, dim3(NZ / 64, 4096 / 64), dim3(256), 0, stream, XN + (size_t)c * 4096 * D, D, (const bf16_t*)(ws + WS_WZ), D, D, scr, NZ);
                hipLaunchKernelGGL(nv_z_epi, dim3(4096), dim3(256), 0, stream, (const float*)scr, c * 4096, P, ws); }
            hipLaunchKernelGGL(nv_gemm, dim3(1024 / 64, MMEM / 64), dim3(256), 0, stream, XN + (size_t)M * D, D, (const bf16_t*)(ws + WS_WZ) + (size_t)NZ * D, D, D, scr, 1024);
            hipLaunchKernelGGL(nv_store_bf16, dim3(1024), dim3(256), 0, stream, (const float*)scr, (bf16_t*)(ws + WS_KVC), (size_t)MMEM * 1024, 1.0f);
            break;
        case 2:
            hipLaunchKernelGGL(nv_attn, dim3(SEQ / 64, 8, BATCH), dim3(256), 4 * 64 * 65 * 4, stream, (const bf16_t*)(ws + WS_Q), (const bf16_t*)(ws + WS_K), (const bf16_t*)(ws + WS_V), (bf16_t*)(ws + WS_ATT));
            hipLaunchKernelGGL(nv_sgu, dim3(M / 128, 4), dim3(256), 128 * 129 * 4 + 1024, stream, P, ws);
            break;
        case 3:
            for (int c = 0; c < M / 4096; ++c) { float* c1 = scr; float* c2 = scr + (size_t)4096 * 1024;
                hipLaunchKernelGGL(nv_gemm, dim3(1024 / 64, 64), dim3(256), 0, stream, (const bf16_t*)(ws + WS_ATT) + (size_t)c * 4096 * 512, 512, (const bf16_t*)(ws + WS_WATT), 512, 512, c1, 1024);
                hipLaunchKernelGGL(nv_gemm, dim3(1024 / 64, 64), dim3(256), 0, stream, (const bf16_t*)(ws + WS_SG) + (size_t)c * 4096 * 512, 512, (const bf16_t*)(ws + WS_WSGU), 512, 512, c2, 1024);
                hipLaunchKernelGGL(nv_merge, dim3(2048), dim3(256), 0, stream, (const float*)c1, (const float*)c2, (const bf16_t*)(ws + WS_GA) + (size_t)c * 4096 * 1024, (const bf16_t*)(ws + WS_GB) + (size_t)c * 4096 * 1024,
                                   (bf16_t*)(ws + WS_MERGED) + (size_t)c * 4096 * 1024, (size_t)4096 * 1024); }
            break;
        case 4:
            for (int c = 0; c < M / 4096; ++c) {
                hipLaunchKernelGGL(nv_gemm, dim3(1024 / 64, 64), dim3(256), 0, stream, (const bf16_t*)(ws + WS_MERGED) + (size_t)c * 4096 * 1024, 1024, (const bf16_t*)(ws + WS_WOUT), 1024, 1024, scr, 1024);
                hipLaunchKernelGGL(nv_resid, dim3(2048), dim3(256), 0, stream, P.in[0] + (size_t)c * 4096 * 1024, (const float*)scr, out + (size_t)c * 4096 * 1024, (size_t)4096 * 1024); }
            break;
        case 5: hipLaunchKernelGGL(k_norm_rows, dim3(256), dim3(512), 0, stream, (const float*)out, P.in[13], (bf16_t*)(ws + WS_XN1), M); break;
        case 6:
            for (int c = 0; c < M / 4096; ++c) {
                hipLaunchKernelGGL(nv_gemm, dim3(512 / 64, 64), dim3(256), 0, stream, (const bf16_t*)(ws + WS_XN1) + (size_t)c * 4096 * 1024, 1024, (const bf16_t*)(ws + WS_WCQ), 1024, 1024, scr, 512);
                hipLaunchKernelGGL(nv_store_bf16, dim3(1024), dim3(256), 0, stream, (const float*)scr, (bf16_t*)(ws + WS_QC) + (size_t)c * 4096 * 512, (size_t)4096 * 512, C2_CROSS); }
            break;
        case 7: hipLaunchKernelGGL(nv_cross, dim3(M), dim3(256), 0, stream, (const bf16_t*)(ws + WS_QC), (const bf16_t*)(ws + WS_KVC), (bf16_t*)(ws + WS_OC)); break;
        case 8:
            for (int c = 0; c < M / 4096; ++c) {
                hipLaunchKernelGGL(nv_gemm, dim3(1024 / 64, 64), dim3(256), 0, stream, (const bf16_t*)(ws + WS_OC) + (size_t)c * 4096 * 512, 512, (const bf16_t*)(ws + WS_WCO), 512, 512, scr, 1024);
                hipLaunchKernelGGL(nv_resid, dim3(2048), dim3(256), 0, stream, (const float*)(out + (size_t)c * 4096 * 1024), (const float*)scr, out + (size_t)c * 4096 * 1024, (size_t)4096 * 1024); }
            break;
        case 9: hipLaunchKernelGGL(k_route, dim3(256), dim3(512), 20 * 1024 * 4 + 4096, stream, P, (const float*)out, ws); break;
        case 10: hipLaunchKernelGGL(nv_moe_a, dim3(2 * M), dim3(256), 0, stream, (const bf16_t*)(ws + WS_XN3), ws); break;
        case 11: hipLaunchKernelGGL(nv_moe_b, dim3(2 * M), dim3(256), 0, stream, ws); break;
        case 12: hipLaunchKernelGGL(k_final, dim3(256), dim3(512), 0, stream, out, (const bf16_t*)(ws + WS_YS), P.in[26]); break;
        }
    }
#endif
}
```

```cpp
#include <hip/hip_runtime.h>
#include <cstdio>
#include <cstdint>
#include <cmath>

#ifndef FOLD_GAINS
#define FOLD_GAINS 1
#endif
#ifndef ATT_FIXM
#define ATT_FIXM 1
#endif
#ifndef GATE_U8
#define GATE_U8 1
#endif
#ifndef MERGE_QC_CROSS
#define MERGE_QC_CROSS 1
#endif
#ifndef TAIL_CONV
#define TAIL_CONV 1
#endif
#ifndef ROUTE_MFMA
#define ROUTE_MFMA 1
#endif
#ifndef FOLD_MOE
#define FOLD_MOE ROUTE_MFMA
#endif
#ifndef X2_BF16
#define X2_BF16 1
#endif
#ifndef MOE_CONV_IN_P2
#define MOE_CONV_IN_P2 0
#endif
typedef unsigned short bf16_t;
typedef float f32x4 __attribute__((ext_vector_type(4)));
typedef unsigned u32x4 __attribute__((ext_vector_type(4)));
typedef unsigned u32x2 __attribute__((ext_vector_type(2)));

constexpr int BATCH = 4, SEQ = 8192, D = 1024, M = BATCH * SEQ;
constexpr int NMEM = 256, MMEM = BATCH * NMEM;
constexpr int NZ = 3840;
constexpr int ZQ = 0, ZK = 512, ZV = 640, ZSU = 768, ZSV = 1280, ZGA = 1792, ZGB = 2816;
constexpr int NE = 16, DE = 512;
constexpr float EPS = 1e-6f;
constexpr float LOG2E = 1.4426950408889634f;
constexpr float C2_SELF = 0.125f * LOG2E;
constexpr float C2_CROSS = 0.08838834764831845f * LOG2E;
constexpr int LIST_CAP = 32768;

constexpr size_t MiB = 1u << 20;
constexpr size_t WS_CTL = 0, CTL_ZERO_BYTES = 64 * 1024;
constexpr size_t WS_TAB = 512 * 1024;
constexpr size_t WS_WZ = 1 * MiB;
constexpr size_t WS_WATT = 11 * MiB, WS_WSGU = 12 * MiB, WS_WOUT = 13 * MiB, WS_WCQ = 15 * MiB, WS_WCO = 16 * MiB, WS_WSS = 17 * MiB;
constexpr size_t WS_WGU = 18 * MiB;
constexpr size_t WS_WD = 50 * MiB;
constexpr size_t WS_XN = 68 * MiB;
constexpr size_t WS_MERGED = 248 * MiB;
constexpr size_t WS_GSCR = 312 * MiB;
constexpr size_t WS_XN3 = 68 * MiB;
constexpr size_t WS_KVC = 134 * MiB;
constexpr size_t WS_Q = 136 * MiB, WS_K = 168 * MiB, WS_V = 176 * MiB, WS_U = 184 * MiB, WS_GV = 216 * MiB, WS_GA = 248 * MiB, WS_GB = 312 * MiB;
constexpr size_t WS_ATT = 376 * MiB, WS_SG = 408 * MiB;
constexpr size_t WS_XN1 = 136 * MiB;
constexpr size_t WS_SSQ1 = 132 * MiB;
constexpr size_t WS_QC = 376 * MiB, WS_OC = 408 * MiB;
constexpr size_t WS_LIST = 200 * MiB;
constexpr size_t WS_RSTOK = 205 * MiB;
constexpr size_t WS_TOKINFO = 204 * MiB;
constexpr size_t WS_YS = 208 * MiB;
constexpr size_t WS_H = 336 * MiB;
constexpr size_t WS_SCR = 440 * MiB;
constexpr size_t WS_END = 504 * MiB;
constexpr int CW_TMO = 0, CW_BAR = 4096, CW_ECNT = 8192;

__host__ __device__ __forceinline__ float bf2f(bf16_t b) { union { unsigned u; float f; } c; c.u = ((unsigned)b) << 16; return c.f; }
__host__ __device__ __forceinline__ unsigned f2bf(float f) { union { unsigned u; float f; } c; c.f = f; unsigned u = c.u; return (u + 0x7fffu + ((u >> 16) & 1u)) >> 16; }
__device__ __forceinline__ unsigned pk2(float lo, float hi) { return f2bf(lo) | (f2bf(hi) << 16); }
__device__ __forceinline__ float wave_sum(float v) {
#pragma unroll
    for (int o = 1; o < 64; o <<= 1) v += __shfl_xor(v, o);
    return v;
}
__device__ __forceinline__ float wave_max(float v) {
#pragma unroll
    for (int o = 1; o < 64; o <<= 1) v = fmaxf(v, __shfl_xor(v, o));
    return v;
}
__device__ __forceinline__ float gelu_tanh(float x) { const float u = 0.7978845608028654f * (x + 0.044715f * x * x * x); return x / (1.0f + __builtin_amdgcn_exp2f(-2.0f * LOG2E * u)); }
__device__ __forceinline__ float sigmoidf_(float x) { return 1.0f / (1.0f + __builtin_amdgcn_exp2f(-LOG2E * x)); }

__host__ __device__ __forceinline__ int z_phys(int c) {
    if (c < 512) { const int h = c >> 6, d = c & 63; return (h >> 2) * 256 + (d >> 5) * 128 + (h & 3) * 32 + (d & 31); }
    if (c < 768) { const int cc = c - 512, w = cc >> 6, d = cc & 63; return 512 + (d >> 5) * 128 + w * 32 + (d & 31); }
    return c;
}

#define LAS __attribute__((address_space(3)))
__device__ __forceinline__ void p0_transpose_item(const float* W, int K, int N, bf16_t* WT, int mode, int row_off, LAS float* scr, int item, int lane, const float* gk = nullptr) {
    const int nblk = N / 32, kb = item / nblk, nb = item % nblk, k0 = 64 * kb, n0 = 32 * nb;
    float tv[32];
#pragma unroll
    for (int i = 0; i < 32; ++i) tv[i] = W[(size_t)(k0 + 2 * i + (lane >> 5)) * N + n0 + (lane & 31)];
    if (gk) {
#pragma unroll
        for (int i = 0; i < 32; ++i) tv[i] *= gk[k0 + 2 * i + (lane >> 5)]; }
#pragma unroll
    for (int i = 0; i < 32; ++i) scr[(2 * i + (lane >> 5)) * 33 + (lane & 31)] = tv[i];
    __builtin_amdgcn_s_waitcnt(0xC07F); asm volatile("" ::: "memory");
    const int c = lane & 7;
#pragma unroll
    for (int j = 0; j < 4; ++j) { const int n = (lane >> 3) + 8 * j; const LAS float* s = scr + (8 * c) * 33 + n;
        u32x4 o; o.x = pk2(s[0 * 33], s[1 * 33]); o.y = pk2(s[2 * 33], s[3 * 33]); o.z = pk2(s[4 * 33], s[5 * 33]); o.w = pk2(s[6 * 33], s[7 * 33]);
        const int nl = n0 + n; int row;
        if (mode == 0) row = row_off + nl; else if (mode == 1) row = z_phys(nl); else if (mode == 2) row = 256 * (nl >> 7) + (nl & 127); else row = 256 * (nl >> 7) + 128 + (nl & 127);
        *(u32x4*)(WT + (size_t)row * K + k0 + 8 * c) = o; }
    __builtin_amdgcn_s_waitcnt(0xC07F); asm volatile("" ::: "memory");
}
struct PtrsIn { const float* in[27]; };
constexpr int IT_WIN = 16 * 120, IT_CKV = 16 * 32, IT_ATT = 8 * 32, IT_SGU = 8 * 32, IT_OUT = 16 * 32, IT_CQ = 16 * 16, IT_CO = 8 * 32, IT_G = 16 * 16, IT_DN = 8 * 32;
constexpr int IT_P0 = IT_WIN + IT_CKV + IT_ATT + IT_SGU + IT_OUT + IT_CQ + IT_CO;
constexpr int IT_TOTAL = IT_P0 + NE * (2 * IT_G + IT_DN);
__device__ __forceinline__ void p0_weight_item(const PtrsIn& P, unsigned char* ws, LAS float* scr, int it, int lane) {
    int r = it;
    bf16_t* WZ = (bf16_t*)(ws + WS_WZ);
    if (r < IT_WIN) { p0_transpose_item(P.in[3], 1024, NZ, WZ, 1, 0, scr, r, lane); return; } r -= IT_WIN;
    if (r < IT_CKV) { p0_transpose_item(P.in[16], 1024, 1024, WZ, 0, NZ, scr, r, lane); return; } r -= IT_CKV;
    if (r < IT_ATT) { p0_transpose_item(P.in[6], 512, 1024, (bf16_t*)(ws + WS_WATT), 0, 0, scr, r, lane); return; } r -= IT_ATT;
    if (r < IT_SGU) { p0_transpose_item(P.in[11], 512, 1024, (bf16_t*)(ws + WS_WSGU), 0, 0, scr, r, lane); return; } r -= IT_SGU;
    if (r < IT_OUT) { p0_transpose_item(P.in[12], 1024, 1024, (bf16_t*)(ws + WS_WOUT), 0, 0, scr, r, lane); return; } r -= IT_OUT;
    if (r < IT_CQ) { p0_transpose_item(P.in[15], 1024, 512, (bf16_t*)(ws + WS_WCQ), 0, 0, scr, r, lane, FOLD_GAINS ? P.in[13] : nullptr); return; } r -= IT_CQ;
    if (r < IT_CO) { p0_transpose_item(P.in[17], 512, 1024, (bf16_t*)(ws + WS_WCO), 0, 0, scr, r, lane); return; } r -= IT_CO;
    const int per = 2 * IT_G + IT_DN, e = r / per; r -= e * per;
    if (r < IT_G) { p0_transpose_item(P.in[23] + (size_t)e * 1024 * 512, 1024, 512, (bf16_t*)(ws + WS_WGU) + (size_t)e * 1024 * 1024, 2, 0, scr, r, lane, FOLD_MOE ? P.in[18] : nullptr); return; } r -= IT_G;
    if (r < IT_G) { p0_transpose_item(P.in[24] + (size_t)e * 1024 * 512, 1024, 512, (bf16_t*)(ws + WS_WGU) + (size_t)e * 1024 * 1024, 3, 0, scr, r, lane, FOLD_MOE ? P.in[18] : nullptr); return; } r -= IT_G;
    p0_transpose_item(P.in[25] + (size_t)e * 512 * 1024, 512, 1024, (bf16_t*)(ws + WS_WD) + (size_t)e * 1024 * 512, 0, 0, scr, r, lane);
}
struct Row4 { f32x4 v[4]; };
__device__ __forceinline__ Row4 row_load(const float* xrow, int lane) { Row4 r; const f32x4* xr = (const f32x4*)xrow + lane;
#pragma unroll
    for (int j = 0; j < 4; ++j) r.v[j] = xr[64 * j];
    return r; }
__device__ __forceinline__ void rms_row_store(const Row4& r, const float* g, bf16_t* orow, int lane) {
    const f32x4* gr = (const f32x4*)g + lane; float s = 0.f;
#pragma unroll
    for (int j = 0; j < 4; ++j) s += (r.v[j].x * r.v[j].x + r.v[j].y * r.v[j].y) + (r.v[j].z * r.v[j].z + r.v[j].w * r.v[j].w);
    const float rs = 1.0f / sqrtf(wave_sum(s) * (1.f / 1024.f) + EPS);
    unsigned long long* o8 = (unsigned long long*)orow + lane;
#pragma unroll
    for (int j = 0; j < 4; ++j) { const f32x4 gg = gr[64 * j]; o8[64 * j] = (unsigned long long)pk2(r.v[j].x * rs * gg.x, r.v[j].y * rs * gg.y) | ((unsigned long long)pk2(r.v[j].z * rs * gg.z, r.v[j].w * rs * gg.w) << 32); }
}
__device__ __forceinline__ void rms_rows(const float* x, const float* g, bf16_t* o, int first, int step, int rows, int lane) {
    if (first >= rows) return;
    const int last = first + ((rows - 1 - first) / step) * step;
    Row4 r0 = row_load(x + (size_t)first * D, lane);
    Row4 r1 = row_load(x + (size_t)((first + step <= last) ? first + step : last) * D, lane);
    for (int m = first; m < rows; m += step) { const int m2 = (m + 2 * step <= last) ? m + 2 * step : last;
        const Row4 r2 = row_load(x + (size_t)m2 * D, lane);
        rms_row_store(r0, g, o + (size_t)m * D, lane); r0 = r1; r1 = r2; }
}
__device__ __forceinline__ void rms_row_to_bf16(const float* xrow, const float* g, bf16_t* orow, int lane) {
    const f32x4* xr = (const f32x4*)xrow + lane; const f32x4* gr = (const f32x4*)g + lane;
    f32x4 v[4]; float s = 0.f;
#pragma unroll
    for (int j = 0; j < 4; ++j) { v[j] = xr[64 * j]; s += (v[j].x * v[j].x + v[j].y * v[j].y) + (v[j].z * v[j].z + v[j].w * v[j].w); }
    const float rs = 1.0f / sqrtf(wave_sum(s) * (1.f / 1024.f) + EPS);
    unsigned long long* o8 = (unsigned long long*)orow + lane;
#pragma unroll
    for (int j = 0; j < 4; ++j) { const f32x4 gg = gr[64 * j]; o8[64 * j] = (unsigned long long)pk2(v[j].x * rs * gg.x, v[j].y * rs * gg.y) | ((unsigned long long)pk2(v[j].z * rs * gg.z, v[j].w * rs * gg.w) << 32); }
}
__device__ __forceinline__ void rope_table_entry(float* tab, int idx) {
    const int pos = idx >> 4, i = idx & 15;
    const float inv = exp2f(-(float)i * (13.287712379549449f / 16.0f));
    const float ang = (float)pos * inv;
    float s, c; sincosf(ang, &s, &c);
    tab[0 * 2048 + idx] = c; tab[1 * 2048 + idx] = s; tab[2 * 2048 + idx] = c; tab[3 * 2048 + idx] = s;
}

__device__ __forceinline__ void route_decide(const float (&lg)[20], const float* b_rg, const float* b_re, int& e0, int& e1, float& w0, float& w1) {
    float g0 = lg[0] + b_rg[0], g1 = lg[1] + b_rg[1], g2 = lg[2] + b_rg[2], g3 = lg[3] + b_rg[3];
    int gi = 0; float gm = g0; if (g1 > gm) { gm = g1; gi = 1; } if (g2 > gm) { gm = g2; gi = 2; } if (g3 > gm) { gm = g3; gi = 3; }
    const float gval = 1.0f / (expf(g0 - gm) + expf(g1 - gm) + expf(g2 - gm) + expf(g3 - gm));
    float ev[4];
#pragma unroll
    for (int j = 0; j < 4; ++j) { float t = 0.f;
#pragma unroll
        for (int g = 0; g < 4; ++g) t = (gi == g) ? (lg[4 + 4 * g + j] + b_re[4 * g + j]) : t;
        ev[j] = t; }
    int i0 = 0; float m0 = ev[0];
#pragma unroll
    for (int j = 1; j < 4; ++j) if (ev[j] > m0) { m0 = ev[j]; i0 = j; }
    int i1 = -1; float m1 = -INFINITY;
#pragma unroll
    for (int j = 0; j < 4; ++j) if (j != i0 && ev[j] > m1) { m1 = ev[j]; i1 = j; }
    const float p1 = expf(m1 - m0), den = 1.0f / (1.0f + p1);
    e0 = gi * 4 + i0; e1 = gi * 4 + i1; w0 = den * gval; w1 = p1 * den * gval;
}
template <class RW> __device__ __forceinline__ void route_token(const Row4& xin, const float* gmoe, RW rw, const float* b_rg, const float* b_re, bf16_t* orow, int lane, int& e0, int& e1, float& w0, float& w1) {
    const f32x4* gr = (const f32x4*)gmoe + lane;
    f32x4 v[4]; float s = 0.f;
#pragma unroll
    for (int j = 0; j < 4; ++j) { v[j] = xin.v[j]; s += (v[j].x * v[j].x + v[j].y * v[j].y) + (v[j].z * v[j].z + v[j].w * v[j].w); }
    const float rs = 1.0f / sqrtf(wave_sum(s) * (1.f / 1024.f) + EPS);
    unsigned long long* o8 = (unsigned long long*)orow + lane;
#pragma unroll
    for (int j = 0; j < 4; ++j) { const f32x4 gg = gr[64 * j]; v[j].x *= rs * gg.x; v[j].y *= rs * gg.y; v[j].z *= rs * gg.z; v[j].w *= rs * gg.w;
        o8[64 * j] = (unsigned long long)pk2(v[j].x, v[j].y) | ((unsigned long long)pk2(v[j].z, v[j].w) << 32); }
    float lg[20];
#pragma unroll
    for (int o = 0; o < 20; ++o) { auto wr = rw + o * 1024 + 4 * lane; float a = 0.f;
#pragma unroll
        for (int j = 0; j < 4; ++j) { const float w0_ = wr[256 * j], w1_ = wr[256 * j + 1], w2_ = wr[256 * j + 2], w3_ = wr[256 * j + 3]; a += (v[j].x * w0_ + v[j].y * w1_) + (v[j].z * w2_ + v[j].w * w3_); }
        lg[o] = wave_sum(a); }
    route_decide(lg, b_rg, b_re, e0, e1, w0, w1);
}
__device__ __forceinline__ void final_row(float* orow, const bf16_t* ys2, const float* g, int lane) {
    f32x4* xr = (f32x4*)orow + lane; const f32x4* gr = (const f32x4*)g + lane;
    const u32x2* y0 = (const u32x2*)ys2 + lane; const u32x2* y1 = (const u32x2*)(ys2 + 1024) + lane;
    f32x4 v[4]; float s = 0.f;
#pragma unroll
    for (int j = 0; j < 4; ++j) { v[j] = xr[64 * j]; const u32x2 a = y0[64 * j], b = y1[64 * j];
        v[j].x += bf2f((bf16_t)(a.x & 0xffff)) + bf2f((bf16_t)(b.x & 0xffff)); v[j].y += bf2f((bf16_t)(a.x >> 16)) + bf2f((bf16_t)(b.x >> 16));
        v[j].z += bf2f((bf16_t)(a.y & 0xffff)) + bf2f((bf16_t)(b.y & 0xffff)); v[j].w += bf2f((bf16_t)(a.y >> 16)) + bf2f((bf16_t)(b.y >> 16));
        s += (v[j].x * v[j].x + v[j].y * v[j].y) + (v[j].z * v[j].z + v[j].w * v[j].w); }
    const float rs = 1.0f / sqrtf(wave_sum(s) * (1.f / 1024.f) + EPS);
#pragma unroll
    for (int j = 0; j < 4; ++j) { const f32x4 gg = gr[64 * j]; f32x4 o; o.x = v[j].x * rs * gg.x; o.y = v[j].y * rs * gg.y; o.z = v[j].z * rs * gg.z; o.w = v[j].w * rs * gg.w; xr[64 * j] = o; }
}

struct RowF { f32x4 v[4]; u32x2 a[4], b[4]; };
__device__ __forceinline__ RowF rowf_load(const float* orow, const bf16_t* ys2, int lane) { RowF r; const f32x4* xr = (const f32x4*)orow + lane; const u32x2* y0 = (const u32x2*)ys2 + lane; const u32x2* y1 = (const u32x2*)(ys2 + 1024) + lane;
#pragma unroll
    for (int j = 0; j < 4; ++j) { r.v[j] = xr[64 * j]; r.a[j] = y0[64 * j]; r.b[j] = y1[64 * j]; }
    return r; }
__device__ __forceinline__ void rowf_store(const RowF& r, float* orow, const float* g, int lane) {
    f32x4* xr = (f32x4*)orow + lane; const f32x4* gr = (const f32x4*)g + lane; f32x4 v[4]; float s = 0.f;
#pragma unroll
    for (int j = 0; j < 4; ++j) { v[j] = r.v[j]; const u32x2 a = r.a[j], b = r.b[j];
        v[j].x += __uint_as_float(a.x << 16) + __uint_as_float(b.x << 16); v[j].y += __uint_as_float(a.x & 0xffff0000u) + __uint_as_float(b.x & 0xffff0000u);
        v[j].z += __uint_as_float(a.y << 16) + __uint_as_float(b.y << 16); v[j].w += __uint_as_float(a.y & 0xffff0000u) + __uint_as_float(b.y & 0xffff0000u);
        s += (v[j].x * v[j].x + v[j].y * v[j].y) + (v[j].z * v[j].z + v[j].w * v[j].w); }
    const float rs = 1.0f / sqrtf(wave_sum(s) * (1.f / 1024.f) + EPS);
#pragma unroll
    for (int j = 0; j < 4; ++j) { const f32x4 gg = gr[64 * j]; f32x4 o; o.x = v[j].x * rs * gg.x; o.y = v[j].y * rs * gg.y; o.z = v[j].z * rs * gg.z; o.w = v[j].w * rs * gg.w; xr[64 * j] = o; }
}
__device__ __forceinline__ RowF rowf_load_b(const bf16_t* xb, const bf16_t* ys2, int lane) { RowF r; const u32x2* xr = (const u32x2*)xb + lane; const u32x2* y0 = (const u32x2*)ys2 + lane; const u32x2* y1 = (const u32x2*)(ys2 + 1024) + lane;
#pragma unroll
    for (int j = 0; j < 4; ++j) { const u32x2 q = xr[64 * j]; r.v[j] = (f32x4){__uint_as_float(q.x << 16), __uint_as_float(q.x & 0xffff0000u), __uint_as_float(q.y << 16), __uint_as_float(q.y & 0xffff0000u)}; r.a[j] = y0[64 * j]; r.b[j] = y1[64 * j]; }
    return r; }
__device__ __forceinline__ void final_rows_b(float* out, const bf16_t* xb, const bf16_t* ys, const float* g, int first, int step, int rows, int lane) {
    if (first >= rows) return;
    RowF cur = rowf_load_b(xb + (size_t)first * D, ys + (size_t)first * 2048, lane);
    for (int m = first; m < rows; m += step) { const int mn = (m + step < rows) ? m + step : m;
        const RowF nxt = rowf_load_b(xb + (size_t)mn * D, ys + (size_t)mn * 2048, lane);
        rowf_store(cur, out + (size_t)m * D, g, lane); cur = nxt; }
}
__device__ __forceinline__ void final_rows(float* out, const bf16_t* ys, const float* g, int first, int step, int rows, int lane) {
    if (first >= rows) return;
    RowF cur = rowf_load(out + (size_t)first * D, ys + (size_t)first * 2048, lane);
    for (int m = first; m < rows; m += step) { const int mn = (m + step < rows) ? m + step : m;
        const RowF nxt = rowf_load(out + (size_t)mn * D, ys + (size_t)mn * 2048, lane);
        rowf_store(cur, out + (size_t)m * D, g, lane); cur = nxt; }
}

__global__ void __launch_bounds__(512) k_prologue(PtrsIn P, unsigned char* ws) {
    extern __shared__ __attribute__((aligned(16))) unsigned char dyn[];
    const int tid = threadIdx.x, lane = tid & 63, wave = tid >> 6;
    const int gw = blockIdx.x * 8 + wave, NGW = gridDim.x * 8;
    LAS float* scr = (LAS float*)dyn + wave * 64 * 33;
    for (int it = gw; it < IT_TOTAL; it += NGW) p0_weight_item(P, ws, scr, it, lane);
    { const float* wsrc = P.in[9]; bf16_t* wd = (bf16_t*)(ws + WS_WSS);
      for (int i = blockIdx.x * 512 + tid; i < 4 * 128 * 128; i += gridDim.x * 512) wd[i] = (bf16_t)f2bf(wsrc[i]); }
    for (int i = blockIdx.x * 512 + tid; i < 2048; i += gridDim.x * 512) rope_table_entry((float*)(ws + WS_TAB), i);
    bf16_t* XN = (bf16_t*)(ws + WS_XN);
    for (int m = gw; m < M; m += NGW) rms_row_to_bf16(P.in[0] + (size_t)m * D, P.in[2], XN + (size_t)m * D, lane);
    for (int m = gw; m < MMEM; m += NGW) rms_row_to_bf16(P.in[1] + (size_t)m * D, P.in[14], XN + (size_t)(M + m) * D, lane);
}
__global__ void __launch_bounds__(512) k_norm_rows(const float* x, const float* g, bf16_t* o, int rows) {
    const int lane = threadIdx.x & 63, gw = blockIdx.x * 8 + (threadIdx.x >> 6), NGW = gridDim.x * 8;
    for (int m = gw; m < rows; m += NGW) rms_row_to_bf16(x + (size_t)m * D, g, o + (size_t)m * D, lane);
}
__global__ void __launch_bounds__(512) k_route(PtrsIn P, const float* x2, unsigned char* ws) {
    extern __shared__ __attribute__((aligned(16))) unsigned char dyn[];
    float* rw = (float*)dyn;
    int* te = (int*)(dyn + 20 * 1024 * 4);
    float* tw = (float*)(te + 256);
    int* tp = (int*)(tw + 256);
    int* ebase = tp + 256;
    const int tid = threadIdx.x, lane = tid & 63, wave = tid >> 6;
    for (int i = tid; i < 1024 * 4; i += 512) { const int k = i >> 2, o = i & 3; rw[o * 1024 + k] = P.in[19][i]; }
    for (int i = tid; i < 1024 * 16; i += 512) { const int k = i >> 4, o = i & 15; rw[(4 + o) * 1024 + k] = P.in[21][i]; }
    __syncthreads();
    bf16_t* XN3 = (bf16_t*)(ws + WS_XN3);
    const int t0 = blockIdx.x * 128;
    for (int i = 0; i < 16; ++i) { const int tl = wave * 16 + i, t = t0 + tl; int e0, e1; float w0, w1;
        route_token(row_load(x2 + (size_t)t * D, lane), P.in[18], rw, P.in[20], P.in[22], XN3 + (size_t)t * D, lane, e0, e1, w0, w1);
        if (lane == 0) { te[2 * tl] = e0; te[2 * tl + 1] = e1; tw[2 * tl] = w0; tw[2 * tl + 1] = w1; } }
    __syncthreads();
    if (wave == 0) {
        int cnt = 0;
        int mye[4]; for (int j = 0; j < 4; ++j) mye[j] = te[j * 64 + lane];
        int pos[4] = {0, 0, 0, 0};
        for (int e = 0; e < 16; ++e) { int run = 0;
            for (int j = 0; j < 4; ++j) { const unsigned long long mk = __ballot(mye[j] == e); const int before = __popcll(mk & ((1ull << lane) - 1ull));
                if (mye[j] == e) pos[j] = run + before; run += __popcll(mk); }
            if (lane == e) cnt = run; }
        for (int j = 0; j < 4; ++j) tp[j * 64 + lane] = pos[j];
        if (lane < 16) { unsigned* ec = (unsigned*)(ws + WS_CTL) + CW_ECNT + 64 * lane; ebase[lane] = (int)atomicAdd(ec, (unsigned)cnt); }
    }
    __syncthreads();
    if (tid < 256) { const int e = te[tid], slot = ebase[e] + tp[tid], dest = (t0 * 2) + tid; const float w = tw[tid];
        int* lst = (int*)(ws + WS_LIST) + ((size_t)e * LIST_CAP + slot) * 2; lst[0] = dest; lst[1] = __float_as_int(w);
        int* ti = (int*)(ws + WS_TOKINFO) + (size_t)dest * 2; ti[0] = e; ti[1] = __float_as_int(w); }
}
__global__ void __launch_bounds__(512) k_final(float* out, const bf16_t* ys, const float* g) {
    const int lane = threadIdx.x & 63, gw = blockIdx.x * 8 + (threadIdx.x >> 6), NGW = gridDim.x * 8;
    for (int m = gw; m < M; m += NGW) final_row(out + (size_t)m * D, ys + (size_t)m * 2048, g, lane);
}

__global__ void __launch_bounds__(256) nv_gemm(const bf16_t* A, int lda, const bf16_t* Bt, int ldb, int K, float* C, int ldc) {
    __shared__ __attribute__((aligned(16))) float As[16][68], Bs[16][68];
    const int tid = threadIdx.x, tx = tid & 15, ty = tid >> 4, r0 = blockIdx.y * 64, n0 = blockIdx.x * 64, lr = tid >> 2, lk = (tid & 3) * 4;
    float acc[4][4];
#pragma unroll
    for (int i = 0; i < 4; ++i)
#pragma unroll
        for (int j = 0; j < 4; ++j) acc[i][j] = 0.f;
    for (int k0 = 0; k0 < K; k0 += 16) {
        const u32x2 av = *(const u32x2*)(A + (size_t)(r0 + lr) * lda + k0 + lk), bv = *(const u32x2*)(Bt + (size_t)(n0 + lr) * ldb + k0 + lk);
        As[lk + 0][lr] = bf2f((bf16_t)(av.x & 0xffff)); As[lk + 1][lr] = bf2f((bf16_t)(av.x >> 16)); As[lk + 2][lr] = bf2f((bf16_t)(av.y & 0xffff)); As[lk + 3][lr] = bf2f((bf16_t)(av.y >> 16));
        Bs[lk + 0][lr] = bf2f((bf16_t)(bv.x & 0xffff)); Bs[lk + 1][lr] = bf2f((bf16_t)(bv.x >> 16)); Bs[lk + 2][lr] = bf2f((bf16_t)(bv.y & 0xffff)); Bs[lk + 3][lr] = bf2f((bf16_t)(bv.y >> 16));
        __syncthreads();
#pragma unroll
        for (int kk = 0; kk < 16; ++kk) { const f32x4 a = *(const f32x4*)&As[kk][ty * 4], b = *(const f32x4*)&Bs[kk][tx * 4];
#pragma unroll
            for (int i = 0; i < 4; ++i)
#pragma unroll
                for (int j = 0; j < 4; ++j) acc[i][j] += a[i] * b[j]; }
        __syncthreads();
    }
#pragma unroll
    for (int i = 0; i < 4; ++i) { f32x4 o = {acc[i][0], acc[i][1], acc[i][2], acc[i][3]}; *(f32x4*)(C + (size_t)(r0 + ty * 4 + i) * ldc + n0 + tx * 4) = o; }
}
__global__ void __launch_bounds__(256) nv_z_epi(const float* Cz, int row0, PtrsIn P, unsigned char* ws) {
    const int tid = threadIdx.x, lane = tid & 63, wave = tid >> 6;
    const int rl = blockIdx.x, row = row0 + rl, t = row % SEQ, rid = t >> 6, cid = t & 63;
    const float* z = Cz + (size_t)rl * NZ; const float* tab = (const float*)(ws + WS_TAB);
    if (wave == 0) {
        for (int hh = 0; hh < 10; ++hh) {
            const int c = (hh < 8) ? hh * 64 + lane : 512 + (hh - 8) * 64 + lane;
            const float v = z[z_phys(c)]; const float ss = wave_sum(v * v); const float rs = 1.0f / sqrtf(ss * (1.f / 64.f) + EPS);
            const float g = (hh < 8) ? P.in[4][lane] : P.in[5][lane];
            const float y = v * rs * g, yp = __shfl_xor(y, 1);
            const int i = lane >> 1; const float cs = (i < 16) ? tab[0 * 2048 + rid * 16 + i] : tab[2 * 2048 + cid * 16 + (i - 16)], sn = (i < 16) ? tab[1 * 2048 + rid * 16 + i] : tab[3 * 2048 + cid * 16 + (i - 16)];
            const float o = (lane & 1) ? (yp * sn + y * cs) : (y * cs - yp * sn);
            if (hh < 8) ((bf16_t*)(ws + WS_Q))[(size_t)row * 512 + hh * 64 + lane] = (bf16_t)f2bf(o * C2_SELF);
            else ((bf16_t*)(ws + WS_K))[(size_t)row * 128 + (hh - 8) * 64 + lane] = (bf16_t)f2bf(o);
        }
        for (int c = lane; c < 128; c += 64) ((bf16_t*)(ws + WS_V))[(size_t)row * 128 + c] = (bf16_t)f2bf(z[z_phys(ZV + c)]);
    } else {
        for (int c = tid - 64; c < 512; c += 192) { ((bf16_t*)(ws + WS_U))[(size_t)row * 512 + c] = (bf16_t)f2bf(gelu_tanh(z[ZSU + c])); ((bf16_t*)(ws + WS_GV))[(size_t)row * 512 + c] = (bf16_t)f2bf(gelu_tanh(z[ZSV + c])); }
        for (int c = tid - 64; c < 1024; c += 192) { ((bf16_t*)(ws + WS_GA))[(size_t)row * 1024 + c] = (bf16_t)f2bf(sigmoidf_(z[ZGA + c])); ((bf16_t*)(ws + WS_GB))[(size_t)row * 1024 + c] = (bf16_t)f2bf(sigmoidf_(z[ZGB + c])); }
    }
}
__global__ void __launch_bounds__(256) nv_store_bf16(const float* C, bf16_t* O, size_t n, float scale) {
    for (size_t i = (size_t)blockIdx.x * 256 + threadIdx.x; i < n; i += (size_t)gridDim.x * 256) O[i] = (bf16_t)f2bf(C[i] * scale);
}
__global__ void __launch_bounds__(256) nv_attn(const bf16_t* Q, const bf16_t* Kb, const bf16_t* Vb, bf16_t* O) {
    extern __shared__ __attribute__((aligned(16))) unsigned char dyn[];
    float (*Qs)[65] = (float (*)[65])dyn; float (*Ks)[65] = Qs + 64; float (*Vs)[65] = Ks + 64; float (*Ps)[65] = Vs + 64;
    const int tid = threadIdx.x, tx = tid & 15, ty = tid >> 4, qb = blockIdx.x, h = blockIdx.y, b = blockIdx.z, kvh = h >> 2;
    const int lr = tid >> 2, lc = (tid & 3) * 16;
    { const bf16_t* src = Q + ((size_t)(b * SEQ + qb * 64 + lr)) * 512 + h * 64 + lc;
      for (int j = 0; j < 16; ++j) Qs[lr][lc + j] = bf2f(src[j]); }
    float m[4], l[4], o[4][4];
    for (int i = 0; i < 4; ++i) { m[i] = -1e30f; l[i] = 0.f; for (int j = 0; j < 4; ++j) o[i][j] = 0.f; }
    for (int kt = 0; kt < SEQ / 64; ++kt) {
        __syncthreads();
        { const bf16_t* ks = Kb + ((size_t)(b * SEQ + kt * 64 + lr)) * 128 + kvh * 64 + lc; const bf16_t* vs = Vb + ((size_t)(b * SEQ + kt * 64 + lr)) * 128 + kvh * 64 + lc;
          for (int j = 0; j < 16; ++j) { Ks[lr][lc + j] = bf2f(ks[j]); Vs[lr][lc + j] = bf2f(vs[j]); } }
        __syncthreads();
        float s[4][4];
        for (int i = 0; i < 4; ++i) for (int j = 0; j < 4; ++j) s[i][j] = 0.f;
        for (int d = 0; d < 64; ++d) { float a[4], bb[4];
            for (int i = 0; i < 4; ++i) { a[i] = Qs[ty * 4 + i][d]; bb[i] = Ks[tx * 4 + i][d]; }
            for (int i = 0; i < 4; ++i) for (int j = 0; j < 4; ++j) s[i][j] += a[i] * bb[j]; }
        for (int i = 0; i < 4; ++i) {
            float rm = fmaxf(fmaxf(s[i][0], s[i][1]), fmaxf(s[i][2], s[i][3]));
            for (int x = 1; x < 16; x <<= 1) rm = fmaxf(rm, __shfl_xor(rm, x));
            const float mn = fmaxf(m[i], rm), al = __builtin_amdgcn_exp2f(m[i] - mn);
            float rsum = 0.f;
            for (int j = 0; j < 4; ++j) { const float p = __builtin_amdgcn_exp2f(s[i][j] - mn); Ps[ty * 4 + i][tx * 4 + j] = p; rsum += p; }
            for (int x = 1; x < 16; x <<= 1) rsum += __shfl_xor(rsum, x);
            l[i] = l[i] * al + rsum; m[i] = mn;
            for (int j = 0; j < 4; ++j) o[i][j] *= al;
        }
        __syncthreads();
        for (int c = 0; c < 64; ++c) { float p[4], v[4];
            for (int i = 0; i < 4; ++i) { p[i] = Ps[ty * 4 + i][c]; v[i] = Vs[c][tx * 4 + i]; }
            for (int i = 0; i < 4; ++i) for (int j = 0; j < 4; ++j) o[i][j] += p[i] * v[j]; }
    }
    for (int i = 0; i < 4; ++i) { const float il = 1.0f / l[i]; bf16_t* dst = O + ((size_t)(b * SEQ + qb * 64 + ty * 4 + i)) * 512 + h * 64 + tx * 4;
        for (int j = 0; j < 4; ++j) dst[j] = (bf16_t)f2bf(o[i][j] * il); }
}
__global__ void __launch_bounds__(256) nv_sgu(PtrsIn P, unsigned char* ws) {
    extern __shared__ __attribute__((aligned(16))) unsigned char dyn[];
    float* vn = (float*)dyn;
    float* mu = vn + 128 * 129; float* rstd = mu + 128;
    const int tid = threadIdx.x, lane = tid & 63, wave = tid >> 6, ch = blockIdx.x, g = blockIdx.y;
    const bf16_t* GV = (const bf16_t*)(ws + WS_GV) + (size_t)ch * 128 * 512;
    for (int r = wave * 32; r < wave * 32 + 32; ++r) { float s = 0.f;
        float xv[8]; for (int j = 0; j < 8; ++j) { xv[j] = bf2f(GV[(size_t)r * 512 + j * 64 + lane]); s += xv[j]; }
        const float mean = wave_sum(s) * (1.f / 512.f); float q = 0.f;
        for (int j = 0; j < 8; ++j) { const float d = xv[j] - mean; q += d * d; }
        const float var = wave_sum(q) * (1.f / 512.f);
        if (lane == 0) { mu[r] = mean; rstd[r] = 1.0f / sqrtf(var + EPS); } }
    __syncthreads();
    for (int i = tid; i < 128 * 128; i += 256) { const int q = i >> 7, c = i & 127, cg = g * 128 + c;
        vn[q * 129 + c] = (bf2f(GV[(size_t)q * 512 + cg]) - mu[q]) * rstd[q] * P.in[7][cg] + P.in[8][cg]; }
    __syncthreads();
    const bf16_t* W = (const bf16_t*)(ws + WS_WSS) + (size_t)g * 128 * 128;
    const bf16_t* U = (const bf16_t*)(ws + WS_U) + (size_t)ch * 128 * 512; bf16_t* SG = (bf16_t*)(ws + WS_SG) + (size_t)ch * 128 * 512;
    const int c = tid & 127;
    for (int p = tid >> 7; p < 128; p += 2) { float a = 0.f;
        for (int q = 0; q < 128; ++q) a += bf2f(W[p * 128 + q]) * vn[q * 129 + c];
        a += P.in[10][g * 128 + p];
        SG[(size_t)p * 512 + g * 128 + c] = (bf16_t)f2bf(bf2f(U[(size_t)p * 512 + g * 128 + c]) * a); }
}
__global__ void __launch_bounds__(256) nv_merge(const float* C1, const float* C2, const bf16_t* GA, const bf16_t* GB, bf16_t* Mg, size_t n) {
    for (size_t i = (size_t)blockIdx.x * 256 + threadIdx.x; i < n; i += (size_t)gridDim.x * 256) Mg[i] = (bf16_t)f2bf(bf2f(GA[i]) * C1[i] + bf2f(GB[i]) * C2[i]);
}
__global__ void __launch_bounds__(256) nv_resid(const float* base, const float* C, float* out, size_t n) {
    for (size_t i = (size_t)blockIdx.x * 256 + threadIdx.x; i < n; i += (size_t)gridDim.x * 256) out[i] = base[i] + C[i];
}
__global__ void __launch_bounds__(256) nv_cross(const bf16_t* QC, const bf16_t* KVC, bf16_t* OC) {
    __shared__ float qs[512]; __shared__ float ps[4][256];
    const int tid = threadIdx.x, lane = tid & 63, h = tid >> 6, tok = blockIdx.x, b = tok / SEQ;
    for (int i = tid; i < 512; i += 256) qs[i] = bf2f(QC[(size_t)tok * 512 + i]);
    __syncthreads();
    float sc[4]; float mx = -1e30f;
    for (int j = 0; j < 4; ++j) { const int mrow = b * NMEM + j * 64 + lane; const bf16_t* kr = KVC + (size_t)mrow * 1024 + h * 128; float a = 0.f;
        for (int d = 0; d < 128; ++d) a += qs[h * 128 + d] * bf2f(kr[d]);
        sc[j] = a; mx = fmaxf(mx, a); }
    mx = wave_max(mx); float sum = 0.f;
    for (int j = 0; j < 4; ++j) { const float p = __builtin_amdgcn_exp2f(sc[j] - mx); ps[h][j * 64 + lane] = p; sum += p; }
    sum = wave_sum(sum);
    __syncthreads();
    for (int dd = 0; dd < 2; ++dd) { const int d = dd * 64 + lane; float a = 0.f;
        for (int mm = 0; mm < 256; ++mm) a += ps[h][mm] * bf2f(KVC[(size_t)(b * NMEM + mm) * 1024 + 512 + h * 128 + d]);
        OC[(size_t)tok * 512 + h * 128 + d] = (bf16_t)f2bf(a / sum); }
}
__global__ void __launch_bounds__(256) nv_moe_a(const bf16_t* XN3, unsigned char* ws) {
    __shared__ float xs[1024];
    const int tid = threadIdx.x, dest = blockIdx.x, tok = dest >> 1;
    const int e = ((const int*)(ws + WS_TOKINFO))[(size_t)dest * 2];
    for (int i = tid; i < 1024; i += 256) xs[i] = bf2f(XN3[(size_t)tok * 1024 + i]);
    __syncthreads();
    const bf16_t* W = (const bf16_t*)(ws + WS_WGU) + (size_t)e * 1024 * 1024; bf16_t* Hh = (bf16_t*)(ws + WS_H) + (size_t)dest * 512;
    for (int n = tid; n < 512; n += 256) { const bf16_t* wg = W + (size_t)(256 * (n >> 7) + (n & 127)) * 1024; const bf16_t* wu = wg + 128 * 1024; float a = 0.f, b = 0.f;
        for (int k = 0; k < 1024; k += 8) { const u32x4 g4 = *(const u32x4*)(wg + k), u4 = *(const u32x4*)(wu + k);
            const unsigned gg[4] = {g4.x, g4.y, g4.z, g4.w}, uu[4] = {u4.x, u4.y, u4.z, u4.w};
            for (int j = 0; j < 4; ++j) { a += xs[k + 2 * j] * bf2f((bf16_t)(gg[j] & 0xffff)) + xs[k + 2 * j + 1] * bf2f((bf16_t)(gg[j] >> 16)); b += xs[k + 2 * j] * bf2f((bf16_t)(uu[j] & 0xffff)) + xs[k + 2 * j + 1] * bf2f((bf16_t)(uu[j] >> 16)); } }
        Hh[n] = (bf16_t)f2bf(a * sigmoidf_(a) * b); }
}
__global__ void __launch_bounds__(256) nv_moe_b(unsigned char* ws) {
    __shared__ float hs[512];
    const int tid = threadIdx.x, dest = blockIdx.x;
    const int* ti = (const int*)(ws + WS_TOKINFO) + (size_t)dest * 2; const int e = ti[0]; const float w = __int_as_float(ti[1]);
    const bf16_t* Hh = (const bf16_t*)(ws + WS_H) + (size_t)dest * 512;
    for (int i = tid; i < 512; i += 256) hs[i] = bf2f(Hh[i]);
    __syncthreads();
    const bf16_t* W = (const bf16_t*)(ws + WS_WD) + (size_t)e * 1024 * 512; bf16_t* Y = (bf16_t*)(ws + WS_YS) + (size_t)dest * 1024;
    for (int n = tid; n < 1024; n += 256) { const bf16_t* wr = W + (size_t)n * 512; float a = 0.f;
        for (int k = 0; k < 512; k += 8) { const u32x4 g4 = *(const u32x4*)(wr + k); const unsigned gg[4] = {g4.x, g4.y, g4.z, g4.w};
            for (int j = 0; j < 4; ++j) a += hs[k + 2 * j] * bf2f((bf16_t)(gg[j] & 0xffff)) + hs[k + 2 * j + 1] * bf2f((bf16_t)(gg[j] >> 16)); }
        Y[n] = (bf16_t)f2bf(a * w); }
}

namespace pg8 {
typedef short bf16x8 __attribute__((ext_vector_type(8)));
#ifndef WGM_V
#define WGM_V 8
#endif
constexpr int BM = 256, BK = 64, HALF = 128, HTB = HALF * BK * 2, STAGE_BYTES = 8 * HTB, NXCD = 8, WGM = WGM_V;
__host__ __device__ __forceinline__ int lds_byte(int r, int c) { const int st = (r >> 4) * 2 + (c >> 5), rr = r & 15, cc = c & 31, ob = rr * 64 + cc * 2; return st * 1024 + (ob ^ (((ob >> 9) & 1) << 5)); }
__host__ __device__ __forceinline__ void stage_rc(int b, int& R, int& C) { const int st = b / 1024, sb = b % 1024, swz = sb ^ (((sb >> 9) & 1) << 5); R = (st >> 1) * 16 + swz / 64; C = (st & 1) * 32 + (swz % 64) / 2; }
__host__ __device__ __forceinline__ int perm32(int rho) { const int n = rho >> 4, i = rho & 15; return 8 * (i >> 2) + 4 * n + (i & 3); }
struct Unit { int pm, pn, kind, dup; };
__device__ __forceinline__ void tile_of(int L, int nM, int nN, int& pm, int& pn) {
    const int nwg = nM * nN; int wgid = L; { const int q = nwg / NXCD, r = nwg % NXCD, xcd = wgid % NXCD, off = wgid / NXCD; wgid = (xcd < r ? xcd * (q + 1) : r * (q + 1) + (xcd - r) * q) + off; }
    const int nig = WGM * nN, gid = wgid / nig, fm = gid * WGM, gsz = (nM - fm) < WGM ? (nM - fm) : WGM;
    pm = fm + ((wgid % nig) % gsz); pn = (wgid % nig) / gsz;
}
__device__ __forceinline__ unsigned cvt_pk_bf16(float lo, float hi) { unsigned r; asm volatile("v_cvt_pk_bf16_f32 %0, %1, %2" : "=v"(r) : "v"(lo), "v"(hi)); return r; }

template <class Epi, class Sched, bool ALIGN_EPI, bool GATHER, bool VARK = false>
__device__ __forceinline__ void gemm_phase(LAS unsigned char* lds, const int Kc, const Sched& S, const Epi& E, const unsigned stag_ticks = 0u) {
    static_assert(!(VARK && GATHER), "VARK computes its offsets arithmetically");
    unsigned k2c = (unsigned)Kc * 2u, k2n = (unsigned)Kc * 2u;
    const int tid = threadIdx.x, wid = __builtin_amdgcn_readfirstlane(tid >> 6), lane = tid & 63, wr = wid >> 2, wc = wid & 3, fr = lane & 15, fq = lane >> 4;
    const int K = Kc; int nt = K / BK;
    unsigned voffA[2], voffB[2]; int RA[2], CA2[2], RB[2];
#pragma unroll
    for (int i = 0; i < 2; ++i) { int R, C; stage_rc(tid * 16 + i * 8192, R, C); const int Rb = Epi::PERM ? ((R & ~31) + perm32(R & 31)) : R;
        voffA[i] = (unsigned)(R * K + C) * 2u; voffB[i] = (unsigned)(Rb * K + C) * 2u; RA[i] = R; CA2[i] = C * 2; RB[i] = Rb; }
    const size_t kstep = (size_t)(BK * 2);
    const size_t hstep = (size_t)HALF * K * 2;
    const unsigned ldsw = (unsigned)wid * 1024u;
    const int aoff = lds_byte(wr * 64 + fr, fq * 8), boff = lds_byte(wc * 32 + fr, fq * 8);
    unsigned vA[2][2] = {{0u, 0u}, {0u, 0u}}, vN[2][2] = {{0u, 0u}, {0u, 0u}};
#define PG8_SA(b, h) (((b) * 2 + (h)) * HTB)
#define PG8_SB(b, h) ((4 + (b) * 2 + (h)) * HTB)
#define PG8_STAGE(bufoff, gbase, voff) do { _Pragma("unroll") for (int _i = 0; _i < 2; ++_i) \
        __builtin_amdgcn_global_load_lds((const unsigned*)((const char*)(gbase) + (voff)[_i]), (LAS unsigned*)(lds + (bufoff) + ldsw + _i * 8192), 16, 0, 0); } while (0)
#define PG8_STAGEA(bufoff, gbase, h, nx) do { _Pragma("unroll") for (int _i = 0; _i < 2; ++_i) { \
        const unsigned _o = VARK ? (unsigned)((h) * HALF + RA[_i]) * ((nx) ? k2n : k2c) + (unsigned)CA2[_i] : (GATHER ? ((nx) ? vN[h][_i] : vA[h][_i]) : voffA[_i]); \
        __builtin_amdgcn_global_load_lds((const unsigned*)((const char*)(gbase) + ((GATHER || VARK) ? (size_t)0 : (size_t)(h) * hstep) + _o), (LAS unsigned*)(lds + (bufoff) + ldsw + _i * 8192), 16, 0, 0); } } while (0)
#define PG8_STAGEB(bufoff, gbase, h, nx) do { _Pragma("unroll") for (int _i = 0; _i < 2; ++_i) { \
        const unsigned _o = VARK ? (unsigned)((h) * HALF + RB[_i]) * ((nx) ? k2n : k2c) + (unsigned)CA2[_i] : voffB[_i]; \
        __builtin_amdgcn_global_load_lds((const unsigned*)((const char*)(gbase) + (VARK ? (size_t)0 : (size_t)(h) * hstep) + _o), (LAS unsigned*)(lds + (bufoff) + ldsw + _i * 8192), 16, 0, 0); } } while (0)
#define PG8_LDA(dst, b, h) do { _Pragma("unroll") for (int m = 0; m < 4; ++m) _Pragma("unroll") for (int k = 0; k < 2; ++k) dst[m][k] = *(const LAS bf16x8*)(lds + PG8_SA(b, h) + aoff + m * 2048 + k * 1024); } while (0)
#define PG8_LDB(dst, b, h) do { _Pragma("unroll") for (int n = 0; n < 2; ++n) _Pragma("unroll") for (int k = 0; k < 2; ++k) dst[n][k] = *(const LAS bf16x8*)(lds + PG8_SB(b, h) + boff + n * 2048 + k * 1024); } while (0)
#define PG8_MMA(ai, bj, At, Bt) do { __builtin_amdgcn_s_setprio(1); _Pragma("unroll") for (int m = 0; m < 4; ++m) _Pragma("unroll") for (int n = 0; n < 2; ++n) _Pragma("unroll") for (int k = 0; k < 2; ++k) \
        acc[ai][bj][m][n] = __builtin_amdgcn_mfma_f32_16x16x32_bf16(Bt[n][k], At[m][k], acc[ai][bj][m][n], 0, 0, 0); __builtin_amdgcn_s_setprio(0); } while (0)
#define PG8_WAIT_V(n) asm volatile("s_waitcnt vmcnt(" #n ")" ::: "memory")
#define PG8_WAIT_L(n) asm volatile("s_waitcnt lgkmcnt(" #n ")" ::: "memory")
#define PG8_BAR __builtin_amdgcn_s_barrier()
#define PG8_SCHED __builtin_amdgcn_sched_barrier(0)
#define PG8_GOFF(dst, ui_) do { if (GATHER) { _Pragma("unroll") for (int _h = 0; _h < 2; ++_h) _Pragma("unroll") for (int _i = 0; _i < 2; ++_i) dst[_h][_i] = S.goff((ui_), _h * HALF + RA[_i]) + (unsigned)CA2[_i]; } } while (0)
    Unit cur, nxt; int ui = 0;
    if (!S.next(0, cur)) return;
    if (stag_ticks) { const unsigned long long t0 = __builtin_amdgcn_s_memrealtime(), dl = (unsigned long long)((blockIdx.x >> 3) & 1) * stag_ticks;
      while (__builtin_amdgcn_s_memrealtime() - t0 < dl) __builtin_amdgcn_s_sleep(8); }
    f32x4 acc[2][2][4][2];
#pragma unroll
    for (int a = 0; a < 2; ++a)
#pragma unroll
        for (int b = 0; b < 2; ++b)
#pragma unroll
            for (int m = 0; m < 4; ++m)
#pragma unroll
                for (int n = 0; n < 2; ++n) acc[a][b][m][n] = (f32x4){0.f, 0.f, 0.f, 0.f};
    bf16x8 At[4][2], B0[2][2], B1[2][2];
    const char* cA = S.a_ptr(cur); const char* cB = S.b_ptr(cur);
    PG8_GOFF(vA, 0);
    if constexpr (VARK) { nt = S.k_of(cur) / BK; k2c = (unsigned)S.k_of(cur) * 2u; k2n = k2c; }
    PG8_STAGEB(PG8_SB(0, 0), cB, 0, false); PG8_STAGEB(PG8_SB(0, 1), cB, 1, false); PG8_STAGEA(PG8_SA(0, 0), cA, 0, false); PG8_STAGEA(PG8_SA(0, 1), cA, 1, false);
    if (wr == 1) PG8_BAR;
    PG8_WAIT_V(2); PG8_BAR;
    PG8_STAGEB(PG8_SB(1, 0), cB + kstep, 0, false); PG8_STAGEA(PG8_SA(1, 0), cA + kstep, 0, false); PG8_STAGEB(PG8_SB(1, 1), cB + kstep, 1, false);
    PG8_WAIT_V(6); PG8_BAR;
    for (;;) {
        const bool has_next = S.next(ui + 1, nxt);
        const char* nA = has_next ? S.a_ptr(nxt) : cA; const char* nB = has_next ? S.b_ptr(nxt) : cB;
        for (int t = 0; t < nt; t += 2) {
            const bool last = (t == nt - 2);
            const char* a1 = cA + (size_t)(t + 1) * kstep;
            const char* a2 = last ? nA : cA + (size_t)(t + 2) * kstep; const char* b2 = last ? nB : cB + (size_t)(t + 2) * kstep;
            const char* a3 = a2 + kstep; const char* b3 = b2 + kstep;
            if constexpr (VARK) { if (last) k2n = has_next ? (unsigned)S.k_of(nxt) * 2u : k2c; }
            if (GATHER && last) { if (has_next) { PG8_GOFF(vN, ui + 1); } else {
#pragma unroll
                for (int _h = 0; _h < 2; ++_h)
#pragma unroll
                    for (int _i = 0; _i < 2; ++_i) vN[_h][_i] = vA[_h][_i]; } }
            PG8_LDB(B0, 0, 0); PG8_LDB(B1, 0, 1); PG8_SCHED; PG8_LDA(At, 0, 0); PG8_STAGEA(PG8_SA(1, 1), a1, 1, false);
            PG8_WAIT_V(8); PG8_WAIT_L(0); PG8_BAR; PG8_MMA(0, 0, At, B0); PG8_MMA(0, 1, At, B1); PG8_BAR; PG8_SCHED;
            PG8_LDA(At, 0, 1); PG8_STAGEB(PG8_SB(0, 0), b2, 0, last); PG8_STAGEB(PG8_SB(0, 1), b2, 1, last); PG8_STAGEA(PG8_SA(0, 0), a2, 0, last);
            PG8_WAIT_V(8); PG8_WAIT_L(0); PG8_BAR; PG8_MMA(1, 0, At, B0); PG8_MMA(1, 1, At, B1); PG8_BAR; PG8_SCHED;
            PG8_LDB(B0, 1, 0); PG8_LDB(B1, 1, 1); PG8_SCHED; PG8_LDA(At, 1, 0); PG8_STAGEA(PG8_SA(0, 1), a2, 1, last);
            PG8_WAIT_V(8); PG8_WAIT_L(0); PG8_BAR; PG8_MMA(0, 0, At, B0); PG8_MMA(0, 1, At, B1); PG8_BAR; PG8_SCHED;
            PG8_LDA(At, 1, 1); PG8_STAGEB(PG8_SB(1, 0), b3, 0, last); PG8_STAGEB(PG8_SB(1, 1), b3, 1, last); PG8_STAGEA(PG8_SA(1, 0), a3, 0, last);
            PG8_WAIT_V(8); PG8_WAIT_L(0); PG8_BAR; PG8_MMA(1, 0, At, B0); PG8_MMA(1, 1, At, B1); PG8_BAR; PG8_SCHED;
        }
        if constexpr (ALIGN_EPI) { if (wr == 0) PG8_BAR; }
        if (!cur.dup) E(acc, cur, ui, wr, wc, fr, fq);
#ifdef PROBE_EDUP
        if (Epi::EDUP) { asm volatile("s_waitcnt vmcnt(0)" ::: "memory"); E(acc, cur, ui, wr, wc, fr, fq); }
#endif
        if (!has_next) break;
#pragma unroll
        for (int a = 0; a < 2; ++a)
#pragma unroll
            for (int b = 0; b < 2; ++b)
#pragma unroll
                for (int m = 0; m < 4; ++m)
#pragma unroll
                    for (int n = 0; n < 2; ++n) acc[a][b][m][n] = (f32x4){0.f, 0.f, 0.f, 0.f};
        cur = nxt; cA = nA; cB = nB; ++ui;
        if constexpr (VARK) { nt = S.k_of(cur) / BK; k2c = k2n; }
        if (GATHER) {
#pragma unroll
            for (int _h = 0; _h < 2; ++_h)
#pragma unroll
                for (int _i = 0; _i < 2; ++_i) vA[_h][_i] = vN[_h][_i]; }
        if constexpr (ALIGN_EPI) { if (wr == 1) PG8_BAR; }
    }
    PG8_WAIT_V(0);
    if constexpr (!ALIGN_EPI) { if (wr == 0) PG8_BAR; }
    PG8_BAR;
#undef PG8_SA
#undef PG8_SB
#undef PG8_STAGE
#undef PG8_STAGEA
#undef PG8_STAGEB
#undef PG8_LDA
#undef PG8_LDB
#undef PG8_MMA
#undef PG8_WAIT_V
#undef PG8_WAIT_L
#undef PG8_BAR
#undef PG8_SCHED
#undef PG8_GOFF
}
}
namespace attn_body {
using bf16=unsigned short;
using bf16x8=__attribute__((ext_vector_type(8)))short;
using s16x4=__attribute__((ext_vector_type(4)))short;
using f32x16=__attribute__((ext_vector_type(16)))float;
constexpr int SEQA=8192,D=64,QP=512,KP=128;
constexpr int NW=8,QBLK=32,QB=QBLK*NW,KVBLK=64,NQB=SEQA/QB;
__device__ __forceinline__ int crow(int r,int hi){return (r&3)+8*(r>>2)+4*hi;}
#define SBAR() __builtin_amdgcn_sched_barrier(0)
__device__ __forceinline__ void cmask(f32x16&p0,f32x16&p1,int jb,int qrel,int hi){
  const float NEG=-INFINITY; int kb=64*jb+4*hi;
  #pragma unroll
  for(int r=0;r<16;++r){int kv=kb+(r&3)+8*(r>>2); if(kv>qrel)p0[r]=NEG; if(kv+32>qrel)p1[r]=NEG;}
}

constexpr int NSLOT=3, SLOTB=8192;
constexpr int LDS_K=0, LDS_V=NSLOT*SLOTB, LDS_WS=2*NSLOT*SLOTB, LDS_OST=LDS_WS+NW*64*4, LDS_BYTES=LDS_OST+NW*4096;
constexpr float C2=0.125f*1.4426950408889634f;
__device__ __forceinline__ void glds16(const void*gsrc,unsigned lds_dst){unsigned keep;
  asm volatile("s_mov_b32 %0, m0\n\ts_mov_b32 m0, %2\n\ts_nop 0\n\tglobal_load_lds_dwordx4 %1, off\n\ts_mov_b32 m0, %0":"=&s"(keep):"v"(gsrc),"s"(lds_dst):"memory");}
__device__ __forceinline__ float max3f(float a,float b,float c){float r;asm("v_max3_f32 %0, %1, %2, %3":"=v"(r):"v"(a),"v"(b),"v"(c));return r;}
__device__ __forceinline__ float max2f(float a,float b){float r;asm("v_max_f32_e32 %0, %1, %2":"=v"(r):"v"(a),"v"(b));return r;}
__device__ __forceinline__ float fadd_s(float a,float b){float r;asm("v_add_f32_e32 %0, %1, %2":"=v"(r):"v"(a),"v"(b));return r;}
__device__ __forceinline__ float fsub_s(float a,float b){float r;asm("v_sub_f32_e32 %0, %1, %2":"=v"(r):"v"(a),"v"(b));return r;}
typedef float f32x2_t __attribute__((ext_vector_type(2))); typedef __bf16 bf16x2_t __attribute__((ext_vector_type(2)));
__device__ __forceinline__ unsigned cvtpk_s(float lo,float hi){f32x2_t v={lo,hi};bf16x2_t b=__builtin_convertvector(v,bf16x2_t);return __builtin_bit_cast(unsigned,b);}
#define WAIT_BAR(N) asm volatile("s_waitcnt vmcnt(" #N ") lgkmcnt(0)\n\ts_barrier":::"memory")

__device__ __forceinline__ void qkt(f32x16&p0,f32x16&p1,const char*Kslot,const bf16x8*qr,const f32x16&negm,int r32,int hi){
  const char*kb=Kslot+hi*1024+r32*16;
  #pragma unroll
  for(int d0=0;d0<4;++d0){
    const bf16x8 b0=*reinterpret_cast<const bf16x8*>(kb+d0*2048);
    const bf16x8 b1=*reinterpret_cast<const bf16x8*>(kb+d0*2048+512);
    if(d0==0){p0=__builtin_amdgcn_mfma_f32_32x32x16_bf16(b0,qr[0],negm,0,0,0);p1=__builtin_amdgcn_mfma_f32_32x32x16_bf16(b1,qr[0],negm,0,0,0);}
    else{p0=__builtin_amdgcn_mfma_f32_32x32x16_bf16(b0,qr[d0],p0,0,0,0);p1=__builtin_amdgcn_mfma_f32_32x32x16_bf16(b1,qr[d0],p1,0,0,0);}}
}
typedef __attribute__((address_space(3))) const char* lds_cptr;
typedef short v4i16_t __attribute__((ext_vector_type(4)));
__device__ __forceinline__ void kload8(bf16x8*kf,lds_cptr kp){
  kf[0]=*(const __attribute__((address_space(3))) bf16x8*)(kp);      kf[1]=*(const __attribute__((address_space(3))) bf16x8*)(kp+512);
  kf[2]=*(const __attribute__((address_space(3))) bf16x8*)(kp+2048); kf[3]=*(const __attribute__((address_space(3))) bf16x8*)(kp+2560);
  kf[4]=*(const __attribute__((address_space(3))) bf16x8*)(kp+4096); kf[5]=*(const __attribute__((address_space(3))) bf16x8*)(kp+4608);
  kf[6]=*(const __attribute__((address_space(3))) bf16x8*)(kp+6144); kf[7]=*(const __attribute__((address_space(3))) bf16x8*)(kp+6656);
}
__device__ __forceinline__ void kload2(bf16x8*kf,lds_cptr kp,int j){ kf[2*j]=*(const __attribute__((address_space(3))) bf16x8*)(kp+j*2048); kf[2*j+1]=*(const __attribute__((address_space(3))) bf16x8*)(kp+j*2048+512); }
__device__ __forceinline__ s16x4 vtr(lds_cptr p){ return __builtin_bit_cast(s16x4,__builtin_amdgcn_ds_read_tr16_b64_v4i16((__attribute__((address_space(3))) v4i16_t*)p)); }
__device__ __forceinline__ float rowmax(const f32x16&p0,const f32x16&p1){
  float a=max3f(p0[0],p0[1],p1[0]),b=max3f(p0[2],p0[3],p1[1]);a=max3f(a,p1[2],p1[3]);
  #pragma unroll
  for(int r=4;r<16;r+=4){a=max3f(a,p0[r],p0[r+1]);b=max3f(b,p0[r+2],p0[r+3]);a=max3f(a,p1[r],p1[r+1]);b=max3f(b,p1[r+2],p1[r+3]);}
  const float m=max2f(a,b);
  auto rr=__builtin_amdgcn_permlane32_swap(__float_as_uint(m),__float_as_uint(m),false,false);
  return max2f(__uint_as_float(rr[0]),__uint_as_float(rr[1]));
}
__device__ __forceinline__ void pv(f32x16*o,int vb,bf16x8 pa0,bf16x8 pa1,bf16x8 pa2,bf16x8 pa3){
  #pragma unroll
  for(int d0=0;d0<2;++d0){s16x4 lo[4],hi[4];
    #pragma unroll
    for(int ks=0;ks<4;++ks){
      asm volatile("ds_read_b64_tr_b16 %0,%1 offset:%c2":"=&v"(lo[ks]):"v"(vb),"i"(d0*4096+ks*1024):"memory");
      asm volatile("ds_read_b64_tr_b16 %0,%1 offset:%c2":"=&v"(hi[ks]):"v"(vb),"i"(d0*4096+ks*1024+512):"memory");}
    asm volatile("s_waitcnt lgkmcnt(0)":::"memory");SBAR();
    #define PK(k) (bf16x8){lo[k][0],lo[k][1],lo[k][2],lo[k][3],hi[k][0],hi[k][1],hi[k][2],hi[k][3]}
    o[d0]=__builtin_amdgcn_mfma_f32_32x32x16_bf16(pa0,PK(0),o[d0],0,0,0);
    o[d0]=__builtin_amdgcn_mfma_f32_32x32x16_bf16(pa1,PK(1),o[d0],0,0,0);
    o[d0]=__builtin_amdgcn_mfma_f32_32x32x16_bf16(pa2,PK(2),o[d0],0,0,0);
    o[d0]=__builtin_amdgcn_mfma_f32_32x32x16_bf16(pa3,PK(3),o[d0],0,0,0);
    #undef PK
  }
}

#ifndef ATTN_STORE16
#define ATTN_STORE16(p,v) (*(u32x4*)(p)=(v))
#endif
template<int THRL,bool FIXM> __device__ __forceinline__ void attn_unit(int b,int h,int kvh,int qb,const bf16*Q,const bf16*__restrict__ K,const bf16*__restrict__ V,bf16*O,char*shm,float cfix){
  const int tid=threadIdx.x,lane=tid&63,r32=lane&31,hi=lane>>5; const int wid=__builtin_amdgcn_readfirstlane(tid>>6);
  const long rowbase=(long)b*SEQA; const int q0=qb*QB;
  const bf16*Qw=Q+(rowbase+q0+wid*QBLK)*QP+h*D;
  const bf16*Kh=K+rowbase*KP+kvh*D,*Vh=V+rowbase*KP+kvh*D;
  const unsigned lds0=(unsigned)(uintptr_t)shm;
  float*wsf=(float*)(shm+LDS_WS)+wid*64;
  const bf16*ksrc=Kh+(long)lane*KP+wid*8;
  const bf16*vsrc=Vh+(long)(16*(wid&3)+(lane>>2))*KP+(wid>>2)*32+(lane&3)*8;
  const unsigned kdst=lds0+LDS_K+wid*1024, vdst=lds0+LDS_V+wid*1024;
  #define DMA_K(t,slot) glds16(ksrc+(long)(t)*KVBLK*KP,(unsigned)__builtin_amdgcn_readfirstlane(kdst+(slot)))
  #define DMA_V(t,slot) glds16(vsrc+(long)(t)*KVBLK*KP,(unsigned)__builtin_amdgcn_readfirstlane(vdst+(slot)))
  const int vb0=(int)(lds0+LDS_V)+((lane>>4)&1)*32+(lane&3)*8+(4*hi+((lane&15)>>2))*64;
  const char*Kbase=shm+LDS_K; bf16x8 kf[8];
  const lds_cptr shm3=(lds_cptr)shm; const lds_cptr kp0=shm3+LDS_K+hi*1024+r32*16; const lds_cptr vp0=shm3+LDS_V+((lane>>4)&1)*32+(lane&3)*8+(4*hi+((lane&15)>>2))*64;
  const int NT=SEQA/KVBLK;
  DMA_K(0,0);DMA_V(0,0);DMA_K(1,SLOTB);
  bf16x8 qr[4];
  #pragma unroll
  for(int d0=0;d0<4;++d0)qr[d0]=*reinterpret_cast<const bf16x8*>(&Qw[(long)r32*QP+d0*16+hi*8]);
  float mhat=FIXM?cfix:0.f,l_reg=0.f;f32x16 o[2];o[0]=f32x16{};o[1]=f32x16{};f32x16 negm=f32x16{};
  if(FIXM){
  #pragma unroll
  for(int r=0;r<16;++r)negm[r]=-cfix;}
  asm volatile("":"+v"(negm));
  const int qrel=wid*QBLK+r32;
  #define CMASK(P0,P1,t) do{}while(0)
  bool resc=false;
  #define START(P0,P1) do{ resc=false; \
    if(!FIXM){ const float rm=rowmax(P0,P1); const float dl=rm; mhat=fadd_s(mhat,dl); \
      _Pragma("unroll") for(int r=0;r<16;++r){P0[r]=fsub_s(P0[r],dl);P1[r]=fsub_s(P1[r],dl);} \
      _Pragma("unroll") for(int r=0;r<16;++r)negm[r]=-mhat; asm volatile("":"+v"(negm)); } \
    _Pragma("unroll") for(int r=0;r<16;++r)P0[r]=__builtin_amdgcn_exp2f(P0[r]); }while(0)
  #define RESC() do{ if(!FIXM&&resc){ asm volatile("s_waitcnt lgkmcnt(0)":::"memory"); \
      _Pragma("unroll") for(int d_=0;d_<2;++d_) _Pragma("unroll") for(int r=0;r<16;++r)o[d_][r]*=wsf[crow(r,hi)]; } }while(0)
  f32x16 pA0,pA1,pB0,pB1;
  int sl_prev=0,sl_cur=0,sl_next=SLOTB;
  #define ROT() do{sl_prev=sl_cur;sl_cur=sl_next;sl_next=(sl_next==(NSLOT-1)*SLOTB)?0:sl_next+SLOTB;}while(0)
  DMA_K(2,2*SLOTB);
  WAIT_BAR(3);
  qkt(pA0,pA1,Kbase,qr,negm,r32,hi);asm volatile("s_nop 15\n\ts_nop 7":"+v"(pA0),"+v"(pA1));CMASK(pA0,pA1,0);
  START(pA0,pA1);
  _Pragma("unroll") for(int r=0;r<16;++r)pA1[r]=__builtin_amdgcn_exp2f(pA1[r]);
  WAIT_BAR(0);
  DMA_K(3,0);DMA_V(1,SLOTB);
  ROT();
  kload8(kf,kp0+sl_cur);
  WAIT_BAR(2);
  s16x4 vlo[8],vhi[8]; u32x4 pw0,pw1,pw2,pw3;
  #define PKW(P,B) cvtpk_s(P[B],P[B+1])
  #define PAF(k) __builtin_bit_cast(bf16x8,pw##k)
  #define VFR(i) (bf16x8){vlo[i][0],vlo[i][1],vlo[i][2],vlo[i][3],vhi[i][0],vhi[i][1],vhi[i][2],vhi[i][3]}
  #define PIN(x) asm volatile("":"+v"(x))
  #define MX3(a,b,c) __builtin_fmaxf(__builtin_fmaxf((a),(b)),(c))
  #define GAPA(MF,A0,A1,A2,A3,W0,W1,PW) do{ MF; sacc+=A0; sacc+=A1; sacc+=A2; sacc+=A3; PIN(sacc); W0; W1; PIN(PW); SBAR(); }while(0)
  #define EX(v) __builtin_amdgcn_exp2f(v)
  #define GAPB(MF,X,B) do{ MF; X[B]=EX(X[B]); X[B+1]=EX(X[B+1]); X[B+2]=EX(X[B+2]); X[B+3]=EX(X[B+3]); PIN(X); SBAR(); }while(0)
  #define VRD(i) do{ vlo[i]=vtr(vp_+(((i)>>2)*4096+((i)&3)*1024)); vhi[i]=vtr(vp_+(((i)>>2)*4096+((i)&3)*1024+512)); }while(0)
  #define KRD(G,j) do{ if(G){ kload2(kf,kp0+sl_next,j); SBAR(); } }while(0)
  #define STEP(C0,C1,P0,P1,t,GK,GV,GL) do{ SBAR(); \
    const lds_cptr vp_=vp0+sl_prev; \
    VRD(0); SBAR(); float sacc=(P0[0]+P0[1]); \
    GAPA(C0=__builtin_amdgcn_mfma_f32_32x32x16_bf16(kf[0],qr[0],negm,0,0,0), P0[2],P0[3],P0[4],P0[5],     pw0[0]=PKW(P0,0), pw0[1]=PKW(P0,2), pw0); \
    VRD(4); SBAR(); GAPA(C1=__builtin_amdgcn_mfma_f32_32x32x16_bf16(kf[1],qr[0],negm,0,0,0), P0[6],P0[7],P0[8],P0[9],     pw0[2]=PKW(P0,4), pw0[3]=PKW(P0,6), pw0); \
    VRD(1); SBAR(); GAPA(C0=__builtin_amdgcn_mfma_f32_32x32x16_bf16(kf[2],qr[1],C0,0,0,0),   P0[10],P0[11],P0[12],P0[13], pw1[0]=PKW(P0,8), pw1[1]=PKW(P0,10), pw1); \
    VRD(5); SBAR(); GAPA(C1=__builtin_amdgcn_mfma_f32_32x32x16_bf16(kf[3],qr[1],C1,0,0,0),   P0[14],P0[15],P1[0],P1[1],   pw1[2]=PKW(P0,12),pw1[3]=PKW(P0,14), pw1); \
    VRD(2); SBAR(); GAPA(C0=__builtin_amdgcn_mfma_f32_32x32x16_bf16(kf[4],qr[2],C0,0,0,0),   P1[2],P1[3],P1[4],P1[5],     pw2[0]=PKW(P1,0), pw2[1]=PKW(P1,2), pw2); \
    VRD(6); SBAR(); GAPA(C1=__builtin_amdgcn_mfma_f32_32x32x16_bf16(kf[5],qr[2],C1,0,0,0),   P1[6],P1[7],P1[8],P1[9],     pw2[2]=PKW(P1,4), pw2[3]=PKW(P1,6), pw2); \
    VRD(3); SBAR(); GAPA(C0=__builtin_amdgcn_mfma_f32_32x32x16_bf16(kf[6],qr[3],C0,0,0,0),   P1[10],P1[11],P1[12],P1[13], pw3[0]=PKW(P1,8), pw3[1]=PKW(P1,10), pw3); \
    VRD(7); SBAR(); GAPA(C1=__builtin_amdgcn_mfma_f32_32x32x16_bf16(kf[7],qr[3],C1,0,0,0),   P1[14],P1[15],0.f,0.f,       pw3[2]=PKW(P1,12),pw3[3]=PKW(P1,14), pw3); \
    l_reg+=sacc; \
    if(GK){DMA_K((t)+3,sl_cur);} if(GV){DMA_V((t)+1,sl_next);} \
    CMASK(C0,C1,t); \
    if(!FIXM){ float a=MX3(C0[0],C0[1],C1[0]),b=MX3(C0[2],C0[3],C1[1]); a=MX3(a,C1[2],C1[3]); \
      _Pragma("unroll") for(int r=4;r<16;r+=4){a=MX3(a,C0[r],C0[r+1]);b=MX3(b,C0[r+2],C0[r+3]);a=MX3(a,C1[r],C1[r+1]);b=MX3(b,C1[r+2],C1[r+3]);} \
      float rm=__builtin_fmaxf(a,b); { auto rr=__builtin_amdgcn_permlane32_swap(__float_as_uint(rm),__float_as_uint(rm),false,false); rm=__builtin_fmaxf(__uint_as_float(rr[0]),__uint_as_float(rr[1])); } \
      resc=false; \
      if(__builtin_expect(__any(rm>(float)THRL),0)){ const float dl=__builtin_fmaxf(rm,0.f); mhat+=dl; \
        _Pragma("unroll") for(int r=0;r<16;++r){C0[r]-=dl;C1[r]-=dl;} \
        _Pragma("unroll") for(int r=0;r<16;++r)negm[r]=-mhat; asm volatile("":"+v"(negm)); \
        const float f=__builtin_amdgcn_exp2f(-dl); l_reg*=f; if(hi==0)wsf[r32]=f; resc=true; } } \
    SBAR(); \
    GAPB(o[0]=__builtin_amdgcn_mfma_f32_32x32x16_bf16(PAF(0),VFR(0),o[0],0,0,0), C0,0); \
    GAPB(o[1]=__builtin_amdgcn_mfma_f32_32x32x16_bf16(PAF(0),VFR(4),o[1],0,0,0), C0,4); \
    KRD(GL,0); GAPB(o[0]=__builtin_amdgcn_mfma_f32_32x32x16_bf16(PAF(1),VFR(1),o[0],0,0,0), C0,8); \
    KRD(GL,1); GAPB(o[1]=__builtin_amdgcn_mfma_f32_32x32x16_bf16(PAF(1),VFR(5),o[1],0,0,0), C0,12); \
    KRD(GL,2); GAPB(o[0]=__builtin_amdgcn_mfma_f32_32x32x16_bf16(PAF(2),VFR(2),o[0],0,0,0), C1,0); \
    KRD(GL,3); GAPB(o[1]=__builtin_amdgcn_mfma_f32_32x32x16_bf16(PAF(2),VFR(6),o[1],0,0,0), C1,4); \
    GAPB(o[0]=__builtin_amdgcn_mfma_f32_32x32x16_bf16(PAF(3),VFR(3),o[0],0,0,0), C1,8); \
    GAPB(o[1]=__builtin_amdgcn_mfma_f32_32x32x16_bf16(PAF(3),VFR(7),o[1],0,0,0), C1,12); \
    }while(0)
  int t=1;
  #undef CMASK
  #define CMASK(P0,P1,t) do{}while(0)
  for(;t+5<NT;t+=2){
    STEP(pB0,pB1,pA0,pA1,t,true,true,true);     WAIT_BAR(2); RESC(); ROT();
    STEP(pA0,pA1,pB0,pB1,t+1,true,true,true);   WAIT_BAR(2); RESC(); ROT();
  }
  #undef CMASK
  #define CMASK(P0,P1,t) do{}while(0)
  #define ENDW(tt) do{ if((tt)+3<NT){WAIT_BAR(2);} else if((tt)+2<NT){WAIT_BAR(1);} else {WAIT_BAR(0);} }while(0)
  for(;t+1<NT;t+=2){
    STEP(pB0,pB1,pA0,pA1,t,(t+3<NT),(t+1<NT),(t+1<NT));       ENDW(t);   RESC(); ROT();
    STEP(pA0,pA1,pB0,pB1,t+1,(t+4<NT),(t+2<NT),(t+2<NT));     ENDW(t+1); RESC(); ROT();
  }
  STEP(pB0,pB1,pA0,pA1,NT-1,false,false,false); RESC();
  { float sacc=pB0[0]+pB0[1]; _Pragma("unroll") for(int r=2;r<16;++r)sacc+=pB0[r]; _Pragma("unroll") for(int r=0;r<16;++r)sacc+=pB1[r]; l_reg+=sacc;
    pw0=(u32x4){PKW(pB0,0),PKW(pB0,2),PKW(pB0,4),PKW(pB0,6)};pw1=(u32x4){PKW(pB0,8),PKW(pB0,10),PKW(pB0,12),PKW(pB0,14)};pw2=(u32x4){PKW(pB1,0),PKW(pB1,2),PKW(pB1,4),PKW(pB1,6)};pw3=(u32x4){PKW(pB1,8),PKW(pB1,10),PKW(pB1,12),PKW(pB1,14)};
    SBAR(); pv(o,vb0+sl_cur,PAF(0),PAF(1),PAF(2),PAF(3)); }
  #undef PKW
  #undef PAF
  #undef VFR
  #undef PIN
  #undef MX3
  #undef GAPA
  #undef GAPB
  #undef EX
  #undef VRD
  #undef KRD
  #undef STEP
  #undef ENDW
  {auto rr=__builtin_amdgcn_permlane32_swap(__float_as_uint(l_reg),__float_as_uint(l_reg),false,false);l_reg=__uint_as_float(rr[0])+__uint_as_float(rr[1]);}
  if(hi==0)wsf[32+r32]=l_reg;asm volatile("s_waitcnt lgkmcnt(0)":::"memory");
  float rli[16];
  #pragma unroll
  for(int r=0;r<16;++r)rli[r]=__builtin_amdgcn_rcpf(wsf[32+crow(r,hi)]);
  bf16*Ow=O+(rowbase+q0+wid*QBLK)*QP+h*D;
  { bf16*stg=(bf16*)(shm+LDS_OST)+wid*2048;
    #pragma unroll
    for(int r=0;r<16;++r){const int orow=crow(r,hi);
      #pragma unroll
      for(int d0=0;d0<2;++d0)stg[orow*64+d0*32+r32]=(bf16)f2bf(o[d0][r]*rli[r]);}
    asm volatile("s_waitcnt lgkmcnt(0)":::"memory");
    #pragma unroll
    for(int i=0;i<4;++i){const int row=i*8+(lane>>3),ch=lane&7; const u32x4 v=*(const u32x4*)(stg+row*64+ch*8); ATTN_STORE16(Ow+(long)row*QP+ch*8,v);} }
  asm volatile("s_waitcnt lgkmcnt(0)\n\ts_barrier":::"memory");
  #undef DMA_K
  #undef DMA_V
  #undef CMASK
  #undef START
  #undef RESC
  #undef ROT
}
constexpr int ATTN_LDS_BYTES=LDS_BYTES;
#undef SBAR
#undef WAIT_BAR
}
constexpr int NWAVES = 8;
constexpr int RING_OFF = 0, RING_BYTES = 131072;
constexpr int SGU_ROWB = 1040, SGU_TILE_BYTES = 128 * SGU_ROWB;
constexpr int TBL_OFF = 133120;
constexpr int MOE_MAXU = 6;
constexpr int RSTBL_OFF = TBL_OFF + MOE_MAXU * 1024;
constexpr int UREC_OFF = RSTBL_OFF + MOE_MAXU * 1024;
constexpr int MISC_OFF = UREC_OFF + 512;
constexpr int LDS_BYTES = 147456;
static_assert(MISC_OFF + 128 <= LDS_BYTES, "LDS map");
constexpr int NPHASE = 13;

#define GAS __attribute__((address_space(1)))
typedef GAS unsigned gu32;
#define RLX_AGENT __ATOMIC_RELAXED, __HIP_MEMORY_SCOPE_AGENT

#define XB_TMO      128
#define XB_XCNT(j)  (256  + 64 * (j))
#define XB_XSUB(j)  (1280 + 64 * (j))
#define XB_XGEN(j)  (2304 + 64 * (j))
#define XB_TOP      3328
#define XB_TOPGEN   3392
#define XCD_BAR_WORDS 3456
#define XB_SPIN_CAP (1u << 18)
__device__ __forceinline__ unsigned xb_ld(unsigned* p)              { return __hip_atomic_load(p, __ATOMIC_RELAXED, __HIP_MEMORY_SCOPE_AGENT); }
__device__ __forceinline__ unsigned xb_add(unsigned* p, unsigned v) { return __hip_atomic_fetch_add(p, v, __ATOMIC_RELAXED, __HIP_MEMORY_SCOPE_AGENT); }
__device__ __forceinline__ unsigned xb_xcc_id() { return (unsigned)__builtin_amdgcn_s_getreg((3 << 11) | 20) & 0xFu; }
#define XB_SPIN(cond, bar) do { unsigned _sp = 0; while (cond) { __builtin_amdgcn_s_sleep(1); \
    if ((++_sp & 255u) == 0u) { if (xb_ld(&(bar)[XB_TMO])) break; if (_sp > XB_SPIN_CAP) { atomicAdd(&(bar)[XB_TMO], 1u); break; } } } } while (0)
struct XcdBarrier { unsigned* bar; unsigned x; volatile LAS unsigned* st; };
__device__ __forceinline__ XcdBarrier xcd_barrier_post(unsigned* bar, volatile LAS unsigned* st) {
    XcdBarrier b; b.bar = bar; b.x = xb_xcc_id(); b.st = st;
    if (threadIdx.x == 0) (void)xb_add(&bar[XB_XCNT(b.x)], 1u);
    return b;
}
__device__ __forceinline__ void xcd_barrier_complete(unsigned* bar, unsigned x, unsigned& nloc, unsigned& nx) {
    const unsigned G = gridDim.x * gridDim.y * gridDim.z;
    unsigned sum, cnt, mine, sp = 0u;
    for (;;) {
        sum = 0u; cnt = 0u; mine = 0u;
#pragma unroll
        for (unsigned j = 0; j < 16; ++j) { const unsigned c = xb_ld(&bar[XB_XCNT(j)]); sum += c; cnt += (c > 0u) ? 1u : 0u; mine = (j == x) ? c : mine; }
        if (sum == G) break;
        __builtin_amdgcn_s_sleep(1);
        if ((++sp & 255u) == 0u) { if (xb_ld(&bar[XB_TMO])) break; if (sp > XB_SPIN_CAP) { atomicAdd(&bar[XB_TMO], 1u); break; } }
    }
    nloc = mine > 0u ? mine : 1u; nx = cnt > 0u ? cnt : 1u;
}
__device__ __forceinline__ void xcd_barrier(const XcdBarrier& b) {
    asm volatile("s_waitcnt vmcnt(0)" ::: "memory");
    __syncthreads();
    if (threadIdx.x == 0) {
        unsigned* bar = b.bar;
        __builtin_amdgcn_s_waitcnt(0);
        unsigned nloc = b.st[0], nx = b.st[1];
        if (nloc == 0u) { xcd_barrier_complete(bar, b.x, nloc, nx); b.st[0] = nloc; b.st[1] = nx; }
        const unsigned old = xb_add(&bar[XB_XSUB(b.x)], 1u);
        const unsigned gen = old / nloc;
        if (old + 1u == (gen + 1u) * nloc) {
            __builtin_amdgcn_fence(__ATOMIC_RELEASE, "agent");
            asm volatile("s_waitcnt vmcnt(0)" ::: "memory");
            const unsigned og = xb_add(&bar[XB_TOP], 1u);
            const unsigned tg = og / nx;
            if (og + 1u == (tg + 1u) * nx) xb_add(&bar[XB_TOPGEN], 1u);
            else XB_SPIN(xb_ld(&bar[XB_TOPGEN]) == tg, bar);
            __builtin_amdgcn_fence(__ATOMIC_ACQUIRE, "agent");
            xb_add(&bar[XB_XGEN(b.x)], 1u);
            asm volatile("s_waitcnt vmcnt(0)" ::: "memory");
        } else {
            XB_SPIN(xb_ld(&bar[XB_XGEN(b.x)]) == gen, bar);
            __builtin_amdgcn_fence(__ATOMIC_ACQUIRE, "agent");
            asm volatile("s_waitcnt vmcnt(0)" ::: "memory");
        }
    }
    __syncthreads();
}

using pg8::Unit;
struct SchedPlain {
    const char* A; const char* Bt; int nM, nN, G, c, K;
    __device__ __forceinline__ bool next(int i, Unit& u) const { const long L = (long)i * G + c; if (L >= (long)nM * nN) return false; pg8::tile_of((int)L, nM, nN, u.pm, u.pn); u.kind = 0; u.dup = 0; return true; }
    __device__ __forceinline__ const char* a_ptr(const Unit& u) const { return A + (size_t)u.pm * 256 * K * 2; }
    __device__ __forceinline__ const char* b_ptr(const Unit& u) const { return Bt + (size_t)u.pn * 256 * K * 2; }
    __device__ __forceinline__ unsigned goff(int, int) const { return 0u; }
};
template <class B> struct SchedDup { B b;
    __device__ __forceinline__ bool next(int i, Unit& u) const { if (!b.next(i >> 1, u)) return false; u.dup = !(i & 1); return true; }
    __device__ __forceinline__ const char* a_ptr(const Unit& u) const { return b.a_ptr(u); }
    __device__ __forceinline__ const char* b_ptr(const Unit& u) const { return b.b_ptr(u); }
    __device__ __forceinline__ unsigned goff(int, int) const { return 0u; }
    __device__ __forceinline__ int k_of(const Unit& u) const { return b.k_of(u); }
};
struct SchedZ {
    const char* A; const char* Bt; int G, c;
    __device__ __forceinline__ bool next(int i, Unit& u) const { const long L = (long)i * G + c; if (L >= 912) return false;
        if (L < 896) pg8::tile_of((int)L, 128, 7, u.pm, u.pn); else { const int j = (int)L - 896; u.pm = 128 + (j >> 2); u.pn = 15 + (j & 3); } u.kind = 0; u.dup = 0; return true; }
    __device__ __forceinline__ const char* a_ptr(const Unit& u) const { return A + (size_t)u.pm * 256 * 2048; }
    __device__ __forceinline__ const char* b_ptr(const Unit& u) const { return Bt + (size_t)u.pn * 256 * 2048; }
    __device__ __forceinline__ unsigned goff(int, int) const { return 0u; }
};
struct SchedY {
    const char* ws; int G, c;
    __device__ __forceinline__ bool next(int i, Unit& u) const { const long L = (long)(i >> 2) * G + c; if (L >= 512) return false; pg8::tile_of((int)L, 128, 4, u.pm, u.pn); u.kind = i & 3; u.dup = 0; return true; }
    __device__ __forceinline__ int k_of(const Unit& u) const { return 1024 - 512 * (u.kind >> 1); }
    __device__ __forceinline__ const char* a_ptr(const Unit& u) const { const size_t mix = (size_t)(u.kind >> 1), sg = (size_t)(u.kind & 1);
        const size_t off = mix * (WS_ATT + sg * (WS_SG - WS_ATT) + (size_t)u.pm * 256 * 1024) + (1 - mix) * (WS_XN + (size_t)u.pm * 256 * 2048); return ws + off; }
    __device__ __forceinline__ const char* b_ptr(const Unit& u) const { const size_t mix = (size_t)(u.kind >> 1), sg = (size_t)(u.kind & 1);
        const size_t off = mix * (WS_WATT + sg * (WS_WSGU - WS_WATT) + (size_t)u.pn * 256 * 1024) + (1 - mix) * (WS_WZ + (size_t)(ZGA + sg * (ZGB - ZGA) + u.pn * 256) * 2048); return ws + off; }
    __device__ __forceinline__ unsigned goff(int, int) const { return 0u; }
};
struct SchedMoe {
    const LAS int* rec; const LAS unsigned* tbl; const char* A; const char* Bt; size_t a_panel_bytes, b_expert_bytes, b_tile_bytes; bool gather;
    __device__ __forceinline__ bool next(int i, Unit& u) const { if (i >= MOE_MAXU || rec[i * 8] == 0) return false; u.pm = rec[i * 8 + 1]; u.pn = rec[i * 8 + 2]; u.kind = rec[i * 8 + 3]; u.dup = 0; return true; }
    __device__ __forceinline__ const char* a_ptr(const Unit& u) const { return gather ? A : A + (size_t)u.pm * a_panel_bytes; }
    __device__ __forceinline__ const char* b_ptr(const Unit& u) const { return Bt + (size_t)u.kind * b_expert_bytes + (size_t)u.pn * b_tile_bytes; }
    __device__ __forceinline__ unsigned goff(int ui, int row) const { return tbl[ui * 256 + row]; }
};

#ifndef EPI_ST
#define EPI_ST 0
#endif
__device__ __forceinline__ void st16(void* p, u32x4 v) {
#if EPI_ST == 1
    asm volatile("global_store_dwordx4 %0, %1, off nt\n\ts_nop 1" :: "v"(p), "v"(v) : "memory");
#elif EPI_ST == 2
    asm volatile("global_store_dwordx4 %0, %1, off sc1\n\ts_nop 1" :: "v"(p), "v"(v) : "memory");
#else
    *(u32x4*)p = v;
#endif
}
typedef const f32x4 (&AccRef)[2][2][4][2];
typedef float f32x2 __attribute__((ext_vector_type(2)));
struct EpiZ {
    static constexpr bool PERM = true, EDUP = false;
    unsigned char* ws; const float* gq; const float* gk; const float* tab;
    __device__ __forceinline__ void operator()(AccRef acc, const Unit& u, int, int wr, int wc, int fr, int fq) const {
        const int pn = u.pn;
        if (pn <= 2) {
            const bool isv = (pn == 2 && wc >= 2), isq = (pn < 2);
            bf16_t* dst; int ldc;
            if (isq) { dst = (bf16_t*)(ws + WS_Q) + (4 * pn + wc) * 64; ldc = 512; }
            else if (!isv) { dst = (bf16_t*)(ws + WS_K) + wc * 64; ldc = 128; }
            else { dst = (bf16_t*)(ws + WS_V) + (wc - 2) * 64; ldc = 128; }
            const float* g = isq ? gq : gk;
            f32x4 gv[2][2];
#pragma unroll
            for (int bj = 0; bj < 2; ++bj)
#pragma unroll
                for (int n = 0; n < 2; ++n) gv[bj][n] = *(const f32x4*)(g + 32 * bj + 8 * fq + 4 * n);
            const float osc = isq ? C2_SELF : 1.0f;
#pragma unroll
            for (int ai = 0; ai < 2; ++ai) {
                const int rid = (4 * u.pm + 2 * ai + wr) & 127;
                f32x4 csr = (f32x4){1.f, 1.f, 1.f, 1.f}, snr = (f32x4){0.f, 0.f, 0.f, 0.f}, csc[4], snc[4];
#pragma unroll
                for (int m = 0; m < 4; ++m) { csc[m] = csr; snc[m] = snr; }
                if (!isv) { const float* tr = tab + rid * 16 + 4 * fq; csr = *(const f32x4*)tr; snr = *(const f32x4*)(tr + 2048);
#pragma unroll
                    for (int m = 0; m < 4; ++m) { const float* tc = tab + 2 * 2048 + (16 * m + fr) * 16 + 4 * fq; csc[m] = *(const f32x4*)tc; snc[m] = *(const f32x4*)(tc + 2048); } }
#pragma unroll
                for (int m = 0; m < 4; ++m) {
                    const int row = u.pm * 256 + ai * 128 + wr * 64 + m * 16 + fr;
                    bf16_t* rowp = dst + (size_t)row * ldc + 8 * fq;
                    if (isv) {
#pragma unroll
                        for (int bj = 0; bj < 2; ++bj) { const f32x4 v0 = acc[ai][bj][m][0], v1 = acc[ai][bj][m][1];
                            u32x4 w; w.x = pg8::cvt_pk_bf16(v0[0], v0[1]); w.y = pg8::cvt_pk_bf16(v0[2], v0[3]); w.z = pg8::cvt_pk_bf16(v1[0], v1[1]); w.w = pg8::cvt_pk_bf16(v1[2], v1[3]);
                            st16(rowp + 32 * bj, w); }
                    } else {
                        float ss = 0.f;
#pragma unroll
                        for (int bj = 0; bj < 2; ++bj)
#pragma unroll
                            for (int n = 0; n < 2; ++n) { const f32x4 x = acc[ai][bj][m][n]; ss += (x[0] * x[0] + x[1] * x[1]) + (x[2] * x[2] + x[3] * x[3]); }
                        ss += __shfl_xor(ss, 16); ss += __shfl_xor(ss, 32);
                        const float rs = osc / sqrtf(ss * (1.f / 64.f) + EPS);
#pragma unroll
                        for (int bj = 0; bj < 2; ++bj) {
                            const f32x4 cs = bj ? csc[m] : csr, sn = bj ? snc[m] : snr;
                            float o[8];
#pragma unroll
                            for (int n = 0; n < 2; ++n) { const f32x4 x = acc[ai][bj][m][n], gg = gv[bj][n];
                                const float y0 = x[0] * rs * gg[0], y1 = x[1] * rs * gg[1], y2 = x[2] * rs * gg[2], y3 = x[3] * rs * gg[3];
                                const float c0 = cs[2 * n], s0 = sn[2 * n], c1 = cs[2 * n + 1], s1 = sn[2 * n + 1];
                                o[4 * n + 0] = y0 * c0 - y1 * s0; o[4 * n + 1] = y0 * s0 + y1 * c0; o[4 * n + 2] = y2 * c1 - y3 * s1; o[4 * n + 3] = y2 * s1 + y3 * c1; }
                            u32x4 w; w.x = pg8::cvt_pk_bf16(o[0], o[1]); w.y = pg8::cvt_pk_bf16(o[2], o[3]); w.z = pg8::cvt_pk_bf16(o[4], o[5]); w.w = pg8::cvt_pk_bf16(o[6], o[7]);
                            st16(rowp + 32 * bj, w); }
                    }
                }
            }
        } else {
            bf16_t* dst; int ldc, row0; int act;
            if (pn < 5) { dst = (bf16_t*)(ws + WS_U) + (pn - 3) * 256; ldc = 512; act = 1; row0 = u.pm * 256; }
            else if (pn < 7) { dst = (bf16_t*)(ws + WS_GV) + (pn - 5) * 256; ldc = 512; act = 1; row0 = u.pm * 256; }
            else if (pn < 11) { dst = (bf16_t*)(ws + WS_GA) + (pn - 7) * 256; ldc = 1024; act = 2; row0 = u.pm * 256; }
            else if (pn < 15) { dst = (bf16_t*)(ws + WS_GB) + (pn - 11) * 256; ldc = 1024; act = 2; row0 = u.pm * 256; }
            else { dst = (bf16_t*)(ws + WS_KVC) + (pn - 15) * 256; ldc = 1024; act = 0; row0 = (u.pm - 128) * 256; }
#pragma unroll
            for (int ai = 0; ai < 2; ++ai)
#pragma unroll
                for (int m = 0; m < 4; ++m) { bf16_t* rowp = dst + (size_t)(row0 + ai * 128 + wr * 64 + m * 16 + fr) * ldc + wc * 32 + 8 * fq;
#pragma unroll
                    for (int bj = 0; bj < 2; ++bj) { f32x2 o[4];
#pragma unroll
                        for (int n = 0; n < 2; ++n)
#pragma unroll
                            for (int hh = 0; hh < 2; ++hh) { const f32x2 x = (f32x2){acc[ai][bj][m][n][2 * hh], acc[ai][bj][m][n][2 * hh + 1]};
                                if (act == 2) { const f32x2 t = x * (-LOG2E); f32x2 e; e.x = __builtin_amdgcn_exp2f(t.x); e.y = __builtin_amdgcn_exp2f(t.y); const f32x2 d = e + 1.0f;
                                    f32x2 r; r.x = __builtin_amdgcn_rcpf(d.x); r.y = __builtin_amdgcn_rcpf(d.y); o[2 * n + hh] = r; }
                                else if (act == 1) { const f32x2 x2 = x * x, t = (x2 * (-2.0f * LOG2E * 0.7978845608028654f * 0.044715f) + (-2.0f * LOG2E * 0.7978845608028654f)) * x;
                                    f32x2 e; e.x = __builtin_amdgcn_exp2f(t.x); e.y = __builtin_amdgcn_exp2f(t.y); const f32x2 d = e + 1.0f;
                                    f32x2 r; r.x = __builtin_amdgcn_rcpf(d.x); r.y = __builtin_amdgcn_rcpf(d.y); o[2 * n + hh] = x * r; }
                                else o[2 * n + hh] = x; }
                        u32x4 w; w.x = pg8::cvt_pk_bf16(o[0].x, o[0].y); w.y = pg8::cvt_pk_bf16(o[1].x, o[1].y); w.z = pg8::cvt_pk_bf16(o[2].x, o[2].y); w.w = pg8::cvt_pk_bf16(o[3].x, o[3].y);
                        st16(rowp + bj * 128, w); } }
        }
    }
};
__device__ __forceinline__ void unpack8(const u32x4 g, float (&f)[8]) {
    f[0] = __uint_as_float(g.x << 16); f[1] = __uint_as_float(g.x & 0xffff0000u); f[2] = __uint_as_float(g.y << 16); f[3] = __uint_as_float(g.y & 0xffff0000u);
    f[4] = __uint_as_float(g.z << 16); f[5] = __uint_as_float(g.z & 0xffff0000u); f[6] = __uint_as_float(g.w << 16); f[7] = __uint_as_float(g.w & 0xffff0000u);
}
struct EpiY {
    static constexpr bool PERM = true, EDUP = false;
    bf16_t* GS; bf16_t* MG;
    __device__ __forceinline__ void operator()(AccRef acc, const Unit& u, int, int wr, int wc, int fr, int fq) const {
#ifdef TEST_TRIV
        if (u.kind >= TEST_TRIV) { GS[(size_t)fr] = (bf16_t)acc[0][0][0][0][0]; return; }
#endif
        int gsl = (wr * 64 + fr) * 256 + wc * 32 + 8 * fq; asm volatile("" : "+v"(gsl));
        static_assert(GATE_U8, "two parked gate tiles need the 8-bit form"); gsl += (u.kind & 1) * 65536;
        if (u.kind < 2) {
#pragma unroll
            for (int ai = 0; ai < 2; ++ai)
#pragma unroll
                for (int m = 0; m < 4; ++m) {
#pragma unroll
                    for (int bj = 0; bj < 2; ++bj) { unsigned q[8];
#pragma unroll
                        for (int n = 0; n < 2; ++n)
#pragma unroll
                            for (int hh = 0; hh < 2; ++hh) { const f32x2 x = (f32x2){acc[ai][bj][m][n][2 * hh], acc[ai][bj][m][n][2 * hh + 1]};
                                const f32x2 t = x * (-LOG2E); f32x2 e; e.x = __builtin_amdgcn_exp2f(t.x); e.y = __builtin_amdgcn_exp2f(t.y); const f32x2 d = e + 1.0f;
                                f32x2 r; r.x = __builtin_amdgcn_rcpf(d.x); r.y = __builtin_amdgcn_rcpf(d.y);
#if GATE_U8
                                const f32x2 s = r * 255.0f + 0.5f; q[4 * n + 2 * hh] = (unsigned)s.x; q[4 * n + 2 * hh + 1] = (unsigned)s.y; }
                        u32x2 w; w.x = q[0] | (q[1] << 8) | (q[2] << 16) | (q[3] << 24); w.y = q[4] | (q[5] << 8) | (q[6] << 16) | (q[7] << 24);
                        *(u32x2*)((unsigned char*)GS + gsl + (ai * 128 + m * 16) * 256 + bj * 128) = w; }
#else
                                q[4 * n + 2 * hh] = __float_as_uint(r.x); q[4 * n + 2 * hh + 1] = __float_as_uint(r.y); }
                        u32x4 w; w.x = pg8::cvt_pk_bf16(__uint_as_float(q[0]), __uint_as_float(q[1])); w.y = pg8::cvt_pk_bf16(__uint_as_float(q[2]), __uint_as_float(q[3]));
                        w.z = pg8::cvt_pk_bf16(__uint_as_float(q[4]), __uint_as_float(q[5])); w.w = pg8::cvt_pk_bf16(__uint_as_float(q[6]), __uint_as_float(q[7]));
                        st16(GS + gsl + (ai * 128 + m * 16) * 256 + bj * 128, w); }
#endif
                }
            return;
        }
        const bool add = (u.kind == 3);
        const size_t offb = (size_t)(u.pm * 256 + wr * 64 + fr) * 1024 + u.pn * 256 + wc * 32 + 8 * fq;
        u32x4 pp[2][2];
#if GATE_U8
        u32x2 gg[2][2];
#define EPIY_GLOAD(buf, bj, ai_, m_) gg[buf][bj] = *(const u32x2*)((const unsigned char*)GS + gsl + (ai_ * 128 + m_ * 16) * 256 + bj * 128)
#else
        u32x4 gg[2][2];
#define EPIY_GLOAD(buf, bj, ai_, m_) gg[buf][bj] = *(const u32x4*)(GS + gsl + (ai_ * 128 + m_ * 16) * 256 + bj * 128)
#endif
#define EPIY_LOAD(buf, s) do { const int ai_ = (s) >> 2, m_ = (s) & 3; _Pragma("unroll") for (int bj = 0; bj < 2; ++bj) { \
            EPIY_GLOAD(buf, bj, ai_, m_); \
            pp[buf][bj] = add ? *(const u32x4*)(MG + offb + (size_t)(ai_ * 128 + m_ * 16) * 1024 + bj * 128) : (u32x4){0u, 0u, 0u, 0u}; } } while (0)
        EPIY_LOAD(0, 0);
#pragma unroll
        for (int s = 0; s < 8; ++s) { const int ai = s >> 2, mm = s & 3, cb = s & 1;
            if (s + 1 < 8) { if (cb == 0) EPIY_LOAD(1, s + 1); else EPIY_LOAD(0, s + 1); }
#pragma unroll
            for (int bj = 0; bj < 2; ++bj) { float g[8], p[8]; unpack8(pp[cb][bj], p); float o[8];
#if GATE_U8
                { const unsigned g0 = gg[cb][bj].x, g1 = gg[cb][bj].y;
                  g[0] = (float)(g0 & 0xffu) * (1.f / 255.f); g[1] = (float)((g0 >> 8) & 0xffu) * (1.f / 255.f); g[2] = (float)((g0 >> 16) & 0xffu) * (1.f / 255.f); g[3] = (float)(g0 >> 24) * (1.f / 255.f);
                  g[4] = (float)(g1 & 0xffu) * (1.f / 255.f); g[5] = (float)((g1 >> 8) & 0xffu) * (1.f / 255.f); g[6] = (float)((g1 >> 16) & 0xffu) * (1.f / 255.f); g[7] = (float)(g1 >> 24) * (1.f / 255.f); }
#else
                unpack8(gg[cb][bj], g);
#endif
#pragma unroll
                for (int n = 0; n < 2; ++n)
#pragma unroll
                    for (int j = 0; j < 4; ++j) o[4 * n + j] = p[4 * n + j] + g[4 * n + j] * acc[ai][bj][mm][n][j];
                u32x4 w; w.x = pg8::cvt_pk_bf16(o[0], o[1]); w.y = pg8::cvt_pk_bf16(o[2], o[3]); w.z = pg8::cvt_pk_bf16(o[4], o[5]); w.w = pg8::cvt_pk_bf16(o[6], o[7]);
                st16(MG + offb + (size_t)(ai * 128 + mm * 16) * 1024 + bj * 128, w); } }
#undef EPIY_LOAD
#undef EPIY_GLOAD
    }
};
struct EpiRes {
    static constexpr bool PERM = false, EDUP = false;
    const float* base; float* out;
    __device__ __forceinline__ void operator()(AccRef acc, const Unit& u, int, int wr, int wc, int fr, int fq) const {
#pragma unroll
        for (int ai = 0; ai < 2; ++ai) {
            const size_t off0 = (size_t)(u.pm * 256 + ai * 128 + wr * 64 + fr) * 1024 + u.pn * 256 + wc * 32 + 4 * fq;
            f32x4 bb[4][2][2];
#pragma unroll
            for (int m = 0; m < 4; ++m)
#pragma unroll
                for (int bj = 0; bj < 2; ++bj)
#pragma unroll
                    for (int n = 0; n < 2; ++n) bb[m][bj][n] = *(const f32x4*)(base + off0 + (size_t)m * 16 * 1024 + bj * 128 + n * 16);
#pragma unroll
            for (int m = 0; m < 4; ++m)
#pragma unroll
                for (int bj = 0; bj < 2; ++bj)
#pragma unroll
                    for (int n = 0; n < 2; ++n) *(f32x4*)(out + off0 + (size_t)m * 16 * 1024 + bj * 128 + n * 16) = bb[m][bj][n] + acc[ai][bj][m][n]; }
    }
};
struct EpiBf16s {
    static constexpr bool PERM = true, EDUP = false;
    bf16_t* O; int ldc; float scale;
    __device__ __forceinline__ void operator()(AccRef acc, const Unit& u, int, int wr, int wc, int fr, int fq) const {
#pragma unroll
        for (int ai = 0; ai < 2; ++ai)
#pragma unroll
            for (int m = 0; m < 4; ++m) { bf16_t* rowp = O + (size_t)(u.pm * 256 + ai * 128 + wr * 64 + m * 16 + fr) * ldc + u.pn * 256 + wc * 32 + 8 * fq;
#pragma unroll
                for (int bj = 0; bj < 2; ++bj) { const f32x4 v0 = acc[ai][bj][m][0] * scale, v1 = acc[ai][bj][m][1] * scale;
                    u32x4 w; w.x = pg8::cvt_pk_bf16(v0[0], v0[1]); w.y = pg8::cvt_pk_bf16(v0[2], v0[3]); w.z = pg8::cvt_pk_bf16(v1[0], v1[1]); w.w = pg8::cvt_pk_bf16(v1[2], v1[3]);
                    st16(rowp + bj * 128, w); } }
    }
};
struct EpiMoeA {
    static constexpr bool PERM = true, EDUP = false;
    bf16_t* H; const LAS float* rstbl;
    __device__ __forceinline__ void operator()(AccRef acc, const Unit& u, int ui, int wr, int wc, int fr, int fq) const {
#pragma unroll
        for (int ai = 0; ai < 2; ++ai)
#pragma unroll
            for (int m = 0; m < 4; ++m) { bf16_t* rowp = H + (size_t)(u.pm * 256 + ai * 128 + wr * 64 + m * 16 + fr) * 512 + u.pn * 128 + wc * 32 + 8 * fq; float o[8];
                const float rs = ROUTE_MFMA ? rstbl[ui * 256 + ai * 128 + wr * 64 + m * 16 + fr] : 1.0f;
#pragma unroll
                for (int n = 0; n < 2; ++n)
#pragma unroll
                    for (int j = 0; j < 4; ++j) { const float g = acc[ai][0][m][n][j] * rs, up = acc[ai][1][m][n][j] * rs; o[4 * n + j] = g * __builtin_amdgcn_rcpf(1.0f + __builtin_amdgcn_exp2f(-LOG2E * g)) * up; }
                u32x4 w; w.x = pg8::cvt_pk_bf16(o[0], o[1]); w.y = pg8::cvt_pk_bf16(o[2], o[3]); w.z = pg8::cvt_pk_bf16(o[4], o[5]); w.w = pg8::cvt_pk_bf16(o[6], o[7]);
                st16(rowp, w); }
    }
};
struct EpiMoeB {
    static constexpr bool PERM = true, EDUP = false;
    const LAS int* rec; const int* list; bf16_t* YS;
    __device__ __forceinline__ void operator()(AccRef acc, const Unit& u, int ui, int wr, int wc, int fr, int fq) const {
        const int e = u.kind, r0 = rec[ui * 8 + 4], ne = rec[ui * 8 + 5];
        u32x2 ent[2][4];
#pragma unroll
        for (int ai = 0; ai < 2; ++ai)
#pragma unroll
            for (int m = 0; m < 4; ++m) { const int idx = r0 + ai * 128 + wr * 64 + m * 16 + fr; ent[ai][m] = (u32x2){0u, 0u};
                if (idx < ne) ent[ai][m] = *(const u32x2*)(list + ((size_t)e * LIST_CAP + idx) * 2); }
#pragma unroll
        for (int ai = 0; ai < 2; ++ai)
#pragma unroll
            for (int m = 0; m < 4; ++m) { const int idx = r0 + ai * 128 + wr * 64 + m * 16 + fr;
                if (idx < ne) { const int dest = (int)ent[ai][m].x; const float w = __uint_as_float(ent[ai][m].y);
                    bf16_t* rowp = YS + (size_t)dest * 1024 + u.pn * 256 + wc * 32 + 8 * fq;
#pragma unroll
                    for (int bj = 0; bj < 2; ++bj) { const f32x4 v0 = acc[ai][bj][m][0] * w, v1 = acc[ai][bj][m][1] * w;
                        u32x4 wv; wv.x = pg8::cvt_pk_bf16(v0[0], v0[1]); wv.y = pg8::cvt_pk_bf16(v0[2], v0[3]); wv.z = pg8::cvt_pk_bf16(v1[0], v1[1]); wv.w = pg8::cvt_pk_bf16(v1[2], v1[3]);
                        st16(rowp + bj * 128, wv); } } }
    }
};

struct EpiX1 {
    static constexpr bool PERM = true, EDUP = true;
    const float* x; bf16_t* XB; float* ssq;
    __device__ __forceinline__ void operator()(AccRef acc, const Unit& u, int, int wr, int wc, int fr, int fq) const {
        const int rowb = u.pm * 256 + wr * 64 + fr; const size_t offb = (size_t)rowb * 1024 + u.pn * 256 + wc * 32 + 8 * fq;
        f32x4 xb[2][2][2];
#define EPIX1_LOAD(buf, s) do { const int ai_ = (s) >> 2, m_ = (s) & 3; _Pragma("unroll") for (int bj = 0; bj < 2; ++bj) _Pragma("unroll") for (int n = 0; n < 2; ++n) \
            xb[buf][bj][n] = *(const f32x4*)(x + offb + (size_t)(ai_ * 128 + m_ * 16) * 1024 + bj * 128 + n * 4); } while (0)
        EPIX1_LOAD(0, 0);
#pragma unroll
        for (int s = 0; s < 8; ++s) { const int ai = s >> 2, mm = s & 3, cb = s & 1;
            if (s + 1 < 8) { if (cb == 0) EPIX1_LOAD(1, s + 1); else EPIX1_LOAD(0, s + 1); }
            float ss = 0.f;
#pragma unroll
            for (int bj = 0; bj < 2; ++bj) { const f32x4 v0 = xb[cb][bj][0] + acc[ai][bj][mm][0], v1 = xb[cb][bj][1] + acc[ai][bj][mm][1];
                ss += (v0[0] * v0[0] + v0[1] * v0[1]) + (v0[2] * v0[2] + v0[3] * v0[3]) + (v1[0] * v1[0] + v1[1] * v1[1]) + (v1[2] * v1[2] + v1[3] * v1[3]);
                u32x4 w; w.x = pg8::cvt_pk_bf16(v0[0], v0[1]); w.y = pg8::cvt_pk_bf16(v0[2], v0[3]); w.z = pg8::cvt_pk_bf16(v1[0], v1[1]); w.w = pg8::cvt_pk_bf16(v1[2], v1[3]);
                st16(XB + offb + (size_t)(ai * 128 + mm * 16) * 1024 + bj * 128, w); }
            ss += __shfl_xor(ss, 16); ss += __shfl_xor(ss, 32);
            if (fq == 0) ssq[(size_t)(rowb + ai * 128 + mm * 16) * 16 + u.pn * 4 + wc] = ss; }
#undef EPIX1_LOAD
    }
};
struct EpiQC {
    static constexpr bool PERM = true, EDUP = false;
    bf16_t* O; const float* ssq; float scale;
    __device__ __forceinline__ void operator()(AccRef acc, const Unit& u, int, int wr, int wc, int fr, int fq) const {
        f32x4 q[2][4];
#pragma unroll
        for (int ai = 0; ai < 2; ++ai)
#pragma unroll
            for (int m = 0; m < 4; ++m) q[ai][m] = *(const f32x4*)(ssq + (size_t)(u.pm * 256 + ai * 128 + wr * 64 + m * 16 + fr) * 16 + 4 * fq);
#pragma unroll
        for (int ai = 0; ai < 2; ++ai)
#pragma unroll
            for (int m = 0; m < 4; ++m) { float s = (q[ai][m][0] + q[ai][m][1]) + (q[ai][m][2] + q[ai][m][3]); s += __shfl_xor(s, 16); s += __shfl_xor(s, 32);
                const float rs = scale / sqrtf(s * (1.f / 1024.f) + EPS);
                bf16_t* rowp = O + (size_t)(u.pm * 256 + ai * 128 + wr * 64 + m * 16 + fr) * 512 + u.pn * 256 + wc * 32 + 8 * fq;
#pragma unroll
                for (int bj = 0; bj < 2; ++bj) { const f32x4 v0 = acc[ai][bj][m][0] * rs, v1 = acc[ai][bj][m][1] * rs;
                    u32x4 w; w.x = pg8::cvt_pk_bf16(v0[0], v0[1]); w.y = pg8::cvt_pk_bf16(v0[2], v0[3]); w.z = pg8::cvt_pk_bf16(v1[0], v1[1]); w.w = pg8::cvt_pk_bf16(v1[2], v1[3]);
                    st16(rowp + bj * 128, w); } }
    }
};
struct EpiX2 {
    static constexpr bool PERM = true, EDUP = false;
    const bf16_t* XB; float* out; bf16_t* XB2;
    __device__ __forceinline__ void operator()(AccRef acc, const Unit& u, int, int wr, int wc, int fr, int fq) const {
        const size_t offb = (size_t)(u.pm * 256 + wr * 64 + fr) * 1024 + u.pn * 256 + wc * 32 + 8 * fq;
        u32x4 xb[2][2];
#define EPIX2_LOAD(buf, s) do { const int ai_ = (s) >> 2, m_ = (s) & 3; _Pragma("unroll") for (int bj = 0; bj < 2; ++bj) xb[buf][bj] = *(const u32x4*)(XB + offb + (size_t)(ai_ * 128 + m_ * 16) * 1024 + bj * 128); } while (0)
        EPIX2_LOAD(0, 0);
#pragma unroll
        for (int s = 0; s < 8; ++s) { const int ai = s >> 2, mm = s & 3, cb = s & 1;
            if (s + 1 < 8) { if (cb == 0) EPIX2_LOAD(1, s + 1); else EPIX2_LOAD(0, s + 1); }
#pragma unroll
            for (int bj = 0; bj < 2; ++bj) { float b[8]; unpack8(xb[cb][bj], b);
                const f32x4 v0 = (f32x4){b[0], b[1], b[2], b[3]} + acc[ai][bj][mm][0], v1 = (f32x4){b[4], b[5], b[6], b[7]} + acc[ai][bj][mm][1];
                const size_t o_ = offb + (size_t)(ai * 128 + mm * 16) * 1024 + bj * 128;
                if (X2_BF16) { u32x4 w; w.x = pg8::cvt_pk_bf16(v0[0], v0[1]); w.y = pg8::cvt_pk_bf16(v0[2], v0[3]); w.z = pg8::cvt_pk_bf16(v1[0], v1[1]); w.w = pg8::cvt_pk_bf16(v1[2], v1[3]); st16(XB2 + o_, w); }
                else { *(f32x4*)(out + o_) = v0; *(f32x4*)(out + o_ + 4) = v1; } } }
#undef EPIX2_LOAD
    }
};
typedef short v4i16_t __attribute__((ext_vector_type(4)));
typedef short bf16x8_t __attribute__((ext_vector_type(8)));
typedef float f32x16_t __attribute__((ext_vector_type(16)));
__device__ __forceinline__ v4i16_t lds_tr16(LAS unsigned char* p) { return __builtin_amdgcn_ds_read_tr16_b64_v4i16((LAS v4i16_t*)p); }

__device__ __forceinline__ void sgu_unit(LAS unsigned char* lds, unsigned char* ws, const PtrsIn& P, int ch) {
    const int tid = threadIdx.x, lane = tid & 63, wave = __builtin_amdgcn_readfirstlane(tid >> 6), fr = lane & 15, fq = lane >> 4;
    {
        const int row = tid >> 2, q4 = tid & 3;
        const u32x4* src = (const u32x4*)((const bf16_t*)(ws + WS_GV) + ((size_t)ch * 128 + row) * 512 + q4 * 128);
        u32x4 raw[16];
#pragma unroll
        for (int j = 0; j < 16; ++j) raw[j] = src[j];
        float s = 0.f;
#pragma unroll
        for (int j = 0; j < 16; ++j) { float f[8]; unpack8(raw[j], f);
#pragma unroll
            for (int k = 0; k < 8; ++k) s += f[k]; }
        s += __shfl_xor(s, 1); s += __shfl_xor(s, 2);
        const float mean = s * (1.f / 512.f); float q = 0.f;
#pragma unroll
        for (int j = 0; j < 16; ++j) { float f[8]; unpack8(raw[j], f);
#pragma unroll
            for (int k = 0; k < 8; ++k) { const float d = f[k] - mean; q += d * d; } }
        q += __shfl_xor(q, 1); q += __shfl_xor(q, 2);
        const float rstd = 1.0f / sqrtf(q * (1.f / 512.f) + EPS);
        const float* lg = P.in[7] + q4 * 128; const float* lb = P.in[8] + q4 * 128;
        LAS unsigned char* dst = lds + row * SGU_ROWB + q4 * 256;
#pragma unroll
        for (int j = 0; j < 16; ++j) { float f[8]; unpack8(raw[j], f);
            const f32x4 g0 = *(const f32x4*)(lg + 8 * j), g1 = *(const f32x4*)(lg + 8 * j + 4), b0 = *(const f32x4*)(lb + 8 * j), b1 = *(const f32x4*)(lb + 8 * j + 4);
            u32x4 w; w.x = pg8::cvt_pk_bf16((f[0] - mean) * rstd * g0[0] + b0[0], (f[1] - mean) * rstd * g0[1] + b0[1]); w.y = pg8::cvt_pk_bf16((f[2] - mean) * rstd * g0[2] + b0[2], (f[3] - mean) * rstd * g0[3] + b0[3]);
            w.z = pg8::cvt_pk_bf16((f[4] - mean) * rstd * g1[0] + b1[0], (f[5] - mean) * rstd * g1[1] + b1[1]); w.w = pg8::cvt_pk_bf16((f[6] - mean) * rstd * g1[2] + b1[2], (f[7] - mean) * rstd * g1[3] + b1[3]);
            *(LAS u32x4*)(dst + j * 16) = w; }
    }
    __syncthreads();
    const int i16 = lane & 15;
    LAS unsigned char* trb = lds + (8 * fq + (i16 >> 2)) * SGU_ROWB + (i16 & 3) * 8;
    const int p = 16 * wave + fr; const size_t tok = (size_t)ch * 128 + p;
    u32x2 uu[4][8]; float bsv[4];
#pragma unroll
    for (int g = 0; g < 4; ++g) { const bf16_t* U = (const bf16_t*)(ws + WS_U) + tok * 512 + g * 128 + 4 * fq; bsv[g] = P.in[10][g * 128 + p];
#pragma unroll
        for (int nt = 0; nt < 8; ++nt) uu[g][nt] = *(const u32x2*)(U + 16 * nt); }
#pragma unroll
    for (int g = 0; g < 4; ++g) {
        const bf16_t* W = (const bf16_t*)(ws + WS_WSS) + ((size_t)g * 128 + p) * 128 + 8 * fq;
        bf16x8_t af[4];
#pragma unroll
        for (int ks = 0; ks < 4; ++ks) af[ks] = *(const bf16x8_t*)(W + 32 * ks);
        const float bs = bsv[g];
        f32x4 acc[8];
#pragma unroll
        for (int nt = 0; nt < 8; ++nt) { acc[nt] = (f32x4){0.f, 0.f, 0.f, 0.f};
#pragma unroll
            for (int ks = 0; ks < 4; ++ks) { LAS unsigned char* a = trb + ks * 32 * SGU_ROWB + (g * 128 + 16 * nt) * 2;
                const v4i16_t lo = lds_tr16(a), hi = lds_tr16(a + 4 * SGU_ROWB);
                const bf16x8_t bfr = (bf16x8_t){lo[0], lo[1], lo[2], lo[3], hi[0], hi[1], hi[2], hi[3]};
                acc[nt] = __builtin_amdgcn_mfma_f32_16x16x32_bf16(bfr, af[ks], acc[nt], 0, 0, 0); } }
        bf16_t* SG = (bf16_t*)(ws + WS_SG) + tok * 512 + g * 128 + 4 * fq;
#pragma unroll
        for (int nt = 0; nt < 8; ++nt) { const u32x2 u2 = uu[g][nt];
            const float u0 = __uint_as_float(u2.x << 16), u1 = __uint_as_float(u2.x & 0xffff0000u), u2f = __uint_as_float(u2.y << 16), u3 = __uint_as_float(u2.y & 0xffff0000u);
            u32x2 o; o.x = pg8::cvt_pk_bf16(u0 * (acc[nt][0] + bs), u1 * (acc[nt][1] + bs)); o.y = pg8::cvt_pk_bf16(u2f * (acc[nt][2] + bs), u3 * (acc[nt][3] + bs));
            *(u32x2*)(SG + 16 * nt) = o; }
    }
    __syncthreads();
}

__device__ __forceinline__ void phase2_sgu_attn(LAS unsigned char* lds, unsigned char* lds_generic, unsigned char* ws, const PtrsIn& P, int vcu, int G) {
    for (int ch = vcu; ch < M / 128; ch += G) sgu_unit(lds, ws, P, ch);
    const int upc = (1024 + G - 1) / G;
    float cfix; { const int l64 = threadIdx.x & 63; const float mq = wave_max(fabsf(P.in[4][l64])), mk = wave_max(fabsf(P.in[5][l64])); cfix = __int_as_float(__builtin_amdgcn_readfirstlane(__float_as_int(C2_SELF * 64.0f * mq * mk))); }
    const bool fixm = ATT_FIXM && (cfix < 60.0f);
    const int nmoe = IT_TOTAL - IT_P0, per = (nmoe + G - 1) / G, it0 = IT_P0 + vcu * per, it1 = (it0 + per < IT_TOTAL) ? it0 + per : IT_TOTAL, slot = vcu % upc;
    for (int i = 0; i < upc; ++i) { const int U = vcu * upc + i;
        if (U < 1024) { const int bkv = U >> 7, jj = U & 127, hl = jj >> 5, qb = jj & 31, b = bkv >> 1, kvh = bkv & 1;
            if (fixm) attn_body::attn_unit<8, true>(b, kvh * 4 + hl, kvh, qb, (const bf16_t*)(ws + WS_Q), (const bf16_t*)(ws + WS_K), (const bf16_t*)(ws + WS_V), (bf16_t*)(ws + WS_ATT), (char*)lds_generic + RING_OFF, cfix);
            else attn_body::attn_unit<8, false>(b, kvh * 4 + hl, kvh, qb, (const bf16_t*)(ws + WS_Q), (const bf16_t*)(ws + WS_K), (const bf16_t*)(ws + WS_V), (bf16_t*)(ws + WS_ATT), (char*)lds_generic + RING_OFF, 0.f); }
        if (MOE_CONV_IN_P2 && i == slot) {
            int tid2 = threadIdx.x; asm volatile("" : "+v"(tid2));
            const int lane2 = tid2 & 63, wave2 = __builtin_amdgcn_readfirstlane(tid2 >> 6);
            LAS float* scr = (LAS float*)(lds + RING_OFF + wave2 * 16384);
            for (int it = it0 + wave2; it < it1; it += NWAVES) p0_weight_item(P, ws, scr, it, lane2);
            __syncthreads(); } }
}

__device__ __forceinline__ void cross_stage_kv(unsigned lds0, const bf16_t* KVC, int b, int h, int wave, int lane) {
#pragma unroll
    for (int j = 0; j < 8; ++j) { const int c = 2 * wave + (j >> 2), rb = j & 3;
        attn_body::glds16(KVC + (size_t)(b * NMEM + rb * 64 + lane) * 1024 + h * 128 + c * 8, (unsigned)__builtin_amdgcn_readfirstlane(lds0 + c * 4096 + rb * 1024)); }
#pragma unroll
    for (int j = 0; j < 8; ++j) { const int pc = wave * 8 + j, db = pc >> 4, r0 = (pc & 15) * 16;
        attn_body::glds16(KVC + (size_t)(b * NMEM + r0 + (lane >> 2)) * 1024 + 512 + h * 128 + db * 32 + (lane & 3) * 8, (unsigned)__builtin_amdgcn_readfirstlane(lds0 + 65536 + db * 16384 + r0 * 64)); }
}
__device__ __forceinline__ void cross_unit(LAS unsigned char* lds, const bf16_t* QC, bf16_t* OC, int row0, int h) {
    const int tid = threadIdx.x, lane = tid & 63, wave = __builtin_amdgcn_readfirstlane(tid >> 6), r32 = lane & 31, hi = lane >> 5;
    const bf16_t* Qw = QC + (size_t)(row0 + 32 * wave + r32) * 512 + h * 128 + 8 * hi;
    bf16x8_t qr[8];
#pragma unroll
    for (int ds = 0; ds < 8; ++ds) qr[ds] = *(const bf16x8_t*)(Qw + 16 * ds);
    f32x16_t p[8];
    const LAS unsigned char* kb0 = lds + hi * 4096 + r32 * 16;
#pragma unroll
    for (int kb = 0; kb < 8; ++kb) { p[kb] = f32x16_t{};
#pragma unroll
        for (int ds = 0; ds < 8; ++ds) { const bf16x8_t kf = *(const LAS bf16x8_t*)(kb0 + ds * 8192 + kb * 512); p[kb] = __builtin_amdgcn_mfma_f32_32x32x16_bf16(kf, qr[ds], p[kb], 0, 0, 0); }
        __builtin_amdgcn_sched_barrier(0); }
    float mx = -1e30f;
#pragma unroll
    for (int kb = 0; kb < 8; ++kb)
#pragma unroll
        for (int r = 0; r < 16; ++r) mx = fmaxf(mx, p[kb][r]);
    { auto rr = __builtin_amdgcn_permlane32_swap(__float_as_uint(mx), __float_as_uint(mx), false, false); mx = fmaxf(__uint_as_float(rr[0]), __uint_as_float(rr[1])); }
    float l = 0.f;
    u32x4 pw[16];
#pragma unroll
    for (int kb = 0; kb < 8; ++kb) {
#pragma unroll
        for (int r = 0; r < 16; ++r) { p[kb][r] = __builtin_amdgcn_exp2f(p[kb][r] - mx); l += p[kb][r]; }
#pragma unroll
        for (int s = 0; s < 2; ++s) { pw[2 * kb + s].x = pg8::cvt_pk_bf16(p[kb][8 * s + 0], p[kb][8 * s + 1]); pw[2 * kb + s].y = pg8::cvt_pk_bf16(p[kb][8 * s + 2], p[kb][8 * s + 3]);
            pw[2 * kb + s].z = pg8::cvt_pk_bf16(p[kb][8 * s + 4], p[kb][8 * s + 5]); pw[2 * kb + s].w = pg8::cvt_pk_bf16(p[kb][8 * s + 6], p[kb][8 * s + 7]); }
        __builtin_amdgcn_sched_barrier(0); }
    { auto rr = __builtin_amdgcn_permlane32_swap(__float_as_uint(l), __float_as_uint(l), false, false); l = __uint_as_float(rr[0]) + __uint_as_float(rr[1]); }
    const float il = 1.0f / l;
    f32x16_t o[4];
#pragma unroll
    for (int db = 0; db < 4; ++db) o[db] = f32x16_t{};
    const int i16 = lane & 15;
    LAS unsigned char* vb = lds + 65536 + (4 * hi + (i16 >> 2)) * 64 + ((lane >> 4) & 1) * 32 + (i16 & 3) * 8;
#pragma unroll
    for (int ks = 0; ks < 16; ++ks) {
        const bf16x8_t pa = __builtin_bit_cast(bf16x8_t, pw[ks]);
#pragma unroll
        for (int db = 0; db < 4; ++db) { LAS unsigned char* a = vb + db * 16384 + (16 * ks) * 64;
            const v4i16_t lo = lds_tr16(a), hh = lds_tr16(a + 512);
            const bf16x8_t vf = (bf16x8_t){lo[0], lo[1], lo[2], lo[3], hh[0], hh[1], hh[2], hh[3]};
            o[db] = __builtin_amdgcn_mfma_f32_32x32x16_bf16(vf, pa, o[db], 0, 0, 0); }
        __builtin_amdgcn_sched_barrier(0); }
    bf16_t* Ow = OC + (size_t)(row0 + 32 * wave + r32) * 512 + h * 128 + 4 * hi;
#pragma unroll
    for (int db = 0; db < 4; ++db)
#pragma unroll
        for (int rg = 0; rg < 4; ++rg) { u32x2 w; w.x = pg8::cvt_pk_bf16(o[db][4 * rg + 0] * il, o[db][4 * rg + 1] * il); w.y = pg8::cvt_pk_bf16(o[db][4 * rg + 2] * il, o[db][4 * rg + 3] * il);
            *(u32x2*)(Ow + 32 * db + 8 * rg) = w; }
}
__device__ __forceinline__ void cross_after_qc(LAS unsigned char* lds, unsigned char* lds_generic, unsigned char* ws, int pm, int pn) {
    const int tid = threadIdx.x, lane = tid & 63, wave = __builtin_amdgcn_readfirstlane(tid >> 6);
    const unsigned lds0 = (unsigned)(uintptr_t)(lds_generic + RING_OFF);
    for (int hh = 0; hh < 2; ++hh) { const int h = 2 * pn + hh, b = pm >> 5;
        cross_stage_kv(lds0, (const bf16_t*)(ws + WS_KVC), b, h, wave, lane);
        asm volatile("s_waitcnt vmcnt(0)" ::: "memory"); __syncthreads();
        cross_unit(lds, (const bf16_t*)(ws + WS_QC), (bf16_t*)(ws + WS_OC), pm * 256, h);
        __syncthreads(); }
}
__device__ __forceinline__ void phase7_cross(LAS unsigned char* lds, unsigned char* lds_generic, unsigned char* ws, int vcu, int G) {
    const int tid = threadIdx.x, lane = tid & 63, wave = __builtin_amdgcn_readfirstlane(tid >> 6);
    const unsigned lds0 = (unsigned)(uintptr_t)(lds_generic + RING_OFF);
    for (int j = vcu; j < 256; j += G) { const int h = j & 3, pp = j >> 2, b = pp >> 4;
        cross_stage_kv(lds0, (const bf16_t*)(ws + WS_KVC), b, h, wave, lane);
        asm volatile("s_waitcnt vmcnt(0)" ::: "memory"); __syncthreads();
        cross_unit(lds, (const bf16_t*)(ws + WS_QC), (bf16_t*)(ws + WS_OC), (2 * pp) * 256, h);
        cross_unit(lds, (const bf16_t*)(ws + WS_QC), (bf16_t*)(ws + WS_OC), (2 * pp + 1) * 256, h);
        __syncthreads(); }
}
struct Args { PtrsIn P; float* out; unsigned char* ws; int ph_lo, ph_hi; };
static_assert(sizeof(Args) == 27 * 8 + 24, "Args has no holes");

__device__ __forceinline__ void moe_setup(LAS unsigned char* lds, unsigned char* ws, int vcu, int G, bool with_gather) {
    LAS int* rec = (LAS int*)(lds + UREC_OFF); LAS unsigned* tbl = (LAS unsigned*)(lds + TBL_OFF);
    const int tid = threadIdx.x;
    const unsigned* ec = (const unsigned*)(ws + WS_CTL) + CW_ECNT;
    int cnt[16], pb[17]; pb[0] = 0;
#pragma unroll
    for (int e = 0; e < 16; ++e) { cnt[e] = (int)__hip_atomic_load(ec + 64 * e, __ATOMIC_RELAXED, __HIP_MEMORY_SCOPE_AGENT); pb[e + 1] = pb[e] + ((cnt[e] + 255) >> 8); }
    const int NP = pb[16];
    LAS float* rstbl = (LAS float*)(lds + RSTBL_OFF);
    for (int i = 0; i < MOE_MAXU; ++i) {
        const int L = i * G + vcu; const bool valid = (L < 4 * NP);
        int panel = 0, pn = 0, e = 0, r0 = 0, ne = 0;
        if (valid) { panel = L >> 2; pn = L & 3;
#pragma unroll
            for (int j = 1; j < 16; ++j) if (panel >= pb[j]) e = j;
#pragma unroll
            for (int j = 0; j < 16; ++j) if (j == e) { r0 = (panel - pb[j]) * 256; ne = cnt[j]; } }
        if (tid == 0) { rec[i * 8 + 0] = valid ? 1 : 0; rec[i * 8 + 1] = panel; rec[i * 8 + 2] = pn; rec[i * 8 + 3] = e; rec[i * 8 + 4] = r0; rec[i * 8 + 5] = ne; }
        if (with_gather && tid < 256) { unsigned off = 0u; float rsv = 0.f;
            if (valid && r0 + tid < ne) { const int dest = ((const int*)(ws + WS_LIST))[((size_t)e * LIST_CAP + r0 + tid) * 2]; off = (unsigned)(dest >> 1) * 2048u; if (ROUTE_MFMA) rsv = ((const float*)(ws + WS_RSTOK))[dest >> 1]; }
            tbl[i * 256 + tid] = off; rstbl[i * 256 + tid] = rsv; }
    }
    if (tid == 0) rec[MOE_MAXU * 8] = 4 * NP;
    __syncthreads();
}

#ifndef LB_W
#define LB_W 2
#endif
__global__ void __launch_bounds__(NWAVES * 64, LB_W) mega(Args args) {
    extern __shared__ __attribute__((aligned(16))) unsigned char lds_raw[];
    LAS unsigned char* lds = (LAS unsigned char*)lds_raw;
    volatile LAS unsigned* MISC = (volatile LAS unsigned*)(lds + MISC_OFF);
    const int tid = threadIdx.x, lane = tid & 63, wave = __builtin_amdgcn_readfirstlane(tid >> 6);
    const int G = gridDim.x, bx = blockIdx.x, vcu = (G % 8 == 0) ? (bx % 8) * (G / 8) + bx / 8 : bx;
    unsigned char* ws = args.ws; const PtrsIn& P = args.P; float* out = args.out;
    for (int u = tid; u < (LDS_BYTES - MISC_OFF) / 4; u += NWAVES * 64) ((LAS unsigned*)(lds + MISC_OFF))[u] = 0u;
    __syncthreads();
    const int lo = args.ph_lo, hi = args.ph_hi;
    const bool fusedrun = (hi - lo) > 1;
    XcdBarrier bar; bar.bar = (unsigned*)(ws + WS_CTL) + CW_BAR; bar.x = 0; bar.st = nullptr;
    if (fusedrun) bar = xcd_barrier_post((unsigned*)(ws + WS_CTL) + CW_BAR, MISC + 8);
#ifndef TAIL_E0
#define TAIL_E0 16
#endif
#ifndef STAG_Y
#define STAG_Y 0u
#endif
#ifndef STAG_MA
#define STAG_MA 0u
#endif
#ifndef STAG_MB
#define STAG_MB 0u
#endif
#ifndef ALIGN_E
#define ALIGN_E true
#endif
#ifndef PH_EN
#define PH_EN 0x1FFF
#endif
#define IN(k) ((((PH_EN) >> (k)) & 1) && lo <= (k) && (k) < hi)
#define SEAM(k) do { if (IN(k) && IN((k) + 1)) xcd_barrier(bar); } while (0)
#ifndef PH_DUP
#define PH_DUP 0
#endif
#define NREP(k) ((((PH_DUP) >> (k)) & 1) ? 2 : 1)
#define REPSEAM(k) do { if (NREP(k) == 2 && rep_ == 0 && fusedrun) xcd_barrier(bar); } while (0)
    const int gw = vcu * NWAVES + wave, NGW = G * NWAVES;

    if (IN(0)) {
        _Pragma("unroll") for (int rep_ = 0; rep_ < NREP(0); ++rep_) {
        LAS float* scr = (LAS float*)(lds + RING_OFF + wave * 16384);
        const bool tailconv = TAIL_CONV && (G == 256);
        for (int it = gw; it < ((MOE_CONV_IN_P2 || tailconv) ? IT_P0 : IT_TOTAL); it += NGW) p0_weight_item(P, ws, scr, it, lane);
        if (tailconv) for (int j = TAIL_E0 * 512 + gw; j < NE * 512; j += NGW) p0_weight_item(P, ws, scr, IT_P0 + (j >> 9) * 768 + (j & 511), lane);
        { const float* wsrc = P.in[9]; bf16_t* wd = (bf16_t*)(ws + WS_WSS);
          for (int i = bx * 512 + tid; i < 4 * 128 * 128; i += G * 512) wd[i] = (bf16_t)f2bf(wsrc[i]); }
        for (int i = bx * 512 + tid; i < 2048; i += G * 512) rope_table_entry((float*)(ws + WS_TAB), i);
        bf16_t* XN = (bf16_t*)(ws + WS_XN);
        rms_rows(P.in[0], P.in[2], XN, gw, NGW, M, lane);
        rms_rows(P.in[1], P.in[14], XN + (size_t)M * D, gw, NGW, MMEM, lane);
            REPSEAM(0); }
    }
    SEAM(0);
    if (IN(1)) {
        _Pragma("unroll") for (int rep_ = 0; rep_ < NREP(1); ++rep_) {
        SchedZ S{(const char*)(ws + WS_XN), (const char*)(ws + WS_WZ), G, bx};
        EpiZ E{ws, P.in[4], P.in[5], (const float*)(ws + WS_TAB)};
        pg8::gemm_phase<EpiZ, SchedZ, ALIGN_E, false>(lds + RING_OFF, 1024, S, E);
        if (TAIL_CONV && G == 256 && bx >= 144) {
            int tid2 = threadIdx.x; asm volatile("" : "+v"(tid2)); const int lane2 = tid2 & 63, wave2 = __builtin_amdgcn_readfirstlane(tid2 >> 6);
            LAS float* scr = (LAS float*)(lds + RING_OFF + wave2 * 16384);
            for (int j = (bx - 144) * NWAVES + wave2; j < TAIL_E0 * 512; j += 112 * NWAVES) p0_weight_item(P, ws, scr, IT_P0 + (j >> 9) * 768 + (j & 511), lane2); }
            REPSEAM(1); }
    }
    SEAM(1);
    if (IN(2)) {
        _Pragma("unroll") for (int rep_ = 0; rep_ < NREP(2); ++rep_) {
        phase2_sgu_attn(lds, lds_raw, ws, P, vcu, G);
            REPSEAM(2); }
    }
    SEAM(2);
    if (IN(3)) {
        _Pragma("unroll") for (int rep_ = 0; rep_ < NREP(3); ++rep_) {
        SchedY S{(const char*)ws, G, bx};
        EpiY E{(bf16_t*)(ws + WS_GSCR) + (size_t)bx * 65536, (bf16_t*)(ws + WS_MERGED)};
#ifdef PROBE_KDUP_Y
        SchedDup<SchedY> SD{S}; pg8::gemm_phase<EpiY, SchedDup<SchedY>, ALIGN_E, false, true>(lds + RING_OFF, 1024, SD, E, STAG_Y);
#else
        pg8::gemm_phase<EpiY, SchedY, ALIGN_E, false, true>(lds + RING_OFF, 1024, S, E, STAG_Y);
#endif
            REPSEAM(3); }
    }
    SEAM(3);
    if (IN(4)) {
        _Pragma("unroll") for (int rep_ = 0; rep_ < NREP(4); ++rep_) {
        SchedPlain S{(const char*)(ws + WS_MERGED), (const char*)(ws + WS_WOUT), 128, 4, G, bx, 1024};
#if FOLD_GAINS
        EpiX1 E{P.in[0], (bf16_t*)(ws + WS_XN1), (float*)(ws + WS_SSQ1)};
#ifdef PROBE_KDUP
        SchedDup<SchedPlain> SD{S}; pg8::gemm_phase<EpiX1, SchedDup<SchedPlain>, ALIGN_E, false>(lds + RING_OFF, 1024, SD, E);
#else
        pg8::gemm_phase<EpiX1, SchedPlain, ALIGN_E, false>(lds + RING_OFF, 1024, S, E);
#endif
#else
        EpiRes E{P.in[0], out};
        pg8::gemm_phase<EpiRes, SchedPlain, ALIGN_E, false>(lds + RING_OFF, 1024, S, E);
#endif
            REPSEAM(4); }
    }
    SEAM(4);
    if (IN(5)) {
        _Pragma("unroll") for (int rep_ = 0; rep_ < NREP(5); ++rep_) {
        bf16_t* XN1 = (bf16_t*)(ws + WS_XN1);
        if (!FOLD_GAINS) rms_rows(out, P.in[13], XN1, gw, NGW, M, lane);
            REPSEAM(5); }
    }
    if (!FOLD_GAINS) SEAM(5);
    if (IN(6)) {
        _Pragma("unroll") for (int rep_ = 0; rep_ < NREP(6); ++rep_) {
        SchedPlain S{(const char*)(ws + WS_XN1), (const char*)(ws + WS_WCQ), 128, 2, G, bx, 1024};
#if FOLD_GAINS
        EpiQC E{(bf16_t*)(ws + WS_QC), (const float*)(ws + WS_SSQ1), C2_CROSS};
        pg8::gemm_phase<EpiQC, SchedPlain, ALIGN_E, false>(lds + RING_OFF, 1024, S, E);
#if MERGE_QC_CROSS
        asm volatile("s_waitcnt vmcnt(0)" ::: "memory"); __syncthreads();
        { Unit u; for (int i = 0; S.next(i, u); ++i) cross_after_qc(lds, lds_raw, ws, u.pm, u.pn); }
#endif
#else
        EpiBf16s E{(bf16_t*)(ws + WS_QC), 512, C2_CROSS};
        pg8::gemm_phase<EpiBf16s, SchedPlain, ALIGN_E, false>(lds + RING_OFF, 1024, S, E);
#endif
            REPSEAM(6); }
    }
    if (!(MERGE_QC_CROSS && FOLD_GAINS)) SEAM(6);
    if (IN(7)) {
        _Pragma("unroll") for (int rep_ = 0; rep_ < NREP(7); ++rep_) {
        if (!(MERGE_QC_CROSS && FOLD_GAINS)) phase7_cross(lds, lds_raw, ws, vcu, G);
            REPSEAM(7); }
    }
    SEAM(7);
    if (IN(8)) {
        SchedPlain S{(const char*)(ws + WS_OC), (const char*)(ws + WS_WCO), 128, 4, G, bx, 512};
#if FOLD_GAINS
        EpiX2 E{(const bf16_t*)(ws + WS_XN1), out, (bf16_t*)(ws + WS_XN3)};
        pg8::gemm_phase<EpiX2, SchedPlain, ALIGN_E, false>(lds + RING_OFF, 512, S, E);
#else
        EpiRes E{out, out};
        pg8::gemm_phase<EpiRes, SchedPlain, ALIGN_E, false>(lds + RING_OFF, 512, S, E);
#endif
        if (!FOLD_GAINS && NREP(8) == 2) { if (fusedrun) xcd_barrier(bar); EpiRes E2{out, (float*)(ws + WS_Q)}; pg8::gemm_phase<EpiRes, SchedPlain, ALIGN_E, false>(lds + RING_OFF, 512, S, E2); }
    }
    SEAM(8);
#if ROUTE_MFMA
    if (IN(9)) {
        LAS float* WT = (LAS float*)(lds + RING_OFF);
        LAS float* PART = WT + 20 * 1028;
        LAS float* SSQP = PART + 2 * 4 * 32 * 33;
        LAS int* te = (LAS int*)(SSQP + 2 * 4 * 2 * 32); LAS float* tw = (LAS float*)(te + 256); LAS int* tp = (LAS int*)(tw + 256); LAS int* ebase = tp + 256;
        for (int i = tid; i < 1024 * 4; i += 512) { const int kk = i >> 2, o = i & 3; WT[o * 1028 + kk] = P.in[19][i] * P.in[18][kk]; }
        for (int i = tid; i < 1024 * 16; i += 512) { const int kk = i >> 4, o = i & 15; WT[(4 + o) * 1028 + kk] = P.in[21][i] * P.in[18][kk]; }
        __syncthreads();
        const int tg = wave & 3, kh = wave >> 2, n = lane & 31, hh = lane >> 5;
        bf16_t* XB2 = (bf16_t*)(ws + WS_XN3); float* rstok = (float*)(ws + WS_RSTOK);
        const LAS float* wrow = WT + (n < 20 ? n : 19) * 1028 + kh * 512 + 4 * hh;
        for (int tb = vcu; tb < M / 128; tb += G) {
            const int t0 = tb * 128; const size_t eoff = (size_t)(t0 + tg * 32 + n) * 1024 + kh * 512 + 4 * hh;
            f32x16_t acc = f32x16_t{}; float ssq = 0.f;
            for (int jb = 0; jb < 64; jb += 8) { f32x4 xv[8];
#pragma unroll
                for (int j = 0; j < 8; ++j) {
                    if (X2_BF16) { const u32x2 q = *(const u32x2*)(XB2 + eoff + 8 * (jb + j)); xv[j] = (f32x4){__uint_as_float(q.x << 16), __uint_as_float(q.x & 0xffff0000u), __uint_as_float(q.y << 16), __uint_as_float(q.y & 0xffff0000u)}; }
                    else xv[j] = *(const f32x4*)(out + eoff + 8 * (jb + j)); }
#pragma unroll
                for (int j = 0; j < 8; ++j) { const f32x4 wv = *(const LAS f32x4*)(wrow + 8 * (jb + j)); const f32x4 x = xv[j];
                    ssq += (x[0] * x[0] + x[1] * x[1]) + (x[2] * x[2] + x[3] * x[3]);
                    acc = __builtin_amdgcn_mfma_f32_32x32x2f32(x[0], wv[0], acc, 0, 0, 0); acc = __builtin_amdgcn_mfma_f32_32x32x2f32(x[1], wv[1], acc, 0, 0, 0);
                    acc = __builtin_amdgcn_mfma_f32_32x32x2f32(x[2], wv[2], acc, 0, 0, 0); acc = __builtin_amdgcn_mfma_f32_32x32x2f32(x[3], wv[3], acc, 0, 0, 0);
                    if (!X2_BF16) { u32x2 w; w.x = pg8::cvt_pk_bf16(x[0], x[1]); w.y = pg8::cvt_pk_bf16(x[2], x[3]); *(u32x2*)(XB2 + eoff + 8 * (jb + j)) = w; } } }
#pragma unroll
            for (int r = 0; r < 16; ++r) PART[((kh * 4 + tg) * 32 + ((r & 3) + 8 * (r >> 2) + 4 * hh)) * 33 + n] = acc[r];
            SSQP[((kh * 4 + tg) * 2 + hh) * 32 + n] = ssq;
            __syncthreads();
            if (wave < 4 && lane < 32) { const int tl = wave * 32 + lane, t = t0 + tl;
                const float s = (SSQP[((0 * 4 + wave) * 2 + 0) * 32 + lane] + SSQP[((0 * 4 + wave) * 2 + 1) * 32 + lane]) + (SSQP[((1 * 4 + wave) * 2 + 0) * 32 + lane] + SSQP[((1 * 4 + wave) * 2 + 1) * 32 + lane]);
                const float rs = 1.0f / sqrtf(s * (1.f / 1024.f) + EPS);
                float lg[20];
#pragma unroll
                for (int nn = 0; nn < 20; ++nn) lg[nn] = (PART[((0 * 4 + wave) * 32 + lane) * 33 + nn] + PART[((1 * 4 + wave) * 32 + lane) * 33 + nn]) * rs;
                int e0, e1; float w0, w1; route_decide(lg, P.in[20], P.in[22], e0, e1, w0, w1);
                te[2 * tl] = e0; te[2 * tl + 1] = e1; tw[2 * tl] = w0; tw[2 * tl + 1] = w1; rstok[t] = rs; }
            __syncthreads();
            if (wave == 0) {
                int cnt = 0; int mye[4];
#pragma unroll
                for (int j = 0; j < 4; ++j) mye[j] = te[j * 64 + lane];
                int pos[4] = {0, 0, 0, 0};
                for (int e = 0; e < 16; ++e) { int run = 0;
#pragma unroll
                    for (int j = 0; j < 4; ++j) { const unsigned long long mk = __ballot(mye[j] == e); const int before = __popcll(mk & ((1ull << lane) - 1ull));
                        if (mye[j] == e) pos[j] = run + before; run += __popcll(mk); }
                    if (lane == e) cnt = run; }
#pragma unroll
                for (int j = 0; j < 4; ++j) tp[j * 64 + lane] = pos[j];
                if (lane < 16) { unsigned* ec = (unsigned*)(ws + WS_CTL) + CW_ECNT + 64 * lane; ebase[lane] = (int)atomicAdd(ec, (unsigned)cnt); }
            }
            __syncthreads();
            if (tid < 256) { const int e = te[tid], slot = ebase[e] + tp[tid], dest = (t0 * 2) + tid; const float w = tw[tid];
                int* lst = (int*)(ws + WS_LIST) + ((size_t)e * LIST_CAP + slot) * 2; lst[0] = dest; lst[1] = __float_as_int(w); }
            __syncthreads();
        }
    }
#else
    if (IN(9)) {
        LAS float* rw = (LAS float*)(lds + RING_OFF);
        LAS int* te = (LAS int*)(lds + RING_OFF + 20 * 1024 * 4); LAS float* tw = (LAS float*)(te + 256); LAS int* tp = (LAS int*)(tw + 256); LAS int* ebase = tp + 256;
        for (int i = tid; i < 1024 * 4; i += 512) { const int k = i >> 2, o = i & 3; rw[o * 1024 + k] = P.in[19][i]; }
        for (int i = tid; i < 1024 * 16; i += 512) { const int k = i >> 4, o = i & 15; rw[(4 + o) * 1024 + k] = P.in[21][i]; }
        __syncthreads();
        bf16_t* XN3 = (bf16_t*)(ws + WS_XN3);
        if (NREP(9) == 2) { for (int tb = vcu; tb < M / 128; tb += G) { const int t0 = tb * 128; Row4 rcur = row_load(out + (size_t)(t0 + wave * 16) * D, lane);
            for (int i = 0; i < 16; ++i) { const int tl = wave * 16 + i, t = t0 + tl; int e0, e1; float w0, w1; const Row4 rnxt = row_load(out + (size_t)(t + (i < 15 ? 1 : 0)) * D, lane);
                route_token(rcur, P.in[18], rw, P.in[20], P.in[22], XN3 + (size_t)t * D, lane, e0, e1, w0, w1); rcur = rnxt; if (lane == 0) { te[2 * tl] = e0; tw[2 * tl] = w0 + w1 + (float)e1; } } }
            if (fusedrun) xcd_barrier(bar); }
        for (int tb = vcu; tb < M / 128; tb += G) {
            const int t0 = tb * 128;
            Row4 rcur = row_load(out + (size_t)(t0 + wave * 16) * D, lane);
            for (int i = 0; i < 16; ++i) { const int tl = wave * 16 + i, t = t0 + tl; int e0, e1; float w0, w1;
                const Row4 rnxt = row_load(out + (size_t)(t + (i < 15 ? 1 : 0)) * D, lane);
                route_token(rcur, P.in[18], rw, P.in[20], P.in[22], XN3 + (size_t)t * D, lane, e0, e1, w0, w1); rcur = rnxt;
                if (lane == 0) { te[2 * tl] = e0; te[2 * tl + 1] = e1; tw[2 * tl] = w0; tw[2 * tl + 1] = w1; } }
            __syncthreads();
            if (wave == 0) {
                int cnt = 0; int mye[4];
#pragma unroll
                for (int j = 0; j < 4; ++j) mye[j] = te[j * 64 + lane];
                int pos[4] = {0, 0, 0, 0};
                for (int e = 0; e < 16; ++e) { int run = 0;
#pragma unroll
                    for (int j = 0; j < 4; ++j) { const unsigned long long mk = __ballot(mye[j] == e); const int before = __popcll(mk & ((1ull << lane) - 1ull));
                        if (mye[j] == e) pos[j] = run + before; run += __popcll(mk); }
                    if (lane == e) cnt = run; }
#pragma unroll
                for (int j = 0; j < 4; ++j) tp[j * 64 + lane] = pos[j];
                if (lane < 16) { unsigned* ec = (unsigned*)(ws + WS_CTL) + CW_ECNT + 64 * lane; ebase[lane] = (int)atomicAdd(ec, (unsigned)cnt); }
            }
            __syncthreads();
            if (tid < 256) { const int e = te[tid], slot = ebase[e] + tp[tid], dest = (t0 * 2) + tid; const float w = tw[tid];
                int* lst = (int*)(ws + WS_LIST) + ((size_t)e * LIST_CAP + slot) * 2; lst[0] = dest; lst[1] = __float_as_int(w);
                int* ti = (int*)(ws + WS_TOKINFO) + (size_t)dest * 2; ti[0] = e; ti[1] = __float_as_int(w); }
            __syncthreads();
        }
    }
#endif
    SEAM(9);
    if (IN(10)) {
        _Pragma("unroll") for (int rep_ = 0; rep_ < NREP(10); ++rep_) {
        moe_setup(lds, ws, vcu, G, true);
        SchedMoe S{(const LAS int*)(lds + UREC_OFF), (const LAS unsigned*)(lds + TBL_OFF), (const char*)(ws + WS_XN3), (const char*)(ws + WS_WGU), 0, (size_t)1024 * 1024 * 2, (size_t)256 * 1024 * 2, true};
        EpiMoeA E{(bf16_t*)(ws + WS_H), (const LAS float*)(lds + RSTBL_OFF)};
        pg8::gemm_phase<EpiMoeA, SchedMoe, ALIGN_E, true>(lds + RING_OFF, 1024, S, E, STAG_MA);
        if (TAIL_CONV && G == 256) {
            const LAS int* rec = (const LAS int*)(lds + UREC_OFF); int myu = 0;
            for (int i = 0; i < MOE_MAXU; ++i) myu += rec[i * 8];
            const int nu = rec[MOE_MAXU * 8], rem = nu % G, maxu = (nu + G - 1) / G;
            const bool idle = (rem == 0) || (myu < maxu); const int nidle = (rem == 0) ? G : G - rem, rank = (rem == 0) ? vcu : vcu - rem;
            if (idle) { int tid2 = threadIdx.x; asm volatile("" : "+v"(tid2)); const int lane2 = tid2 & 63, wave2 = __builtin_amdgcn_readfirstlane(tid2 >> 6);
                LAS float* scr = (LAS float*)(lds + RING_OFF + wave2 * 16384);
                for (int j = rank * NWAVES + wave2; j < NE * 256; j += nidle * NWAVES) p0_weight_item(P, ws, scr, IT_P0 + (j >> 8) * 768 + 512 + (j & 255), lane2); } }
            REPSEAM(10); }
    }
    SEAM(10);
    if (IN(11)) {
        _Pragma("unroll") for (int rep_ = 0; rep_ < NREP(11); ++rep_) {
        moe_setup(lds, ws, vcu, G, false);
        SchedMoe S{(const LAS int*)(lds + UREC_OFF), (const LAS unsigned*)(lds + TBL_OFF), (const char*)(ws + WS_H), (const char*)(ws + WS_WD), (size_t)256 * 512 * 2, (size_t)1024 * 512 * 2, (size_t)256 * 512 * 2, false};
        EpiMoeB E{(const LAS int*)(lds + UREC_OFF), (const int*)(ws + WS_LIST), (bf16_t*)(ws + WS_YS)};
        pg8::gemm_phase<EpiMoeB, SchedMoe, ALIGN_E, false>(lds + RING_OFF, 512, S, E, STAG_MB);
            REPSEAM(11); }
    }
    SEAM(11);
    if (IN(12)) {
        const bf16_t* ys = (const bf16_t*)(ws + WS_YS);
        if (NREP(12) == 2) { float* dead = (float*)(ws + WS_H);
            for (int m = gw; m < M; m += NGW) { RowF r = rowf_load(out + (size_t)m * D, ys + (size_t)m * 2048, lane); const f32x4* src = (const f32x4*)(out + (size_t)m * D) + lane; f32x4* dd = (f32x4*)(dead + (size_t)m * D) + lane;
                (void)src; rowf_store(r, dead + (size_t)m * D, P.in[26], lane); (void)dd; }
            if (fusedrun) xcd_barrier(bar); }
        if (X2_BF16) final_rows_b(out, (const bf16_t*)(ws + WS_XN3), ys, P.in[26], gw, NGW, M, lane); else final_rows(out, ys, P.in[26], gw, NGW, M, lane);
    }
#undef IN
#undef SEAM
}
#ifndef OPT_MASK
#define OPT_MASK 0x1FFF
#endif
#ifndef FUSED
#define FUSED 1
#endif
static void launch_mega(const Args& a0, int lo, int hi, int grid, hipStream_t stream) {
    Args a = a0; a.ph_lo = lo; a.ph_hi = hi;
    hipLaunchKernelGGL(mega, dim3(grid), dim3(NWAVES * 64), LDS_BYTES, stream, a);
    const hipError_t le = hipPeekAtLastError();
    if (le != hipSuccess) fprintf(stderr, "kernel_launch: launch [%d,%d) failed: %s\n", lo, hi, hipGetErrorName(le));
}
extern "C" void kernel_launch(void* const* d_in, const int* in_sizes, int n_in, void* d_out, int out_size, void* d_ws, size_t ws_size, hipStream_t stream) {
    static int grid = 0;
    if (grid == 0) {
        if (n_in != 27 || in_sizes[0] != M * D || out_size != M * D || ws_size < WS_END) { fprintf(stderr, "kernel_launch: unexpected problem (n_in %d, in0 %d, out %d, ws %zu)\n", n_in, n_in > 0 ? in_sizes[0] : -1, out_size, ws_size); grid = -1; return; }
        (void)hipFuncSetAttribute((const void*)k_route, hipFuncAttributeMaxDynamicSharedMemorySize, 20 * 1024 * 4 + 4096);
        (void)hipFuncSetAttribute((const void*)nv_sgu, hipFuncAttributeMaxDynamicSharedMemorySize, 128 * 129 * 4 + 1024);
        (void)hipFuncSetAttribute((const void*)nv_attn, hipFuncAttributeMaxDynamicSharedMemorySize, 4 * 64 * 65 * 4);
        (void)hipFuncSetAttribute((const void*)k_prologue, hipFuncAttributeMaxDynamicSharedMemorySize, 8 * 64 * 33 * 4);
        if (hipFuncSetAttribute((const void*)mega, hipFuncAttributeMaxDynamicSharedMemorySize, LDS_BYTES) != hipSuccess) { fprintf(stderr, "kernel_launch: hipFuncSetAttribute(mega) failed\n"); grid = -1; return; }
        int dev = 0, cus = 0, per_cu = 0;
        if (hipGetDevice(&dev) != hipSuccess || hipDeviceGetAttribute(&cus, hipDeviceAttributeMultiprocessorCount, dev) != hipSuccess) { grid = -1; return; }
        if (hipOccupancyMaxActiveBlocksPerMultiprocessor(&per_cu, (const void*)mega, NWAVES * 64, LDS_BYTES) != hipSuccess || per_cu < 1) fprintf(stderr, "kernel_launch: occupancy query says %d blocks per CU\n", per_cu);
        (void)hipGetLastError();
        grid = cus;
    }
    if (grid < 0) return;
    unsigned char* ws = (unsigned char*)d_ws; float* out = (float*)d_out;
    Args a{}; for (int i = 0; i < 27; ++i) a.P.in[i] = (const float*)d_in[i];
    a.out = out; a.ws = ws; a.ph_lo = 0; a.ph_hi = NPHASE;
    const PtrsIn& P = a.P;
    (void)hipMemsetAsync(ws + WS_CTL, 0, CTL_ZERO_BYTES, stream);
#if FUSED
    launch_mega(a, 0, NPHASE, grid, stream);
#else
    float* scr = (float*)(ws + WS_SCR);
    bf16_t* XN = (bf16_t*)(ws + WS_XN);
    for (int ph = 0; ph < NPHASE; ++ph) {
        if ((OPT_MASK >> ph) & 1) { launch_mega(a, ph, ph + 1, grid, stream); continue; }
        switch (ph) {
        case 0: hipLaunchKernelGGL(k_prologue, dim3(256), dim3(512), 8 * 64 * 33 * 4, stream, P, ws); break;
        case 1:
            for (int c = 0; c < M / 4096; ++c) {
                hipLaunchKernelGGL(nv_gemm, dim3(NZ / 64, 4096 / 64), dim3(256), 0, stream, XN + (size_t)c * 4096 * D, D, (const bf16_t*)(ws + WS_WZ), D, D, scr, NZ);
                hipLaunchKernelGGL(nv_z_epi, dim3(4096), dim3(256), 0, stream, (const float*)scr, c * 4096, P, ws); }
            hipLaunchKernelGGL(nv_gemm, dim3(1024 / 64, MMEM / 64), dim3(256), 0, stream, XN + (size_t)M * D, D, (const bf16_t*)(ws + WS_WZ) + (size_t)NZ * D, D, D, scr, 1024);
            hipLaunchKernelGGL(nv_store_bf16, dim3(1024), dim3(256), 0, stream, (const float*)scr, (bf16_t*)(ws + WS_KVC), (size_t)MMEM * 1024, 1.0f);
            break;
        case 2:
            hipLaunchKernelGGL(nv_attn, dim3(SEQ / 64, 8, BATCH), dim3(256), 4 * 64 * 65 * 4, stream, (const bf16_t*)(ws + WS_Q), (const bf16_t*)(ws + WS_K), (const bf16_t*)(ws + WS_V), (bf16_t*)(ws + WS_ATT));
            hipLaunchKernelGGL(nv_sgu, dim3(M / 128, 4), dim3(256), 128 * 129 * 4 + 1024, stream, P, ws);
            break;
        case 3:
            for (int c = 0; c < M / 4096; ++c) { float* c1 = scr; float* c2 = scr + (size_t)4096 * 1024;
                hipLaunchKernelGGL(nv_gemm, dim3(1024 / 64, 64), dim3(256), 0, stream, (const bf16_t*)(ws + WS_ATT) + (size_t)c * 4096 * 512, 512, (const bf16_t*)(ws + WS_WATT), 512, 512, c1, 1024);
                hipLaunchKernelGGL(nv_gemm, dim3(1024 / 64, 64), dim3(256), 0, stream, (const bf16_t*)(ws + WS_SG) + (size_t)c * 4096 * 512, 512, (const bf16_t*)(ws + WS_WSGU), 512, 512, c2, 1024);
                hipLaunchKernelGGL(nv_merge, dim3(2048), dim3(256), 0, stream, (const float*)c1, (const float*)c2, (const bf16_t*)(ws + WS_GA) + (size_t)c * 4096 * 1024, (const bf16_t*)(ws + WS_GB) + (size_t)c * 4096 * 1024,
                                   (bf16_t*)(ws + WS_MERGED) + (size_t)c * 4096 * 1024, (size_t)4096 * 1024); }
            break;
        case 4:
            for (int c = 0; c < M / 4096; ++c) {
                hipLaunchKernelGGL(nv_gemm, dim3(1024 / 64, 64), dim3(256), 0, stream, (const bf16_t*)(ws + WS_MERGED) + (size_t)c * 4096 * 1024, 1024, (const bf16_t*)(ws + WS_WOUT), 1024, 1024, scr, 1024);
                hipLaunchKernelGGL(nv_resid, dim3(2048), dim3(256), 0, stream, P.in[0] + (size_t)c * 4096 * 1024, (const float*)scr, out + (size_t)c * 4096 * 1024, (size_t)4096 * 1024); }
            break;
        case 5: hipLaunchKernelGGL(k_norm_rows, dim3(256), dim3(512), 0, stream, (const float*)out, P.in[13], (bf16_t*)(ws + WS_XN1), M); break;
        case 6:
            for (int c = 0; c < M / 4096; ++c) {
                hipLaunchKernelGGL(nv_gemm, dim3(512 / 64, 64), dim3(256), 0, stream, (const bf16_t*)(ws + WS_XN1) + (size_t)c * 4096 * 1024, 1024, (const bf16_t*)(ws + WS_WCQ), 1024, 1024, scr, 512);
                hipLaunchKernelGGL(nv_store_bf16, dim3(1024), dim3(256), 0, stream, (const float*)scr, (bf16_t*)(ws + WS_QC) + (size_t)c * 4096 * 512, (size_t)4096 * 512, C2_CROSS); }
            break;
        case 7: hipLaunchKernelGGL(nv_cross, dim3(M), dim3(256), 0, stream, (const bf16_t*)(ws + WS_QC), (const bf16_t*)(ws + WS_KVC), (bf16_t*)(ws + WS_OC)); break;
        case 8:
            for (int c = 0; c < M / 4096; ++c) {
                hipLaunchKernelGGL(nv_gemm, dim3(1024 / 64, 64), dim3(256), 0, stream, (const bf16_t*)(ws + WS_OC) + (size_t)c * 4096 * 512, 512, (const bf16_t*)(ws + WS_WCO), 512, 512, scr, 1024);
                hipLaunchKernelGGL(nv_resid, dim3(2048), dim3(256), 0, stream, (const float*)(out + (size_t)c * 4096 * 1024), (const float*)scr, out + (size_t)c * 4096 * 1024, (size_t)4096 * 1024); }
            break;
        case 9: hipLaunchKernelGGL(k_route, dim3(256), dim3(512), 20 * 1024 * 4 + 4096, stream, P, (const float*)out, ws); break;
        case 10: hipLaunchKernelGGL(nv_moe_a, dim3(2 * M), dim3(256), 0, stream, (const bf16_t*)(ws + WS_XN3), ws); break;
        case 11: hipLaunchKernelGGL(nv_moe_b, dim3(2 * M), dim3(256), 0, stream, ws); break;
        case 12: hipLaunchKernelGGL(k_final, dim3(256), dim3(512), 0, stream, out, (const bf16_t*)(ws + WS_YS), P.in[26]); break;
        }
    }
#endif
}
```

```cpp
#include <hip/hip_runtime.h>
#include <cstdio>
#include <cstdint>
#include <cmath>

#ifndef FOLD_GAINS
#define FOLD_GAINS 1
#endif
#ifndef ATT_FIXM
#define ATT_FIXM 1
#endif
#ifndef X0_BF16
#define X0_BF16 1
#endif
#ifndef GATE_U8
#define GATE_U8 1
#endif
#ifndef MERGE_QC_CROSS
#define MERGE_QC_CROSS 1
#endif
#ifndef TAIL_CONV
#define TAIL_CONV 1
#endif
#ifndef ROUTE_MFMA
#define ROUTE_MFMA 1
#endif
#ifndef FOLD_MOE
#define FOLD_MOE ROUTE_MFMA
#endif
#ifndef X2_BF16
#define X2_BF16 1
#endif
#ifndef MOE_CONV_IN_P2
#define MOE_CONV_IN_P2 0
#endif
typedef unsigned short bf16_t;
typedef float f32x4 __attribute__((ext_vector_type(4)));
typedef unsigned u32x4 __attribute__((ext_vector_type(4)));
typedef unsigned u32x2 __attribute__((ext_vector_type(2)));

constexpr int BATCH = 4, SEQ = 8192, D = 1024, M = BATCH * SEQ;
constexpr int NMEM = 256, MMEM = BATCH * NMEM;
constexpr int NZ = 3840;
constexpr int ZQ = 0, ZK = 512, ZV = 640, ZSU = 768, ZSV = 1280, ZGA = 1792, ZGB = 2816;
constexpr int NE = 16, DE = 512;
constexpr float EPS = 1e-6f;
constexpr float LOG2E = 1.4426950408889634f;
constexpr float C2_SELF = 0.125f * LOG2E;
constexpr float C2_CROSS = 0.08838834764831845f * LOG2E;
constexpr int LIST_CAP = 32768;

constexpr size_t MiB = 1u << 20;
constexpr size_t WS_CTL = 0, CTL_ZERO_BYTES = 64 * 1024;
constexpr size_t WS_TAB = 512 * 1024;
constexpr size_t WS_WZ = 1 * MiB;
constexpr size_t WS_WATT = 11 * MiB, WS_WSGU = 12 * MiB, WS_WOUT = 13 * MiB, WS_WCQ = 15 * MiB, WS_WCO = 16 * MiB, WS_WSS = 17 * MiB;
constexpr size_t WS_WGU = 18 * MiB;
constexpr size_t WS_WD = 50 * MiB;
constexpr size_t WS_XN = 68 * MiB;
constexpr size_t WS_MERGED = 248 * MiB;
constexpr size_t WS_GSCR = 312 * MiB;
constexpr size_t WS_XN3 = 68 * MiB;
constexpr size_t WS_KVC = 134 * MiB;
constexpr size_t WS_Q = 136 * MiB, WS_K = 168 * MiB, WS_V = 176 * MiB, WS_U = 184 * MiB, WS_GV = 216 * MiB, WS_GA = 248 * MiB, WS_GB = 312 * MiB;
constexpr size_t WS_ATT = 376 * MiB, WS_SG = 408 * MiB;
constexpr size_t WS_XN1 = 136 * MiB;
constexpr size_t WS_SSQ1 = 132 * MiB;
constexpr size_t WS_QC = 376 * MiB, WS_OC = 408 * MiB;
constexpr size_t WS_LIST = 200 * MiB;
constexpr size_t WS_RS0 = 66 * MiB;
constexpr size_t WS_RSTOK = 205 * MiB;
constexpr size_t WS_TOKINFO = 204 * MiB;
constexpr size_t WS_YS = 208 * MiB;
constexpr size_t WS_H = 336 * MiB;
constexpr size_t WS_SCR = 440 * MiB;
constexpr size_t WS_END = 504 * MiB;
constexpr int CW_TMO = 0, CW_BAR = 4096, CW_ECNT = 8192;

__host__ __device__ __forceinline__ float bf2f(bf16_t b) { union { unsigned u; float f; } c; c.u = ((unsigned)b) << 16; return c.f; }
__host__ __device__ __forceinline__ unsigned f2bf(float f) { union { unsigned u; float f; } c; c.f = f; unsigned u = c.u; return (u + 0x7fffu + ((u >> 16) & 1u)) >> 16; }
__device__ __forceinline__ unsigned pk2(float lo, float hi) { return f2bf(lo) | (f2bf(hi) << 16); }
__device__ __forceinline__ float wave_sum(float v) {
#pragma unroll
    for (int o = 1; o < 64; o <<= 1) v += __shfl_xor(v, o);
    return v;
}
__device__ __forceinline__ float wave_max(float v) {
#pragma unroll
    for (int o = 1; o < 64; o <<= 1) v = fmaxf(v, __shfl_xor(v, o));
    return v;
}
__device__ __forceinline__ float gelu_tanh(float x) { const float u = 0.7978845608028654f * (x + 0.044715f * x * x * x); return x / (1.0f + __builtin_amdgcn_exp2f(-2.0f * LOG2E * u)); }
__device__ __forceinline__ float sigmoidf_(float x) { return 1.0f / (1.0f + __builtin_amdgcn_exp2f(-LOG2E * x)); }

__host__ __device__ __forceinline__ int z_phys(int c) {
    if (c < 512) { const int h = c >> 6, d = c & 63; return (h >> 2) * 256 + (d >> 5) * 128 + (h & 3) * 32 + (d & 31); }
    if (c < 768) { const int cc = c - 512, w = cc >> 6, d = cc & 63; return 512 + (d >> 5) * 128 + w * 32 + (d & 31); }
    return c;
}

#define LAS __attribute__((address_space(3)))
__device__ __forceinline__ void p0_transpose_item(const float* W, int K, int N, bf16_t* WT, int mode, int row_off, LAS float* scr, int item, int lane, const float* gk = nullptr) {
    const int nblk = N / 32, kb = item / nblk, nb = item % nblk, k0 = 64 * kb, n0 = 32 * nb;
    float tv[32];
#pragma unroll
    for (int i = 0; i < 32; ++i) tv[i] = W[(size_t)(k0 + 2 * i + (lane >> 5)) * N + n0 + (lane & 31)];
    if (gk) {
#pragma unroll
        for (int i = 0; i < 32; ++i) tv[i] *= gk[k0 + 2 * i + (lane >> 5)]; }
#pragma unroll
    for (int i = 0; i < 32; ++i) scr[(2 * i + (lane >> 5)) * 33 + (lane & 31)] = tv[i];
    __builtin_amdgcn_s_waitcnt(0xC07F); asm volatile("" ::: "memory");
    const int c = lane & 7;
#pragma unroll
    for (int j = 0; j < 4; ++j) { const int n = (lane >> 3) + 8 * j; const LAS float* s = scr + (8 * c) * 33 + n;
        u32x4 o; o.x = pk2(s[0 * 33], s[1 * 33]); o.y = pk2(s[2 * 33], s[3 * 33]); o.z = pk2(s[4 * 33], s[5 * 33]); o.w = pk2(s[6 * 33], s[7 * 33]);
        const int nl = n0 + n; int row;
        if (mode == 0) row = row_off + nl; else if (mode == 1) row = z_phys(nl); else if (mode == 2) row = 256 * (nl >> 7) + (nl & 127); else row = 256 * (nl >> 7) + 128 + (nl & 127);
        *(u32x4*)(WT + (size_t)row * K + k0 + 8 * c) = o; }
    __builtin_amdgcn_s_waitcnt(0xC07F); asm volatile("" ::: "memory");
}
struct PtrsIn { const float* in[27]; };
constexpr int IT_WIN = 16 * 120, IT_CKV = 16 * 32, IT_ATT = 8 * 32, IT_SGU = 8 * 32, IT_OUT = 16 * 32, IT_CQ = 16 * 16, IT_CO = 8 * 32, IT_G = 16 * 16, IT_DN = 8 * 32;
constexpr int IT_P0 = IT_WIN + IT_CKV + IT_ATT + IT_SGU + IT_OUT + IT_CQ + IT_CO;
constexpr int IT_TOTAL = IT_P0 + NE * (2 * IT_G + IT_DN);
__device__ __forceinline__ void p0_weight_item(const PtrsIn& P, unsigned char* ws, LAS float* scr, int it, int lane) {
    int r = it;
    bf16_t* WZ = (bf16_t*)(ws + WS_WZ);
    if (r < IT_WIN) { p0_transpose_item(P.in[3], 1024, NZ, WZ, 1, 0, scr, r, lane, X0_BF16 ? P.in[2] : nullptr); return; } r -= IT_WIN;
    if (r < IT_CKV) { p0_transpose_item(P.in[16], 1024, 1024, WZ, 0, NZ, scr, r, lane); return; } r -= IT_CKV;
    if (r < IT_ATT) { p0_transpose_item(P.in[6], 512, 1024, (bf16_t*)(ws + WS_WATT), 0, 0, scr, r, lane); return; } r -= IT_ATT;
    if (r < IT_SGU) { p0_transpose_item(P.in[11], 512, 1024, (bf16_t*)(ws + WS_WSGU), 0, 0, scr, r, lane); return; } r -= IT_SGU;
    if (r < IT_OUT) { p0_transpose_item(P.in[12], 1024, 1024, (bf16_t*)(ws + WS_WOUT), 0, 0, scr, r, lane); return; } r -= IT_OUT;
    if (r < IT_CQ) { p0_transpose_item(P.in[15], 1024, 512, (bf16_t*)(ws + WS_WCQ), 0, 0, scr, r, lane, FOLD_GAINS ? P.in[13] : nullptr); return; } r -= IT_CQ;
    if (r < IT_CO) { p0_transpose_item(P.in[17], 512, 1024, (bf16_t*)(ws + WS_WCO), 0, 0, scr, r, lane); return; } r -= IT_CO;
    const int per = 2 * IT_G + IT_DN, e = r / per; r -= e * per;
    if (r < IT_G) { p0_transpose_item(P.in[23] + (size_t)e * 1024 * 512, 1024, 512, (bf16_t*)(ws + WS_WGU) + (size_t)e * 1024 * 1024, 2, 0, scr, r, lane, FOLD_MOE ? P.in[18] : nullptr); return; } r -= IT_G;
    if (r < IT_G) { p0_transpose_item(P.in[24] + (size_t)e * 1024 * 512, 1024, 512, (bf16_t*)(ws + WS_WGU) + (size_t)e * 1024 * 1024, 3, 0, scr, r, lane, FOLD_MOE ? P.in[18] : nullptr); return; } r -= IT_G;
    p0_transpose_item(P.in[25] + (size_t)e * 512 * 1024, 512, 1024, (bf16_t*)(ws + WS_WD) + (size_t)e * 1024 * 512, 0, 0, scr, r, lane);
}
struct Row4 { f32x4 v[4]; };
__device__ __forceinline__ Row4 row_load(const float* xrow, int lane) { Row4 r; const f32x4* xr = (const f32x4*)xrow + lane;
#pragma unroll
    for (int j = 0; j < 4; ++j) r.v[j] = xr[64 * j];
    return r; }
__device__ __forceinline__ void rms_row_store(const Row4& r, const float* g, bf16_t* orow, int lane) {
    const f32x4* gr = (const f32x4*)g + lane; float s = 0.f;
#pragma unroll
    for (int j = 0; j < 4; ++j) s += (r.v[j].x * r.v[j].x + r.v[j].y * r.v[j].y) + (r.v[j].z * r.v[j].z + r.v[j].w * r.v[j].w);
    const float rs = 1.0f / sqrtf(wave_sum(s) * (1.f / 1024.f) + EPS);
    unsigned long long* o8 = (unsigned long long*)orow + lane;
#pragma unroll
    for (int j = 0; j < 4; ++j) { const f32x4 gg = gr[64 * j]; o8[64 * j] = (unsigned long long)pk2(r.v[j].x * rs * gg.x, r.v[j].y * rs * gg.y) | ((unsigned long long)pk2(r.v[j].z * rs * gg.z, r.v[j].w * rs * gg.w) << 32); }
}
__device__ __forceinline__ void xb0_row_store(const Row4& r, bf16_t* orow, float* rs_out, int lane) {
    float s = 0.f;
#pragma unroll
    for (int j = 0; j < 4; ++j) s += (r.v[j].x * r.v[j].x + r.v[j].y * r.v[j].y) + (r.v[j].z * r.v[j].z + r.v[j].w * r.v[j].w);
    const float rs = 1.0f / sqrtf(wave_sum(s) * (1.f / 1024.f) + EPS);
    unsigned long long* o8 = (unsigned long long*)orow + lane;
#pragma unroll
    for (int j = 0; j < 4; ++j) o8[64 * j] = (unsigned long long)pk2(r.v[j].x, r.v[j].y) | ((unsigned long long)pk2(r.v[j].z, r.v[j].w) << 32);
    if (lane == 0) *rs_out = rs;
}
__device__ __forceinline__ void xb0_rows(const float* x, bf16_t* o, float* rs0, int first, int step, int rows, int lane) {
    if (first >= rows) return;
    const int last = first + ((rows - 1 - first) / step) * step;
    Row4 r0 = row_load(x + (size_t)first * D, lane);
    Row4 r1 = row_load(x + (size_t)((first + step <= last) ? first + step : last) * D, lane);
    for (int m = first; m < rows; m += step) { const int m2 = (m + 2 * step <= last) ? m + 2 * step : last;
        const Row4 r2 = row_load(x + (size_t)m2 * D, lane);
        xb0_row_store(r0, o + (size_t)m * D, rs0 + m, lane); r0 = r1; r1 = r2; }
}
__device__ __forceinline__ void rms_rows(const float* x, const float* g, bf16_t* o, int first, int step, int rows, int lane) {
    if (first >= rows) return;
    const int last = first + ((rows - 1 - first) / step) * step;
    Row4 r0 = row_load(x + (size_t)first * D, lane);
    Row4 r1 = row_load(x + (size_t)((first + step <= last) ? first + step : last) * D, lane);
    for (int m = first; m < rows; m += step) { const int m2 = (m + 2 * step <= last) ? m + 2 * step : last;
        const Row4 r2 = row_load(x + (size_t)m2 * D, lane);
        rms_row_store(r0, g, o + (size_t)m * D, lane); r0 = r1; r1 = r2; }
}
__device__ __forceinline__ void rms_row_to_bf16(const float* xrow, const float* g, bf16_t* orow, int lane) {
    const f32x4* xr = (const f32x4*)xrow + lane; const f32x4* gr = (const f32x4*)g + lane;
    f32x4 v[4]; float s = 0.f;
#pragma unroll
    for (int j = 0; j < 4; ++j) { v[j] = xr[64 * j]; s += (v[j].x * v[j].x + v[j].y * v[j].y) + (v[j].z * v[j].z + v[j].w * v[j].w); }
    const float rs = 1.0f / sqrtf(wave_sum(s) * (1.f / 1024.f) + EPS);
    unsigned long long* o8 = (unsigned long long*)orow + lane;
#pragma unroll
    for (int j = 0; j < 4; ++j) { const f32x4 gg = gr[64 * j]; o8[64 * j] = (unsigned long long)pk2(v[j].x * rs * gg.x, v[j].y * rs * gg.y) | ((unsigned long long)pk2(v[j].z * rs * gg.z, v[j].w * rs * gg.w) << 32); }
}
__device__ __forceinline__ void rope_table_entry(float* tab, int idx) {
    const int pos = idx >> 4, i = idx & 15;
    const float inv = exp2f(-(float)i * (13.287712379549449f / 16.0f));
    const float ang = (float)pos * inv;
    float s, c; sincosf(ang, &s, &c);
    tab[0 * 2048 + idx] = c; tab[1 * 2048 + idx] = s; tab[2 * 2048 + idx] = c; tab[3 * 2048 + idx] = s;
}

__device__ __forceinline__ void route_decide(const float (&lg)[20], const float* b_rg, const float* b_re, int& e0, int& e1, float& w0, float& w1) {
    float g0 = lg[0] + b_rg[0], g1 = lg[1] + b_rg[1], g2 = lg[2] + b_rg[2], g3 = lg[3] + b_rg[3];
    int gi = 0; float gm = g0; if (g1 > gm) { gm = g1; gi = 1; } if (g2 > gm) { gm = g2; gi = 2; } if (g3 > gm) { gm = g3; gi = 3; }
    const float gval = 1.0f / (expf(g0 - gm) + expf(g1 - gm) + expf(g2 - gm) + expf(g3 - gm));
    float ev[4];
#pragma unroll
    for (int j = 0; j < 4; ++j) { float t = 0.f;
#pragma unroll
        for (int g = 0; g < 4; ++g) t = (gi == g) ? (lg[4 + 4 * g + j] + b_re[4 * g + j]) : t;
        ev[j] = t; }
    int i0 = 0; float m0 = ev[0];
#pragma unroll
    for (int j = 1; j < 4; ++j) if (ev[j] > m0) { m0 = ev[j]; i0 = j; }
    int i1 = -1; float m1 = -INFINITY;
#pragma unroll
    for (int j = 0; j < 4; ++j) if (j != i0 && ev[j] > m1) { m1 = ev[j]; i1 = j; }
    const float p1 = expf(m1 - m0), den = 1.0f / (1.0f + p1);
    e0 = gi * 4 + i0; e1 = gi * 4 + i1; w0 = den * gval; w1 = p1 * den * gval;
}
template <class RW> __device__ __forceinline__ void route_token(const Row4& xin, const float* gmoe, RW rw, const float* b_rg, const float* b_re, bf16_t* orow, int lane, int& e0, int& e1, float& w0, float& w1) {
    const f32x4* gr = (const f32x4*)gmoe + lane;
    f32x4 v[4]; float s = 0.f;
#pragma unroll
    for (int j = 0; j < 4; ++j) { v[j] = xin.v[j]; s += (v[j].x * v[j].x + v[j].y * v[j].y) + (v[j].z * v[j].z + v[j].w * v[j].w); }
    const float rs = 1.0f / sqrtf(wave_sum(s) * (1.f / 1024.f) + EPS);
    unsigned long long* o8 = (unsigned long long*)orow + lane;
#pragma unroll
    for (int j = 0; j < 4; ++j) { const f32x4 gg = gr[64 * j]; v[j].x *= rs * gg.x; v[j].y *= rs * gg.y; v[j].z *= rs * gg.z; v[j].w *= rs * gg.w;
        o8[64 * j] = (unsigned long long)pk2(v[j].x, v[j].y) | ((unsigned long long)pk2(v[j].z, v[j].w) << 32); }
    float lg[20];
#pragma unroll
    for (int o = 0; o < 20; ++o) { auto wr = rw + o * 1024 + 4 * lane; float a = 0.f;
#pragma unroll
        for (int j = 0; j < 4; ++j) { const float w0_ = wr[256 * j], w1_ = wr[256 * j + 1], w2_ = wr[256 * j + 2], w3_ = wr[256 * j + 3]; a += (v[j].x * w0_ + v[j].y * w1_) + (v[j].z * w2_ + v[j].w * w3_); }
        lg[o] = wave_sum(a); }
    route_decide(lg, b_rg, b_re, e0, e1, w0, w1);
}
__device__ __forceinline__ void final_row(float* orow, const bf16_t* ys2, const float* g, int lane) {
    f32x4* xr = (f32x4*)orow + lane; const f32x4* gr = (const f32x4*)g + lane;
    const u32x2* y0 = (const u32x2*)ys2 + lane; const u32x2* y1 = (const u32x2*)(ys2 + 1024) + lane;
    f32x4 v[4]; float s = 0.f;
#pragma unroll
    for (int j = 0; j < 4; ++j) { v[j] = xr[64 * j]; const u32x2 a = y0[64 * j], b = y1[64 * j];
        v[j].x += bf2f((bf16_t)(a.x & 0xffff)) + bf2f((bf16_t)(b.x & 0xffff)); v[j].y += bf2f((bf16_t)(a.x >> 16)) + bf2f((bf16_t)(b.x >> 16));
        v[j].z += bf2f((bf16_t)(a.y & 0xffff)) + bf2f((bf16_t)(b.y & 0xffff)); v[j].w += bf2f((bf16_t)(a.y >> 16)) + bf2f((bf16_t)(b.y >> 16));
        s += (v[j].x * v[j].x + v[j].y * v[j].y) + (v[j].z * v[j].z + v[j].w * v[j].w); }
    const float rs = 1.0f / sqrtf(wave_sum(s) * (1.f / 1024.f) + EPS);
#pragma unroll
    for (int j = 0; j < 4; ++j) { const f32x4 gg = gr[64 * j]; f32x4 o; o.x = v[j].x * rs * gg.x; o.y = v[j].y * rs * gg.y; o.z = v[j].z * rs * gg.z; o.w = v[j].w * rs * gg.w; xr[64 * j] = o; }
}

struct RowF { f32x4 v[4]; u32x2 a[4], b[4]; };
__device__ __forceinline__ RowF rowf_load(const float* orow, const bf16_t* ys2, int lane) { RowF r; const f32x4* xr = (const f32x4*)orow + lane; const u32x2* y0 = (const u32x2*)ys2 + lane; const u32x2* y1 = (const u32x2*)(ys2 + 1024) + lane;
#pragma unroll
    for (int j = 0; j < 4; ++j) { r.v[j] = xr[64 * j]; r.a[j] = y0[64 * j]; r.b[j] = y1[64 * j]; }
    return r; }
__device__ __forceinline__ void rowf_store(const RowF& r, float* orow, const float* g, int lane) {
    f32x4* xr = (f32x4*)orow + lane; const f32x4* gr = (const f32x4*)g + lane; f32x4 v[4]; float s = 0.f;
#pragma unroll
    for (int j = 0; j < 4; ++j) { v[j] = r.v[j]; const u32x2 a = r.a[j], b = r.b[j];
        v[j].x += __uint_as_float(a.x << 16) + __uint_as_float(b.x << 16); v[j].y += __uint_as_float(a.x & 0xffff0000u) + __uint_as_float(b.x & 0xffff0000u);
        v[j].z += __uint_as_float(a.y << 16) + __uint_as_float(b.y << 16); v[j].w += __uint_as_float(a.y & 0xffff0000u) + __uint_as_float(b.y & 0xffff0000u);
        s += (v[j].x * v[j].x + v[j].y * v[j].y) + (v[j].z * v[j].z + v[j].w * v[j].w); }
    const float rs = 1.0f / sqrtf(wave_sum(s) * (1.f / 1024.f) + EPS);
#pragma unroll
    for (int j = 0; j < 4; ++j) { const f32x4 gg = gr[64 * j]; f32x4 o; o.x = v[j].x * rs * gg.x; o.y = v[j].y * rs * gg.y; o.z = v[j].z * rs * gg.z; o.w = v[j].w * rs * gg.w; xr[64 * j] = o; }
}
__device__ __forceinline__ RowF rowf_load_b(const bf16_t* xb, const bf16_t* ys2, int lane) { RowF r; const u32x2* xr = (const u32x2*)xb + lane; const u32x2* y0 = (const u32x2*)ys2 + lane; const u32x2* y1 = (const u32x2*)(ys2 + 1024) + lane;
#pragma unroll
    for (int j = 0; j < 4; ++j) { const u32x2 q = xr[64 * j]; r.v[j] = (f32x4){__uint_as_float(q.x << 16), __uint_as_float(q.x & 0xffff0000u), __uint_as_float(q.y << 16), __uint_as_float(q.y & 0xffff0000u)}; r.a[j] = y0[64 * j]; r.b[j] = y1[64 * j]; }
    return r; }
__device__ __forceinline__ void final_rows_b(float* out, const bf16_t* xb, const bf16_t* ys, const float* g, int first, int step, int rows, int lane) {
    if (first >= rows) return;
    RowF cur = rowf_load_b(xb + (size_t)first * D, ys + (size_t)first * 2048, lane);
    for (int m = first; m < rows; m += step) { const int mn = (m + step < rows) ? m + step : m;
        const RowF nxt = rowf_load_b(xb + (size_t)mn * D, ys + (size_t)mn * 2048, lane);
        rowf_store(cur, out + (size_t)m * D, g, lane); cur = nxt; }
}
__device__ __forceinline__ void final_rows(float* out, const bf16_t* ys, const float* g, int first, int step, int rows, int lane) {
    if (first >= rows) return;
    RowF cur = rowf_load(out + (size_t)first * D, ys + (size_t)first * 2048, lane);
    for (int m = first; m < rows; m += step) { const int mn = (m + step < rows) ? m + step : m;
        const RowF nxt = rowf_load(out + (size_t)mn * D, ys + (size_t)mn * 2048, lane);
        rowf_store(cur, out + (size_t)m * D, g, lane); cur = nxt; }
}

__global__ void __launch_bounds__(512) k_prologue(PtrsIn P, unsigned char* ws) {
    extern __shared__ __attribute__((aligned(16))) unsigned char dyn[];
    const int tid = threadIdx.x, lane = tid & 63, wave = tid >> 6;
    const int gw = blockIdx.x * 8 + wave, NGW = gridDim.x * 8;
    LAS float* scr = (LAS float*)dyn + wave * 64 * 33;
    for (int it = gw; it < IT_TOTAL; it += NGW) p0_weight_item(P, ws, scr, it, lane);
    { const float* wsrc = P.in[9]; bf16_t* wd = (bf16_t*)(ws + WS_WSS);
      for (int i = blockIdx.x * 512 + tid; i < 4 * 128 * 128; i += gridDim.x * 512) wd[i] = (bf16_t)f2bf(wsrc[i]); }
    for (int i = blockIdx.x * 512 + tid; i < 2048; i += gridDim.x * 512) rope_table_entry((float*)(ws + WS_TAB), i);
    bf16_t* XN = (bf16_t*)(ws + WS_XN);
    for (int m = gw; m < M; m += NGW) rms_row_to_bf16(P.in[0] + (size_t)m * D, P.in[2], XN + (size_t)m * D, lane);
    for (int m = gw; m < MMEM; m += NGW) rms_row_to_bf16(P.in[1] + (size_t)m * D, P.in[14], XN + (size_t)(M + m) * D, lane);
}
__global__ void __launch_bounds__(512) k_norm_rows(const float* x, const float* g, bf16_t* o, int rows) {
    const int lane = threadIdx.x & 63, gw = blockIdx.x * 8 + (threadIdx.x >> 6), NGW = gridDim.x * 8;
    for (int m = gw; m < rows; m += NGW) rms_row_to_bf16(x + (size_t)m * D, g, o + (size_t)m * D, lane);
}
__global__ void __launch_bounds__(512) k_route(PtrsIn P, const float* x2, unsigned char* ws) {
    extern __shared__ __attribute__((aligned(16))) unsigned char dyn[];
    float* rw = (float*)dyn;
    int* te = (int*)(dyn + 20 * 1024 * 4);
    float* tw = (float*)(te + 256);
    int* tp = (int*)(tw + 256);
    int* ebase = tp + 256;
    const int tid = threadIdx.x, lane = tid & 63, wave = tid >> 6;
    for (int i = tid; i < 1024 * 4; i += 512) { const int k = i >> 2, o = i & 3; rw[o * 1024 + k] = P.in[19][i]; }
    for (int i = tid; i < 1024 * 16; i += 512) { const int k = i >> 4, o = i & 15; rw[(4 + o) * 1024 + k] = P.in[21][i]; }
    __syncthreads();
    bf16_t* XN3 = (bf16_t*)(ws + WS_XN3);
    const int t0 = blockIdx.x * 128;
    for (int i = 0; i < 16; ++i) { const int tl = wave * 16 + i, t = t0 + tl; int e0, e1; float w0, w1;
        route_token(row_load(x2 + (size_t)t * D, lane), P.in[18], rw, P.in[20], P.in[22], XN3 + (size_t)t * D, lane, e0, e1, w0, w1);
        if (lane == 0) { te[2 * tl] = e0; te[2 * tl + 1] = e1; tw[2 * tl] = w0; tw[2 * tl + 1] = w1; } }
    __syncthreads();
    if (wave == 0) {
        int cnt = 0;
        int mye[4]; for (int j = 0; j < 4; ++j) mye[j] = te[j * 64 + lane];
        int pos[4] = {0, 0, 0, 0};
        for (int e = 0; e < 16; ++e) { int run = 0;
            for (int j = 0; j < 4; ++j) { const unsigned long long mk = __ballot(mye[j] == e); const int before = __popcll(mk & ((1ull << lane) - 1ull));
                if (mye[j] == e) pos[j] = run + before; run += __popcll(mk); }
            if (lane == e) cnt = run; }
        for (int j = 0; j < 4; ++j) tp[j * 64 + lane] = pos[j];
        if (lane < 16) { unsigned* ec = (unsigned*)(ws + WS_CTL) + CW_ECNT + 64 * lane; ebase[lane] = (int)atomicAdd(ec, (unsigned)cnt); }
    }
    __syncthreads();
    if (tid < 256) { const int e = te[tid], slot = ebase[e] + tp[tid], dest = (t0 * 2) + tid; const float w = tw[tid];
        int* lst = (int*)(ws + WS_LIST) + ((size_t)e * LIST_CAP + slot) * 2; lst[0] = dest; lst[1] = __float_as_int(w);
        int* ti = (int*)(ws + WS_TOKINFO) + (size_t)dest * 2; ti[0] = e; ti[1] = __float_as_int(w); }
}
__global__ void __launch_bounds__(512) k_final(float* out, const bf16_t* ys, const float* g) {
    const int lane = threadIdx.x & 63, gw = blockIdx.x * 8 + (threadIdx.x >> 6), NGW = gridDim.x * 8;
    for (int m = gw; m < M; m += NGW) final_row(out + (size_t)m * D, ys + (size_t)m * 2048, g, lane);
}

__global__ void __launch_bounds__(256) nv_gemm(const bf16_t* A, int lda, const bf16_t* Bt, int ldb, int K, float* C, int ldc) {
    __shared__ __attribute__((aligned(16))) float As[16][68], Bs[16][68];
    const int tid = threadIdx.x, tx = tid & 15, ty = tid >> 4, r0 = blockIdx.y * 64, n0 = blockIdx.x * 64, lr = tid >> 2, lk = (tid & 3) * 4;
    float acc[4][4];
#pragma unroll
    for (int i = 0; i < 4; ++i)
#pragma unroll
        for (int j = 0; j < 4; ++j) acc[i][j] = 0.f;
    for (int k0 = 0; k0 < K; k0 += 16) {
        const u32x2 av = *(const u32x2*)(A + (size_t)(r0 + lr) * lda + k0 + lk), bv = *(const u32x2*)(Bt + (size_t)(n0 + lr) * ldb + k0 + lk);
        As[lk + 0][lr] = bf2f((bf16_t)(av.x & 0xffff)); As[lk + 1][lr] = bf2f((bf16_t)(av.x >> 16)); As[lk + 2][lr] = bf2f((bf16_t)(av.y & 0xffff)); As[lk + 3][lr] = bf2f((bf16_t)(av.y >> 16));
        Bs[lk + 0][lr] = bf2f((bf16_t)(bv.x & 0xffff)); Bs[lk + 1][lr] = bf2f((bf16_t)(bv.x >> 16)); Bs[lk + 2][lr] = bf2f((bf16_t)(bv.y & 0xffff)); Bs[lk + 3][lr] = bf2f((bf16_t)(bv.y >> 16));
        __syncthreads();
#pragma unroll
        for (int kk = 0; kk < 16; ++kk) { const f32x4 a = *(const f32x4*)&As[kk][ty * 4], b = *(const f32x4*)&Bs[kk][tx * 4];
#pragma unroll
            for (int i = 0; i < 4; ++i)
#pragma unroll
                for (int j = 0; j < 4; ++j) acc[i][j] += a[i] * b[j]; }
        __syncthreads();
    }
#pragma unroll
    for (int i = 0; i < 4; ++i) { f32x4 o = {acc[i][0], acc[i][1], acc[i][2], acc[i][3]}; *(f32x4*)(C + (size_t)(r0 + ty * 4 + i) * ldc + n0 + tx * 4) = o; }
}
__global__ void __launch_bounds__(256) nv_z_epi(const float* Cz, int row0, PtrsIn P, unsigned char* ws) {
    const int tid = threadIdx.x, lane = tid & 63, wave = tid >> 6;
    const int rl = blockIdx.x, row = row0 + rl, t = row % SEQ, rid = t >> 6, cid = t & 63;
    const float* z = Cz + (size_t)rl * NZ; const float* tab = (const float*)(ws + WS_TAB);
    if (wave == 0) {
        for (int hh = 0; hh < 10; ++hh) {
            const int c = (hh < 8) ? hh * 64 + lane : 512 + (hh - 8) * 64 + lane;
            const float v = z[z_phys(c)]; const float ss = wave_sum(v * v); const float rs = 1.0f / sqrtf(ss * (1.f / 64.f) + EPS);
            const float g = (hh < 8) ? P.in[4][lane] : P.in[5][lane];
            const float y = v * rs * g, yp = __shfl_xor(y, 1);
            const int i = lane >> 1; const float cs = (i < 16) ? tab[0 * 2048 + rid * 16 + i] : tab[2 * 2048 + cid * 16 + (i - 16)], sn = (i < 16) ? tab[1 * 2048 + rid * 16 + i] : tab[3 * 2048 + cid * 16 + (i - 16)];
            const float o = (lane & 1) ? (yp * sn + y * cs) : (y * cs - yp * sn);
            if (hh < 8) ((bf16_t*)(ws + WS_Q))[(size_t)row * 512 + hh * 64 + lane] = (bf16_t)f2bf(o * C2_SELF);
            else ((bf16_t*)(ws + WS_K))[(size_t)row * 128 + (hh - 8) * 64 + lane] = (bf16_t)f2bf(o);
        }
        for (int c = lane; c < 128; c += 64) ((bf16_t*)(ws + WS_V))[(size_t)row * 128 + c] = (bf16_t)f2bf(z[z_phys(ZV + c)]);
    } else {
        for (int c = tid - 64; c < 512; c += 192) { ((bf16_t*)(ws + WS_U))[(size_t)row * 512 + c] = (bf16_t)f2bf(gelu_tanh(z[ZSU + c])); ((bf16_t*)(ws + WS_GV))[(size_t)row * 512 + c] = (bf16_t)f2bf(gelu_tanh(z[ZSV + c])); }
        for (int c = tid - 64; c < 1024; c += 192) { ((bf16_t*)(ws + WS_GA))[(size_t)row * 1024 + c] = (bf16_t)f2bf(sigmoidf_(z[ZGA + c])); ((bf16_t*)(ws + WS_GB))[(size_t)row * 1024 + c] = (bf16_t)f2bf(sigmoidf_(z[ZGB + c])); }
    }
}
__global__ void __launch_bounds__(256) nv_store_bf16(const float* C, bf16_t* O, size_t n, float scale) {
    for (size_t i = (size_t)blockIdx.x * 256 + threadIdx.x; i < n; i += (size_t)gridDim.x * 256) O[i] = (bf16_t)f2bf(C[i] * scale);
}
__global__ void __launch_bounds__(256) nv_attn(const bf16_t* Q, const bf16_t* Kb, const bf16_t* Vb, bf16_t* O) {
    extern __shared__ __attribute__((aligned(16))) unsigned char dyn[];
    float (*Qs)[65] = (float (*)[65])dyn; float (*Ks)[65] = Qs + 64; float (*Vs)[65] = Ks + 64; float (*Ps)[65] = Vs + 64;
    const int tid = threadIdx.x, tx = tid & 15, ty = tid >> 4, qb = blockIdx.x, h = blockIdx.y, b = blockIdx.z, kvh = h >> 2;
    const int lr = tid >> 2, lc = (tid & 3) * 16;
    { const bf16_t* src = Q + ((size_t)(b * SEQ + qb * 64 + lr)) * 512 + h * 64 + lc;
      for (int j = 0; j < 16; ++j) Qs[lr][lc + j] = bf2f(src[j]); }
    float m[4], l[4], o[4][4];
    for (int i = 0; i < 4; ++i) { m[i] = -1e30f; l[i] = 0.f; for (int j = 0; j < 4; ++j) o[i][j] = 0.f; }
    for (int kt = 0; kt < SEQ / 64; ++kt) {
        __syncthreads();
        { const bf16_t* ks = Kb + ((size_t)(b * SEQ + kt * 64 + lr)) * 128 + kvh * 64 + lc; const bf16_t* vs = Vb + ((size_t)(b * SEQ + kt * 64 + lr)) * 128 + kvh * 64 + lc;
          for (int j = 0; j < 16; ++j) { Ks[lr][lc + j] = bf2f(ks[j]); Vs[lr][lc + j] = bf2f(vs[j]); } }
        __syncthreads();
        float s[4][4];
        for (int i = 0; i < 4; ++i) for (int j = 0; j < 4; ++j) s[i][j] = 0.f;
        for (int d = 0; d < 64; ++d) { float a[4], bb[4];
            for (int i = 0; i < 4; ++i) { a[i] = Qs[ty * 4 + i][d]; bb[i] = Ks[tx * 4 + i][d]; }
            for (int i = 0; i < 4; ++i) for (int j = 0; j < 4; ++j) s[i][j] += a[i] * bb[j]; }
        for (int i = 0; i < 4; ++i) {
            float rm = fmaxf(fmaxf(s[i][0], s[i][1]), fmaxf(s[i][2], s[i][3]));
            for (int x = 1; x < 16; x <<= 1) rm = fmaxf(rm, __shfl_xor(rm, x));
            const float mn = fmaxf(m[i], rm), al = __builtin_amdgcn_exp2f(m[i] - mn);
            float rsum = 0.f;
            for (int j = 0; j < 4; ++j) { const float p = __builtin_amdgcn_exp2f(s[i][j] - mn); Ps[ty * 4 + i][tx * 4 + j] = p; rsum += p; }
            for (int x = 1; x < 16; x <<= 1) rsum += __shfl_xor(rsum, x);
            l[i] = l[i] * al + rsum; m[i] = mn;
            for (int j = 0; j < 4; ++j) o[i][j] *= al;
        }
        __syncthreads();
        for (int c = 0; c < 64; ++c) { float p[4], v[4];
            for (int i = 0; i < 4; ++i) { p[i] = Ps[ty * 4 + i][c]; v[i] = Vs[c][tx * 4 + i]; }
            for (int i = 0; i < 4; ++i) for (int j = 0; j < 4; ++j) o[i][j] += p[i] * v[j]; }
    }
    for (int i = 0; i < 4; ++i) { const float il = 1.0f / l[i]; bf16_t* dst = O + ((size_t)(b * SEQ + qb * 64 + ty * 4 + i)) * 512 + h * 64 + tx * 4;
        for (int j = 0; j < 4; ++j) dst[j] = (bf16_t)f2bf(o[i][j] * il); }
}
__global__ void __launch_bounds__(256) nv_sgu(PtrsIn P, unsigned char* ws) {
    extern __shared__ __attribute__((aligned(16))) unsigned char dyn[];
    float* vn = (float*)dyn;
    float* mu = vn + 128 * 129; float* rstd = mu + 128;
    const int tid = threadIdx.x, lane = tid & 63, wave = tid >> 6, ch = blockIdx.x, g = blockIdx.y;
    const bf16_t* GV = (const bf16_t*)(ws + WS_GV) + (size_t)ch * 128 * 512;
    for (int r = wave * 32; r < wave * 32 + 32; ++r) { float s = 0.f;
        float xv[8]; for (int j = 0; j < 8; ++j) { xv[j] = bf2f(GV[(size_t)r * 512 + j * 64 + lane]); s += xv[j]; }
        const float mean = wave_sum(s) * (1.f / 512.f); float q = 0.f;
        for (int j = 0; j < 8; ++j) { const float d = xv[j] - mean; q += d * d; }
        const float var = wave_sum(q) * (1.f / 512.f);
        if (lane == 0) { mu[r] = mean; rstd[r] = 1.0f / sqrtf(var + EPS); } }
    __syncthreads();
    for (int i = tid; i < 128 * 128; i += 256) { const int q = i >> 7, c = i & 127, cg = g * 128 + c;
        vn[q * 129 + c] = (bf2f(GV[(size_t)q * 512 + cg]) - mu[q]) * rstd[q] * P.in[7][cg] + P.in[8][cg]; }
    __syncthreads();
    const bf16_t* W = (const bf16_t*)(ws + WS_WSS) + (size_t)g * 128 * 128;
    const bf16_t* U = (const bf16_t*)(ws + WS_U) + (size_t)ch * 128 * 512; bf16_t* SG = (bf16_t*)(ws + WS_SG) + (size_t)ch * 128 * 512;
    const int c = tid & 127;
    for (int p = tid >> 7; p < 128; p += 2) { float a = 0.f;
        for (int q = 0; q < 128; ++q) a += bf2f(W[p * 128 + q]) * vn[q * 129 + c];
        a += P.in[10][g * 128 + p];
        SG[(size_t)p * 512 + g * 128 + c] = (bf16_t)f2bf(bf2f(U[(size_t)p * 512 + g * 128 + c]) * a); }
}
__global__ void __launch_bounds__(256) nv_merge(const float* C1, const float* C2, const bf16_t* GA, const bf16_t* GB, bf16_t* Mg, size_t n) {
    for (size_t i = (size_t)blockIdx.x * 256 + threadIdx.x; i < n; i += (size_t)gridDim.x * 256) Mg[i] = (bf16_t)f2bf(bf2f(GA[i]) * C1[i] + bf2f(GB[i]) * C2[i]);
}
__global__ void __launch_bounds__(256) nv_resid(const float* base, const float* C, float* out, size_t n) {
    for (size_t i = (size_t)blockIdx.x * 256 + threadIdx.x; i < n; i += (size_t)gridDim.x * 256) out[i] = base[i] + C[i];
}
__global__ void __launch_bounds__(256) nv_cross(const bf16_t* QC, const bf16_t* KVC, bf16_t* OC) {
    __shared__ float qs[512]; __shared__ float ps[4][256];
    const int tid = threadIdx.x, lane = tid & 63, h = tid >> 6, tok = blockIdx.x, b = tok / SEQ;
    for (int i = tid; i < 512; i += 256) qs[i] = bf2f(QC[(size_t)tok * 512 + i]);
    __syncthreads();
    float sc[4]; float mx = -1e30f;
    for (int j = 0; j < 4; ++j) { const int mrow = b * NMEM + j * 64 + lane; const bf16_t* kr = KVC + (size_t)mrow * 1024 + h * 128; float a = 0.f;
        for (int d = 0; d < 128; ++d) a += qs[h * 128 + d] * bf2f(kr[d]);
        sc[j] = a; mx = fmaxf(mx, a); }
    mx = wave_max(mx); float sum = 0.f;
    for (int j = 0; j < 4; ++j) { const float p = __builtin_amdgcn_exp2f(sc[j] - mx); ps[h][j * 64 + lane] = p; sum += p; }
    sum = wave_sum(sum);
    __syncthreads();
    for (int dd = 0; dd < 2; ++dd) { const int d = dd * 64 + lane; float a = 0.f;
        for (int mm = 0; mm < 256; ++mm) a += ps[h][mm] * bf2f(KVC[(size_t)(b * NMEM + mm) * 1024 + 512 + h * 128 + d]);
        OC[(size_t)tok * 512 + h * 128 + d] = (bf16_t)f2bf(a / sum); }
}
__global__ void __launch_bounds__(256) nv_moe_a(const bf16_t* XN3, unsigned char* ws) {
    __shared__ float xs[1024];
    const int tid = threadIdx.x, dest = blockIdx.x, tok = dest >> 1;
    const int e = ((const int*)(ws + WS_TOKINFO))[(size_t)dest * 2];
    for (int i = tid; i < 1024; i += 256) xs[i] = bf2f(XN3[(size_t)tok * 1024 + i]);
    __syncthreads();
    const bf16_t* W = (const bf16_t*)(ws + WS_WGU) + (size_t)e * 1024 * 1024; bf16_t* Hh = (bf16_t*)(ws + WS_H) + (size_t)dest * 512;
    for (int n = tid; n < 512; n += 256) { const bf16_t* wg = W + (size_t)(256 * (n >> 7) + (n & 127)) * 1024; const bf16_t* wu = wg + 128 * 1024; float a = 0.f, b = 0.f;
        for (int k = 0; k < 1024; k += 8) { const u32x4 g4 = *(const u32x4*)(wg + k), u4 = *(const u32x4*)(wu + k);
            const unsigned gg[4] = {g4.x, g4.y, g4.z, g4.w}, uu[4] = {u4.x, u4.y, u4.z, u4.w};
            for (int j = 0; j < 4; ++j) { a += xs[k + 2 * j] * bf2f((bf16_t)(gg[j] & 0xffff)) + xs[k + 2 * j + 1] * bf2f((bf16_t)(gg[j] >> 16)); b += xs[k + 2 * j] * bf2f((bf16_t)(uu[j] & 0xffff)) + xs[k + 2 * j + 1] * bf2f((bf16_t)(uu[j] >> 16)); } }
        Hh[n] = (bf16_t)f2bf(a * sigmoidf_(a) * b); }
}
__global__ void __launch_bounds__(256) nv_moe_b(unsigned char* ws) {
    __shared__ float hs[512];
    const int tid = threadIdx.x, dest = blockIdx.x;
    const int* ti = (const int*)(ws + WS_TOKINFO) + (size_t)dest * 2; const int e = ti[0]; const float w = __int_as_float(ti[1]);
    const bf16_t* Hh = (const bf16_t*)(ws + WS_H) + (size_t)dest * 512;
    for (int i = tid; i < 512; i += 256) hs[i] = bf2f(Hh[i]);
    __syncthreads();
    const bf16_t* W = (const bf16_t*)(ws + WS_WD) + (size_t)e * 1024 * 512; bf16_t* Y = (bf16_t*)(ws + WS_YS) + (size_t)dest * 1024;
    for (int n = tid; n < 1024; n += 256) { const bf16_t* wr = W + (size_t)n * 512; float a = 0.f;
        for (int k = 0; k < 512; k += 8) { const u32x4 g4 = *(const u32x4*)(wr + k); const unsigned gg[4] = {g4.x, g4.y, g4.z, g4.w};
            for (int j = 0; j < 4; ++j) a += hs[k + 2 * j] * bf2f((bf16_t)(gg[j] & 0xffff)) + hs[k + 2 * j + 1] * bf2f((bf16_t)(gg[j] >> 16)); }
        Y[n] = (bf16_t)f2bf(a * w); }
}

namespace pg8 {
typedef short bf16x8 __attribute__((ext_vector_type(8)));
#ifndef WGM_V
#define WGM_V 8
#endif
constexpr int BM = 256, BK = 64, HALF = 128, HTB = HALF * BK * 2, STAGE_BYTES = 8 * HTB, NXCD = 8, WGM = WGM_V;
__host__ __device__ __forceinline__ int lds_byte(int r, int c) { const int st = (r >> 4) * 2 + (c >> 5), rr = r & 15, cc = c & 31, ob = rr * 64 + cc * 2; return st * 1024 + (ob ^ (((ob >> 9) & 1) << 5)); }
__host__ __device__ __forceinline__ void stage_rc(int b, int& R, int& C) { const int st = b / 1024, sb = b % 1024, swz = sb ^ (((sb >> 9) & 1) << 5); R = (st >> 1) * 16 + swz / 64; C = (st & 1) * 32 + (swz % 64) / 2; }
__host__ __device__ __forceinline__ int perm32(int rho) { const int n = rho >> 4, i = rho & 15; return 8 * (i >> 2) + 4 * n + (i & 3); }
struct Unit { int pm, pn, kind, dup; };
__device__ __forceinline__ void tile_of(int L, int nM, int nN, int& pm, int& pn) {
    const int nwg = nM * nN; int wgid = L; { const int q = nwg / NXCD, r = nwg % NXCD, xcd = wgid % NXCD, off = wgid / NXCD; wgid = (xcd < r ? xcd * (q + 1) : r * (q + 1) + (xcd - r) * q) + off; }
    const int nig = WGM * nN, gid = wgid / nig, fm = gid * WGM, gsz = (nM - fm) < WGM ? (nM - fm) : WGM;
    pm = fm + ((wgid % nig) % gsz); pn = (wgid % nig) / gsz;
}
__device__ __forceinline__ unsigned cvt_pk_bf16(float lo, float hi) { unsigned r; asm volatile("v_cvt_pk_bf16_f32 %0, %1, %2" : "=v"(r) : "v"(lo), "v"(hi)); return r; }

template <class Epi, class Sched, bool ALIGN_EPI, bool GATHER, bool VARK = false>
__device__ __forceinline__ void gemm_phase(LAS unsigned char* lds, const int Kc, const Sched& S, const Epi& E, const unsigned stag_ticks = 0u) {
    static_assert(!(VARK && GATHER), "VARK computes its offsets arithmetically");
    unsigned k2c = (unsigned)Kc * 2u, k2n = (unsigned)Kc * 2u;
    const int tid = threadIdx.x, wid = __builtin_amdgcn_readfirstlane(tid >> 6), lane = tid & 63, wr = wid >> 2, wc = wid & 3, fr = lane & 15, fq = lane >> 4;
    const int K = Kc; int nt = K / BK;
    unsigned voffA[2], voffB[2]; int RA[2], CA2[2], RB[2];
#pragma unroll
    for (int i = 0; i < 2; ++i) { int R, C; stage_rc(tid * 16 + i * 8192, R, C); const int Rb = Epi::PERM ? ((R & ~31) + perm32(R & 31)) : R;
        voffA[i] = (unsigned)(R * K + C) * 2u; voffB[i] = (unsigned)(Rb * K + C) * 2u; RA[i] = R; CA2[i] = C * 2; RB[i] = Rb; }
    const size_t kstep = (size_t)(BK * 2);
    const size_t hstep = (size_t)HALF * K * 2;
    const unsigned ldsw = (unsigned)wid * 1024u;
    const int aoff = lds_byte(wr * 64 + fr, fq * 8), boff = lds_byte(wc * 32 + fr, fq * 8);
    unsigned vA[2][2] = {{0u, 0u}, {0u, 0u}}, vN[2][2] = {{0u, 0u}, {0u, 0u}};
#define PG8_SA(b, h) (((b) * 2 + (h)) * HTB)
#define PG8_SB(b, h) ((4 + (b) * 2 + (h)) * HTB)
#define PG8_STAGE(bufoff, gbase, voff) do { _Pragma("unroll") for (int _i = 0; _i < 2; ++_i) \
        __builtin_amdgcn_global_load_lds((const unsigned*)((const char*)(gbase) + (voff)[_i]), (LAS unsigned*)(lds + (bufoff) + ldsw + _i * 8192), 16, 0, 0); } while (0)
#define PG8_STAGEA(bufoff, gbase, h, nx) do { _Pragma("unroll") for (int _i = 0; _i < 2; ++_i) { \
        const unsigned _o = VARK ? (unsigned)((h) * HALF + RA[_i]) * ((nx) ? k2n : k2c) + (unsigned)CA2[_i] : (GATHER ? ((nx) ? vN[h][_i] : vA[h][_i]) : voffA[_i]); \
        __builtin_amdgcn_global_load_lds((const unsigned*)((const char*)(gbase) + ((GATHER || VARK) ? (size_t)0 : (size_t)(h) * hstep) + _o), (LAS unsigned*)(lds + (bufoff) + ldsw + _i * 8192), 16, 0, 0); } } while (0)
#define PG8_STAGEB(bufoff, gbase, h, nx) do { _Pragma("unroll") for (int _i = 0; _i < 2; ++_i) { \
        const unsigned _o = VARK ? (unsigned)((h) * HALF + RB[_i]) * ((nx) ? k2n : k2c) + (unsigned)CA2[_i] : voffB[_i]; \
        __builtin_amdgcn_global_load_lds((const unsigned*)((const char*)(gbase) + (VARK ? (size_t)0 : (size_t)(h) * hstep) + _o), (LAS unsigned*)(lds + (bufoff) + ldsw + _i * 8192), 16, 0, 0); } } while (0)
#define PG8_LDA(dst, b, h) do { _Pragma("unroll") for (int m = 0; m < 4; ++m) _Pragma("unroll") for (int k = 0; k < 2; ++k) dst[m][k] = *(const LAS bf16x8*)(lds + PG8_SA(b, h) + aoff + m * 2048 + k * 1024); } while (0)
#define PG8_LDB(dst, b, h) do { _Pragma("unroll") for (int n = 0; n < 2; ++n) _Pragma("unroll") for (int k = 0; k < 2; ++k) dst[n][k] = *(const LAS bf16x8*)(lds + PG8_SB(b, h) + boff + n * 2048 + k * 1024); } while (0)
#define PG8_MMA(ai, bj, At, Bt) do { __builtin_amdgcn_s_setprio(1); _Pragma("unroll") for (int m = 0; m < 4; ++m) _Pragma("unroll") for (int n = 0; n < 2; ++n) _Pragma("unroll") for (int k = 0; k < 2; ++k) \
        acc[ai][bj][m][n] = __builtin_amdgcn_mfma_f32_16x16x32_bf16(Bt[n][k], At[m][k], acc[ai][bj][m][n], 0, 0, 0); __builtin_amdgcn_s_setprio(0); } while (0)
#define PG8_WAIT_V(n) asm volatile("s_waitcnt vmcnt(" #n ")" ::: "memory")
#define PG8_WAIT_L(n) asm volatile("s_waitcnt lgkmcnt(" #n ")" ::: "memory")
#define PG8_BAR __builtin_amdgcn_s_barrier()
#define PG8_SCHED __builtin_amdgcn_sched_barrier(0)
#define PG8_GOFF(dst, ui_) do { if (GATHER) { _Pragma("unroll") for (int _h = 0; _h < 2; ++_h) _Pragma("unroll") for (int _i = 0; _i < 2; ++_i) dst[_h][_i] = S.goff((ui_), _h * HALF + RA[_i]) + (unsigned)CA2[_i]; } } while (0)
    Unit cur, nxt; int ui = 0;
    if (!S.next(0, cur)) return;
    if (stag_ticks) { const unsigned long long t0 = __builtin_amdgcn_s_memrealtime(), dl = (unsigned long long)((blockIdx.x >> 3) & 1) * stag_ticks;
      while (__builtin_amdgcn_s_memrealtime() - t0 < dl) __builtin_amdgcn_s_sleep(8); }
    f32x4 acc[2][2][4][2];
#pragma unroll
    for (int a = 0; a < 2; ++a)
#pragma unroll
        for (int b = 0; b < 2; ++b)
#pragma unroll
            for (int m = 0; m < 4; ++m)
#pragma unroll
                for (int n = 0; n < 2; ++n) acc[a][b][m][n] = (f32x4){0.f, 0.f, 0.f, 0.f};
    bf16x8 At[4][2], B0[2][2], B1[2][2];
    const char* cA = S.a_ptr(cur); const char* cB = S.b_ptr(cur);
    PG8_GOFF(vA, 0);
    if constexpr (VARK) { nt = S.k_of(cur) / BK; k2c = (unsigned)S.k_of(cur) * 2u; k2n = k2c; }
    PG8_STAGEB(PG8_SB(0, 0), cB, 0, false); PG8_STAGEB(PG8_SB(0, 1), cB, 1, false); PG8_STAGEA(PG8_SA(0, 0), cA, 0, false); PG8_STAGEA(PG8_SA(0, 1), cA, 1, false);
    if (wr == 1) PG8_BAR;
    PG8_WAIT_V(2); PG8_BAR;
    PG8_STAGEB(PG8_SB(1, 0), cB + kstep, 0, false); PG8_STAGEA(PG8_SA(1, 0), cA + kstep, 0, false); PG8_STAGEB(PG8_SB(1, 1), cB + kstep, 1, false);
    PG8_WAIT_V(6); PG8_BAR;
    for (;;) {
        const bool has_next = S.next(ui + 1, nxt);
        const char* nA = has_next ? S.a_ptr(nxt) : cA; const char* nB = has_next ? S.b_ptr(nxt) : cB;
        for (int t = 0; t < nt; t += 2) {
            const bool last = (t == nt - 2);
            const char* a1 = cA + (size_t)(t + 1) * kstep;
            const char* a2 = last ? nA : cA + (size_t)(t + 2) * kstep; const char* b2 = last ? nB : cB + (size_t)(t + 2) * kstep;
            const char* a3 = a2 + kstep; const char* b3 = b2 + kstep;
            if constexpr (VARK) { if (last) k2n = has_next ? (unsigned)S.k_of(nxt) * 2u : k2c; }
            if (GATHER && last) { if (has_next) { PG8_GOFF(vN, ui + 1); } else {
#pragma unroll
                for (int _h = 0; _h < 2; ++_h)
#pragma unroll
                    for (int _i = 0; _i < 2; ++_i) vN[_h][_i] = vA[_h][_i]; } }
            PG8_LDB(B0, 0, 0); PG8_LDB(B1, 0, 1); PG8_SCHED; PG8_LDA(At, 0, 0); PG8_STAGEA(PG8_SA(1, 1), a1, 1, false);
            PG8_WAIT_V(8); PG8_WAIT_L(0); PG8_BAR; PG8_MMA(0, 0, At, B0); PG8_MMA(0, 1, At, B1); PG8_BAR; PG8_SCHED;
            PG8_LDA(At, 0, 1); PG8_STAGEB(PG8_SB(0, 0), b2, 0, last); PG8_STAGEB(PG8_SB(0, 1), b2, 1, last); PG8_STAGEA(PG8_SA(0, 0), a2, 0, last);
            PG8_WAIT_V(8); PG8_WAIT_L(0); PG8_BAR; PG8_MMA(1, 0, At, B0); PG8_MMA(1, 1, At, B1); PG8_BAR; PG8_SCHED;
            PG8_LDB(B0, 1, 0); PG8_LDB(B1, 1, 1); PG8_SCHED; PG8_LDA(At, 1, 0); PG8_STAGEA(PG8_SA(0, 1), a2, 1, last);
            PG8_WAIT_V(8); PG8_WAIT_L(0); PG8_BAR; PG8_MMA(0, 0, At, B0); PG8_MMA(0, 1, At, B1); PG8_BAR; PG8_SCHED;
            PG8_LDA(At, 1, 1); PG8_STAGEB(PG8_SB(1, 0), b3, 0, last); PG8_STAGEB(PG8_SB(1, 1), b3, 1, last); PG8_STAGEA(PG8_SA(1, 0), a3, 0, last);
            PG8_WAIT_V(8); PG8_WAIT_L(0); PG8_BAR; PG8_MMA(1, 0, At, B0); PG8_MMA(1, 1, At, B1); PG8_BAR; PG8_SCHED;
        }
        if constexpr (ALIGN_EPI) { if (wr == 0) PG8_BAR; }
        if (!cur.dup) E(acc, cur, ui, wr, wc, fr, fq);
#ifdef PROBE_EDUP
        if (Epi::EDUP) { asm volatile("s_waitcnt vmcnt(0)" ::: "memory"); E(acc, cur, ui, wr, wc, fr, fq); }
#endif
        if (!has_next) break;
#pragma unroll
        for (int a = 0; a < 2; ++a)
#pragma unroll
            for (int b = 0; b < 2; ++b)
#pragma unroll
                for (int m = 0; m < 4; ++m)
#pragma unroll
                    for (int n = 0; n < 2; ++n) acc[a][b][m][n] = (f32x4){0.f, 0.f, 0.f, 0.f};
        cur = nxt; cA = nA; cB = nB; ++ui;
        if constexpr (VARK) { nt = S.k_of(cur) / BK; k2c = k2n; }
        if (GATHER) {
#pragma unroll
            for (int _h = 0; _h < 2; ++_h)
#pragma unroll
                for (int _i = 0; _i < 2; ++_i) vA[_h][_i] = vN[_h][_i]; }
        if constexpr (ALIGN_EPI) { if (wr == 1) PG8_BAR; }
    }
    PG8_WAIT_V(0);
    if constexpr (!ALIGN_EPI) { if (wr == 0) PG8_BAR; }
    PG8_BAR;
#undef PG8_SA
#undef PG8_SB
#undef PG8_STAGE
#undef PG8_STAGEA
#undef PG8_STAGEB
#undef PG8_LDA
#undef PG8_LDB
#undef PG8_MMA
#undef PG8_WAIT_V
#undef PG8_WAIT_L
#undef PG8_BAR
#undef PG8_SCHED
#undef PG8_GOFF
}
}
namespace attn_body {
using bf16=unsigned short;
using bf16x8=__attribute__((ext_vector_type(8)))short;
using s16x4=__attribute__((ext_vector_type(4)))short;
using f32x16=__attribute__((ext_vector_type(16)))float;
constexpr int SEQA=8192,D=64,QP=512,KP=128;
constexpr int NW=8,QBLK=32,QB=QBLK*NW,KVBLK=64,NQB=SEQA/QB;
__device__ __forceinline__ int crow(int r,int hi){return (r&3)+8*(r>>2)+4*hi;}
#define SBAR() __builtin_amdgcn_sched_barrier(0)
__device__ __forceinline__ void cmask(f32x16&p0,f32x16&p1,int jb,int qrel,int hi){
  const float NEG=-INFINITY; int kb=64*jb+4*hi;
  #pragma unroll
  for(int r=0;r<16;++r){int kv=kb+(r&3)+8*(r>>2); if(kv>qrel)p0[r]=NEG; if(kv+32>qrel)p1[r]=NEG;}
}

constexpr int NSLOT=3, SLOTB=8192;
constexpr int LDS_K=0, LDS_V=NSLOT*SLOTB, LDS_WS=2*NSLOT*SLOTB, LDS_OST=LDS_WS+NW*64*4, LDS_BYTES=LDS_OST+NW*4096;
constexpr float C2=0.125f*1.4426950408889634f;
__device__ __forceinline__ void glds16(const void*gsrc,unsigned lds_dst){unsigned keep;
  asm volatile("s_mov_b32 %0, m0\n\ts_mov_b32 m0, %2\n\ts_nop 0\n\tglobal_load_lds_dwordx4 %1, off\n\ts_mov_b32 m0, %0":"=&s"(keep):"v"(gsrc),"s"(lds_dst):"memory");}
__device__ __forceinline__ float max3f(float a,float b,float c){float r;asm("v_max3_f32 %0, %1, %2, %3":"=v"(r):"v"(a),"v"(b),"v"(c));return r;}
__device__ __forceinline__ float max2f(float a,float b){float r;asm("v_max_f32_e32 %0, %1, %2":"=v"(r):"v"(a),"v"(b));return r;}
__device__ __forceinline__ float fadd_s(float a,float b){float r;asm("v_add_f32_e32 %0, %1, %2":"=v"(r):"v"(a),"v"(b));return r;}
__device__ __forceinline__ float fsub_s(float a,float b){float r;asm("v_sub_f32_e32 %0, %1, %2":"=v"(r):"v"(a),"v"(b));return r;}
typedef float f32x2_t __attribute__((ext_vector_type(2))); typedef __bf16 bf16x2_t __attribute__((ext_vector_type(2)));
__device__ __forceinline__ unsigned cvtpk_s(float lo,float hi){f32x2_t v={lo,hi};bf16x2_t b=__builtin_convertvector(v,bf16x2_t);return __builtin_bit_cast(unsigned,b);}
#define WAIT_BAR(N) asm volatile("s_waitcnt vmcnt(" #N ") lgkmcnt(0)\n\ts_barrier":::"memory")

__device__ __forceinline__ void qkt(f32x16&p0,f32x16&p1,const char*Kslot,const bf16x8*qr,const f32x16&negm,int r32,int hi){
  const char*kb=Kslot+hi*1024+r32*16;
  #pragma unroll
  for(int d0=0;d0<4;++d0){
    const bf16x8 b0=*reinterpret_cast<const bf16x8*>(kb+d0*2048);
    const bf16x8 b1=*reinterpret_cast<const bf16x8*>(kb+d0*2048+512);
    if(d0==0){p0=__builtin_amdgcn_mfma_f32_32x32x16_bf16(b0,qr[0],negm,0,0,0);p1=__builtin_amdgcn_mfma_f32_32x32x16_bf16(b1,qr[0],negm,0,0,0);}
    else{p0=__builtin_amdgcn_mfma_f32_32x32x16_bf16(b0,qr[d0],p0,0,0,0);p1=__builtin_amdgcn_mfma_f32_32x32x16_bf16(b1,qr[d0],p1,0,0,0);}}
}
typedef __attribute__((address_space(3))) const char* lds_cptr;
typedef short v4i16_t __attribute__((ext_vector_type(4)));
__device__ __forceinline__ void kload8(bf16x8*kf,lds_cptr kp){
  kf[0]=*(const __attribute__((address_space(3))) bf16x8*)(kp);      kf[1]=*(const __attribute__((address_space(3))) bf16x8*)(kp+512);
  kf[2]=*(const __attribute__((address_space(3))) bf16x8*)(kp+2048); kf[3]=*(const __attribute__((address_space(3))) bf16x8*)(kp+2560);
  kf[4]=*(const __attribute__((address_space(3))) bf16x8*)(kp+4096); kf[5]=*(const __attribute__((address_space(3))) bf16x8*)(kp+4608);
  kf[6]=*(const __attribute__((address_space(3))) bf16x8*)(kp+6144); kf[7]=*(const __attribute__((address_space(3))) bf16x8*)(kp+6656);
}
__device__ __forceinline__ void kload2(bf16x8*kf,lds_cptr kp,int j){ kf[2*j]=*(const __attribute__((address_space(3))) bf16x8*)(kp+j*2048); kf[2*j+1]=*(const __attribute__((address_space(3))) bf16x8*)(kp+j*2048+512); }
__device__ __forceinline__ s16x4 vtr(lds_cptr p){ return __builtin_bit_cast(s16x4,__builtin_amdgcn_ds_read_tr16_b64_v4i16((__attribute__((address_space(3))) v4i16_t*)p)); }
__device__ __forceinline__ float rowmax(const f32x16&p0,const f32x16&p1){
  float a=max3f(p0[0],p0[1],p1[0]),b=max3f(p0[2],p0[3],p1[1]);a=max3f(a,p1[2],p1[3]);
  #pragma unroll
  for(int r=4;r<16;r+=4){a=max3f(a,p0[r],p0[r+1]);b=max3f(b,p0[r+2],p0[r+3]);a=max3f(a,p1[r],p1[r+1]);b=max3f(b,p1[r+2],p1[r+3]);}
  const float m=max2f(a,b);
  auto rr=__builtin_amdgcn_permlane32_swap(__float_as_uint(m),__float_as_uint(m),false,false);
  return max2f(__uint_as_float(rr[0]),__uint_as_float(rr[1]));
}
__device__ __forceinline__ void pv(f32x16*o,int vb,bf16x8 pa0,bf16x8 pa1,bf16x8 pa2,bf16x8 pa3){
  #pragma unroll
  for(int d0=0;d0<2;++d0){s16x4 lo[4],hi[4];
    #pragma unroll
    for(int ks=0;ks<4;++ks){
      asm volatile("ds_read_b64_tr_b16 %0,%1 offset:%c2":"=&v"(lo[ks]):"v"(vb),"i"(d0*4096+ks*1024):"memory");
      asm volatile("ds_read_b64_tr_b16 %0,%1 offset:%c2":"=&v"(hi[ks]):"v"(vb),"i"(d0*4096+ks*1024+512):"memory");}
    asm volatile("s_waitcnt lgkmcnt(0)":::"memory");SBAR();
    #define PK(k) (bf16x8){lo[k][0],lo[k][1],lo[k][2],lo[k][3],hi[k][0],hi[k][1],hi[k][2],hi[k][3]}
    o[d0]=__builtin_amdgcn_mfma_f32_32x32x16_bf16(pa0,PK(0),o[d0],0,0,0);
    o[d0]=__builtin_amdgcn_mfma_f32_32x32x16_bf16(pa1,PK(1),o[d0],0,0,0);
    o[d0]=__builtin_amdgcn_mfma_f32_32x32x16_bf16(pa2,PK(2),o[d0],0,0,0);
    o[d0]=__builtin_amdgcn_mfma_f32_32x32x16_bf16(pa3,PK(3),o[d0],0,0,0);
    #undef PK
  }
}

#ifndef ATTN_STORE16
#define ATTN_STORE16(p,v) (*(u32x4*)(p)=(v))
#endif
template<int THRL,bool FIXM> __device__ __forceinline__ void attn_unit(int b,int h,int kvh,int qb,const bf16*Q,const bf16*__restrict__ K,const bf16*__restrict__ V,bf16*O,char*shm,float cfix){
  const int tid=threadIdx.x,lane=tid&63,r32=lane&31,hi=lane>>5; const int wid=__builtin_amdgcn_readfirstlane(tid>>6);
  const long rowbase=(long)b*SEQA; const int q0=qb*QB;
  const bf16*Qw=Q+(rowbase+q0+wid*QBLK)*QP+h*D;
  const bf16*Kh=K+rowbase*KP+kvh*D,*Vh=V+rowbase*KP+kvh*D;
  const unsigned lds0=(unsigned)(uintptr_t)shm;
  float*wsf=(float*)(shm+LDS_WS)+wid*64;
  const bf16*ksrc=Kh+(long)lane*KP+wid*8;
  const bf16*vsrc=Vh+(long)(16*(wid&3)+(lane>>2))*KP+(wid>>2)*32+(lane&3)*8;
  const unsigned kdst=lds0+LDS_K+wid*1024, vdst=lds0+LDS_V+wid*1024;
  #define DMA_K(t,slot) glds16(ksrc+(long)(t)*KVBLK*KP,(unsigned)__builtin_amdgcn_readfirstlane(kdst+(slot)))
  #define DMA_V(t,slot) glds16(vsrc+(long)(t)*KVBLK*KP,(unsigned)__builtin_amdgcn_readfirstlane(vdst+(slot)))
  const int vb0=(int)(lds0+LDS_V)+((lane>>4)&1)*32+(lane&3)*8+(4*hi+((lane&15)>>2))*64;
  const char*Kbase=shm+LDS_K; bf16x8 kf[8];
  const lds_cptr shm3=(lds_cptr)shm; const lds_cptr kp0=shm3+LDS_K+hi*1024+r32*16; const lds_cptr vp0=shm3+LDS_V+((lane>>4)&1)*32+(lane&3)*8+(4*hi+((lane&15)>>2))*64;
  const int NT=SEQA/KVBLK;
  DMA_K(0,0);DMA_V(0,0);DMA_K(1,SLOTB);
  bf16x8 qr[4];
  #pragma unroll
  for(int d0=0;d0<4;++d0)qr[d0]=*reinterpret_cast<const bf16x8*>(&Qw[(long)r32*QP+d0*16+hi*8]);
  float mhat=FIXM?cfix:0.f,l_reg=0.f;f32x16 o[2];o[0]=f32x16{};o[1]=f32x16{};f32x16 negm=f32x16{};
  if(FIXM){
  #pragma unroll
  for(int r=0;r<16;++r)negm[r]=-cfix;}
  asm volatile("":"+v"(negm));
  const int qrel=wid*QBLK+r32;
  #define CMASK(P0,P1,t) do{}while(0)
  bool resc=false;
  #define START(P0,P1) do{ resc=false; \
    if(!FIXM){ const float rm=rowmax(P0,P1); const float dl=rm; mhat=fadd_s(mhat,dl); \
      _Pragma("unroll") for(int r=0;r<16;++r){P0[r]=fsub_s(P0[r],dl);P1[r]=fsub_s(P1[r],dl);} \
      _Pragma("unroll") for(int r=0;r<16;++r)negm[r]=-mhat; asm volatile("":"+v"(negm)); } \
    _Pragma("unroll") for(int r=0;r<16;++r)P0[r]=__builtin_amdgcn_exp2f(P0[r]); }while(0)
  #define RESC() do{ if(!FIXM&&resc){ asm volatile("s_waitcnt lgkmcnt(0)":::"memory"); \
      _Pragma("unroll") for(int d_=0;d_<2;++d_) _Pragma("unroll") for(int r=0;r<16;++r)o[d_][r]*=wsf[crow(r,hi)]; } }while(0)
  f32x16 pA0,pA1,pB0,pB1;
  int sl_prev=0,sl_cur=0,sl_next=SLOTB;
  #define ROT() do{sl_prev=sl_cur;sl_cur=sl_next;sl_next=(sl_next==(NSLOT-1)*SLOTB)?0:sl_next+SLOTB;}while(0)
  DMA_K(2,2*SLOTB);
  WAIT_BAR(3);
  qkt(pA0,pA1,Kbase,qr,negm,r32,hi);asm volatile("s_nop 15\n\ts_nop 7":"+v"(pA0),"+v"(pA1));CMASK(pA0,pA1,0);
  START(pA0,pA1);
  _Pragma("unroll") for(int r=0;r<16;++r)pA1[r]=__builtin_amdgcn_exp2f(pA1[r]);
  WAIT_BAR(0);
  DMA_K(3,0);DMA_V(1,SLOTB);
  ROT();
  kload8(kf,kp0+sl_cur);
  WAIT_BAR(2);
  s16x4 vlo[8],vhi[8]; u32x4 pw0,pw1,pw2,pw3;
  #define PKW(P,B) cvtpk_s(P[B],P[B+1])
  #define PAF(k) __builtin_bit_cast(bf16x8,pw##k)
  #define VFR(i) (bf16x8){vlo[i][0],vlo[i][1],vlo[i][2],vlo[i][3],vhi[i][0],vhi[i][1],vhi[i][2],vhi[i][3]}
  #define PIN(x) asm volatile("":"+v"(x))
  #define MX3(a,b,c) __builtin_fmaxf(__builtin_fmaxf((a),(b)),(c))
  #define GAPA(MF,A0,A1,A2,A3,W0,W1,PW) do{ MF; sacc+=A0; sacc+=A1; sacc+=A2; sacc+=A3; PIN(sacc); W0; W1; PIN(PW); SBAR(); }while(0)
  #define EX(v) __builtin_amdgcn_exp2f(v)
  #define GAPB(MF,X,B) do{ MF; X[B]=EX(X[B]); X[B+1]=EX(X[B+1]); X[B+2]=EX(X[B+2]); X[B+3]=EX(X[B+3]); PIN(X); SBAR(); }while(0)
  #define VRD(i) do{ vlo[i]=vtr(vp_+(((i)>>2)*4096+((i)&3)*1024)); vhi[i]=vtr(vp_+(((i)>>2)*4096+((i)&3)*1024+512)); }while(0)
  #define KRD(G,j) do{ if(G){ kload2(kf,kp0+sl_next,j); SBAR(); } }while(0)
  #define STEP(C0,C1,P0,P1,t,GK,GV,GL) do{ SBAR(); \
    const lds_cptr vp_=vp0+sl_prev; \
    VRD(0); SBAR(); float sacc=(P0[0]+P0[1]); \
    GAPA(C0=__builtin_amdgcn_mfma_f32_32x32x16_bf16(kf[0],qr[0],negm,0,0,0), P0[2],P0[3],P0[4],P0[5],     pw0[0]=PKW(P0,0), pw0[1]=PKW(P0,2), pw0); \
    VRD(4); SBAR(); GAPA(C1=__builtin_amdgcn_mfma_f32_32x32x16_bf16(kf[1],qr[0],negm,0,0,0), P0[6],P0[7],P0[8],P0[9],     pw0[2]=PKW(P0,4), pw0[3]=PKW(P0,6), pw0); \
    VRD(1); SBAR(); GAPA(C0=__builtin_amdgcn_mfma_f32_32x32x16_bf16(kf[2],qr[1],C0,0,0,0),   P0[10],P0[11],P0[12],P0[13], pw1[0]=PKW(P0,8), pw1[1]=PKW(P0,10), pw1); \
    VRD(5); SBAR(); GAPA(C1=__builtin_amdgcn_mfma_f32_32x32x16_bf16(kf[3],qr[1],C1,0,0,0),   P0[14],P0[15],P1[0],P1[1],   pw1[2]=PKW(P0,12),pw1[3]=PKW(P0,14), pw1); \
    VRD(2); SBAR(); GAPA(C0=__builtin_amdgcn_mfma_f32_32x32x16_bf16(kf[4],qr[2],C0,0,0,0),   P1[2],P1[3],P1[4],P1[5],     pw2[0]=PKW(P1,0), pw2[1]=PKW(P1,2), pw2); \
    VRD(6); SBAR(); GAPA(C1=__builtin_amdgcn_mfma_f32_32x32x16_bf16(kf[5],qr[2],C1,0,0,0),   P1[6],P1[7],P1[8],P1[9],     pw2[2]=PKW(P1,4), pw2[3]=PKW(P1,6), pw2); \
    VRD(3); SBAR(); GAPA(C0=__builtin_amdgcn_mfma_f32_32x32x16_bf16(kf[6],qr[3],C0,0,0,0),   P1[10],P1[11],P1[12],P1[13], pw3[0]=PKW(P1,8), pw3[1]=PKW(P1,10), pw3); \
    VRD(7); SBAR(); GAPA(C1=__builtin_amdgcn_mfma_f32_32x32x16_bf16(kf[7],qr[3],C1,0,0,0),   P1[14],P1[15],0.f,0.f,       pw3[2]=PKW(P1,12),pw3[3]=PKW(P1,14), pw3); \
    l_reg+=sacc; \
    if(GK){DMA_K((t)+3,sl_cur);} if(GV){DMA_V((t)+1,sl_next);} \
    CMASK(C0,C1,t); \
    if(!FIXM){ float a=MX3(C0[0],C0[1],C1[0]),b=MX3(C0[2],C0[3],C1[1]); a=MX3(a,C1[2],C1[3]); \
      _Pragma("unroll") for(int r=4;r<16;r+=4){a=MX3(a,C0[r],C0[r+1]);b=MX3(b,C0[r+2],C0[r+3]);a=MX3(a,C1[r],C1[r+1]);b=MX3(b,C1[r+2],C1[r+3]);} \
      float rm=__builtin_fmaxf(a,b); { auto rr=__builtin_amdgcn_permlane32_swap(__float_as_uint(rm),__float_as_uint(rm),false,false); rm=__builtin_fmaxf(__uint_as_float(rr[0]),__uint_as_float(rr[1])); } \
      resc=false; \
      if(__builtin_expect(__any(rm>(float)THRL),0)){ const float dl=__builtin_fmaxf(rm,0.f); mhat+=dl; \
        _Pragma("unroll") for(int r=0;r<16;++r){C0[r]-=dl;C1[r]-=dl;} \
        _Pragma("unroll") for(int r=0;r<16;++r)negm[r]=-mhat; asm volatile("":"+v"(negm)); \
        const float f=__builtin_amdgcn_exp2f(-dl); l_reg*=f; if(hi==0)wsf[r32]=f; resc=true; } } \
    SBAR(); \
    GAPB(o[0]=__builtin_amdgcn_mfma_f32_32x32x16_bf16(PAF(0),VFR(0),o[0],0,0,0), C0,0); \
    GAPB(o[1]=__builtin_amdgcn_mfma_f32_32x32x16_bf16(PAF(0),VFR(4),o[1],0,0,0), C0,4); \
    KRD(GL,0); GAPB(o[0]=__builtin_amdgcn_mfma_f32_32x32x16_bf16(PAF(1),VFR(1),o[0],0,0,0), C0,8); \
    KRD(GL,1); GAPB(o[1]=__builtin_amdgcn_mfma_f32_32x32x16_bf16(PAF(1),VFR(5),o[1],0,0,0), C0,12); \
    KRD(GL,2); GAPB(o[0]=__builtin_amdgcn_mfma_f32_32x32x16_bf16(PAF(2),VFR(2),o[0],0,0,0), C1,0); \
    KRD(GL,3); GAPB(o[1]=__builtin_amdgcn_mfma_f32_32x32x16_bf16(PAF(2),VFR(6),o[1],0,0,0), C1,4); \
    GAPB(o[0]=__builtin_amdgcn_mfma_f32_32x32x16_bf16(PAF(3),VFR(3),o[0],0,0,0), C1,8); \
    GAPB(o[1]=__builtin_amdgcn_mfma_f32_32x32x16_bf16(PAF(3),VFR(7),o[1],0,0,0), C1,12); \
    }while(0)
  int t=1;
  #undef CMASK
  #define CMASK(P0,P1,t) do{}while(0)
  for(;t+5<NT;t+=2){
    STEP(pB0,pB1,pA0,pA1,t,true,true,true);     WAIT_BAR(2); RESC(); ROT();
    STEP(pA0,pA1,pB0,pB1,t+1,true,true,true);   WAIT_BAR(2); RESC(); ROT();
  }
  #undef CMASK
  #define CMASK(P0,P1,t) do{}while(0)
  #define ENDW(tt) do{ if((tt)+3<NT){WAIT_BAR(2);} else if((tt)+2<NT){WAIT_BAR(1);} else {WAIT_BAR(0);} }while(0)
  for(;t+1<NT;t+=2){
    STEP(pB0,pB1,pA0,pA1,t,(t+3<NT),(t+1<NT),(t+1<NT));       ENDW(t);   RESC(); ROT();
    STEP(pA0,pA1,pB0,pB1,t+1,(t+4<NT),(t+2<NT),(t+2<NT));     ENDW(t+1); RESC(); ROT();
  }
  STEP(pB0,pB1,pA0,pA1,NT-1,false,false,false); RESC();
  { float sacc=pB0[0]+pB0[1]; _Pragma("unroll") for(int r=2;r<16;++r)sacc+=pB0[r]; _Pragma("unroll") for(int r=0;r<16;++r)sacc+=pB1[r]; l_reg+=sacc;
    pw0=(u32x4){PKW(pB0,0),PKW(pB0,2),PKW(pB0,4),PKW(pB0,6)};pw1=(u32x4){PKW(pB0,8),PKW(pB0,10),PKW(pB0,12),PKW(pB0,14)};pw2=(u32x4){PKW(pB1,0),PKW(pB1,2),PKW(pB1,4),PKW(pB1,6)};pw3=(u32x4){PKW(pB1,8),PKW(pB1,10),PKW(pB1,12),PKW(pB1,14)};
    SBAR(); pv(o,vb0+sl_cur,PAF(0),PAF(1),PAF(2),PAF(3)); }
  #undef PKW
  #undef PAF
  #undef VFR
  #undef PIN
  #undef MX3
  #undef GAPA
  #undef GAPB
  #undef EX
  #undef VRD
  #undef KRD
  #undef STEP
  #undef ENDW
  {auto rr=__builtin_amdgcn_permlane32_swap(__float_as_uint(l_reg),__float_as_uint(l_reg),false,false);l_reg=__uint_as_float(rr[0])+__uint_as_float(rr[1]);}
  if(hi==0)wsf[32+r32]=l_reg;asm volatile("s_waitcnt lgkmcnt(0)":::"memory");
  float rli[16];
  #pragma unroll
  for(int r=0;r<16;++r)rli[r]=__builtin_amdgcn_rcpf(wsf[32+crow(r,hi)]);
  bf16*Ow=O+(rowbase+q0+wid*QBLK)*QP+h*D;
  { bf16*stg=(bf16*)(shm+LDS_OST)+wid*2048;
    #pragma unroll
    for(int r=0;r<16;++r){const int orow=crow(r,hi);
      #pragma unroll
      for(int d0=0;d0<2;++d0)stg[orow*64+d0*32+r32]=(bf16)f2bf(o[d0][r]*rli[r]);}
    asm volatile("s_waitcnt lgkmcnt(0)":::"memory");
    #pragma unroll
    for(int i=0;i<4;++i){const int row=i*8+(lane>>3),ch=lane&7; const u32x4 v=*(const u32x4*)(stg+row*64+ch*8); ATTN_STORE16(Ow+(long)row*QP+ch*8,v);} }
  asm volatile("s_waitcnt lgkmcnt(0)\n\ts_barrier":::"memory");
  #undef DMA_K
  #undef DMA_V
  #undef CMASK
  #undef START
  #undef RESC
  #undef ROT
}
constexpr int ATTN_LDS_BYTES=LDS_BYTES;
#undef SBAR
#undef WAIT_BAR
}
constexpr int NWAVES = 8;
constexpr int RING_OFF = 0, RING_BYTES = 131072;
constexpr int SGU_ROWB = 1040, SGU_TILE_BYTES = 128 * SGU_ROWB;
constexpr int TBL_OFF = 133120;
constexpr int MOE_MAXU = 6;
constexpr int RSTBL_OFF = TBL_OFF + MOE_MAXU * 1024;
constexpr int UREC_OFF = RSTBL_OFF + MOE_MAXU * 1024;
constexpr int MISC_OFF = UREC_OFF + 512;
constexpr int LDS_BYTES = 147456;
static_assert(MISC_OFF + 128 <= LDS_BYTES, "LDS map");
constexpr int NPHASE = 13;

#define GAS __attribute__((address_space(1)))
typedef GAS unsigned gu32;
#define RLX_AGENT __ATOMIC_RELAXED, __HIP_MEMORY_SCOPE_AGENT

#define XB_TMO      128
#define XB_XCNT(j)  (256  + 64 * (j))
#define XB_XSUB(j)  (1280 + 64 * (j))
#define XB_XGEN(j)  (2304 + 64 * (j))
#define XB_TOP      3328
#define XB_TOPGEN   3392
#define XCD_BAR_WORDS 3456
#define XB_SPIN_CAP (1u << 18)
__device__ __forceinline__ unsigned xb_ld(unsigned* p)              { return __hip_atomic_load(p, __ATOMIC_RELAXED, __HIP_MEMORY_SCOPE_AGENT); }
__device__ __forceinline__ unsigned xb_add(unsigned* p, unsigned v) { return __hip_atomic_fetch_add(p, v, __ATOMIC_RELAXED, __HIP_MEMORY_SCOPE_AGENT); }
__device__ __forceinline__ unsigned xb_xcc_id() { return (unsigned)__builtin_amdgcn_s_getreg((3 << 11) | 20) & 0xFu; }
#define XB_SPIN(cond, bar) do { unsigned _sp = 0; while (cond) { __builtin_amdgcn_s_sleep(1); \
    if ((++_sp & 255u) == 0u) { if (xb_ld(&(bar)[XB_TMO])) break; if (_sp > XB_SPIN_CAP) { atomicAdd(&(bar)[XB_TMO], 1u); break; } } } } while (0)
struct XcdBarrier { unsigned* bar; unsigned x; volatile LAS unsigned* st; };
__device__ __forceinline__ XcdBarrier xcd_barrier_post(unsigned* bar, volatile LAS unsigned* st) {
    XcdBarrier b; b.bar = bar; b.x = xb_xcc_id(); b.st = st;
    if (threadIdx.x == 0) (void)xb_add(&bar[XB_XCNT(b.x)], 1u);
    return b;
}
__device__ __forceinline__ void xcd_barrier_complete(unsigned* bar, unsigned x, unsigned& nloc, unsigned& nx) {
    const unsigned G = gridDim.x * gridDim.y * gridDim.z;
    unsigned sum, cnt, mine, sp = 0u;
    for (;;) {
        sum = 0u; cnt = 0u; mine = 0u;
#pragma unroll
        for (unsigned j = 0; j < 16; ++j) { const unsigned c = xb_ld(&bar[XB_XCNT(j)]); sum += c; cnt += (c > 0u) ? 1u : 0u; mine = (j == x) ? c : mine; }
        if (sum == G) break;
        __builtin_amdgcn_s_sleep(1);
        if ((++sp & 255u) == 0u) { if (xb_ld(&bar[XB_TMO])) break; if (sp > XB_SPIN_CAP) { atomicAdd(&bar[XB_TMO], 1u); break; } }
    }
    nloc = mine > 0u ? mine : 1u; nx = cnt > 0u ? cnt : 1u;
}
__device__ __forceinline__ void xcd_barrier(const XcdBarrier& b) {
    asm volatile("s_waitcnt vmcnt(0)" ::: "memory");
    __syncthreads();
    if (threadIdx.x == 0) {
        unsigned* bar = b.bar;
        __builtin_amdgcn_s_waitcnt(0);
        unsigned nloc = b.st[0], nx = b.st[1];
        if (nloc == 0u) { xcd_barrier_complete(bar, b.x, nloc, nx); b.st[0] = nloc; b.st[1] = nx; }
        const unsigned old = xb_add(&bar[XB_XSUB(b.x)], 1u);
        const unsigned gen = old / nloc;
        if (old + 1u == (gen + 1u) * nloc) {
            __builtin_amdgcn_fence(__ATOMIC_RELEASE, "agent");
            asm volatile("s_waitcnt vmcnt(0)" ::: "memory");
            const unsigned og = xb_add(&bar[XB_TOP], 1u);
            const unsigned tg = og / nx;
            if (og + 1u == (tg + 1u) * nx) xb_add(&bar[XB_TOPGEN], 1u);
            else XB_SPIN(xb_ld(&bar[XB_TOPGEN]) == tg, bar);
            __builtin_amdgcn_fence(__ATOMIC_ACQUIRE, "agent");
            xb_add(&bar[XB_XGEN(b.x)], 1u);
            asm volatile("s_waitcnt vmcnt(0)" ::: "memory");
        } else {
            XB_SPIN(xb_ld(&bar[XB_XGEN(b.x)]) == gen, bar);
            __builtin_amdgcn_fence(__ATOMIC_ACQUIRE, "agent");
            asm volatile("s_waitcnt vmcnt(0)" ::: "memory");
        }
    }
    __syncthreads();
}

using pg8::Unit;
struct SchedPlain {
    const char* A; const char* Bt; int nM, nN, G, c, K;
    __device__ __forceinline__ bool next(int i, Unit& u) const { const long L = (long)i * G + c; if (L >= (long)nM * nN) return false; pg8::tile_of((int)L, nM, nN, u.pm, u.pn); u.kind = 0; u.dup = 0; return true; }
    __device__ __forceinline__ const char* a_ptr(const Unit& u) const { return A + (size_t)u.pm * 256 * K * 2; }
    __device__ __forceinline__ const char* b_ptr(const Unit& u) const { return Bt + (size_t)u.pn * 256 * K * 2; }
    __device__ __forceinline__ unsigned goff(int, int) const { return 0u; }
};
template <class B> struct SchedDup { B b;
    __device__ __forceinline__ bool next(int i, Unit& u) const { if (!b.next(i >> 1, u)) return false; u.dup = !(i & 1); return true; }
    __device__ __forceinline__ const char* a_ptr(const Unit& u) const { return b.a_ptr(u); }
    __device__ __forceinline__ const char* b_ptr(const Unit& u) const { return b.b_ptr(u); }
    __device__ __forceinline__ unsigned goff(int, int) const { return 0u; }
    __device__ __forceinline__ int k_of(const Unit& u) const { return b.k_of(u); }
};
struct SchedZ {
    const char* A; const char* Bt; int G, c;
    __device__ __forceinline__ bool next(int i, Unit& u) const { const long L = (long)i * G + c; if (L >= 912) return false;
        if (L < 896) pg8::tile_of((int)L, 128, 7, u.pm, u.pn); else { const int j = (int)L - 896; u.pm = 128 + (j >> 2); u.pn = 15 + (j & 3); } u.kind = 0; u.dup = 0; return true; }
    __device__ __forceinline__ const char* a_ptr(const Unit& u) const { return A + (size_t)u.pm * 256 * 2048; }
    __device__ __forceinline__ const char* b_ptr(const Unit& u) const { return Bt + (size_t)u.pn * 256 * 2048; }
    __device__ __forceinline__ unsigned goff(int, int) const { return 0u; }
};
struct SchedY {
    const char* ws; int G, c;
    __device__ __forceinline__ bool next(int i, Unit& u) const { const long L = (long)(i >> 2) * G + c; if (L >= 512) return false; pg8::tile_of((int)L, 128, 4, u.pm, u.pn); u.kind = i & 3; u.dup = 0; return true; }
    __device__ __forceinline__ int k_of(const Unit& u) const { return 1024 - 512 * (u.kind >> 1); }
    __device__ __forceinline__ const char* a_ptr(const Unit& u) const { const size_t mix = (size_t)(u.kind >> 1), sg = (size_t)(u.kind & 1);
        const size_t off = mix * (WS_ATT + sg * (WS_SG - WS_ATT) + (size_t)u.pm * 256 * 1024) + (1 - mix) * (WS_XN + (size_t)u.pm * 256 * 2048); return ws + off; }
    __device__ __forceinline__ const char* b_ptr(const Unit& u) const { const size_t mix = (size_t)(u.kind >> 1), sg = (size_t)(u.kind & 1);
        const size_t off = mix * (WS_WATT + sg * (WS_WSGU - WS_WATT) + (size_t)u.pn * 256 * 1024) + (1 - mix) * (WS_WZ + (size_t)(ZGA + sg * (ZGB - ZGA) + u.pn * 256) * 2048); return ws + off; }
    __device__ __forceinline__ unsigned goff(int, int) const { return 0u; }
};
struct SchedMoe {
    const LAS int* rec; const LAS unsigned* tbl; const char* A; const char* Bt; size_t a_panel_bytes, b_expert_bytes, b_tile_bytes; bool gather;
    __device__ __forceinline__ bool next(int i, Unit& u) const { if (i >= MOE_MAXU || rec[i * 8] == 0) return false; u.pm = rec[i * 8 + 1]; u.pn = rec[i * 8 + 2]; u.kind = rec[i * 8 + 3]; u.dup = 0; return true; }
    __device__ __forceinline__ const char* a_ptr(const Unit& u) const { return gather ? A : A + (size_t)u.pm * a_panel_bytes; }
    __device__ __forceinline__ const char* b_ptr(const Unit& u) const { return Bt + (size_t)u.kind * b_expert_bytes + (size_t)u.pn * b_tile_bytes; }
    __device__ __forceinline__ unsigned goff(int ui, int row) const { return tbl[ui * 256 + row]; }
};

#ifndef EPI_ST
#define EPI_ST 0
#endif
__device__ __forceinline__ void st16(void* p, u32x4 v) {
#if EPI_ST == 1
    asm volatile("global_store_dwordx4 %0, %1, off nt\n\ts_nop 1" :: "v"(p), "v"(v) : "memory");
#elif EPI_ST == 2
    asm volatile("global_store_dwordx4 %0, %1, off sc1\n\ts_nop 1" :: "v"(p), "v"(v) : "memory");
#else
    *(u32x4*)p = v;
#endif
}
typedef const f32x4 (&AccRef)[2][2][4][2];
typedef float f32x2 __attribute__((ext_vector_type(2)));
struct EpiZ {
    static constexpr bool PERM = true, EDUP = false;
    unsigned char* ws; const float* gq; const float* gk; const float* tab; const float* rs0;
    __device__ __forceinline__ void operator()(AccRef acc, const Unit& u, int, int wr, int wc, int fr, int fq) const {
        const int pn = u.pn;
#define EPIZ_R0(ai_) float r0m[4]; _Pragma("unroll") for (int m_ = 0; m_ < 4; ++m_) r0m[m_] = (X0_BF16 && pn < 15) ? rs0[u.pm * 256 + (ai_) * 128 + wr * 64 + m_ * 16 + fr] : 1.0f
        if (pn <= 2) {
            const bool isv = (pn == 2 && wc >= 2), isq = (pn < 2);
            bf16_t* dst; int ldc;
            if (isq) { dst = (bf16_t*)(ws + WS_Q) + (4 * pn + wc) * 64; ldc = 512; }
            else if (!isv) { dst = (bf16_t*)(ws + WS_K) + wc * 64; ldc = 128; }
            else { dst = (bf16_t*)(ws + WS_V) + (wc - 2) * 64; ldc = 128; }
            const float* g = isq ? gq : gk;
            f32x4 gv[2][2];
#pragma unroll
            for (int bj = 0; bj < 2; ++bj)
#pragma unroll
                for (int n = 0; n < 2; ++n) gv[bj][n] = *(const f32x4*)(g + 32 * bj + 8 * fq + 4 * n);
            const float osc = isq ? C2_SELF : 1.0f;
#pragma unroll
            for (int ai = 0; ai < 2; ++ai) {
                EPIZ_R0(ai);
                const int rid = (4 * u.pm + 2 * ai + wr) & 127;
                f32x4 csr = (f32x4){1.f, 1.f, 1.f, 1.f}, snr = (f32x4){0.f, 0.f, 0.f, 0.f}, csc[4], snc[4];
#pragma unroll
                for (int m = 0; m < 4; ++m) { csc[m] = csr; snc[m] = snr; }
                if (!isv) { const float* tr = tab + rid * 16 + 4 * fq; csr = *(const f32x4*)tr; snr = *(const f32x4*)(tr + 2048);
#pragma unroll
                    for (int m = 0; m < 4; ++m) { const float* tc = tab + 2 * 2048 + (16 * m + fr) * 16 + 4 * fq; csc[m] = *(const f32x4*)tc; snc[m] = *(const f32x4*)(tc + 2048); } }
#pragma unroll
                for (int m = 0; m < 4; ++m) {
                    const int row = u.pm * 256 + ai * 128 + wr * 64 + m * 16 + fr;
                    bf16_t* rowp = dst + (size_t)row * ldc + 8 * fq;
                    if (isv) {
#pragma unroll
                        for (int bj = 0; bj < 2; ++bj) { const f32x4 v0 = acc[ai][bj][m][0] * r0m[m], v1 = acc[ai][bj][m][1] * r0m[m];
                            u32x4 w; w.x = pg8::cvt_pk_bf16(v0[0], v0[1]); w.y = pg8::cvt_pk_bf16(v0[2], v0[3]); w.z = pg8::cvt_pk_bf16(v1[0], v1[1]); w.w = pg8::cvt_pk_bf16(v1[2], v1[3]);
                            st16(rowp + 32 * bj, w); }
                    } else {
                        float ss = 0.f;
#pragma unroll
                        for (int bj = 0; bj < 2; ++bj)
#pragma unroll
                            for (int n = 0; n < 2; ++n) { const f32x4 x = acc[ai][bj][m][n]; ss += (x[0] * x[0] + x[1] * x[1]) + (x[2] * x[2] + x[3] * x[3]); }
                        ss += __shfl_xor(ss, 16); ss += __shfl_xor(ss, 32);
                        const float rq = r0m[m]; const float rs = rq * osc / sqrtf(rq * rq * ss * (1.f / 64.f) + EPS);
#pragma unroll
                        for (int bj = 0; bj < 2; ++bj) {
                            const f32x4 cs = bj ? csc[m] : csr, sn = bj ? snc[m] : snr;
                            float o[8];
#pragma unroll
                            for (int n = 0; n < 2; ++n) { const f32x4 x = acc[ai][bj][m][n], gg = gv[bj][n];
                                const float y0 = x[0] * rs * gg[0], y1 = x[1] * rs * gg[1], y2 = x[2] * rs * gg[2], y3 = x[3] * rs * gg[3];
                                const float c0 = cs[2 * n], s0 = sn[2 * n], c1 = cs[2 * n + 1], s1 = sn[2 * n + 1];
                                o[4 * n + 0] = y0 * c0 - y1 * s0; o[4 * n + 1] = y0 * s0 + y1 * c0; o[4 * n + 2] = y2 * c1 - y3 * s1; o[4 * n + 3] = y2 * s1 + y3 * c1; }
                            u32x4 w; w.x = pg8::cvt_pk_bf16(o[0], o[1]); w.y = pg8::cvt_pk_bf16(o[2], o[3]); w.z = pg8::cvt_pk_bf16(o[4], o[5]); w.w = pg8::cvt_pk_bf16(o[6], o[7]);
                            st16(rowp + 32 * bj, w); }
                    }
                }
            }
        } else {
            bf16_t* dst; int ldc, row0; int act;
            if (pn < 5) { dst = (bf16_t*)(ws + WS_U) + (pn - 3) * 256; ldc = 512; act = 1; row0 = u.pm * 256; }
            else if (pn < 7) { dst = (bf16_t*)(ws + WS_GV) + (pn - 5) * 256; ldc = 512; act = 1; row0 = u.pm * 256; }
            else if (pn < 11) { dst = (bf16_t*)(ws + WS_GA) + (pn - 7) * 256; ldc = 1024; act = 2; row0 = u.pm * 256; }
            else if (pn < 15) { dst = (bf16_t*)(ws + WS_GB) + (pn - 11) * 256; ldc = 1024; act = 2; row0 = u.pm * 256; }
            else { dst = (bf16_t*)(ws + WS_KVC) + (pn - 15) * 256; ldc = 1024; act = 0; row0 = (u.pm - 128) * 256; }
#pragma unroll
            for (int ai = 0; ai < 2; ++ai) { EPIZ_R0(ai);
#pragma unroll
                for (int m = 0; m < 4; ++m) { bf16_t* rowp = dst + (size_t)(row0 + ai * 128 + wr * 64 + m * 16 + fr) * ldc + wc * 32 + 8 * fq;
#pragma unroll
                    for (int bj = 0; bj < 2; ++bj) { f32x2 o[4];
#pragma unroll
                        for (int n = 0; n < 2; ++n)
#pragma unroll
                            for (int hh = 0; hh < 2; ++hh) { const f32x2 x = (f32x2){acc[ai][bj][m][n][2 * hh], acc[ai][bj][m][n][2 * hh + 1]} * r0m[m];
                                if (act == 2) { const f32x2 t = x * (-LOG2E); f32x2 e; e.x = __builtin_amdgcn_exp2f(t.x); e.y = __builtin_amdgcn_exp2f(t.y); const f32x2 d = e + 1.0f;
                                    f32x2 r; r.x = __builtin_amdgcn_rcpf(d.x); r.y = __builtin_amdgcn_rcpf(d.y); o[2 * n + hh] = r; }
                                else if (act == 1) { const f32x2 x2 = x * x, t = (x2 * (-2.0f * LOG2E * 0.7978845608028654f * 0.044715f) + (-2.0f * LOG2E * 0.7978845608028654f)) * x;
                                    f32x2 e; e.x = __builtin_amdgcn_exp2f(t.x); e.y = __builtin_amdgcn_exp2f(t.y); const f32x2 d = e + 1.0f;
                                    f32x2 r; r.x = __builtin_amdgcn_rcpf(d.x); r.y = __builtin_amdgcn_rcpf(d.y); o[2 * n + hh] = x * r; }
                                else o[2 * n + hh] = x; }
                        u32x4 w; w.x = pg8::cvt_pk_bf16(o[0].x, o[0].y); w.y = pg8::cvt_pk_bf16(o[1].x, o[1].y); w.z = pg8::cvt_pk_bf16(o[2].x, o[2].y); w.w = pg8::cvt_pk_bf16(o[3].x, o[3].y);
                        st16(rowp + bj * 128, w); } } }
        }
#undef EPIZ_R0
    }
};
__device__ __forceinline__ void unpack8(const u32x4 g, float (&f)[8]) {
    f[0] = __uint_as_float(g.x << 16); f[1] = __uint_as_float(g.x & 0xffff0000u); f[2] = __uint_as_float(g.y << 16); f[3] = __uint_as_float(g.y & 0xffff0000u);
    f[4] = __uint_as_float(g.z << 16); f[5] = __uint_as_float(g.z & 0xffff0000u); f[6] = __uint_as_float(g.w << 16); f[7] = __uint_as_float(g.w & 0xffff0000u);
}
struct EpiY {
    static constexpr bool PERM = true, EDUP = false;
    bf16_t* GS; bf16_t* MG; const float* rs0;
    __device__ __forceinline__ void operator()(AccRef acc, const Unit& u, int, int wr, int wc, int fr, int fq) const {
#ifdef TEST_TRIV
        if (u.kind >= TEST_TRIV) { GS[(size_t)fr] = (bf16_t)acc[0][0][0][0][0]; return; }
#endif
        int gsl = (wr * 64 + fr) * 256 + wc * 32 + 8 * fq; asm volatile("" : "+v"(gsl));
        static_assert(GATE_U8, "two parked gate tiles need the 8-bit form"); gsl += (u.kind & 1) * 65536;
        if (u.kind < 2) {
            float r0[2][4];
#pragma unroll
            for (int ai = 0; ai < 2; ++ai)
#pragma unroll
                for (int m = 0; m < 4; ++m) r0[ai][m] = X0_BF16 ? rs0[u.pm * 256 + ai * 128 + wr * 64 + m * 16 + fr] : 1.0f;
#pragma unroll
            for (int ai = 0; ai < 2; ++ai)
#pragma unroll
                for (int m = 0; m < 4; ++m) {
#pragma unroll
                    for (int bj = 0; bj < 2; ++bj) { unsigned q[8];
#pragma unroll
                        for (int n = 0; n < 2; ++n)
#pragma unroll
                            for (int hh = 0; hh < 2; ++hh) { const f32x2 x = (f32x2){acc[ai][bj][m][n][2 * hh], acc[ai][bj][m][n][2 * hh + 1]};
                                const f32x2 t = x * (-LOG2E * r0[ai][m]); f32x2 e; e.x = __builtin_amdgcn_exp2f(t.x); e.y = __builtin_amdgcn_exp2f(t.y); const f32x2 d = e + 1.0f;
                                f32x2 r; r.x = __builtin_amdgcn_rcpf(d.x); r.y = __builtin_amdgcn_rcpf(d.y);
#if GATE_U8
                                const f32x2 s = r * 255.0f + 0.5f; q[4 * n + 2 * hh] = (unsigned)s.x; q[4 * n + 2 * hh + 1] = (unsigned)s.y; }
                        u32x2 w; w.x = q[0] | (q[1] << 8) | (q[2] << 16) | (q[3] << 24); w.y = q[4] | (q[5] << 8) | (q[6] << 16) | (q[7] << 24);
                        *(u32x2*)((unsigned char*)GS + gsl + (ai * 128 + m * 16) * 256 + bj * 128) = w; }
#else
                                q[4 * n + 2 * hh] = __float_as_uint(r.x); q[4 * n + 2 * hh + 1] = __float_as_uint(r.y); }
                        u32x4 w; w.x = pg8::cvt_pk_bf16(__uint_as_float(q[0]), __uint_as_float(q[1])); w.y = pg8::cvt_pk_bf16(__uint_as_float(q[2]), __uint_as_float(q[3]));
                        w.z = pg8::cvt_pk_bf16(__uint_as_float(q[4]), __uint_as_float(q[5])); w.w = pg8::cvt_pk_bf16(__uint_as_float(q[6]), __uint_as_float(q[7]));
                        st16(GS + gsl + (ai * 128 + m * 16) * 256 + bj * 128, w); }
#endif
                }
            return;
        }
        const bool add = (u.kind == 3);
        const size_t offb = (size_t)(u.pm * 256 + wr * 64 + fr) * 1024 + u.pn * 256 + wc * 32 + 8 * fq;
        u32x4 pp[2][2];
#if GATE_U8
        u32x2 gg[2][2];
#define EPIY_GLOAD(buf, bj, ai_, m_) gg[buf][bj] = *(const u32x2*)((const unsigned char*)GS + gsl + (ai_ * 128 + m_ * 16) * 256 + bj * 128)
#else
        u32x4 gg[2][2];
#define EPIY_GLOAD(buf, bj, ai_, m_) gg[buf][bj] = *(const u32x4*)(GS + gsl + (ai_ * 128 + m_ * 16) * 256 + bj * 128)
#endif
#define EPIY_LOAD(buf, s) do { const int ai_ = (s) >> 2, m_ = (s) & 3; _Pragma("unroll") for (int bj = 0; bj < 2; ++bj) { \
            EPIY_GLOAD(buf, bj, ai_, m_); \
            pp[buf][bj] = add ? *(const u32x4*)(MG + offb + (size_t)(ai_ * 128 + m_ * 16) * 1024 + bj * 128) : (u32x4){0u, 0u, 0u, 0u}; } } while (0)
        EPIY_LOAD(0, 0);
#pragma unroll
        for (int s = 0; s < 8; ++s) { const int ai = s >> 2, mm = s & 3, cb = s & 1;
            if (s + 1 < 8) { if (cb == 0) EPIY_LOAD(1, s + 1); else EPIY_LOAD(0, s + 1); }
#pragma unroll
            for (int bj = 0; bj < 2; ++bj) { float g[8], p[8]; unpack8(pp[cb][bj], p); float o[8];
#if GATE_U8
                { const unsigned g0 = gg[cb][bj].x, g1 = gg[cb][bj].y;
                  g[0] = (float)(g0 & 0xffu) * (1.f / 255.f); g[1] = (float)((g0 >> 8) & 0xffu) * (1.f / 255.f); g[2] = (float)((g0 >> 16) & 0xffu) * (1.f / 255.f); g[3] = (float)(g0 >> 24) * (1.f / 255.f);
                  g[4] = (float)(g1 & 0xffu) * (1.f / 255.f); g[5] = (float)((g1 >> 8) & 0xffu) * (1.f / 255.f); g[6] = (float)((g1 >> 16) & 0xffu) * (1.f / 255.f); g[7] = (float)(g1 >> 24) * (1.f / 255.f); }
#else
                unpack8(gg[cb][bj], g);
#endif
#pragma unroll
                for (int n = 0; n < 2; ++n)
#pragma unroll
                    for (int j = 0; j < 4; ++j) o[4 * n + j] = p[4 * n + j] + g[4 * n + j] * acc[ai][bj][mm][n][j];
                u32x4 w; w.x = pg8::cvt_pk_bf16(o[0], o[1]); w.y = pg8::cvt_pk_bf16(o[2], o[3]); w.z = pg8::cvt_pk_bf16(o[4], o[5]); w.w = pg8::cvt_pk_bf16(o[6], o[7]);
                st16(MG + offb + (size_t)(ai * 128 + mm * 16) * 1024 + bj * 128, w); } }
#undef EPIY_LOAD
#undef EPIY_GLOAD
    }
};
struct EpiRes {
    static constexpr bool PERM = false, EDUP = false;
    const float* base; float* out;
    __device__ __forceinline__ void operator()(AccRef acc, const Unit& u, int, int wr, int wc, int fr, int fq) const {
#pragma unroll
        for (int ai = 0; ai < 2; ++ai) {
            const size_t off0 = (size_t)(u.pm * 256 + ai * 128 + wr * 64 + fr) * 1024 + u.pn * 256 + wc * 32 + 4 * fq;
            f32x4 bb[4][2][2];
#pragma unroll
            for (int m = 0; m < 4; ++m)
#pragma unroll
                for (int bj = 0; bj < 2; ++bj)
#pragma unroll
                    for (int n = 0; n < 2; ++n) bb[m][bj][n] = *(const f32x4*)(base + off0 + (size_t)m * 16 * 1024 + bj * 128 + n * 16);
#pragma unroll
            for (int m = 0; m < 4; ++m)
#pragma unroll
                for (int bj = 0; bj < 2; ++bj)
#pragma unroll
                    for (int n = 0; n < 2; ++n) *(f32x4*)(out + off0 + (size_t)m * 16 * 1024 + bj * 128 + n * 16) = bb[m][bj][n] + acc[ai][bj][m][n]; }
    }
};
struct EpiBf16s {
    static constexpr bool PERM = true, EDUP = false;
    bf16_t* O; int ldc; float scale;
    __device__ __forceinline__ void operator()(AccRef acc, const Unit& u, int, int wr, int wc, int fr, int fq) const {
#pragma unroll
        for (int ai = 0; ai < 2; ++ai)
#pragma unroll
            for (int m = 0; m < 4; ++m) { bf16_t* rowp = O + (size_t)(u.pm * 256 + ai * 128 + wr * 64 + m * 16 + fr) * ldc + u.pn * 256 + wc * 32 + 8 * fq;
#pragma unroll
                for (int bj = 0; bj < 2; ++bj) { const f32x4 v0 = acc[ai][bj][m][0] * scale, v1 = acc[ai][bj][m][1] * scale;
                    u32x4 w; w.x = pg8::cvt_pk_bf16(v0[0], v0[1]); w.y = pg8::cvt_pk_bf16(v0[2], v0[3]); w.z = pg8::cvt_pk_bf16(v1[0], v1[1]); w.w = pg8::cvt_pk_bf16(v1[2], v1[3]);
                    st16(rowp + bj * 128, w); } }
    }
};
struct EpiMoeA {
    static constexpr bool PERM = true, EDUP = false;
    bf16_t* H; const LAS float* rstbl;
    __device__ __forceinline__ void operator()(AccRef acc, const Unit& u, int ui, int wr, int wc, int fr, int fq) const {
#pragma unroll
        for (int ai = 0; ai < 2; ++ai)
#pragma unroll
            for (int m = 0; m < 4; ++m) { bf16_t* rowp = H + (size_t)(u.pm * 256 + ai * 128 + wr * 64 + m * 16 + fr) * 512 + u.pn * 128 + wc * 32 + 8 * fq; float o[8];
                const float rs = ROUTE_MFMA ? rstbl[ui * 256 + ai * 128 + wr * 64 + m * 16 + fr] : 1.0f;
#pragma unroll
                for (int n = 0; n < 2; ++n)
#pragma unroll
                    for (int j = 0; j < 4; ++j) { const float g = acc[ai][0][m][n][j] * rs, up = acc[ai][1][m][n][j] * rs; o[4 * n + j] = g * __builtin_amdgcn_rcpf(1.0f + __builtin_amdgcn_exp2f(-LOG2E * g)) * up; }
                u32x4 w; w.x = pg8::cvt_pk_bf16(o[0], o[1]); w.y = pg8::cvt_pk_bf16(o[2], o[3]); w.z = pg8::cvt_pk_bf16(o[4], o[5]); w.w = pg8::cvt_pk_bf16(o[6], o[7]);
                st16(rowp, w); }
    }
};
struct EpiMoeB {
    static constexpr bool PERM = true, EDUP = false;
    const LAS int* rec; const int* list; bf16_t* YS;
    __device__ __forceinline__ void operator()(AccRef acc, const Unit& u, int ui, int wr, int wc, int fr, int fq) const {
        const int e = u.kind, r0 = rec[ui * 8 + 4], ne = rec[ui * 8 + 5];
        u32x2 ent[2][4];
#pragma unroll
        for (int ai = 0; ai < 2; ++ai)
#pragma unroll
            for (int m = 0; m < 4; ++m) { const int idx = r0 + ai * 128 + wr * 64 + m * 16 + fr; ent[ai][m] = (u32x2){0u, 0u};
                if (idx < ne) ent[ai][m] = *(const u32x2*)(list + ((size_t)e * LIST_CAP + idx) * 2); }
#pragma unroll
        for (int ai = 0; ai < 2; ++ai)
#pragma unroll
            for (int m = 0; m < 4; ++m) { const int idx = r0 + ai * 128 + wr * 64 + m * 16 + fr;
                if (idx < ne) { const int dest = (int)ent[ai][m].x; const float w = __uint_as_float(ent[ai][m].y);
                    bf16_t* rowp = YS + (size_t)dest * 1024 + u.pn * 256 + wc * 32 + 8 * fq;
#pragma unroll
                    for (int bj = 0; bj < 2; ++bj) { const f32x4 v0 = acc[ai][bj][m][0] * w, v1 = acc[ai][bj][m][1] * w;
                        u32x4 wv; wv.x = pg8::cvt_pk_bf16(v0[0], v0[1]); wv.y = pg8::cvt_pk_bf16(v0[2], v0[3]); wv.z = pg8::cvt_pk_bf16(v1[0], v1[1]); wv.w = pg8::cvt_pk_bf16(v1[2], v1[3]);
                        st16(rowp + bj * 128, wv); } } }
    }
};

struct EpiX1 {
    static constexpr bool PERM = true, EDUP = true;
    const float* x; const bf16_t* XB0; bf16_t* XB; float* ssq;
    __device__ __forceinline__ void operator()(AccRef acc, const Unit& u, int, int wr, int wc, int fr, int fq) const {
        const int rowb = u.pm * 256 + wr * 64 + fr; const size_t offb = (size_t)rowb * 1024 + u.pn * 256 + wc * 32 + 8 * fq;
#if X0_BF16
        u32x4 xq[2][2];
#define EPIX1_LOAD(buf, s) do { const int ai_ = (s) >> 2, m_ = (s) & 3; _Pragma("unroll") for (int bj = 0; bj < 2; ++bj) xq[buf][bj] = *(const u32x4*)(XB0 + offb + (size_t)(ai_ * 128 + m_ * 16) * 1024 + bj * 128); } while (0)
#else
        f32x4 xb[2][2][2];
#define EPIX1_LOAD(buf, s) do { const int ai_ = (s) >> 2, m_ = (s) & 3; _Pragma("unroll") for (int bj = 0; bj < 2; ++bj) _Pragma("unroll") for (int n = 0; n < 2; ++n) \
            xb[buf][bj][n] = *(const f32x4*)(x + offb + (size_t)(ai_ * 128 + m_ * 16) * 1024 + bj * 128 + n * 4); } while (0)
#endif
        EPIX1_LOAD(0, 0);
#pragma unroll
        for (int s = 0; s < 8; ++s) { const int ai = s >> 2, mm = s & 3, cb = s & 1;
            if (s + 1 < 8) { if (cb == 0) EPIX1_LOAD(1, s + 1); else EPIX1_LOAD(0, s + 1); }
            float ss = 0.f;
#pragma unroll
            for (int bj = 0; bj < 2; ++bj) {
#if X0_BF16
                float b[8]; unpack8(xq[cb][bj], b); const f32x4 v0 = (f32x4){b[0], b[1], b[2], b[3]} + acc[ai][bj][mm][0], v1 = (f32x4){b[4], b[5], b[6], b[7]} + acc[ai][bj][mm][1];
#else
                const f32x4 v0 = xb[cb][bj][0] + acc[ai][bj][mm][0], v1 = xb[cb][bj][1] + acc[ai][bj][mm][1];
#endif
                ss += (v0[0] * v0[0] + v0[1] * v0[1]) + (v0[2] * v0[2] + v0[3] * v0[3]) + (v1[0] * v1[0] + v1[1] * v1[1]) + (v1[2] * v1[2] + v1[3] * v1[3]);
                u32x4 w; w.x = pg8::cvt_pk_bf16(v0[0], v0[1]); w.y = pg8::cvt_pk_bf16(v0[2], v0[3]); w.z = pg8::cvt_pk_bf16(v1[0], v1[1]); w.w = pg8::cvt_pk_bf16(v1[2], v1[3]);
                st16(XB + offb + (size_t)(ai * 128 + mm * 16) * 1024 + bj * 128, w); }
            ss += __shfl_xor(ss, 16); ss += __shfl_xor(ss, 32);
            if (fq == 0) ssq[(size_t)(rowb + ai * 128 + mm * 16) * 16 + u.pn * 4 + wc] = ss; }
#undef EPIX1_LOAD
    }
};
struct EpiQC {
    static constexpr bool PERM = true, EDUP = false;
    bf16_t* O; const float* ssq; float scale;
    __device__ __forceinline__ void operator()(AccRef acc, const Unit& u, int, int wr, int wc, int fr, int fq) const {
        f32x4 q[2][4];
#pragma unroll
        for (int ai = 0; ai < 2; ++ai)
#pragma unroll
            for (int m = 0; m < 4; ++m) q[ai][m] = *(const f32x4*)(ssq + (size_t)(u.pm * 256 + ai * 128 + wr * 64 + m * 16 + fr) * 16 + 4 * fq);
#pragma unroll
        for (int ai = 0; ai < 2; ++ai)
#pragma unroll
            for (int m = 0; m < 4; ++m) { float s = (q[ai][m][0] + q[ai][m][1]) + (q[ai][m][2] + q[ai][m][3]); s += __shfl_xor(s, 16); s += __shfl_xor(s, 32);
                const float rs = scale / sqrtf(s * (1.f / 1024.f) + EPS);
                bf16_t* rowp = O + (size_t)(u.pm * 256 + ai * 128 + wr * 64 + m * 16 + fr) * 512 + u.pn * 256 + wc * 32 + 8 * fq;
#pragma unroll
                for (int bj = 0; bj < 2; ++bj) { const f32x4 v0 = acc[ai][bj][m][0] * rs, v1 = acc[ai][bj][m][1] * rs;
                    u32x4 w; w.x = pg8::cvt_pk_bf16(v0[0], v0[1]); w.y = pg8::cvt_pk_bf16(v0[2], v0[3]); w.z = pg8::cvt_pk_bf16(v1[0], v1[1]); w.w = pg8::cvt_pk_bf16(v1[2], v1[3]);
                    st16(rowp + bj * 128, w); } }
    }
};
struct EpiX2 {
    static constexpr bool PERM = true, EDUP = false;
    const bf16_t* XB; float* out; bf16_t* XB2;
    __device__ __forceinline__ void operator()(AccRef acc, const Unit& u, int, int wr, int wc, int fr, int fq) const {
        const size_t offb = (size_t)(u.pm * 256 + wr * 64 + fr) * 1024 + u.pn * 256 + wc * 32 + 8 * fq;
        u32x4 xb[2][2];
#define EPIX2_LOAD(buf, s) do { const int ai_ = (s) >> 2, m_ = (s) & 3; _Pragma("unroll") for (int bj = 0; bj < 2; ++bj) xb[buf][bj] = *(const u32x4*)(XB + offb + (size_t)(ai_ * 128 + m_ * 16) * 1024 + bj * 128); } while (0)
        EPIX2_LOAD(0, 0);
#pragma unroll
        for (int s = 0; s < 8; ++s) { const int ai = s >> 2, mm = s & 3, cb = s & 1;
            if (s + 1 < 8) { if (cb == 0) EPIX2_LOAD(1, s + 1); else EPIX2_LOAD(0, s + 1); }
#pragma unroll
            for (int bj = 0; bj < 2; ++bj) { float b[8]; unpack8(xb[cb][bj], b);
                const f32x4 v0 = (f32x4){b[0], b[1], b[2], b[3]} + acc[ai][bj][mm][0], v1 = (f32x4){b[4], b[5], b[6], b[7]} + acc[ai][bj][mm][1];
                const size_t o_ = offb + (size_t)(ai * 128 + mm * 16) * 1024 + bj * 128;
                if (X2_BF16) { u32x4 w; w.x = pg8::cvt_pk_bf16(v0[0], v0[1]); w.y = pg8::cvt_pk_bf16(v0[2], v0[3]); w.z = pg8::cvt_pk_bf16(v1[0], v1[1]); w.w = pg8::cvt_pk_bf16(v1[2], v1[3]); st16(XB2 + o_, w); }
                else { *(f32x4*)(out + o_) = v0; *(f32x4*)(out + o_ + 4) = v1; } } }
#undef EPIX2_LOAD
    }
};
typedef short v4i16_t __attribute__((ext_vector_type(4)));
typedef short bf16x8_t __attribute__((ext_vector_type(8)));
typedef float f32x16_t __attribute__((ext_vector_type(16)));
__device__ __forceinline__ v4i16_t lds_tr16(LAS unsigned char* p) { return __builtin_amdgcn_ds_read_tr16_b64_v4i16((LAS v4i16_t*)p); }

__device__ __forceinline__ void sgu_unit(LAS unsigned char* lds, unsigned char* ws, const PtrsIn& P, int ch) {
    const int tid = threadIdx.x, lane = tid & 63, wave = __builtin_amdgcn_readfirstlane(tid >> 6), fr = lane & 15, fq = lane >> 4;
    {
        const int row = tid >> 2, q4 = tid & 3;
        const u32x4* src = (const u32x4*)((const bf16_t*)(ws + WS_GV) + ((size_t)ch * 128 + row) * 512 + q4 * 128);
        u32x4 raw[16];
#pragma unroll
        for (int j = 0; j < 16; ++j) raw[j] = src[j];
        float s = 0.f;
#pragma unroll
        for (int j = 0; j < 16; ++j) { float f[8]; unpack8(raw[j], f);
#pragma unroll
            for (int k = 0; k < 8; ++k) s += f[k]; }
        s += __shfl_xor(s, 1); s += __shfl_xor(s, 2);
        const float mean = s * (1.f / 512.f); float q = 0.f;
#pragma unroll
        for (int j = 0; j < 16; ++j) { float f[8]; unpack8(raw[j], f);
#pragma unroll
            for (int k = 0; k < 8; ++k) { const float d = f[k] - mean; q += d * d; } }
        q += __shfl_xor(q, 1); q += __shfl_xor(q, 2);
        const float rstd = 1.0f / sqrtf(q * (1.f / 512.f) + EPS);
        const float* lg = P.in[7] + q4 * 128; const float* lb = P.in[8] + q4 * 128;
        LAS unsigned char* dst = lds + row * SGU_ROWB + q4 * 256;
#pragma unroll
        for (int j = 0; j < 16; ++j) { float f[8]; unpack8(raw[j], f);
            const f32x4 g0 = *(const f32x4*)(lg + 8 * j), g1 = *(const f32x4*)(lg + 8 * j + 4), b0 = *(const f32x4*)(lb + 8 * j), b1 = *(const f32x4*)(lb + 8 * j + 4);
            u32x4 w; w.x = pg8::cvt_pk_bf16((f[0] - mean) * rstd * g0[0] + b0[0], (f[1] - mean) * rstd * g0[1] + b0[1]); w.y = pg8::cvt_pk_bf16((f[2] - mean) * rstd * g0[2] + b0[2], (f[3] - mean) * rstd * g0[3] + b0[3]);
            w.z = pg8::cvt_pk_bf16((f[4] - mean) * rstd * g1[0] + b1[0], (f[5] - mean) * rstd * g1[1] + b1[1]); w.w = pg8::cvt_pk_bf16((f[6] - mean) * rstd * g1[2] + b1[2], (f[7] - mean) * rstd * g1[3] + b1[3]);
            *(LAS u32x4*)(dst + j * 16) = w; }
    }
    __syncthreads();
    const int i16 = lane & 15;
    LAS unsigned char* trb = lds + (8 * fq + (i16 >> 2)) * SGU_ROWB + (i16 & 3) * 8;
    const int p = 16 * wave + fr; const size_t tok = (size_t)ch * 128 + p;
    u32x2 uu[4][8]; float bsv[4];
#pragma unroll
    for (int g = 0; g < 4; ++g) { const bf16_t* U = (const bf16_t*)(ws + WS_U) + tok * 512 + g * 128 + 4 * fq; bsv[g] = P.in[10][g * 128 + p];
#pragma unroll
        for (int nt = 0; nt < 8; ++nt) uu[g][nt] = *(const u32x2*)(U + 16 * nt); }
#pragma unroll
    for (int g = 0; g < 4; ++g) {
        const bf16_t* W = (const bf16_t*)(ws + WS_WSS) + ((size_t)g * 128 + p) * 128 + 8 * fq;
        bf16x8_t af[4];
#pragma unroll
        for (int ks = 0; ks < 4; ++ks) af[ks] = *(const bf16x8_t*)(W + 32 * ks);
        const float bs = bsv[g];
        f32x4 acc[8];
#pragma unroll
        for (int nt = 0; nt < 8; ++nt) { acc[nt] = (f32x4){0.f, 0.f, 0.f, 0.f};
#pragma unroll
            for (int ks = 0; ks < 4; ++ks) { LAS unsigned char* a = trb + ks * 32 * SGU_ROWB + (g * 128 + 16 * nt) * 2;
                const v4i16_t lo = lds_tr16(a), hi = lds_tr16(a + 4 * SGU_ROWB);
                const bf16x8_t bfr = (bf16x8_t){lo[0], lo[1], lo[2], lo[3], hi[0], hi[1], hi[2], hi[3]};
                acc[nt] = __builtin_amdgcn_mfma_f32_16x16x32_bf16(bfr, af[ks], acc[nt], 0, 0, 0); } }
        bf16_t* SG = (bf16_t*)(ws + WS_SG) + tok * 512 + g * 128 + 4 * fq;
#pragma unroll
        for (int nt = 0; nt < 8; ++nt) { const u32x2 u2 = uu[g][nt];
            const float u0 = __uint_as_float(u2.x << 16), u1 = __uint_as_float(u2.x & 0xffff0000u), u2f = __uint_as_float(u2.y << 16), u3 = __uint_as_float(u2.y & 0xffff0000u);
            u32x2 o; o.x = pg8::cvt_pk_bf16(u0 * (acc[nt][0] + bs), u1 * (acc[nt][1] + bs)); o.y = pg8::cvt_pk_bf16(u2f * (acc[nt][2] + bs), u3 * (acc[nt][3] + bs));
            *(u32x2*)(SG + 16 * nt) = o; }
    }
    __syncthreads();
}

__device__ __forceinline__ void phase2_sgu_attn(LAS unsigned char* lds, unsigned char* lds_generic, unsigned char* ws, const PtrsIn& P, int vcu, int G) {
    for (int ch = vcu; ch < M / 128; ch += G) sgu_unit(lds, ws, P, ch);
    const int upc = (1024 + G - 1) / G;
    float cfix; { const int l64 = threadIdx.x & 63; const float mq = wave_max(fabsf(P.in[4][l64])), mk = wave_max(fabsf(P.in[5][l64])); cfix = __int_as_float(__builtin_amdgcn_readfirstlane(__float_as_int(C2_SELF * 64.0f * mq * mk))); }
    const bool fixm = ATT_FIXM && (cfix < 60.0f);
    const int nmoe = IT_TOTAL - IT_P0, per = (nmoe + G - 1) / G, it0 = IT_P0 + vcu * per, it1 = (it0 + per < IT_TOTAL) ? it0 + per : IT_TOTAL, slot = vcu % upc;
    for (int i = 0; i < upc; ++i) { const int U = vcu * upc + i;
        if (U < 1024) { const int bkv = U >> 7, jj = U & 127, hl = jj >> 5, qb = jj & 31, b = bkv >> 1, kvh = bkv & 1;
            if (fixm) attn_body::attn_unit<8, true>(b, kvh * 4 + hl, kvh, qb, (const bf16_t*)(ws + WS_Q), (const bf16_t*)(ws + WS_K), (const bf16_t*)(ws + WS_V), (bf16_t*)(ws + WS_ATT), (char*)lds_generic + RING_OFF, cfix);
            else attn_body::attn_unit<8, false>(b, kvh * 4 + hl, kvh, qb, (const bf16_t*)(ws + WS_Q), (const bf16_t*)(ws + WS_K), (const bf16_t*)(ws + WS_V), (bf16_t*)(ws + WS_ATT), (char*)lds_generic + RING_OFF, 0.f); }
        if (MOE_CONV_IN_P2 && i == slot) {
            int tid2 = threadIdx.x; asm volatile("" : "+v"(tid2));
            const int lane2 = tid2 & 63, wave2 = __builtin_amdgcn_readfirstlane(tid2 >> 6);
            LAS float* scr = (LAS float*)(lds + RING_OFF + wave2 * 16384);
            for (int it = it0 + wave2; it < it1; it += NWAVES) p0_weight_item(P, ws, scr, it, lane2);
            __syncthreads(); } }
}

__device__ __forceinline__ void cross_stage_kv(unsigned lds0, const bf16_t* KVC, int b, int h, int wave, int lane) {
#pragma unroll
    for (int j = 0; j < 8; ++j) { const int c = 2 * wave + (j >> 2), rb = j & 3;
        attn_body::glds16(KVC + (size_t)(b * NMEM + rb * 64 + lane) * 1024 + h * 128 + c * 8, (unsigned)__builtin_amdgcn_readfirstlane(lds0 + c * 4096 + rb * 1024)); }
#pragma unroll
    for (int j = 0; j < 8; ++j) { const int pc = wave * 8 + j, db = pc >> 4, r0 = (pc & 15) * 16;
        attn_body::glds16(KVC + (size_t)(b * NMEM + r0 + (lane >> 2)) * 1024 + 512 + h * 128 + db * 32 + (lane & 3) * 8, (unsigned)__builtin_amdgcn_readfirstlane(lds0 + 65536 + db * 16384 + r0 * 64)); }
}
__device__ __forceinline__ void cross_unit(LAS unsigned char* lds, const bf16_t* QC, bf16_t* OC, int row0, int h) {
    const int tid = threadIdx.x, lane = tid & 63, wave = __builtin_amdgcn_readfirstlane(tid >> 6), r32 = lane & 31, hi = lane >> 5;
    const bf16_t* Qw = QC + (size_t)(row0 + 32 * wave + r32) * 512 + h * 128 + 8 * hi;
    bf16x8_t qr[8];
#pragma unroll
    for (int ds = 0; ds < 8; ++ds) qr[ds] = *(const bf16x8_t*)(Qw + 16 * ds);
    f32x16_t p[8];
    const LAS unsigned char* kb0 = lds + hi * 4096 + r32 * 16;
#pragma unroll
    for (int kb = 0; kb < 8; ++kb) { p[kb] = f32x16_t{};
#pragma unroll
        for (int ds = 0; ds < 8; ++ds) { const bf16x8_t kf = *(const LAS bf16x8_t*)(kb0 + ds * 8192 + kb * 512); p[kb] = __builtin_amdgcn_mfma_f32_32x32x16_bf16(kf, qr[ds], p[kb], 0, 0, 0); }
        __builtin_amdgcn_sched_barrier(0); }
    float mx = -1e30f;
#pragma unroll
    for (int kb = 0; kb < 8; ++kb)
#pragma unroll
        for (int r = 0; r < 16; ++r) mx = fmaxf(mx, p[kb][r]);
    { auto rr = __builtin_amdgcn_permlane32_swap(__float_as_uint(mx), __float_as_uint(mx), false, false); mx = fmaxf(__uint_as_float(rr[0]), __uint_as_float(rr[1])); }
    float l = 0.f;
    u32x4 pw[16];
#pragma unroll
    for (int kb = 0; kb < 8; ++kb) {
#pragma unroll
        for (int r = 0; r < 16; ++r) { p[kb][r] = __builtin_amdgcn_exp2f(p[kb][r] - mx); l += p[kb][r]; }
#pragma unroll
        for (int s = 0; s < 2; ++s) { pw[2 * kb + s].x = pg8::cvt_pk_bf16(p[kb][8 * s + 0], p[kb][8 * s + 1]); pw[2 * kb + s].y = pg8::cvt_pk_bf16(p[kb][8 * s + 2], p[kb][8 * s + 3]);
            pw[2 * kb + s].z = pg8::cvt_pk_bf16(p[kb][8 * s + 4], p[kb][8 * s + 5]); pw[2 * kb + s].w = pg8::cvt_pk_bf16(p[kb][8 * s + 6], p[kb][8 * s + 7]); }
        __builtin_amdgcn_sched_barrier(0); }
    { auto rr = __builtin_amdgcn_permlane32_swap(__float_as_uint(l), __float_as_uint(l), false, false); l = __uint_as_float(rr[0]) + __uint_as_float(rr[1]); }
    const float il = 1.0f / l;
    f32x16_t o[4];
#pragma unroll
    for (int db = 0; db < 4; ++db) o[db] = f32x16_t{};
    const int i16 = lane & 15;
    LAS unsigned char* vb = lds + 65536 + (4 * hi + (i16 >> 2)) * 64 + ((lane >> 4) & 1) * 32 + (i16 & 3) * 8;
#pragma unroll
    for (int ks = 0; ks < 16; ++ks) {
        const bf16x8_t pa = __builtin_bit_cast(bf16x8_t, pw[ks]);
#pragma unroll
        for (int db = 0; db < 4; ++db) { LAS unsigned char* a = vb + db * 16384 + (16 * ks) * 64;
            const v4i16_t lo = lds_tr16(a), hh = lds_tr16(a + 512);
            const bf16x8_t vf = (bf16x8_t){lo[0], lo[1], lo[2], lo[3], hh[0], hh[1], hh[2], hh[3]};
            o[db] = __builtin_amdgcn_mfma_f32_32x32x16_bf16(vf, pa, o[db], 0, 0, 0); }
        __builtin_amdgcn_sched_barrier(0); }
    bf16_t* Ow = OC + (size_t)(row0 + 32 * wave + r32) * 512 + h * 128 + 4 * hi;
#pragma unroll
    for (int db = 0; db < 4; ++db)
#pragma unroll
        for (int rg = 0; rg < 4; ++rg) { u32x2 w; w.x = pg8::cvt_pk_bf16(o[db][4 * rg + 0] * il, o[db][4 * rg + 1] * il); w.y = pg8::cvt_pk_bf16(o[db][4 * rg + 2] * il, o[db][4 * rg + 3] * il);
            *(u32x2*)(Ow + 32 * db + 8 * rg) = w; }
}
__device__ __forceinline__ void cross_after_qc(LAS unsigned char* lds, unsigned char* lds_generic, unsigned char* ws, int pm, int pn) {
    const int tid = threadIdx.x, lane = tid & 63, wave = __builtin_amdgcn_readfirstlane(tid >> 6);
    const unsigned lds0 = (unsigned)(uintptr_t)(lds_generic + RING_OFF);
    for (int hh = 0; hh < 2; ++hh) { const int h = 2 * pn + hh, b = pm >> 5;
        cross_stage_kv(lds0, (const bf16_t*)(ws + WS_KVC), b, h, wave, lane);
        asm volatile("s_waitcnt vmcnt(0)" ::: "memory"); __syncthreads();
        cross_unit(lds, (const bf16_t*)(ws + WS_QC), (bf16_t*)(ws + WS_OC), pm * 256, h);
        __syncthreads(); }
}
__device__ __forceinline__ void phase7_cross(LAS unsigned char* lds, unsigned char* lds_generic, unsigned char* ws, int vcu, int G) {
    const int tid = threadIdx.x, lane = tid & 63, wave = __builtin_amdgcn_readfirstlane(tid >> 6);
    const unsigned lds0 = (unsigned)(uintptr_t)(lds_generic + RING_OFF);
    for (int j = vcu; j < 256; j += G) { const int h = j & 3, pp = j >> 2, b = pp >> 4;
        cross_stage_kv(lds0, (const bf16_t*)(ws + WS_KVC), b, h, wave, lane);
        asm volatile("s_waitcnt vmcnt(0)" ::: "memory"); __syncthreads();
        cross_unit(lds, (const bf16_t*)(ws + WS_QC), (bf16_t*)(ws + WS_OC), (2 * pp) * 256, h);
        cross_unit(lds, (const bf16_t*)(ws + WS_QC), (bf16_t*)(ws + WS_OC), (2 * pp + 1) * 256, h);
        __syncthreads(); }
}
struct Args { PtrsIn P; float* out; unsigned char* ws; int ph_lo, ph_hi; };
static_assert(sizeof(Args) == 27 * 8 + 24, "Args has no holes");

__device__ __forceinline__ void moe_setup(LAS unsigned char* lds, unsigned char* ws, int vcu, int G, bool with_gather) {
    LAS int* rec = (LAS int*)(lds + UREC_OFF); LAS unsigned* tbl = (LAS unsigned*)(lds + TBL_OFF);
    const int tid = threadIdx.x;
    const unsigned* ec = (const unsigned*)(ws + WS_CTL) + CW_ECNT;
    int cnt[16], pb[17]; pb[0] = 0;
#pragma unroll
    for (int e = 0; e < 16; ++e) { cnt[e] = (int)__hip_atomic_load(ec + 64 * e, __ATOMIC_RELAXED, __HIP_MEMORY_SCOPE_AGENT); pb[e + 1] = pb[e] + ((cnt[e] + 255) >> 8); }
    const int NP = pb[16];
    LAS float* rstbl = (LAS float*)(lds + RSTBL_OFF);
    for (int i = 0; i < MOE_MAXU; ++i) {
        const int L = i * G + vcu; const bool valid = (L < 4 * NP);
        int panel = 0, pn = 0, e = 0, r0 = 0, ne = 0;
        if (valid) { panel = L >> 2; pn = L & 3;
#pragma unroll
            for (int j = 1; j < 16; ++j) if (panel >= pb[j]) e = j;
#pragma unroll
            for (int j = 0; j < 16; ++j) if (j == e) { r0 = (panel - pb[j]) * 256; ne = cnt[j]; } }
        if (tid == 0) { rec[i * 8 + 0] = valid ? 1 : 0; rec[i * 8 + 1] = panel; rec[i * 8 + 2] = pn; rec[i * 8 + 3] = e; rec[i * 8 + 4] = r0; rec[i * 8 + 5] = ne; }
        if (with_gather && tid < 256) { unsigned off = 0u; float rsv = 0.f;
            if (valid && r0 + tid < ne) { const int dest = ((const int*)(ws + WS_LIST))[((size_t)e * LIST_CAP + r0 + tid) * 2]; off = (unsigned)(dest >> 1) * 2048u; if (ROUTE_MFMA) rsv = ((const float*)(ws + WS_RSTOK))[dest >> 1]; }
            tbl[i * 256 + tid] = off; rstbl[i * 256 + tid] = rsv; }
    }
    if (tid == 0) rec[MOE_MAXU * 8] = 4 * NP;
    __syncthreads();
}

#ifndef LB_W
#define LB_W 2
#endif
__global__ void __launch_bounds__(NWAVES * 64, LB_W) mega(Args args) {
    extern __shared__ __attribute__((aligned(16))) unsigned char lds_raw[];
    LAS unsigned char* lds = (LAS unsigned char*)lds_raw;
    volatile LAS unsigned* MISC = (volatile LAS unsigned*)(lds + MISC_OFF);
    const int tid = threadIdx.x, lane = tid & 63, wave = __builtin_amdgcn_readfirstlane(tid >> 6);
    const int G = gridDim.x, bx = blockIdx.x, vcu = (G % 8 == 0) ? (bx % 8) * (G / 8) + bx / 8 : bx;
    unsigned char* ws = args.ws; const PtrsIn& P = args.P; float* out = args.out;
    for (int u = tid; u < (LDS_BYTES - MISC_OFF) / 4; u += NWAVES * 64) ((LAS unsigned*)(lds + MISC_OFF))[u] = 0u;
    __syncthreads();
    const int lo = args.ph_lo, hi = args.ph_hi;
    const bool fusedrun = (hi - lo) > 1;
    XcdBarrier bar; bar.bar = (unsigned*)(ws + WS_CTL) + CW_BAR; bar.x = 0; bar.st = nullptr;
    if (fusedrun) bar = xcd_barrier_post((unsigned*)(ws + WS_CTL) + CW_BAR, MISC + 8);
#ifndef TAIL_E0
#define TAIL_E0 16
#endif
#ifndef STAG_Y
#define STAG_Y 0u
#endif
#ifndef STAG_MA
#define STAG_MA 0u
#endif
#ifndef STAG_MB
#define STAG_MB 0u
#endif
#ifndef ALIGN_E
#define ALIGN_E true
#endif
#ifndef PH_EN
#define PH_EN 0x1FFF
#endif
#define IN(k) ((((PH_EN) >> (k)) & 1) && lo <= (k) && (k) < hi)
#define SEAM(k) do { if (IN(k) && IN((k) + 1)) xcd_barrier(bar); } while (0)
#ifndef PH_DUP
#define PH_DUP 0
#endif
#define NREP(k) ((((PH_DUP) >> (k)) & 1) ? 2 : 1)
#define REPSEAM(k) do { if (NREP(k) == 2 && rep_ == 0 && fusedrun) xcd_barrier(bar); } while (0)
    const int gw = vcu * NWAVES + wave, NGW = G * NWAVES;

    if (IN(0)) {
        _Pragma("unroll") for (int rep_ = 0; rep_ < NREP(0); ++rep_) {
        LAS float* scr = (LAS float*)(lds + RING_OFF + wave * 16384);
        const bool tailconv = TAIL_CONV && (G == 256);
        for (int it = gw; it < ((MOE_CONV_IN_P2 || tailconv) ? IT_P0 : IT_TOTAL); it += NGW) p0_weight_item(P, ws, scr, it, lane);
        if (tailconv) for (int j = TAIL_E0 * 512 + gw; j < NE * 512; j += NGW) p0_weight_item(P, ws, scr, IT_P0 + (j >> 9) * 768 + (j & 511), lane);
        { const float* wsrc = P.in[9]; bf16_t* wd = (bf16_t*)(ws + WS_WSS);
          for (int i = bx * 512 + tid; i < 4 * 128 * 128; i += G * 512) wd[i] = (bf16_t)f2bf(wsrc[i]); }
        for (int i = bx * 512 + tid; i < 2048; i += G * 512) rope_table_entry((float*)(ws + WS_TAB), i);
        bf16_t* XN = (bf16_t*)(ws + WS_XN);
        if (X0_BF16) xb0_rows(P.in[0], XN, (float*)(ws + WS_RS0), gw, NGW, M, lane); else rms_rows(P.in[0], P.in[2], XN, gw, NGW, M, lane);
        rms_rows(P.in[1], P.in[14], XN + (size_t)M * D, gw, NGW, MMEM, lane);
            REPSEAM(0); }
    }
    SEAM(0);
    if (IN(1)) {
        _Pragma("unroll") for (int rep_ = 0; rep_ < NREP(1); ++rep_) {
        SchedZ S{(const char*)(ws + WS_XN), (const char*)(ws + WS_WZ), G, bx};
        EpiZ E{ws, P.in[4], P.in[5], (const float*)(ws + WS_TAB), (const float*)(ws + WS_RS0)};
        pg8::gemm_phase<EpiZ, SchedZ, ALIGN_E, false>(lds + RING_OFF, 1024, S, E);
        if (TAIL_CONV && G == 256 && bx >= 144) {
            int tid2 = threadIdx.x; asm volatile("" : "+v"(tid2)); const int lane2 = tid2 & 63, wave2 = __builtin_amdgcn_readfirstlane(tid2 >> 6);
            LAS float* scr = (LAS float*)(lds + RING_OFF + wave2 * 16384);
            for (int j = (bx - 144) * NWAVES + wave2; j < TAIL_E0 * 512; j += 112 * NWAVES) p0_weight_item(P, ws, scr, IT_P0 + (j >> 9) * 768 + (j & 511), lane2); }
            REPSEAM(1); }
    }
    SEAM(1);
    if (IN(2)) {
        _Pragma("unroll") for (int rep_ = 0; rep_ < NREP(2); ++rep_) {
        phase2_sgu_attn(lds, lds_raw, ws, P, vcu, G);
            REPSEAM(2); }
    }
    SEAM(2);
    if (IN(3)) {
        _Pragma("unroll") for (int rep_ = 0; rep_ < NREP(3); ++rep_) {
        SchedY S{(const char*)ws, G, bx};
        EpiY E{(bf16_t*)(ws + WS_GSCR) + (size_t)bx * 65536, (bf16_t*)(ws + WS_MERGED), (const float*)(ws + WS_RS0)};
#ifdef PROBE_KDUP_Y
        SchedDup<SchedY> SD{S}; pg8::gemm_phase<EpiY, SchedDup<SchedY>, ALIGN_E, false, true>(lds + RING_OFF, 1024, SD, E, STAG_Y);
#else
        pg8::gemm_phase<EpiY, SchedY, ALIGN_E, false, true>(lds + RING_OFF, 1024, S, E, STAG_Y);
#endif
            REPSEAM(3); }
    }
    SEAM(3);
    if (IN(4)) {
        _Pragma("unroll") for (int rep_ = 0; rep_ < NREP(4); ++rep_) {
        SchedPlain S{(const char*)(ws + WS_MERGED), (const char*)(ws + WS_WOUT), 128, 4, G, bx, 1024};
#if FOLD_GAINS
        EpiX1 E{P.in[0], (const bf16_t*)(ws + WS_XN), (bf16_t*)(ws + WS_XN1), (float*)(ws + WS_SSQ1)};
#ifdef PROBE_KDUP
        SchedDup<SchedPlain> SD{S}; pg8::gemm_phase<EpiX1, SchedDup<SchedPlain>, ALIGN_E, false>(lds + RING_OFF, 1024, SD, E);
#else
        pg8::gemm_phase<EpiX1, SchedPlain, ALIGN_E, false>(lds + RING_OFF, 1024, S, E);
#endif
#else
        EpiRes E{P.in[0], out};
        pg8::gemm_phase<EpiRes, SchedPlain, ALIGN_E, false>(lds + RING_OFF, 1024, S, E);
#endif
            REPSEAM(4); }
    }
    SEAM(4);
    if (IN(5)) {
        _Pragma("unroll") for (int rep_ = 0; rep_ < NREP(5); ++rep_) {
        bf16_t* XN1 = (bf16_t*)(ws + WS_XN1);
        if (!FOLD_GAINS) rms_rows(out, P.in[13], XN1, gw, NGW, M, lane);
            REPSEAM(5); }
    }
    if (!FOLD_GAINS) SEAM(5);
    if (IN(6)) {
        _Pragma("unroll") for (int rep_ = 0; rep_ < NREP(6); ++rep_) {
        SchedPlain S{(const char*)(ws + WS_XN1), (const char*)(ws + WS_WCQ), 128, 2, G, bx, 1024};
#if FOLD_GAINS
        EpiQC E{(bf16_t*)(ws + WS_QC), (const float*)(ws + WS_SSQ1), C2_CROSS};
        pg8::gemm_phase<EpiQC, SchedPlain, ALIGN_E, false>(lds + RING_OFF, 1024, S, E);
#if MERGE_QC_CROSS
        asm volatile("s_waitcnt vmcnt(0)" ::: "memory"); __syncthreads();
        { Unit u; for (int i = 0; S.next(i, u); ++i) cross_after_qc(lds, lds_raw, ws, u.pm, u.pn); }
#endif
#else
        EpiBf16s E{(bf16_t*)(ws + WS_QC), 512, C2_CROSS};
        pg8::gemm_phase<EpiBf16s, SchedPlain, ALIGN_E, false>(lds + RING_OFF, 1024, S, E);
#endif
            REPSEAM(6); }
    }
    if (!(MERGE_QC_CROSS && FOLD_GAINS)) SEAM(6);
    if (IN(7)) {
        _Pragma("unroll") for (int rep_ = 0; rep_ < NREP(7); ++rep_) {
        if (!(MERGE_QC_CROSS && FOLD_GAINS)) phase7_cross(lds, lds_raw, ws, vcu, G);
            REPSEAM(7); }
    }
    SEAM(7);
    if (IN(8)) {
        SchedPlain S{(const char*)(ws + WS_OC), (const char*)(ws + WS_WCO), 128, 4, G, bx, 512};
#if FOLD_GAINS
        EpiX2 E{(const bf16_t*)(ws + WS_XN1), out, (bf16_t*)(ws + WS_XN3)};
        pg8::gemm_phase<EpiX2, SchedPlain, ALIGN_E, false>(lds + RING_OFF, 512, S, E);
#else
        EpiRes E{out, out};
        pg8::gemm_phase<EpiRes, SchedPlain, ALIGN_E, false>(lds + RING_OFF, 512, S, E);
#endif
        if (!FOLD_GAINS && NREP(8) == 2) { if (fusedrun) xcd_barrier(bar); EpiRes E2{out, (float*)(ws + WS_Q)}; pg8::gemm_phase<EpiRes, SchedPlain, ALIGN_E, false>(lds + RING_OFF, 512, S, E2); }
    }
    SEAM(8);
#if ROUTE_MFMA
    if (IN(9)) {
        LAS float* WT = (LAS float*)(lds + RING_OFF);
        LAS float* PART = WT + 20 * 1028;
        LAS float* SSQP = PART + 2 * 4 * 32 * 33;
        LAS int* te = (LAS int*)(SSQP + 2 * 4 * 2 * 32); LAS float* tw = (LAS float*)(te + 256); LAS int* tp = (LAS int*)(tw + 256); LAS int* ebase = tp + 256;
        for (int i = tid; i < 1024 * 4; i += 512) { const int kk = i >> 2, o = i & 3; WT[o * 1028 + kk] = P.in[19][i] * P.in[18][kk]; }
        for (int i = tid; i < 1024 * 16; i += 512) { const int kk = i >> 4, o = i & 15; WT[(4 + o) * 1028 + kk] = P.in[21][i] * P.in[18][kk]; }
        __syncthreads();
        const int tg = wave & 3, kh = wave >> 2, n = lane & 31, hh = lane >> 5;
        bf16_t* XB2 = (bf16_t*)(ws + WS_XN3); float* rstok = (float*)(ws + WS_RSTOK);
        const LAS float* wrow = WT + (n < 20 ? n : 19) * 1028 + kh * 512 + 4 * hh;
        for (int tb = vcu; tb < M / 128; tb += G) {
            const int t0 = tb * 128; const size_t eoff = (size_t)(t0 + tg * 32 + n) * 1024 + kh * 512 + 4 * hh;
            f32x16_t acc = f32x16_t{}; float ssq = 0.f;
            for (int jb = 0; jb < 64; jb += 8) { f32x4 xv[8];
#pragma unroll
                for (int j = 0; j < 8; ++j) {
                    if (X2_BF16) { const u32x2 q = *(const u32x2*)(XB2 + eoff + 8 * (jb + j)); xv[j] = (f32x4){__uint_as_float(q.x << 16), __uint_as_float(q.x & 0xffff0000u), __uint_as_float(q.y << 16), __uint_as_float(q.y & 0xffff0000u)}; }
                    else xv[j] = *(const f32x4*)(out + eoff + 8 * (jb + j)); }
#pragma unroll
                for (int j = 0; j < 8; ++j) { const f32x4 wv = *(const LAS f32x4*)(wrow + 8 * (jb + j)); const f32x4 x = xv[j];
                    ssq += (x[0] * x[0] + x[1] * x[1]) + (x[2] * x[2] + x[3] * x[3]);
                    acc = __builtin_amdgcn_mfma_f32_32x32x2f32(x[0], wv[0], acc, 0, 0, 0); acc = __builtin_amdgcn_mfma_f32_32x32x2f32(x[1], wv[1], acc, 0, 0, 0);
                    acc = __builtin_amdgcn_mfma_f32_32x32x2f32(x[2], wv[2], acc, 0, 0, 0); acc = __builtin_amdgcn_mfma_f32_32x32x2f32(x[3], wv[3], acc, 0, 0, 0);
                    if (!X2_BF16) { u32x2 w; w.x = pg8::cvt_pk_bf16(x[0], x[1]); w.y = pg8::cvt_pk_bf16(x[2], x[3]); *(u32x2*)(XB2 + eoff + 8 * (jb + j)) = w; } } }
#pragma unroll
            for (int r = 0; r < 16; ++r) PART[((kh * 4 + tg) * 32 + ((r & 3) + 8 * (r >> 2) + 4 * hh)) * 33 + n] = acc[r];
            SSQP[((kh * 4 + tg) * 2 + hh) * 32 + n] = ssq;
            __syncthreads();
            if (wave < 4 && lane < 32) { const int tl = wave * 32 + lane, t = t0 + tl;
                const float s = (SSQP[((0 * 4 + wave) * 2 + 0) * 32 + lane] + SSQP[((0 * 4 + wave) * 2 + 1) * 32 + lane]) + (SSQP[((1 * 4 + wave) * 2 + 0) * 32 + lane] + SSQP[((1 * 4 + wave) * 2 + 1) * 32 + lane]);
                const float rs = 1.0f / sqrtf(s * (1.f / 1024.f) + EPS);
                float lg[20];
#pragma unroll
                for (int nn = 0; nn < 20; ++nn) lg[nn] = (PART[((0 * 4 + wave) * 32 + lane) * 33 + nn] + PART[((1 * 4 + wave) * 32 + lane) * 33 + nn]) * rs;
                int e0, e1; float w0, w1; route_decide(lg, P.in[20], P.in[22], e0, e1, w0, w1);
                te[2 * tl] = e0; te[2 * tl + 1] = e1; tw[2 * tl] = w0; tw[2 * tl + 1] = w1; rstok[t] = rs; }
            __syncthreads();
            if (wave == 0) {
                int cnt = 0; int mye[4];
#pragma unroll
                for (int j = 0; j < 4; ++j) mye[j] = te[j * 64 + lane];
                int pos[4] = {0, 0, 0, 0};
                for (int e = 0; e < 16; ++e) { int run = 0;
#pragma unroll
                    for (int j = 0; j < 4; ++j) { const unsigned long long mk = __ballot(mye[j] == e); const int before = __popcll(mk & ((1ull << lane) - 1ull));
                        if (mye[j] == e) pos[j] = run + before; run += __popcll(mk); }
                    if (lane == e) cnt = run; }
#pragma unroll
                for (int j = 0; j < 4; ++j) tp[j * 64 + lane] = pos[j];
                if (lane < 16) { unsigned* ec = (unsigned*)(ws + WS_CTL) + CW_ECNT + 64 * lane; ebase[lane] = (int)atomicAdd(ec, (unsigned)cnt); }
            }
            __syncthreads();
            if (tid < 256) { const int e = te[tid], slot = ebase[e] + tp[tid], dest = (t0 * 2) + tid; const float w = tw[tid];
                int* lst = (int*)(ws + WS_LIST) + ((size_t)e * LIST_CAP + slot) * 2; lst[0] = dest; lst[1] = __float_as_int(w); }
            __syncthreads();
        }
    }
#else
    if (IN(9)) {
        LAS float* rw = (LAS float*)(lds + RING_OFF);
        LAS int* te = (LAS int*)(lds + RING_OFF + 20 * 1024 * 4); LAS float* tw = (LAS float*)(te + 256); LAS int* tp = (LAS int*)(tw + 256); LAS int* ebase = tp + 256;
        for (int i = tid; i < 1024 * 4; i += 512) { const int k = i >> 2, o = i & 3; rw[o * 1024 + k] = P.in[19][i]; }
        for (int i = tid; i < 1024 * 16; i += 512) { const int k = i >> 4, o = i & 15; rw[(4 + o) * 1024 + k] = P.in[21][i]; }
        __syncthreads();
        bf16_t* XN3 = (bf16_t*)(ws + WS_XN3);
        if (NREP(9) == 2) { for (int tb = vcu; tb < M / 128; tb += G) { const int t0 = tb * 128; Row4 rcur = row_load(out + (size_t)(t0 + wave * 16) * D, lane);
            for (int i = 0; i < 16; ++i) { const int tl = wave * 16 + i, t = t0 + tl; int e0, e1; float w0, w1; const Row4 rnxt = row_load(out + (size_t)(t + (i < 15 ? 1 : 0)) * D, lane);
                route_token(rcur, P.in[18], rw, P.in[20], P.in[22], XN3 + (size_t)t * D, lane, e0, e1, w0, w1); rcur = rnxt; if (lane == 0) { te[2 * tl] = e0; tw[2 * tl] = w0 + w1 + (float)e1; } } }
            if (fusedrun) xcd_barrier(bar); }
        for (int tb = vcu; tb < M / 128; tb += G) {
            const int t0 = tb * 128;
            Row4 rcur = row_load(out + (size_t)(t0 + wave * 16) * D, lane);
            for (int i = 0; i < 16; ++i) { const int tl = wave * 16 + i, t = t0 + tl; int e0, e1; float w0, w1;
                const Row4 rnxt = row_load(out + (size_t)(t + (i < 15 ? 1 : 0)) * D, lane);
                route_token(rcur, P.in[18], rw, P.in[20], P.in[22], XN3 + (size_t)t * D, lane, e0, e1, w0, w1); rcur = rnxt;
                if (lane == 0) { te[2 * tl] = e0; te[2 * tl + 1] = e1; tw[2 * tl] = w0; tw[2 * tl + 1] = w1; } }
            __syncthreads();
            if (wave == 0) {
                int cnt = 0; int mye[4];
#pragma unroll
                for (int j = 0; j < 4; ++j) mye[j] = te[j * 64 + lane];
                int pos[4] = {0, 0, 0, 0};
                for (int e = 0; e < 16; ++e) { int run = 0;
#pragma unroll
                    for (int j = 0; j < 4; ++j) { const unsigned long long mk = __ballot(mye[j] == e); const int before = __popcll(mk & ((1ull << lane) - 1ull));
                        if (mye[j] == e) pos[j] = run + before; run += __popcll(mk); }
                    if (lane == e) cnt = run; }
#pragma unroll
                for (int j = 0; j < 4; ++j) tp[j * 64 + lane] = pos[j];
                if (lane < 16) { unsigned* ec = (unsigned*)(ws + WS_CTL) + CW_ECNT + 64 * lane; ebase[lane] = (int)atomicAdd(ec, (unsigned)cnt); }
            }
            __syncthreads();
            if (tid < 256) { const int e = te[tid], slot = ebase[e] + tp[tid], dest = (t0 * 2) + tid; const float w = tw[tid];
                int* lst = (int*)(ws + WS_LIST) + ((size_t)e * LIST_CAP + slot) * 2; lst[0] = dest; lst[1] = __float_as_int(w);
                int* ti = (int*)(ws + WS_TOKINFO) + (size_t)dest * 2; ti[0] = e; ti[1] = __float_as_int(w); }
            __syncthreads();
        }
    }
#endif
    SEAM(9);
    if (IN(10)) {
        _Pragma("unroll") for (int rep_ = 0; rep_ < NREP(10); ++rep_) {
        moe_setup(lds, ws, vcu, G, true);
        SchedMoe S{(const LAS int*)(lds + UREC_OFF), (const LAS unsigned*)(lds + TBL_OFF), (const char*)(ws + WS_XN3), (const char*)(ws + WS_WGU), 0, (size_t)1024 * 1024 * 2, (size_t)256 * 1024 * 2, true};
        EpiMoeA E{(bf16_t*)(ws + WS_H), (const LAS float*)(lds + RSTBL_OFF)};
        pg8::gemm_phase<EpiMoeA, SchedMoe, ALIGN_E, true>(lds + RING_OFF, 1024, S, E, STAG_MA);
        if (TAIL_CONV && G == 256) {
            const LAS int* rec = (const LAS int*)(lds + UREC_OFF); int myu = 0;
            for (int i = 0; i < MOE_MAXU; ++i) myu += rec[i * 8];
            const int nu = rec[MOE_MAXU * 8], rem = nu % G, maxu = (nu + G - 1) / G;
            const bool idle = (rem == 0) || (myu < maxu); const int nidle = (rem == 0) ? G : G - rem, rank = (rem == 0) ? vcu : vcu - rem;
            if (idle) { int tid2 = threadIdx.x; asm volatile("" : "+v"(tid2)); const int lane2 = tid2 & 63, wave2 = __builtin_amdgcn_readfirstlane(tid2 >> 6);
                LAS float* scr = (LAS float*)(lds + RING_OFF + wave2 * 16384);
                for (int j = rank * NWAVES + wave2; j < NE * 256; j += nidle * NWAVES) p0_weight_item(P, ws, scr, IT_P0 + (j >> 8) * 768 + 512 + (j & 255), lane2); } }
            REPSEAM(10); }
    }
    SEAM(10);
    if (IN(11)) {
        _Pragma("unroll") for (int rep_ = 0; rep_ < NREP(11); ++rep_) {
        moe_setup(lds, ws, vcu, G, false);
        SchedMoe S{(const LAS int*)(lds + UREC_OFF), (const LAS unsigned*)(lds + TBL_OFF), (const char*)(ws + WS_H), (const char*)(ws + WS_WD), (size_t)256 * 512 * 2, (size_t)1024 * 512 * 2, (size_t)256 * 512 * 2, false};
        EpiMoeB E{(const LAS int*)(lds + UREC_OFF), (const int*)(ws + WS_LIST), (bf16_t*)(ws + WS_YS)};
        pg8::gemm_phase<EpiMoeB, SchedMoe, ALIGN_E, false>(lds + RING_OFF, 512, S, E, STAG_MB);
            REPSEAM(11); }
    }
    SEAM(11);
    if (IN(12)) {
        const bf16_t* ys = (const bf16_t*)(ws + WS_YS);
        if (NREP(12) == 2) { float* dead = (float*)(ws + WS_H);
            for (int m = gw; m < M; m += NGW) { RowF r = rowf_load(out + (size_t)m * D, ys + (size_t)m * 2048, lane); const f32x4* src = (const f32x4*)(out + (size_t)m * D) + lane; f32x4* dd = (f32x4*)(dead + (size_t)m * D) + lane;
                (void)src; rowf_store(r, dead + (size_t)m * D, P.in[26], lane); (void)dd; }
            if (fusedrun) xcd_barrier(bar); }
        if (X2_BF16) final_rows_b(out, (const bf16_t*)(ws + WS_XN3), ys, P.in[26], gw, NGW, M, lane); else final_rows(out, ys, P.in[26], gw, NGW, M, lane);
    }
#undef IN
#undef SEAM
}
#ifndef OPT_MASK
#define OPT_MASK 0x1FFF
#endif
#ifndef FUSED
#define FUSED 1
#endif
static void launch_mega(const Args& a0, int lo, int hi, int grid, hipStream_t stream) {
    Args a = a0; a.ph_lo = lo; a.ph_hi = hi;
    hipLaunchKernelGGL(mega, dim3(grid), dim3(NWAVES * 64), LDS_BYTES, stream, a);
    const hipError_t le = hipPeekAtLastError();
    if (le != hipSuccess) fprintf(stderr, "kernel_launch: launch [%d,%d) failed: %s\n", lo, hi, hipGetErrorName(le));
}
extern "C" void kernel_launch(void* const* d_in, const int* in_sizes, int n_in, void* d_out, int out_size, void* d_ws, size_t ws_size, hipStream_t stream) {
    static int grid = 0;
    if (grid == 0) {
        if (n_in != 27 || in_sizes[0] != M * D || out_size != M * D || ws_size < WS_END) { fprintf(stderr, "kernel_launch: unexpected problem (n_in %d, in0 %d, out %d, ws %zu)\n", n_in, n_in > 0 ? in_sizes[0] : -1, out_size, ws_size); grid = -1; return; }
        (void)hipFuncSetAttribute((const void*)k_route, hipFuncAttributeMaxDynamicSharedMemorySize, 20 * 1024 * 4 + 4096);
        (void)hipFuncSetAttribute((const void*)nv_sgu, hipFuncAttributeMaxDynamicSharedMemorySize, 128 * 129 * 4 + 1024);
        (void)hipFuncSetAttribute((const void*)nv_attn, hipFuncAttributeMaxDynamicSharedMemorySize, 4 * 64 * 65 * 4);
        (void)hipFuncSetAttribute((const void*)k_prologue, hipFuncAttributeMaxDynamicSharedMemorySize, 8 * 64 * 33 * 4);
        if (hipFuncSetAttribute((const void*)mega, hipFuncAttributeMaxDynamicSharedMemorySize, LDS_BYTES) != hipSuccess) { fprintf(stderr, "kernel_launch: hipFuncSetAttribute(mega) failed\n"); grid = -1; return; }
        int dev = 0, cus = 0, per_cu = 0;
        if (hipGetDevice(&dev) != hipSuccess || hipDeviceGetAttribute(&cus, hipDeviceAttributeMultiprocessorCount, dev) != hipSuccess) { grid = -1; return; }
        if (hipOccupancyMaxActiveBlocksPerMultiprocessor(&per_cu, (const void*)mega, NWAVES * 64, LDS_BYTES) != hipSuccess || per_cu < 1) fprintf(stderr, "kernel_launch: occupancy query says %d blocks per CU\n", per_cu);
        (void)hipGetLastError();
        grid = cus;
    }
    if (grid < 0) return;
    unsigned char* ws = (unsigned char*)d_ws; float* out = (float*)d_out;
    Args a{}; for (int i = 0; i < 27; ++i) a.P.in[i] = (const float*)d_in[i];
    a.out = out; a.ws = ws; a.ph_lo = 0; a.ph_hi = NPHASE;
    const PtrsIn& P = a.P;
    (void)hipMemsetAsync(ws + WS_CTL, 0, CTL_ZERO_BYTES, stream);
#if FUSED
    launch_mega(a, 0, NPHASE, grid, stream);
#else
    float* scr = (float*)(ws + WS_SCR);
    bf16_t* XN = (bf16_t*)(ws + WS_XN);
    for (int ph = 0; ph < NPHASE; ++ph) {
        if ((OPT_MASK >> ph) & 1) { launch_mega(a, ph, ph + 1, grid, stream); continue; }
        switch (ph) {
        case 0: hipLaunchKernelGGL(k_prologue, dim3(256), dim3(512), 8 * 64 * 33 * 4, stream, P, ws); break;
        case 1:
            for (int c = 0; c < M / 4096; ++c) {
                hipLaunchKernelGGL(nv_gemm, dim3(NZ / 64, 4096 / 64), dim3(256), 0, stream, XN + (size_t)c * 4096 * D, D, (const bf16_t*)(ws + WS_WZ), D, D, scr, NZ);
                hipLaunchKernelGGL(nv_z_epi, dim3(4096), dim3(256), 0, stream, (const float*)scr, c * 4096, P, ws); }
            hipLaunchKernelGGL(nv_gemm, dim3(1024 / 64, MMEM / 64), dim3(256), 0, stream, XN + (size_t)M * D, D, (const bf16_t*)(ws + WS_WZ) + (size_t)NZ * D, D, D, scr, 1024);
            hipLaunchKernelGGL(nv_store_bf16, dim3(1024), dim3(256), 0, stream, (const float*)scr, (bf16_t*)(ws + WS_KVC), (size_t)MMEM * 1024, 1.0f);
            break;
        case 2:
            hipLaunchKernelGGL(nv_attn, dim3(SEQ / 64, 8, BATCH), dim3(256), 4 * 64 * 65 * 4, stream, (const bf16_t*)(ws + WS_Q), (const bf16_t*)(ws + WS_K), (const bf16_t*)(ws + WS_V), (bf16_t*)(ws + WS_ATT));
            hipLaunchKernelGGL(nv_sgu, dim3(M / 128, 4), dim3(256), 128 * 129 * 4 + 1024, stream, P, ws);
            break;
        case 3:
            for (int c = 0; c < M / 4096; ++c) { float* c1 = scr; float* c2 = scr + (size_t)4096 * 1024;
                hipLaunchKernelGGL(nv_gemm, dim3(1024 / 64, 64), dim3(256), 0, stream, (const bf16_t*)(ws + WS_ATT) + (size_t)c * 4096 * 512, 512, (const bf16_t*)(ws + WS_WATT), 512, 512, c1, 1024);
                hipLaunchKernelGGL(nv_gemm, dim3(1024 / 64, 64), dim3(256), 0, stream, (const bf16_t*)(ws + WS_SG) + (size_t)c * 4096 * 512, 512, (const bf16_t*)(ws + WS_WSGU), 512, 512, c2, 1024);
                hipLaunchKernelGGL(nv_merge, dim3(2048), dim3(256), 0, stream, (const float*)c1, (const float*)c2, (const bf16_t*)(ws + WS_GA) + (size_t)c * 4096 * 1024, (const bf16_t*)(ws + WS_GB) + (size_t)c * 4096 * 1024,
                                   (bf16_t*)(ws + WS_MERGED) + (size_t)c * 4096 * 1024, (size_t)4096 * 1024); }
            break;
        case 4:
            for (int c = 0; c < M / 4096; ++c) {
                hipLaunchKernelGGL(nv_gemm, dim3(1024 / 64, 64), dim3(256), 0, stream, (const bf16_t*)(ws + WS_MERGED) + (size_t)c * 4096 * 1024, 1024, (const bf16_t*)(ws + WS_WOUT), 1024, 1024, scr, 1024);
                hipLaunchKernelGGL(nv_resid, dim3(2048), dim3(256), 0, stream, P.in[0] + (size_t)c * 4096 * 1024, (const float*)scr, out + (size_t)c * 4096 * 1024, (size_t)4096 * 1024); }
            break;
        case 5: hipLaunchKernelGGL(k_norm_rows, dim3(256), dim3(512), 0, stream, (const float*)out, P.in[13], (bf16_t*)(ws + WS_XN1), M); break;
        case 6:
            for (int c = 0; c < M / 4096; ++c) {
                hipLaunchKernelGGL(nv_gemm, dim3(512 / 64, 64), dim3(256), 0, stream, (const bf16_t*)(ws + WS_XN1) + (size_t)c * 4096 * 1024, 1024, (const bf16_t*)(ws + WS_WCQ), 1024, 1024, scr, 512);
                hipLaunchKernelGGL(nv_store_bf16, dim3(1024), dim3(256), 0, stream, (const float*)scr, (bf16_t*)(ws + WS_QC) + (size_t)c * 4096 * 512, (size_t)4096 * 512, C2_CROSS); }
            break;
        case 7: hipLaunchKernelGGL(nv_cross, dim3(M), dim3(256), 0, stream, (const bf16_t*)(ws + WS_QC), (const bf16_t*)(ws + WS_KVC), (bf16_t*)(ws + WS_OC)); break;
        case 8:
            for (int c = 0; c < M / 4096; ++c) {
                hipLaunchKernelGGL(nv_gemm, dim3(1024 / 64, 64), dim3(256), 0, stream, (const bf16_t*)(ws + WS_OC) + (size_t)c * 4096 * 512, 512, (const bf16_t*)(ws + WS_WCO), 512, 512, scr, 1024);
                hipLaunchKernelGGL(nv_resid, dim3(2048), dim3(256), 0, stream, (const float*)(out + (size_t)c * 4096 * 1024), (const float*)scr, out + (size_t)c * 4096 * 1024, (size_t)4096 * 1024); }
            break;
        case 9: hipLaunchKernelGGL(k_route, dim3(256), dim3(512), 20 * 1024 * 4 + 4096, stream, P, (const float*)out, ws); break;
        case 10: hipLaunchKernelGGL(nv_moe_a, dim3(2 * M), dim3(256), 0, stream, (const bf16_t*)(ws + WS_XN3), ws); break;
        case 11: hipLaunchKernelGGL(nv_moe_b, dim3(2 * M), dim3(256), 0, stream, ws); break;
        case 12: hipLaunchKernelGGL(k_final, dim3(256), dim3(512), 0, stream, out, (const bf16_t*)(ws + WS_YS), P.in[26]); break;
        }
    }
#endif
}
```

```cpp
#include <hip/hip_runtime.h>
#include <cstdio>
#include <cstdint>
#include <cmath>

#ifndef FOLD_GAINS
#define FOLD_GAINS 1
#endif
#ifndef ATT_FIXM
#define ATT_FIXM 1
#endif
#ifndef X0_BF16
#define X0_BF16 1
#endif
#ifndef GATE_U8
#define GATE_U8 1
#endif
#ifndef MERGE_QC_CROSS
#define MERGE_QC_CROSS 1
#endif
#ifndef TAIL_CONV
#define TAIL_CONV 1
#endif
#ifndef ROUTE_MFMA
#define ROUTE_MFMA 1
#endif
#ifndef FOLD_MOE
#define FOLD_MOE ROUTE_MFMA
#endif
#ifndef X2_BF16
#define X2_BF16 1
#endif
#ifndef MOE_CONV_IN_P2
#define MOE_CONV_IN_P2 0
#endif
typedef unsigned short bf16_t;
typedef float f32x4 __attribute__((ext_vector_type(4)));
typedef unsigned u32x4 __attribute__((ext_vector_type(4)));
typedef unsigned u32x2 __attribute__((ext_vector_type(2)));

constexpr int BATCH = 4, SEQ = 8192, D = 1024, M = BATCH * SEQ;
constexpr int NMEM = 256, MMEM = BATCH * NMEM;
constexpr int NZ = 3840;
constexpr int ZQ = 0, ZK = 512, ZV = 640, ZSU = 768, ZSV = 1280, ZGA = 1792, ZGB = 2816;
constexpr int NE = 16, DE = 512;
constexpr float EPS = 1e-6f;
constexpr float LOG2E = 1.4426950408889634f;
constexpr float C2_SELF = 0.125f * LOG2E;
constexpr float C2_CROSS = 0.08838834764831845f * LOG2E;
constexpr int LIST_CAP = 32768;

constexpr size_t MiB = 1u << 20;
constexpr size_t WS_CTL = 0, CTL_ZERO_BYTES = 64 * 1024;
constexpr size_t WS_TAB = 512 * 1024;
constexpr size_t WS_WZ = 1 * MiB;
constexpr size_t WS_WATT = 11 * MiB, WS_WSGU = 12 * MiB, WS_WOUT = 13 * MiB, WS_WCQ = 15 * MiB, WS_WCO = 16 * MiB, WS_WSS = 17 * MiB;
constexpr size_t WS_WGU = 18 * MiB;
constexpr size_t WS_WD = 50 * MiB;
constexpr size_t WS_XN = 68 * MiB;
constexpr size_t WS_MERGED = 248 * MiB;
constexpr size_t WS_GSCR = 312 * MiB;
constexpr size_t WS_XN3 = 68 * MiB;
constexpr size_t WS_KVC = 134 * MiB;
constexpr size_t WS_Q = 136 * MiB, WS_K = 168 * MiB, WS_V = 176 * MiB, WS_U = 184 * MiB, WS_GV = 216 * MiB, WS_GA = 248 * MiB, WS_GB = 312 * MiB;
constexpr size_t WS_ATT = 376 * MiB, WS_SG = 408 * MiB;
constexpr size_t WS_XN1 = 136 * MiB;
constexpr size_t WS_SSQ1 = 132 * MiB;
constexpr size_t WS_QC = 376 * MiB, WS_OC = 408 * MiB;
constexpr size_t WS_LIST = 200 * MiB;
constexpr size_t WS_RS0 = 66 * MiB;
constexpr size_t WS_RSTOK = 205 * MiB;
constexpr size_t WS_TOKINFO = 204 * MiB;
constexpr size_t WS_YS = 208 * MiB;
constexpr size_t WS_H = 336 * MiB;
constexpr size_t WS_SCR = 440 * MiB;
constexpr size_t WS_END = 504 * MiB;
constexpr int CW_TMO = 0, CW_BAR = 4096, CW_ECNT = 8192;

__host__ __device__ __forceinline__ float bf2f(bf16_t b) { union { unsigned u; float f; } c; c.u = ((unsigned)b) << 16; return c.f; }
__host__ __device__ __forceinline__ unsigned f2bf(float f) { union { unsigned u; float f; } c; c.f = f; unsigned u = c.u; return (u + 0x7fffu + ((u >> 16) & 1u)) >> 16; }
__device__ __forceinline__ unsigned pk2(float lo, float hi) { return f2bf(lo) | (f2bf(hi) << 16); }
__device__ __forceinline__ float wave_sum(float v) {
#pragma unroll
    for (int o = 1; o < 64; o <<= 1) v += __shfl_xor(v, o);
    return v;
}
__device__ __forceinline__ float wave_max(float v) {
#pragma unroll
    for (int o = 1; o < 64; o <<= 1) v = fmaxf(v, __shfl_xor(v, o));
    return v;
}
__device__ __forceinline__ float gelu_tanh(float x) { const float u = 0.7978845608028654f * (x + 0.044715f * x * x * x); return x / (1.0f + __builtin_amdgcn_exp2f(-2.0f * LOG2E * u)); }
__device__ __forceinline__ float sigmoidf_(float x) { return 1.0f / (1.0f + __builtin_amdgcn_exp2f(-LOG2E * x)); }

__host__ __device__ __forceinline__ int z_phys(int c) {
    if (c < 512) { const int h = c >> 6, d = c & 63; return (h >> 2) * 256 + (d >> 5) * 128 + (h & 3) * 32 + (d & 31); }
    if (c < 768) { const int cc = c - 512, w = cc >> 6, d = cc & 63; return 512 + (d >> 5) * 128 + w * 32 + (d & 31); }
    return c;
}

#define LAS __attribute__((address_space(3)))
__device__ __forceinline__ void p0_transpose_item(const float* W, int K, int N, bf16_t* WT, int mode, int row_off, LAS float* scr, int item, int lane, const float* gk = nullptr) {
    const int nblk = N / 32, kb = item / nblk, nb = item % nblk, k0 = 64 * kb, n0 = 32 * nb;
    float tv[32];
#pragma unroll
    for (int i = 0; i < 32; ++i) tv[i] = W[(size_t)(k0 + 2 * i + (lane >> 5)) * N + n0 + (lane & 31)];
    if (gk) {
#pragma unroll
        for (int i = 0; i < 32; ++i) tv[i] *= gk[k0 + 2 * i + (lane >> 5)]; }
#pragma unroll
    for (int i = 0; i < 32; ++i) scr[(2 * i + (lane >> 5)) * 33 + (lane & 31)] = tv[i];
    __builtin_amdgcn_s_waitcnt(0xC07F); asm volatile("" ::: "memory");
    const int c = lane & 7;
#pragma unroll
    for (int j = 0; j < 4; ++j) { const int n = (lane >> 3) + 8 * j; const LAS float* s = scr + (8 * c) * 33 + n;
        u32x4 o; o.x = pk2(s[0 * 33], s[1 * 33]); o.y = pk2(s[2 * 33], s[3 * 33]); o.z = pk2(s[4 * 33], s[5 * 33]); o.w = pk2(s[6 * 33], s[7 * 33]);
        const int nl = n0 + n; int row;
        if (mode == 0) row = row_off + nl; else if (mode == 1) row = z_phys(nl); else if (mode == 2) row = 256 * (nl >> 7) + (nl & 127); else row = 256 * (nl >> 7) + 128 + (nl & 127);
        *(u32x4*)(WT + (size_t)row * K + k0 + 8 * c) = o; }
    __builtin_amdgcn_s_waitcnt(0xC07F); asm volatile("" ::: "memory");
}
struct PtrsIn { const float* in[27]; };
constexpr int IT_WIN = 16 * 120, IT_CKV = 16 * 32, IT_ATT = 8 * 32, IT_SGU = 8 * 32, IT_OUT = 16 * 32, IT_CQ = 16 * 16, IT_CO = 8 * 32, IT_G = 16 * 16, IT_DN = 8 * 32;
constexpr int IT_P0 = IT_WIN + IT_CKV + IT_ATT + IT_SGU + IT_OUT + IT_CQ + IT_CO;
constexpr int IT_TOTAL = IT_P0 + NE * (2 * IT_G + IT_DN);
__device__ __forceinline__ void p0_weight_item(const PtrsIn& P, unsigned char* ws, LAS float* scr, int it, int lane) {
    int r = it;
    bf16_t* WZ = (bf16_t*)(ws + WS_WZ);
    if (r < IT_WIN) { p0_transpose_item(P.in[3], 1024, NZ, WZ, 1, 0, scr, r, lane, X0_BF16 ? P.in[2] : nullptr); return; } r -= IT_WIN;
    if (r < IT_CKV) { p0_transpose_item(P.in[16], 1024, 1024, WZ, 0, NZ, scr, r, lane); return; } r -= IT_CKV;
    if (r < IT_ATT) { p0_transpose_item(P.in[6], 512, 1024, (bf16_t*)(ws + WS_WATT), 0, 0, scr, r, lane); return; } r -= IT_ATT;
    if (r < IT_SGU) { p0_transpose_item(P.in[11], 512, 1024, (bf16_t*)(ws + WS_WSGU), 0, 0, scr, r, lane); return; } r -= IT_SGU;
    if (r < IT_OUT) { p0_transpose_item(P.in[12], 1024, 1024, (bf16_t*)(ws + WS_WOUT), 0, 0, scr, r, lane); return; } r -= IT_OUT;
    if (r < IT_CQ) { p0_transpose_item(P.in[15], 1024, 512, (bf16_t*)(ws + WS_WCQ), 0, 0, scr, r, lane, FOLD_GAINS ? P.in[13] : nullptr); return; } r -= IT_CQ;
    if (r < IT_CO) { p0_transpose_item(P.in[17], 512, 1024, (bf16_t*)(ws + WS_WCO), 0, 0, scr, r, lane); return; } r -= IT_CO;
    const int per = 2 * IT_G + IT_DN, e = r / per; r -= e * per;
    if (r < IT_G) { p0_transpose_item(P.in[23] + (size_t)e * 1024 * 512, 1024, 512, (bf16_t*)(ws + WS_WGU) + (size_t)e * 1024 * 1024, 2, 0, scr, r, lane, FOLD_MOE ? P.in[18] : nullptr); return; } r -= IT_G;
    if (r < IT_G) { p0_transpose_item(P.in[24] + (size_t)e * 1024 * 512, 1024, 512, (bf16_t*)(ws + WS_WGU) + (size_t)e * 1024 * 1024, 3, 0, scr, r, lane, FOLD_MOE ? P.in[18] : nullptr); return; } r -= IT_G;
    p0_transpose_item(P.in[25] + (size_t)e * 512 * 1024, 512, 1024, (bf16_t*)(ws + WS_WD) + (size_t)e * 1024 * 512, 0, 0, scr, r, lane);
}
struct Row4 { f32x4 v[4]; };
__device__ __forceinline__ Row4 row_load(const float* xrow, int lane) { Row4 r; const f32x4* xr = (const f32x4*)xrow + lane;
#pragma unroll
    for (int j = 0; j < 4; ++j) r.v[j] = xr[64 * j];
    return r; }
__device__ __forceinline__ void rms_row_store(const Row4& r, const float* g, bf16_t* orow, int lane) {
    const f32x4* gr = (const f32x4*)g + lane; float s = 0.f;
#pragma unroll
    for (int j = 0; j < 4; ++j) s += (r.v[j].x * r.v[j].x + r.v[j].y * r.v[j].y) + (r.v[j].z * r.v[j].z + r.v[j].w * r.v[j].w);
    const float rs = 1.0f / sqrtf(wave_sum(s) * (1.f / 1024.f) + EPS);
    unsigned long long* o8 = (unsigned long long*)orow + lane;
#pragma unroll
    for (int j = 0; j < 4; ++j) { const f32x4 gg = gr[64 * j]; o8[64 * j] = (unsigned long long)pk2(r.v[j].x * rs * gg.x, r.v[j].y * rs * gg.y) | ((unsigned long long)pk2(r.v[j].z * rs * gg.z, r.v[j].w * rs * gg.w) << 32); }
}
__device__ __forceinline__ void xb0_row_store(const Row4& r, bf16_t* orow, float* rs_out, int lane) {
    float s = 0.f;
#pragma unroll
    for (int j = 0; j < 4; ++j) s += (r.v[j].x * r.v[j].x + r.v[j].y * r.v[j].y) + (r.v[j].z * r.v[j].z + r.v[j].w * r.v[j].w);
    const float rs = 1.0f / sqrtf(wave_sum(s) * (1.f / 1024.f) + EPS);
    unsigned long long* o8 = (unsigned long long*)orow + lane;
#pragma unroll
    for (int j = 0; j < 4; ++j) o8[64 * j] = (unsigned long long)pk2(r.v[j].x, r.v[j].y) | ((unsigned long long)pk2(r.v[j].z, r.v[j].w) << 32);
    if (lane == 0) *rs_out = rs;
}
__device__ __forceinline__ void xb0_rows(const float* x, bf16_t* o, float* rs0, int first, int step, int rows, int lane) {
    if (first >= rows) return;
    const int last = first + ((rows - 1 - first) / step) * step;
    Row4 r0 = row_load(x + (size_t)first * D, lane);
    Row4 r1 = row_load(x + (size_t)((first + step <= last) ? first + step : last) * D, lane);
    for (int m = first; m < rows; m += step) { const int m2 = (m + 2 * step <= last) ? m + 2 * step : last;
        const Row4 r2 = row_load(x + (size_t)m2 * D, lane);
        xb0_row_store(r0, o + (size_t)m * D, rs0 + m, lane); r0 = r1; r1 = r2; }
}
__device__ __forceinline__ void rms_rows(const float* x, const float* g, bf16_t* o, int first, int step, int rows, int lane) {
    if (first >= rows) return;
    const int last = first + ((rows - 1 - first) / step) * step;
    Row4 r0 = row_load(x + (size_t)first * D, lane);
    Row4 r1 = row_load(x + (size_t)((first + step <= last) ? first + step : last) * D, lane);
    for (int m = first; m < rows; m += step) { const int m2 = (m + 2 * step <= last) ? m + 2 * step : last;
        const Row4 r2 = row_load(x + (size_t)m2 * D, lane);
        rms_row_store(r0, g, o + (size_t)m * D, lane); r0 = r1; r1 = r2; }
}
__device__ __forceinline__ void rms_row_to_bf16(const float* xrow, const float* g, bf16_t* orow, int lane) {
    const f32x4* xr = (const f32x4*)xrow + lane; const f32x4* gr = (const f32x4*)g + lane;
    f32x4 v[4]; float s = 0.f;
#pragma unroll
    for (int j = 0; j < 4; ++j) { v[j] = xr[64 * j]; s += (v[j].x * v[j].x + v[j].y * v[j].y) + (v[j].z * v[j].z + v[j].w * v[j].w); }
    const float rs = 1.0f / sqrtf(wave_sum(s) * (1.f / 1024.f) + EPS);
    unsigned long long* o8 = (unsigned long long*)orow + lane;
#pragma unroll
    for (int j = 0; j < 4; ++j) { const f32x4 gg = gr[64 * j]; o8[64 * j] = (unsigned long long)pk2(v[j].x * rs * gg.x, v[j].y * rs * gg.y) | ((unsigned long long)pk2(v[j].z * rs * gg.z, v[j].w * rs * gg.w) << 32); }
}
__device__ __forceinline__ void rope_table_entry(float* tab, int idx) {
    const int pos = idx >> 4, i = idx & 15;
    const float inv = exp2f(-(float)i * (13.287712379549449f / 16.0f));
    const float ang = (float)pos * inv;
    float s, c; sincosf(ang, &s, &c);
    tab[0 * 2048 + idx] = c; tab[1 * 2048 + idx] = s; tab[2 * 2048 + idx] = c; tab[3 * 2048 + idx] = s;
}

__device__ __forceinline__ void route_decide(const float (&lg)[20], const float* b_rg, const float* b_re, int& e0, int& e1, float& w0, float& w1) {
    float g0 = lg[0] + b_rg[0], g1 = lg[1] + b_rg[1], g2 = lg[2] + b_rg[2], g3 = lg[3] + b_rg[3];
    int gi = 0; float gm = g0; if (g1 > gm) { gm = g1; gi = 1; } if (g2 > gm) { gm = g2; gi = 2; } if (g3 > gm) { gm = g3; gi = 3; }
    const float gval = 1.0f / (expf(g0 - gm) + expf(g1 - gm) + expf(g2 - gm) + expf(g3 - gm));
    float ev[4];
#pragma unroll
    for (int j = 0; j < 4; ++j) { float t = 0.f;
#pragma unroll
        for (int g = 0; g < 4; ++g) t = (gi == g) ? (lg[4 + 4 * g + j] + b_re[4 * g + j]) : t;
        ev[j] = t; }
    int i0 = 0; float m0 = ev[0];
#pragma unroll
    for (int j = 1; j < 4; ++j) if (ev[j] > m0) { m0 = ev[j]; i0 = j; }
    int i1 = -1; float m1 = -INFINITY;
#pragma unroll
    for (int j = 0; j < 4; ++j) if (j != i0 && ev[j] > m1) { m1 = ev[j]; i1 = j; }
    const float p1 = expf(m1 - m0), den = 1.0f / (1.0f + p1);
    e0 = gi * 4 + i0; e1 = gi * 4 + i1; w0 = den * gval; w1 = p1 * den * gval;
}
template <class RW> __device__ __forceinline__ void route_token(const Row4& xin, const float* gmoe, RW rw, const float* b_rg, const float* b_re, bf16_t* orow, int lane, int& e0, int& e1, float& w0, float& w1) {
    const f32x4* gr = (const f32x4*)gmoe + lane;
    f32x4 v[4]; float s = 0.f;
#pragma unroll
    for (int j = 0; j < 4; ++j) { v[j] = xin.v[j]; s += (v[j].x * v[j].x + v[j].y * v[j].y) + (v[j].z * v[j].z + v[j].w * v[j].w); }
    const float rs = 1.0f / sqrtf(wave_sum(s) * (1.f / 1024.f) + EPS);
    unsigned long long* o8 = (unsigned long long*)orow + lane;
#pragma unroll
    for (int j = 0; j < 4; ++j) { const f32x4 gg = gr[64 * j]; v[j].x *= rs * gg.x; v[j].y *= rs * gg.y; v[j].z *= rs * gg.z; v[j].w *= rs * gg.w;
        o8[64 * j] = (unsigned long long)pk2(v[j].x, v[j].y) | ((unsigned long long)pk2(v[j].z, v[j].w) << 32); }
    float lg[20];
#pragma unroll
    for (int o = 0; o < 20; ++o) { auto wr = rw + o * 1024 + 4 * lane; float a = 0.f;
#pragma unroll
        for (int j = 0; j < 4; ++j) { const float w0_ = wr[256 * j], w1_ = wr[256 * j + 1], w2_ = wr[256 * j + 2], w3_ = wr[256 * j + 3]; a += (v[j].x * w0_ + v[j].y * w1_) + (v[j].z * w2_ + v[j].w * w3_); }
        lg[o] = wave_sum(a); }
    route_decide(lg, b_rg, b_re, e0, e1, w0, w1);
}
__device__ __forceinline__ void final_row(float* orow, const bf16_t* ys2, const float* g, int lane) {
    f32x4* xr = (f32x4*)orow + lane; const f32x4* gr = (const f32x4*)g + lane;
    const u32x2* y0 = (const u32x2*)ys2 + lane; const u32x2* y1 = (const u32x2*)(ys2 + 1024) + lane;
    f32x4 v[4]; float s = 0.f;
#pragma unroll
    for (int j = 0; j < 4; ++j) { v[j] = xr[64 * j]; const u32x2 a = y0[64 * j], b = y1[64 * j];
        v[j].x += bf2f((bf16_t)(a.x & 0xffff)) + bf2f((bf16_t)(b.x & 0xffff)); v[j].y += bf2f((bf16_t)(a.x >> 16)) + bf2f((bf16_t)(b.x >> 16));
        v[j].z += bf2f((bf16_t)(a.y & 0xffff)) + bf2f((bf16_t)(b.y & 0xffff)); v[j].w += bf2f((bf16_t)(a.y >> 16)) + bf2f((bf16_t)(b.y >> 16));
        s += (v[j].x * v[j].x + v[j].y * v[j].y) + (v[j].z * v[j].z + v[j].w * v[j].w); }
    const float rs = 1.0f / sqrtf(wave_sum(s) * (1.f / 1024.f) + EPS);
#pragma unroll
    for (int j = 0; j < 4; ++j) { const f32x4 gg = gr[64 * j]; f32x4 o; o.x = v[j].x * rs * gg.x; o.y = v[j].y * rs * gg.y; o.z = v[j].z * rs * gg.z; o.w = v[j].w * rs * gg.w; xr[64 * j] = o; }
}

struct RowF { f32x4 v[4]; u32x2 a[4], b[4]; };
__device__ __forceinline__ RowF rowf_load(const float* orow, const bf16_t* ys2, int lane) { RowF r; const f32x4* xr = (const f32x4*)orow + lane; const u32x2* y0 = (const u32x2*)ys2 + lane; const u32x2* y1 = (const u32x2*)(ys2 + 1024) + lane;
#pragma unroll
    for (int j = 0; j < 4; ++j) { r.v[j] = xr[64 * j]; r.a[j] = y0[64 * j]; r.b[j] = y1[64 * j]; }
    return r; }
__device__ __forceinline__ void rowf_store(const RowF& r, float* orow, const float* g, int lane) {
    f32x4* xr = (f32x4*)orow + lane; const f32x4* gr = (const f32x4*)g + lane; f32x4 v[4]; float s = 0.f;
#pragma unroll
    for (int j = 0; j < 4; ++j) { v[j] = r.v[j]; const u32x2 a = r.a[j], b = r.b[j];
        v[j].x += __uint_as_float(a.x << 16) + __uint_as_float(b.x << 16); v[j].y += __uint_as_float(a.x & 0xffff0000u) + __uint_as_float(b.x & 0xffff0000u);
        v[j].z += __uint_as_float(a.y << 16) + __uint_as_float(b.y << 16); v[j].w += __uint_as_float(a.y & 0xffff0000u) + __uint_as_float(b.y & 0xffff0000u);
        s += (v[j].x * v[j].x + v[j].y * v[j].y) + (v[j].z * v[j].z + v[j].w * v[j].w); }
    const float rs = 1.0f / sqrtf(wave_sum(s) * (1.f / 1024.f) + EPS);
#pragma unroll
    for (int j = 0; j < 4; ++j) { const f32x4 gg = gr[64 * j]; f32x4 o; o.x = v[j].x * rs * gg.x; o.y = v[j].y * rs * gg.y; o.z = v[j].z * rs * gg.z; o.w = v[j].w * rs * gg.w; xr[64 * j] = o; }
}
__device__ __forceinline__ RowF rowf_load_b(const bf16_t* xb, const bf16_t* ys2, int lane) { RowF r; const u32x2* xr = (const u32x2*)xb + lane; const u32x2* y0 = (const u32x2*)ys2 + lane; const u32x2* y1 = (const u32x2*)(ys2 + 1024) + lane;
#pragma unroll
    for (int j = 0; j < 4; ++j) { const u32x2 q = xr[64 * j]; r.v[j] = (f32x4){__uint_as_float(q.x << 16), __uint_as_float(q.x & 0xffff0000u), __uint_as_float(q.y << 16), __uint_as_float(q.y & 0xffff0000u)}; r.a[j] = y0[64 * j]; r.b[j] = y1[64 * j]; }
    return r; }
__device__ __forceinline__ void final_rows_b(float* out, const bf16_t* xb, const bf16_t* ys, const float* g, int first, int step, int rows, int lane) {
    if (first >= rows) return;
    RowF cur = rowf_load_b(xb + (size_t)first * D, ys + (size_t)first * 2048, lane);
    for (int m = first; m < rows; m += step) { const int mn = (m + step < rows) ? m + step : m;
        const RowF nxt = rowf_load_b(xb + (size_t)mn * D, ys + (size_t)mn * 2048, lane);
        rowf_store(cur, out + (size_t)m * D, g, lane); cur = nxt; }
}
__device__ __forceinline__ void final_rows(float* out, const bf16_t* ys, const float* g, int first, int step, int rows, int lane) {
    if (first >= rows) return;
    RowF cur = rowf_load(out + (size_t)first * D, ys + (size_t)first * 2048, lane);
    for (int m = first; m < rows; m += step) { const int mn = (m + step < rows) ? m + step : m;
        const RowF nxt = rowf_load(out + (size_t)mn * D, ys + (size_t)mn * 2048, lane);
        rowf_store(cur, out + (size_t)m * D, g, lane); cur = nxt; }
}

__global__ void __launch_bounds__(512) k_prologue(PtrsIn P, unsigned char* ws) {
    extern __shared__ __attribute__((aligned(16))) unsigned char dyn[];
    const int tid = threadIdx.x, lane = tid & 63, wave = tid >> 6;
    const int gw = blockIdx.x * 8 + wave, NGW = gridDim.x * 8;
    LAS float* scr = (LAS float*)dyn + wave * 64 * 33;
    for (int it = gw; it < IT_TOTAL; it += NGW) p0_weight_item(P, ws, scr, it, lane);
    { const float* wsrc = P.in[9]; bf16_t* wd = (bf16_t*)(ws + WS_WSS);
      for (int i = blockIdx.x * 512 + tid; i < 4 * 128 * 128; i += gridDim.x * 512) wd[i] = (bf16_t)f2bf(wsrc[i]); }
    for (int i = blockIdx.x * 512 + tid; i < 2048; i += gridDim.x * 512) rope_table_entry((float*)(ws + WS_TAB), i);
    bf16_t* XN = (bf16_t*)(ws + WS_XN);
    for (int m = gw; m < M; m += NGW) rms_row_to_bf16(P.in[0] + (size_t)m * D, P.in[2], XN + (size_t)m * D, lane);
    for (int m = gw; m < MMEM; m += NGW) rms_row_to_bf16(P.in[1] + (size_t)m * D, P.in[14], XN + (size_t)(M + m) * D, lane);
}
__global__ void __launch_bounds__(512) k_norm_rows(const float* x, const float* g, bf16_t* o, int rows) {
    const int lane = threadIdx.x & 63, gw = blockIdx.x * 8 + (threadIdx.x >> 6), NGW = gridDim.x * 8;
    for (int m = gw; m < rows; m += NGW) rms_row_to_bf16(x + (size_t)m * D, g, o + (size_t)m * D, lane);
}
__global__ void __launch_bounds__(512) k_route(PtrsIn P, const float* x2, unsigned char* ws) {
    extern __shared__ __attribute__((aligned(16))) unsigned char dyn[];
    float* rw = (float*)dyn;
    int* te = (int*)(dyn + 20 * 1024 * 4);
    float* tw = (float*)(te + 256);
    int* tp = (int*)(tw + 256);
    int* ebase = tp + 256;
    const int tid = threadIdx.x, lane = tid & 63, wave = tid >> 6;
    for (int i = tid; i < 1024 * 4; i += 512) { const int k = i >> 2, o = i & 3; rw[o * 1024 + k] = P.in[19][i]; }
    for (int i = tid; i < 1024 * 16; i += 512) { const int k = i >> 4, o = i & 15; rw[(4 + o) * 1024 + k] = P.in[21][i]; }
    __syncthreads();
    bf16_t* XN3 = (bf16_t*)(ws + WS_XN3);
    const int t0 = blockIdx.x * 128;
    for (int i = 0; i < 16; ++i) { const int tl = wave * 16 + i, t = t0 + tl; int e0, e1; float w0, w1;
        route_token(row_load(x2 + (size_t)t * D, lane), P.in[18], rw, P.in[20], P.in[22], XN3 + (size_t)t * D, lane, e0, e1, w0, w1);
        if (lane == 0) { te[2 * tl] = e0; te[2 * tl + 1] = e1; tw[2 * tl] = w0; tw[2 * tl + 1] = w1; } }
    __syncthreads();
    if (wave == 0) {
        int cnt = 0;
        int mye[4]; for (int j = 0; j < 4; ++j) mye[j] = te[j * 64 + lane];
        int pos[4] = {0, 0, 0, 0};
        for (int e = 0; e < 16; ++e) { int run = 0;
            for (int j = 0; j < 4; ++j) { const unsigned long long mk = __ballot(mye[j] == e); const int before = __popcll(mk & ((1ull << lane) - 1ull));
                if (mye[j] == e) pos[j] = run + before; run += __popcll(mk); }
            if (lane == e) cnt = run; }
        for (int j = 0; j < 4; ++j) tp[j * 64 + lane] = pos[j];
        if (lane < 16) { unsigned* ec = (unsigned*)(ws + WS_CTL) + CW_ECNT + 64 * lane; ebase[lane] = (int)atomicAdd(ec, (unsigned)cnt); }
    }
    __syncthreads();
    if (tid < 256) { const int e = te[tid], slot = ebase[e] + tp[tid], dest = (t0 * 2) + tid; const float w = tw[tid];
        int* lst = (int*)(ws + WS_LIST) + ((size_t)e * LIST_CAP + slot) * 2; lst[0] = dest; lst[1] = __float_as_int(w);
        int* ti = (int*)(ws + WS_TOKINFO) + (size_t)dest * 2; ti[0] = e; ti[1] = __float_as_int(w); }
}
__global__ void __launch_bounds__(512) k_final(float* out, const bf16_t* ys, const float* g) {
    const int lane = threadIdx.x & 63, gw = blockIdx.x * 8 + (threadIdx.x >> 6), NGW = gridDim.x * 8;
    for (int m = gw; m < M; m += NGW) final_row(out + (size_t)m * D, ys + (size_t)m * 2048, g, lane);
}

__global__ void __launch_bounds__(256) nv_gemm(const bf16_t* A, int lda, const bf16_t* Bt, int ldb, int K, float* C, int ldc) {
    __shared__ __attribute__((aligned(16))) float As[16][68], Bs[16][68];
    const int tid = threadIdx.x, tx = tid & 15, ty = tid >> 4, r0 = blockIdx.y * 64, n0 = blockIdx.x * 64, lr = tid >> 2, lk = (tid & 3) * 4;
    float acc[4][4];
#pragma unroll
    for (int i = 0; i < 4; ++i)
#pragma unroll
        for (int j = 0; j < 4; ++j) acc[i][j] = 0.f;
    for (int k0 = 0; k0 < K; k0 += 16) {
        const u32x2 av = *(const u32x2*)(A + (size_t)(r0 + lr) * lda + k0 + lk), bv = *(const u32x2*)(Bt + (size_t)(n0 + lr) * ldb + k0 + lk);
        As[lk + 0][lr] = bf2f((bf16_t)(av.x & 0xffff)); As[lk + 1][lr] = bf2f((bf16_t)(av.x >> 16)); As[lk + 2][lr] = bf2f((bf16_t)(av.y & 0xffff)); As[lk + 3][lr] = bf2f((bf16_t)(av.y >> 16));
        Bs[lk + 0][lr] = bf2f((bf16_t)(bv.x & 0xffff)); Bs[lk + 1][lr] = bf2f((bf16_t)(bv.x >> 16)); Bs[lk + 2][lr] = bf2f((bf16_t)(bv.y & 0xffff)); Bs[lk + 3][lr] = bf2f((bf16_t)(bv.y >> 16));
        __syncthreads();
#pragma unroll
        for (int kk = 0; kk < 16; ++kk) { const f32x4 a = *(const f32x4*)&As[kk][ty * 4], b = *(const f32x4*)&Bs[kk][tx * 4];
#pragma unroll
            for (int i = 0; i < 4; ++i)
#pragma unroll
                for (int j = 0; j < 4; ++j) acc[i][j] += a[i] * b[j]; }
        __syncthreads();
    }
#pragma unroll
    for (int i = 0; i < 4; ++i) { f32x4 o = {acc[i][0], acc[i][1], acc[i][2], acc[i][3]}; *(f32x4*)(C + (size_t)(r0 + ty * 4 + i) * ldc + n0 + tx * 4) = o; }
}
__global__ void __launch_bounds__(256) nv_z_epi(const float* Cz, int row0, PtrsIn P, unsigned char* ws) {
    const int tid = threadIdx.x, lane = tid & 63, wave = tid >> 6;
    const int rl = blockIdx.x, row = row0 + rl, t = row % SEQ, rid = t >> 6, cid = t & 63;
    const float* z = Cz + (size_t)rl * NZ; const float* tab = (const float*)(ws + WS_TAB);
    if (wave == 0) {
        for (int hh = 0; hh < 10; ++hh) {
            const int c = (hh < 8) ? hh * 64 + lane : 512 + (hh - 8) * 64 + lane;
            const float v = z[z_phys(c)]; const float ss = wave_sum(v * v); const float rs = 1.0f / sqrtf(ss * (1.f / 64.f) + EPS);
            const float g = (hh < 8) ? P.in[4][lane] : P.in[5][lane];
            const float y = v * rs * g, yp = __shfl_xor(y, 1);
            const int i = lane >> 1; const float cs = (i < 16) ? tab[0 * 2048 + rid * 16 + i] : tab[2 * 2048 + cid * 16 + (i - 16)], sn = (i < 16) ? tab[1 * 2048 + rid * 16 + i] : tab[3 * 2048 + cid * 16 + (i - 16)];
            const float o = (lane & 1) ? (yp * sn + y * cs) : (y * cs - yp * sn);
            if (hh < 8) ((bf16_t*)(ws + WS_Q))[(size_t)row * 512 + hh * 64 + lane] = (bf16_t)f2bf(o * C2_SELF);
            else ((bf16_t*)(ws + WS_K))[(size_t)row * 128 + (hh - 8) * 64 + lane] = (bf16_t)f2bf(o);
        }
        for (int c = lane; c < 128; c += 64) ((bf16_t*)(ws + WS_V))[(size_t)row * 128 + c] = (bf16_t)f2bf(z[z_phys(ZV + c)]);
    } else {
        for (int c = tid - 64; c < 512; c += 192) { ((bf16_t*)(ws + WS_U))[(size_t)row * 512 + c] = (bf16_t)f2bf(gelu_tanh(z[ZSU + c])); ((bf16_t*)(ws + WS_GV))[(size_t)row * 512 + c] = (bf16_t)f2bf(gelu_tanh(z[ZSV + c])); }
        for (int c = tid - 64; c < 1024; c += 192) { ((bf16_t*)(ws + WS_GA))[(size_t)row * 1024 + c] = (bf16_t)f2bf(sigmoidf_(z[ZGA + c])); ((bf16_t*)(ws + WS_GB))[(size_t)row * 1024 + c] = (bf16_t)f2bf(sigmoidf_(z[ZGB + c])); }
    }
}
__global__ void __launch_bounds__(256) nv_store_bf16(const float* C, bf16_t* O, size_t n, float scale) {
    for (size_t i = (size_t)blockIdx.x * 256 + threadIdx.x; i < n; i += (size_t)gridDim.x * 256) O[i] = (bf16_t)f2bf(C[i] * scale);
}
__global__ void __launch_bounds__(256) nv_attn(const bf16_t* Q, const bf16_t* Kb, const bf16_t* Vb, bf16_t* O) {
    extern __shared__ __attribute__((aligned(16))) unsigned char dyn[];
    float (*Qs)[65] = (float (*)[65])dyn; float (*Ks)[65] = Qs + 64; float (*Vs)[65] = Ks + 64; float (*Ps)[65] = Vs + 64;
    const int tid = threadIdx.x, tx = tid & 15, ty = tid >> 4, qb = blockIdx.x, h = blockIdx.y, b = blockIdx.z, kvh = h >> 2;
    const int lr = tid >> 2, lc = (tid & 3) * 16;
    { const bf16_t* src = Q + ((size_t)(b * SEQ + qb * 64 + lr)) * 512 + h * 64 + lc;
      for (int j = 0; j < 16; ++j) Qs[lr][lc + j] = bf2f(src[j]); }
    float m[4], l[4], o[4][4];
    for (int i = 0; i < 4; ++i) { m[i] = -1e30f; l[i] = 0.f; for (int j = 0; j < 4; ++j) o[i][j] = 0.f; }
    for (int kt = 0; kt < SEQ / 64; ++kt) {
        __syncthreads();
        { const bf16_t* ks = Kb + ((size_t)(b * SEQ + kt * 64 + lr)) * 128 + kvh * 64 + lc; const bf16_t* vs = Vb + ((size_t)(b * SEQ + kt * 64 + lr)) * 128 + kvh * 64 + lc;
          for (int j = 0; j < 16; ++j) { Ks[lr][lc + j] = bf2f(ks[j]); Vs[lr][lc + j] = bf2f(vs[j]); } }
        __syncthreads();
        float s[4][4];
        for (int i = 0; i < 4; ++i) for (int j = 0; j < 4; ++j) s[i][j] = 0.f;
        for (int d = 0; d < 64; ++d) { float a[4], bb[4];
            for (int i = 0; i < 4; ++i) { a[i] = Qs[ty * 4 + i][d]; bb[i] = Ks[tx * 4 + i][d]; }
            for (int i = 0; i < 4; ++i) for (int j = 0; j < 4; ++j) s[i][j] += a[i] * bb[j]; }
        for (int i = 0; i < 4; ++i) {
            float rm = fmaxf(fmaxf(s[i][0], s[i][1]), fmaxf(s[i][2], s[i][3]));
            for (int x = 1; x < 16; x <<= 1) rm = fmaxf(rm, __shfl_xor(rm, x));
            const float mn = fmaxf(m[i], rm), al = __builtin_amdgcn_exp2f(m[i] - mn);
            float rsum = 0.f;
            for (int j = 0; j < 4; ++j) { const float p = __builtin_amdgcn_exp2f(s[i][j] - mn); Ps[ty * 4 + i][tx * 4 + j] = p; rsum += p; }
            for (int x = 1; x < 16; x <<= 1) rsum += __shfl_xor(rsum, x);
            l[i] = l[i] * al + rsum; m[i] = mn;
            for (int j = 0; j < 4; ++j) o[i][j] *= al;
        }
        __syncthreads();
        for (int c = 0; c < 64; ++c) { float p[4], v[4];
            for (int i = 0; i < 4; ++i) { p[i] = Ps[ty * 4 + i][c]; v[i] = Vs[c][tx * 4 + i]; }
            for (int i = 0; i < 4; ++i) for (int j = 0; j < 4; ++j) o[i][j] += p[i] * v[j]; }
    }
    for (int i = 0; i < 4; ++i) { const float il = 1.0f / l[i]; bf16_t* dst = O + ((size_t)(b * SEQ + qb * 64 + ty * 4 + i)) * 512 + h * 64 + tx * 4;
        for (int j = 0; j < 4; ++j) dst[j] = (bf16_t)f2bf(o[i][j] * il); }
}
__global__ void __launch_bounds__(256) nv_sgu(PtrsIn P, unsigned char* ws) {
    extern __shared__ __attribute__((aligned(16))) unsigned char dyn[];
    float* vn = (float*)dyn;
    float* mu = vn + 128 * 129; float* rstd = mu + 128;
    const int tid = threadIdx.x, lane = tid & 63, wave = tid >> 6, ch = blockIdx.x, g = blockIdx.y;
    const bf16_t* GV = (const bf16_t*)(ws + WS_GV) + (size_t)ch * 128 * 512;
    for (int r = wave * 32; r < wave * 32 + 32; ++r) { float s = 0.f;
        float xv[8]; for (int j = 0; j < 8; ++j) { xv[j] = bf2f(GV[(size_t)r * 512 + j * 64 + lane]); s += xv[j]; }
        const float mean = wave_sum(s) * (1.f / 512.f); float q = 0.f;
        for (int j = 0; j < 8; ++j) { const float d = xv[j] - mean; q += d * d; }
        const float var = wave_sum(q) * (1.f / 512.f);
        if (lane == 0) { mu[r] = mean; rstd[r] = 1.0f / sqrtf(var + EPS); } }
    __syncthreads();
    for (int i = tid; i < 128 * 128; i += 256) { const int q = i >> 7, c = i & 127, cg = g * 128 + c;
        vn[q * 129 + c] = (bf2f(GV[(size_t)q * 512 + cg]) - mu[q]) * rstd[q] * P.in[7][cg] + P.in[8][cg]; }
    __syncthreads();
    const bf16_t* W = (const bf16_t*)(ws + WS_WSS) + (size_t)g * 128 * 128;
    const bf16_t* U = (const bf16_t*)(ws + WS_U) + (size_t)ch * 128 * 512; bf16_t* SG = (bf16_t*)(ws + WS_SG) + (size_t)ch * 128 * 512;
    const int c = tid & 127;
    for (int p = tid >> 7; p < 128; p += 2) { float a = 0.f;
        for (int q = 0; q < 128; ++q) a += bf2f(W[p * 128 + q]) * vn[q * 129 + c];
        a += P.in[10][g * 128 + p];
        SG[(size_t)p * 512 + g * 128 + c] = (bf16_t)f2bf(bf2f(U[(size_t)p * 512 + g * 128 + c]) * a); }
}
__global__ void __launch_bounds__(256) nv_merge(const float* C1, const float* C2, const bf16_t* GA, const bf16_t* GB, bf16_t* Mg, size_t n) {
    for (size_t i = (size_t)blockIdx.x * 256 + threadIdx.x; i < n; i += (size_t)gridDim.x * 256) Mg[i] = (bf16_t)f2bf(bf2f(GA[i]) * C1[i] + bf2f(GB[i]) * C2[i]);
}
__global__ void __launch_bounds__(256) nv_resid(const float* base, const float* C, float* out, size_t n) {
    for (size_t i = (size_t)blockIdx.x * 256 + threadIdx.x; i < n; i += (size_t)gridDim.x * 256) out[i] = base[i] + C[i];
}
__global__ void __launch_bounds__(256) nv_cross(const bf16_t* QC, const bf16_t* KVC, bf16_t* OC) {
    __shared__ float qs[512]; __shared__ float ps[4][256];
    const int tid = threadIdx.x, lane = tid & 63, h = tid >> 6, tok = blockIdx.x, b = tok / SEQ;
    for (int i = tid; i < 512; i += 256) qs[i] = bf2f(QC[(size_t)tok * 512 + i]);
    __syncthreads();
    float sc[4]; float mx = -1e30f;
    for (int j = 0; j < 4; ++j) { const int mrow = b * NMEM + j * 64 + lane; const bf16_t* kr = KVC + (size_t)mrow * 1024 + h * 128; float a = 0.f;
        for (int d = 0; d < 128; ++d) a += qs[h * 128 + d] * bf2f(kr[d]);
        sc[j] = a; mx = fmaxf(mx, a); }
    mx = wave_max(mx); float sum = 0.f;
    for (int j = 0; j < 4; ++j) { const float p = __builtin_amdgcn_exp2f(sc[j] - mx); ps[h][j * 64 + lane] = p; sum += p; }
    sum = wave_sum(sum);
    __syncthreads();
    for (int dd = 0; dd < 2; ++dd) { const int d = dd * 64 + lane; float a = 0.f;
        for (int mm = 0; mm < 256; ++mm) a += ps[h][mm] * bf2f(KVC[(size_t)(b * NMEM + mm) * 1024 + 512 + h * 128 + d]);
        OC[(size_t)tok * 512 + h * 128 + d] = (bf16_t)f2bf(a / sum); }
}
__global__ void __launch_bounds__(256) nv_moe_a(const bf16_t* XN3, unsigned char* ws) {
    __shared__ float xs[1024];
    const int tid = threadIdx.x, dest = blockIdx.x, tok = dest >> 1;
    const int e = ((const int*)(ws + WS_TOKINFO))[(size_t)dest * 2];
    for (int i = tid; i < 1024; i += 256) xs[i] = bf2f(XN3[(size_t)tok * 1024 + i]);
    __syncthreads();
    const bf16_t* W = (const bf16_t*)(ws + WS_WGU) + (size_t)e * 1024 * 1024; bf16_t* Hh = (bf16_t*)(ws + WS_H) + (size_t)dest * 512;
    for (int n = tid; n < 512; n += 256) { const bf16_t* wg = W + (size_t)(256 * (n >> 7) + (n & 127)) * 1024; const bf16_t* wu = wg + 128 * 1024; float a = 0.f, b = 0.f;
        for (int k = 0; k < 1024; k += 8) { const u32x4 g4 = *(const u32x4*)(wg + k), u4 = *(const u32x4*)(wu + k);
            const unsigned gg[4] = {g4.x, g4.y, g4.z, g4.w}, uu[4] = {u4.x, u4.y, u4.z, u4.w};
            for (int j = 0; j < 4; ++j) { a += xs[k + 2 * j] * bf2f((bf16_t)(gg[j] & 0xffff)) + xs[k + 2 * j + 1] * bf2f((bf16_t)(gg[j] >> 16)); b += xs[k + 2 * j] * bf2f((bf16_t)(uu[j] & 0xffff)) + xs[k + 2 * j + 1] * bf2f((bf16_t)(uu[j] >> 16)); } }
        Hh[n] = (bf16_t)f2bf(a * sigmoidf_(a) * b); }
}
__global__ void __launch_bounds__(256) nv_moe_b(unsigned char* ws) {
    __shared__ float hs[512];
    const int tid = threadIdx.x, dest = blockIdx.x;
    const int* ti = (const int*)(ws + WS_TOKINFO) + (size_t)dest * 2; const int e = ti[0]; const float w = __int_as_float(ti[1]);
    const bf16_t* Hh = (const bf16_t*)(ws + WS_H) + (size_t)dest * 512;
    for (int i = tid; i < 512; i += 256) hs[i] = bf2f(Hh[i]);
    __syncthreads();
    const bf16_t* W = (const bf16_t*)(ws + WS_WD) + (size_t)e * 1024 * 512; bf16_t* Y = (bf16_t*)(ws + WS_YS) + (size_t)dest * 1024;
    for (int n = tid; n < 1024; n += 256) { const bf16_t* wr = W + (size_t)n * 512; float a = 0.f;
        for (int k = 0; k < 512; k += 8) { const u32x4 g4 = *(const u32x4*)(wr + k); const unsigned gg[4] = {g4.x, g4.y, g4.z, g4.w};
            for (int j = 0; j < 4; ++j) a += hs[k + 2 * j] * bf2f((bf16_t)(gg[j] & 0xffff)) + hs[k + 2 * j + 1] * bf2f((bf16_t)(gg[j] >> 16)); }
        Y[n] = (bf16_t)f2bf(a * w); }
}

namespace pg8 {
typedef short bf16x8 __attribute__((ext_vector_type(8)));
#ifndef WGM_V
#define WGM_V 8
#endif
constexpr int BM = 256, BK = 64, HALF = 128, HTB = HALF * BK * 2, STAGE_BYTES = 8 * HTB, NXCD = 8, WGM = WGM_V;
__host__ __device__ __forceinline__ int lds_byte(int r, int c) { const int st = (r >> 4) * 2 + (c >> 5), rr = r & 15, cc = c & 31, ob = rr * 64 + cc * 2; return st * 1024 + (ob ^ (((ob >> 9) & 1) << 5)); }
__host__ __device__ __forceinline__ void stage_rc(int b, int& R, int& C) { const int st = b / 1024, sb = b % 1024, swz = sb ^ (((sb >> 9) & 1) << 5); R = (st >> 1) * 16 + swz / 64; C = (st & 1) * 32 + (swz % 64) / 2; }
__host__ __device__ __forceinline__ int perm32(int rho) { const int n = rho >> 4, i = rho & 15; return 8 * (i >> 2) + 4 * n + (i & 3); }
struct Unit { int pm, pn, kind, dup; };
__device__ __forceinline__ void tile_of(int L, int nM, int nN, int& pm, int& pn) {
    const int nwg = nM * nN; int wgid = L; { const int q = nwg / NXCD, r = nwg % NXCD, xcd = wgid % NXCD, off = wgid / NXCD; wgid = (xcd < r ? xcd * (q + 1) : r * (q + 1) + (xcd - r) * q) + off; }
    const int nig = WGM * nN, gid = wgid / nig, fm = gid * WGM, gsz = (nM - fm) < WGM ? (nM - fm) : WGM;
    pm = fm + ((wgid % nig) % gsz); pn = (wgid % nig) / gsz;
}
__device__ __forceinline__ unsigned cvt_pk_bf16(float lo, float hi) { unsigned r; asm volatile("v_cvt_pk_bf16_f32 %0, %1, %2" : "=v"(r) : "v"(lo), "v"(hi)); return r; }

template <class Epi, class Sched, bool ALIGN_EPI, bool GATHER, bool VARK = false>
__device__ __forceinline__ void gemm_phase(LAS unsigned char* lds, const int Kc, const Sched& S, const Epi& E, const unsigned stag_ticks = 0u) {
    static_assert(!(VARK && GATHER), "VARK computes its offsets arithmetically");
    unsigned k2c = (unsigned)Kc * 2u, k2n = (unsigned)Kc * 2u;
    const int tid = threadIdx.x, wid = __builtin_amdgcn_readfirstlane(tid >> 6), lane = tid & 63, wr = wid >> 2, wc = wid & 3, fr = lane & 15, fq = lane >> 4;
    const int K = Kc; int nt = K / BK;
    unsigned voffA[2], voffB[2]; int RA[2], CA2[2], RB[2];
#pragma unroll
    for (int i = 0; i < 2; ++i) { int R, C; stage_rc(tid * 16 + i * 8192, R, C); const int Rb = Epi::PERM ? ((R & ~31) + perm32(R & 31)) : R;
        voffA[i] = (unsigned)(R * K + C) * 2u; voffB[i] = (unsigned)(Rb * K + C) * 2u; RA[i] = R; CA2[i] = C * 2; RB[i] = Rb; }
    const size_t kstep = (size_t)(BK * 2);
    const size_t hstep = (size_t)HALF * K * 2;
    const unsigned ldsw = (unsigned)wid * 1024u;
    const int aoff = lds_byte(wr * 64 + fr, fq * 8), boff = lds_byte(wc * 32 + fr, fq * 8);
    unsigned vA[2][2] = {{0u, 0u}, {0u, 0u}}, vN[2][2] = {{0u, 0u}, {0u, 0u}};
#define PG8_SA(b, h) (((b) * 2 + (h)) * HTB)
#define PG8_SB(b, h) ((4 + (b) * 2 + (h)) * HTB)
#define PG8_STAGE(bufoff, gbase, voff) do { _Pragma("unroll") for (int _i = 0; _i < 2; ++_i) \
        __builtin_amdgcn_global_load_lds((const unsigned*)((const char*)(gbase) + (voff)[_i]), (LAS unsigned*)(lds + (bufoff) + ldsw + _i * 8192), 16, 0, 0); } while (0)
#define PG8_STAGEA(bufoff, gbase, h, nx) do { _Pragma("unroll") for (int _i = 0; _i < 2; ++_i) { \
        const unsigned _o = VARK ? (unsigned)((h) * HALF + RA[_i]) * ((nx) ? k2n : k2c) + (unsigned)CA2[_i] : (GATHER ? ((nx) ? vN[h][_i] : vA[h][_i]) : voffA[_i]); \
        __builtin_amdgcn_global_load_lds((const unsigned*)((const char*)(gbase) + ((GATHER || VARK) ? (size_t)0 : (size_t)(h) * hstep) + _o), (LAS unsigned*)(lds + (bufoff) + ldsw + _i * 8192), 16, 0, 0); } } while (0)
#define PG8_STAGEB(bufoff, gbase, h, nx) do { _Pragma("unroll") for (int _i = 0; _i < 2; ++_i) { \
        const unsigned _o = VARK ? (unsigned)((h) * HALF + RB[_i]) * ((nx) ? k2n : k2c) + (unsigned)CA2[_i] : voffB[_i]; \
        __builtin_amdgcn_global_load_lds((const unsigned*)((const char*)(gbase) + (VARK ? (size_t)0 : (size_t)(h) * hstep) + _o), (LAS unsigned*)(lds + (bufoff) + ldsw + _i * 8192), 16, 0, 0); } } while (0)
#define PG8_LDA(dst, b, h) do { _Pragma("unroll") for (int m = 0; m < 4; ++m) _Pragma("unroll") for (int k = 0; k < 2; ++k) dst[m][k] = *(const LAS bf16x8*)(lds + PG8_SA(b, h) + aoff + m * 2048 + k * 1024); } while (0)
#define PG8_LDB(dst, b, h) do { _Pragma("unroll") for (int n = 0; n < 2; ++n) _Pragma("unroll") for (int k = 0; k < 2; ++k) dst[n][k] = *(const LAS bf16x8*)(lds + PG8_SB(b, h) + boff + n * 2048 + k * 1024); } while (0)
#define PG8_MMA(ai, bj, At, Bt) do { __builtin_amdgcn_s_setprio(1); _Pragma("unroll") for (int m = 0; m < 4; ++m) _Pragma("unroll") for (int n = 0; n < 2; ++n) _Pragma("unroll") for (int k = 0; k < 2; ++k) \
        acc[ai][bj][m][n] = __builtin_amdgcn_mfma_f32_16x16x32_bf16(Bt[n][k], At[m][k], acc[ai][bj][m][n], 0, 0, 0); __builtin_amdgcn_s_setprio(0); } while (0)
#define PG8_WAIT_V(n) asm volatile("s_waitcnt vmcnt(" #n ")" ::: "memory")
#define PG8_WAIT_L(n) asm volatile("s_waitcnt lgkmcnt(" #n ")" ::: "memory")
#define PG8_BAR __builtin_amdgcn_s_barrier()
#define PG8_SCHED __builtin_amdgcn_sched_barrier(0)
#define PG8_GOFF(dst, ui_) do { if (GATHER) { _Pragma("unroll") for (int _h = 0; _h < 2; ++_h) _Pragma("unroll") for (int _i = 0; _i < 2; ++_i) dst[_h][_i] = S.goff((ui_), _h * HALF + RA[_i]) + (unsigned)CA2[_i]; } } while (0)
    Unit cur, nxt; int ui = 0;
    if (!S.next(0, cur)) return;
    if (stag_ticks) { const unsigned long long t0 = __builtin_amdgcn_s_memrealtime(), dl = (unsigned long long)((blockIdx.x >> 3) & 1) * stag_ticks;
      while (__builtin_amdgcn_s_memrealtime() - t0 < dl) __builtin_amdgcn_s_sleep(8); }
    f32x4 acc[2][2][4][2];
#pragma unroll
    for (int a = 0; a < 2; ++a)
#pragma unroll
        for (int b = 0; b < 2; ++b)
#pragma unroll
            for (int m = 0; m < 4; ++m)
#pragma unroll
                for (int n = 0; n < 2; ++n) acc[a][b][m][n] = (f32x4){0.f, 0.f, 0.f, 0.f};
    bf16x8 At[4][2], B0[2][2], B1[2][2];
    const char* cA = S.a_ptr(cur); const char* cB = S.b_ptr(cur);
    PG8_GOFF(vA, 0);
    if constexpr (VARK) { nt = S.k_of(cur) / BK; k2c = (unsigned)S.k_of(cur) * 2u; k2n = k2c; }
    PG8_STAGEB(PG8_SB(0, 0), cB, 0, false); PG8_STAGEB(PG8_SB(0, 1), cB, 1, false); PG8_STAGEA(PG8_SA(0, 0), cA, 0, false); PG8_STAGEA(PG8_SA(0, 1), cA, 1, false);
    if (wr == 1) PG8_BAR;
    PG8_WAIT_V(2); PG8_BAR;
    PG8_STAGEB(PG8_SB(1, 0), cB + kstep, 0, false); PG8_STAGEA(PG8_SA(1, 0), cA + kstep, 0, false); PG8_STAGEB(PG8_SB(1, 1), cB + kstep, 1, false);
    PG8_WAIT_V(6); PG8_BAR;
    for (;;) {
        const bool has_next = S.next(ui + 1, nxt);
        const char* nA = has_next ? S.a_ptr(nxt) : cA; const char* nB = has_next ? S.b_ptr(nxt) : cB;
        for (int t = 0; t < nt; t += 2) {
            const bool last = (t == nt - 2);
            const char* a1 = cA + (size_t)(t + 1) * kstep;
            const char* a2 = last ? nA : cA + (size_t)(t + 2) * kstep; const char* b2 = last ? nB : cB + (size_t)(t + 2) * kstep;
            const char* a3 = a2 + kstep; const char* b3 = b2 + kstep;
            if constexpr (VARK) { if (last) k2n = has_next ? (unsigned)S.k_of(nxt) * 2u : k2c; }
            if (GATHER && last) { if (has_next) { PG8_GOFF(vN, ui + 1); } else {
#pragma unroll
                for (int _h = 0; _h < 2; ++_h)
#pragma unroll
                    for (int _i = 0; _i < 2; ++_i) vN[_h][_i] = vA[_h][_i]; } }
            PG8_LDB(B0, 0, 0); PG8_LDB(B1, 0, 1); PG8_SCHED; PG8_LDA(At, 0, 0); PG8_STAGEA(PG8_SA(1, 1), a1, 1, false);
            PG8_WAIT_V(8); PG8_WAIT_L(0); PG8_BAR; PG8_MMA(0, 0, At, B0); PG8_MMA(0, 1, At, B1); PG8_BAR; PG8_SCHED;
            PG8_LDA(At, 0, 1); PG8_STAGEB(PG8_SB(0, 0), b2, 0, last); PG8_STAGEB(PG8_SB(0, 1), b2, 1, last); PG8_STAGEA(PG8_SA(0, 0), a2, 0, last);
            PG8_WAIT_V(8); PG8_WAIT_L(0); PG8_BAR; PG8_MMA(1, 0, At, B0); PG8_MMA(1, 1, At, B1); PG8_BAR; PG8_SCHED;
            PG8_LDB(B0, 1, 0); PG8_LDB(B1, 1, 1); PG8_SCHED; PG8_LDA(At, 1, 0); PG8_STAGEA(PG8_SA(0, 1), a2, 1, last);
            PG8_WAIT_V(8); PG8_WAIT_L(0); PG8_BAR; PG8_MMA(0, 0, At, B0); PG8_MMA(0, 1, At, B1); PG8_BAR; PG8_SCHED;
            PG8_LDA(At, 1, 1); PG8_STAGEB(PG8_SB(1, 0), b3, 0, last); PG8_STAGEB(PG8_SB(1, 1), b3, 1, last); PG8_STAGEA(PG8_SA(1, 0), a3, 0, last);
            PG8_WAIT_V(8); PG8_WAIT_L(0); PG8_BAR; PG8_MMA(1, 0, At, B0); PG8_MMA(1, 1, At, B1); PG8_BAR; PG8_SCHED;
        }
        if constexpr (ALIGN_EPI) { if (wr == 0) PG8_BAR; }
        if (!cur.dup) E(acc, cur, ui, wr, wc, fr, fq);
#ifdef PROBE_EDUP
        if (Epi::EDUP) { asm volatile("s_waitcnt vmcnt(0)" ::: "memory"); E(acc, cur, ui, wr, wc, fr, fq); }
#endif
        if (!has_next) break;
#pragma unroll
        for (int a = 0; a < 2; ++a)
#pragma unroll
            for (int b = 0; b < 2; ++b)
#pragma unroll
                for (int m = 0; m < 4; ++m)
#pragma unroll
                    for (int n = 0; n < 2; ++n) acc[a][b][m][n] = (f32x4){0.f, 0.f, 0.f, 0.f};
        cur = nxt; cA = nA; cB = nB; ++ui;
        if constexpr (VARK) { nt = S.k_of(cur) / BK; k2c = k2n; }
        if (GATHER) {
#pragma unroll
            for (int _h = 0; _h < 2; ++_h)
#pragma unroll
                for (int _i = 0; _i < 2; ++_i) vA[_h][_i] = vN[_h][_i]; }
        if constexpr (ALIGN_EPI) { if (wr == 1) PG8_BAR; }
    }
    PG8_WAIT_V(0);
    if constexpr (!ALIGN_EPI) { if (wr == 0) PG8_BAR; }
    PG8_BAR;
#undef PG8_SA
#undef PG8_SB
#undef PG8_STAGE
#undef PG8_STAGEA
#undef PG8_STAGEB
#undef PG8_LDA
#undef PG8_LDB
#undef PG8_MMA
#undef PG8_WAIT_V
#undef PG8_WAIT_L
#undef PG8_BAR
#undef PG8_SCHED
#undef PG8_GOFF
}
}
namespace attn_body {
using bf16=unsigned short;
using bf16x8=__attribute__((ext_vector_type(8)))short;
using s16x4=__attribute__((ext_vector_type(4)))short;
using f32x16=__attribute__((ext_vector_type(16)))float;
constexpr int SEQA=8192,D=64,QP=512,KP=128;
constexpr int NW=8,QBLK=32,QB=QBLK*NW,KVBLK=64,NQB=SEQA/QB;
__device__ __forceinline__ int crow(int r,int hi){return (r&3)+8*(r>>2)+4*hi;}
#define SBAR() __builtin_amdgcn_sched_barrier(0)
__device__ __forceinline__ void cmask(f32x16&p0,f32x16&p1,int jb,int qrel,int hi){
  const float NEG=-INFINITY; int kb=64*jb+4*hi;
  #pragma unroll
  for(int r=0;r<16;++r){int kv=kb+(r&3)+8*(r>>2); if(kv>qrel)p0[r]=NEG; if(kv+32>qrel)p1[r]=NEG;}
}

constexpr int NSLOT=3, SLOTB=8192;
constexpr int LDS_K=0, LDS_V=NSLOT*SLOTB, LDS_WS=2*NSLOT*SLOTB, LDS_OST=LDS_WS+NW*64*4, LDS_BYTES=LDS_OST+NW*4096;
constexpr float C2=0.125f*1.4426950408889634f;
__device__ __forceinline__ void glds16(const void*gsrc,unsigned lds_dst){unsigned keep;
  asm volatile("s_mov_b32 %0, m0\n\ts_mov_b32 m0, %2\n\ts_nop 0\n\tglobal_load_lds_dwordx4 %1, off\n\ts_mov_b32 m0, %0":"=&s"(keep):"v"(gsrc),"s"(lds_dst):"memory");}
__device__ __forceinline__ float max3f(float a,float b,float c){float r;asm("v_max3_f32 %0, %1, %2, %3":"=v"(r):"v"(a),"v"(b),"v"(c));return r;}
__device__ __forceinline__ float max2f(float a,float b){float r;asm("v_max_f32_e32 %0, %1, %2":"=v"(r):"v"(a),"v"(b));return r;}
__device__ __forceinline__ float fadd_s(float a,float b){float r;asm("v_add_f32_e32 %0, %1, %2":"=v"(r):"v"(a),"v"(b));return r;}
__device__ __forceinline__ float fsub_s(float a,float b){float r;asm("v_sub_f32_e32 %0, %1, %2":"=v"(r):"v"(a),"v"(b));return r;}
typedef float f32x2_t __attribute__((ext_vector_type(2))); typedef __bf16 bf16x2_t __attribute__((ext_vector_type(2)));
__device__ __forceinline__ unsigned cvtpk_s(float lo,float hi){f32x2_t v={lo,hi};bf16x2_t b=__builtin_convertvector(v,bf16x2_t);return __builtin_bit_cast(unsigned,b);}
#define WAIT_BAR(N) asm volatile("s_waitcnt vmcnt(" #N ") lgkmcnt(0)\n\ts_barrier":::"memory")

__device__ __forceinline__ void qkt(f32x16&p0,f32x16&p1,const char*Kslot,const bf16x8*qr,const f32x16&negm,int r32,int hi){
  const char*kb=Kslot+hi*1024+r32*16;
  #pragma unroll
  for(int d0=0;d0<4;++d0){
    const bf16x8 b0=*reinterpret_cast<const bf16x8*>(kb+d0*2048);
    const bf16x8 b1=*reinterpret_cast<const bf16x8*>(kb+d0*2048+512);
    if(d0==0){p0=__builtin_amdgcn_mfma_f32_32x32x16_bf16(b0,qr[0],negm,0,0,0);p1=__builtin_amdgcn_mfma_f32_32x32x16_bf16(b1,qr[0],negm,0,0,0);}
    else{p0=__builtin_amdgcn_mfma_f32_32x32x16_bf16(b0,qr[d0],p0,0,0,0);p1=__builtin_amdgcn_mfma_f32_32x32x16_bf16(b1,qr[d0],p1,0,0,0);}}
}
typedef __attribute__((address_space(3))) const char* lds_cptr;
typedef short v4i16_t __attribute__((ext_vector_type(4)));
__device__ __forceinline__ void kload8(bf16x8*kf,lds_cptr kp){
  kf[0]=*(const __attribute__((address_space(3))) bf16x8*)(kp);      kf[1]=*(const __attribute__((address_space(3))) bf16x8*)(kp+512);
  kf[2]=*(const __attribute__((address_space(3))) bf16x8*)(kp+2048); kf[3]=*(const __attribute__((address_space(3))) bf16x8*)(kp+2560);
  kf[4]=*(const __attribute__((address_space(3))) bf16x8*)(kp+4096); kf[5]=*(const __attribute__((address_space(3))) bf16x8*)(kp+4608);
  kf[6]=*(const __attribute__((address_space(3))) bf16x8*)(kp+6144); kf[7]=*(const __attribute__((address_space(3))) bf16x8*)(kp+6656);
}
__device__ __forceinline__ void kload2(bf16x8*kf,lds_cptr kp,int j){ kf[2*j]=*(const __attribute__((address_space(3))) bf16x8*)(kp+j*2048); kf[2*j+1]=*(const __attribute__((address_space(3))) bf16x8*)(kp+j*2048+512); }
__device__ __forceinline__ s16x4 vtr(lds_cptr p){ return __builtin_bit_cast(s16x4,__builtin_amdgcn_ds_read_tr16_b64_v4i16((__attribute__((address_space(3))) v4i16_t*)p)); }
__device__ __forceinline__ float rowmax(const f32x16&p0,const f32x16&p1){
  float a=max3f(p0[0],p0[1],p1[0]),b=max3f(p0[2],p0[3],p1[1]);a=max3f(a,p1[2],p1[3]);
  #pragma unroll
  for(int r=4;r<16;r+=4){a=max3f(a,p0[r],p0[r+1]);b=max3f(b,p0[r+2],p0[r+3]);a=max3f(a,p1[r],p1[r+1]);b=max3f(b,p1[r+2],p1[r+3]);}
  const float m=max2f(a,b);
  auto rr=__builtin_amdgcn_permlane32_swap(__float_as_uint(m),__float_as_uint(m),false,false);
  return max2f(__uint_as_float(rr[0]),__uint_as_float(rr[1]));
}
__device__ __forceinline__ void pv(f32x16*o,int vb,bf16x8 pa0,bf16x8 pa1,bf16x8 pa2,bf16x8 pa3){
  #pragma unroll
  for(int d0=0;d0<2;++d0){s16x4 lo[4],hi[4];
    #pragma unroll
    for(int ks=0;ks<4;++ks){
      asm volatile("ds_read_b64_tr_b16 %0,%1 offset:%c2":"=&v"(lo[ks]):"v"(vb),"i"(d0*4096+ks*1024):"memory");
      asm volatile("ds_read_b64_tr_b16 %0,%1 offset:%c2":"=&v"(hi[ks]):"v"(vb),"i"(d0*4096+ks*1024+512):"memory");}
    asm volatile("s_waitcnt lgkmcnt(0)":::"memory");SBAR();
    #define PK(k) (bf16x8){lo[k][0],lo[k][1],lo[k][2],lo[k][3],hi[k][0],hi[k][1],hi[k][2],hi[k][3]}
    o[d0]=__builtin_amdgcn_mfma_f32_32x32x16_bf16(pa0,PK(0),o[d0],0,0,0);
    o[d0]=__builtin_amdgcn_mfma_f32_32x32x16_bf16(pa1,PK(1),o[d0],0,0,0);
    o[d0]=__builtin_amdgcn_mfma_f32_32x32x16_bf16(pa2,PK(2),o[d0],0,0,0);
    o[d0]=__builtin_amdgcn_mfma_f32_32x32x16_bf16(pa3,PK(3),o[d0],0,0,0);
    #undef PK
  }
}

#ifndef ATTN_STORE16
#define ATTN_STORE16(p,v) (*(u32x4*)(p)=(v))
#endif
template<int THRL,bool FIXM> __device__ __forceinline__ void attn_unit(int b,int h,int kvh,int qb,const bf16*Q,const bf16*__restrict__ K,const bf16*__restrict__ V,bf16*O,char*shm,float cfix){
  const int tid=threadIdx.x,lane=tid&63,r32=lane&31,hi=lane>>5; const int wid=__builtin_amdgcn_readfirstlane(tid>>6);
  const long rowbase=(long)b*SEQA; const int q0=qb*QB;
  const bf16*Qw=Q+(rowbase+q0+wid*QBLK)*QP+h*D;
  const bf16*Kh=K+rowbase*KP+kvh*D,*Vh=V+rowbase*KP+kvh*D;
  const unsigned lds0=(unsigned)(uintptr_t)shm;
  float*wsf=(float*)(shm+LDS_WS)+wid*64;
  const bf16*ksrc=Kh+(long)lane*KP+wid*8;
  const bf16*vsrc=Vh+(long)(16*(wid&3)+(lane>>2))*KP+(wid>>2)*32+(lane&3)*8;
  const unsigned kdst=lds0+LDS_K+wid*1024, vdst=lds0+LDS_V+wid*1024;
  #define DMA_K(t,slot) glds16(ksrc+(long)(t)*KVBLK*KP,(unsigned)__builtin_amdgcn_readfirstlane(kdst+(slot)))
  #define DMA_V(t,slot) glds16(vsrc+(long)(t)*KVBLK*KP,(unsigned)__builtin_amdgcn_readfirstlane(vdst+(slot)))
  const int vb0=(int)(lds0+LDS_V)+((lane>>4)&1)*32+(lane&3)*8+(4*hi+((lane&15)>>2))*64;
  const char*Kbase=shm+LDS_K; bf16x8 kf[8];
  const lds_cptr shm3=(lds_cptr)shm; const lds_cptr kp0=shm3+LDS_K+hi*1024+r32*16; const lds_cptr vp0=shm3+LDS_V+((lane>>4)&1)*32+(lane&3)*8+(4*hi+((lane&15)>>2))*64;
  const int NT=SEQA/KVBLK;
  DMA_K(0,0);DMA_V(0,0);DMA_K(1,SLOTB);
  bf16x8 qr[4];
  #pragma unroll
  for(int d0=0;d0<4;++d0)qr[d0]=*reinterpret_cast<const bf16x8*>(&Qw[(long)r32*QP+d0*16+hi*8]);
  float mhat=FIXM?cfix:0.f,l_reg=0.f;f32x16 o[2];o[0]=f32x16{};o[1]=f32x16{};f32x16 negm=f32x16{};
  if(FIXM){
  #pragma unroll
  for(int r=0;r<16;++r)negm[r]=-cfix;}
  asm volatile("":"+v"(negm));
  const int qrel=wid*QBLK+r32;
  #define CMASK(P0,P1,t) do{}while(0)
  bool resc=false;
  #define START(P0,P1) do{ resc=false; \
    if(!FIXM){ const float rm=rowmax(P0,P1); const float dl=rm; mhat=fadd_s(mhat,dl); \
      _Pragma("unroll") for(int r=0;r<16;++r){P0[r]=fsub_s(P0[r],dl);P1[r]=fsub_s(P1[r],dl);} \
      _Pragma("unroll") for(int r=0;r<16;++r)negm[r]=-mhat; asm volatile("":"+v"(negm)); } \
    _Pragma("unroll") for(int r=0;r<16;++r)P0[r]=__builtin_amdgcn_exp2f(P0[r]); }while(0)
  #define RESC() do{ if(!FIXM&&resc){ asm volatile("s_waitcnt lgkmcnt(0)":::"memory"); \
      _Pragma("unroll") for(int d_=0;d_<2;++d_) _Pragma("unroll") for(int r=0;r<16;++r)o[d_][r]*=wsf[crow(r,hi)]; } }while(0)
  f32x16 pA0,pA1,pB0,pB1;
  int sl_prev=0,sl_cur=0,sl_next=SLOTB;
  #define ROT() do{sl_prev=sl_cur;sl_cur=sl_next;sl_next=(sl_next==(NSLOT-1)*SLOTB)?0:sl_next+SLOTB;}while(0)
  DMA_K(2,2*SLOTB);
  WAIT_BAR(3);
  qkt(pA0,pA1,Kbase,qr,negm,r32,hi);asm volatile("s_nop 15\n\ts_nop 7":"+v"(pA0),"+v"(pA1));CMASK(pA0,pA1,0);
  START(pA0,pA1);
  _Pragma("unroll") for(int r=0;r<16;++r)pA1[r]=__builtin_amdgcn_exp2f(pA1[r]);
  WAIT_BAR(0);
  DMA_K(3,0);DMA_V(1,SLOTB);
  ROT();
  kload8(kf,kp0+sl_cur);
  WAIT_BAR(2);
  s16x4 vlo[8],vhi[8]; u32x4 pw0,pw1,pw2,pw3;
  #define PKW(P,B) cvtpk_s(P[B],P[B+1])
  #define PAF(k) __builtin_bit_cast(bf16x8,pw##k)
  #define VFR(i) (bf16x8){vlo[i][0],vlo[i][1],vlo[i][2],vlo[i][3],vhi[i][0],vhi[i][1],vhi[i][2],vhi[i][3]}
  #define PIN(x) asm volatile("":"+v"(x))
  #define MX3(a,b,c) __builtin_fmaxf(__builtin_fmaxf((a),(b)),(c))
  #define GAPA(MF,A0,A1,A2,A3,W0,W1,PW) do{ MF; sacc+=A0; sacc+=A1; sacc+=A2; sacc+=A3; PIN(sacc); W0; W1; PIN(PW); SBAR(); }while(0)
  #define EX(v) __builtin_amdgcn_exp2f(v)
  #define GAPB(MF,X,B) do{ MF; X[B]=EX(X[B]); X[B+1]=EX(X[B+1]); X[B+2]=EX(X[B+2]); X[B+3]=EX(X[B+3]); PIN(X); SBAR(); }while(0)
  #define VRD(i) do{ vlo[i]=vtr(vp_+(((i)>>2)*4096+((i)&3)*1024)); vhi[i]=vtr(vp_+(((i)>>2)*4096+((i)&3)*1024+512)); }while(0)
  #define KRD(G,j) do{ if(G){ kload2(kf,kp0+sl_next,j); SBAR(); } }while(0)
  #define STEP(C0,C1,P0,P1,t,GK,GV,GL) do{ SBAR(); \
    const lds_cptr vp_=vp0+sl_prev; \
    VRD(0); SBAR(); float sacc=(P0[0]+P0[1]); \
    GAPA(C0=__builtin_amdgcn_mfma_f32_32x32x16_bf16(kf[0],qr[0],negm,0,0,0), P0[2],P0[3],P0[4],P0[5],     pw0[0]=PKW(P0,0), pw0[1]=PKW(P0,2), pw0); \
    VRD(4); SBAR(); GAPA(C1=__builtin_amdgcn_mfma_f32_32x32x16_bf16(kf[1],qr[0],negm,0,0,0), P0[6],P0[7],P0[8],P0[9],     pw0[2]=PKW(P0,4), pw0[3]=PKW(P0,6), pw0); \
    VRD(1); SBAR(); GAPA(C0=__builtin_amdgcn_mfma_f32_32x32x16_bf16(kf[2],qr[1],C0,0,0,0),   P0[10],P0[11],P0[12],P0[13], pw1[0]=PKW(P0,8), pw1[1]=PKW(P0,10), pw1); \
    VRD(5); SBAR(); GAPA(C1=__builtin_amdgcn_mfma_f32_32x32x16_bf16(kf[3],qr[1],C1,0,0,0),   P0[14],P0[15],P1[0],P1[1],   pw1[2]=PKW(P0,12),pw1[3]=PKW(P0,14), pw1); \
    VRD(2); SBAR(); GAPA(C0=__builtin_amdgcn_mfma_f32_32x32x16_bf16(kf[4],qr[2],C0,0,0,0),   P1[2],P1[3],P1[4],P1[5],     pw2[0]=PKW(P1,0), pw2[1]=PKW(P1,2), pw2); \
    VRD(6); SBAR(); GAPA(C1=__builtin_amdgcn_mfma_f32_32x32x16_bf16(kf[5],qr[2],C1,0,0,0),   P1[6],P1[7],P1[8],P1[9],     pw2[2]=PKW(P1,4), pw2[3]=PKW(P1,6), pw2); \
    VRD(3); SBAR(); GAPA(C0=__builtin_amdgcn_mfma_f32_32x32x16_bf16(kf[6],qr[3],C0,0,0,0),   P1[10],P1[11],P1[12],P1[13], pw3[0]=PKW(P1,8), pw3[1]=PKW(P1,10), pw3); \
    VRD(7); SBAR(); GAPA(C1=__builtin_amdgcn_mfma_f32_32x32x16_bf16(kf[7],qr[3],C1,0,0,0),   P1[14],P1[15],0.f,0.f,       pw3[2]=PKW(P1,12),pw3[3]=PKW(P1,14), pw3); \
    l_reg+=sacc; \
    if(GK){DMA_K((t)+3,sl_cur);} if(GV){DMA_V((t)+1,sl_next);} \
    CMASK(C0,C1,t); \
    if(!FIXM){ float a=MX3(C0[0],C0[1],C1[0]),b=MX3(C0[2],C0[3],C1[1]); a=MX3(a,C1[2],C1[3]); \
      _Pragma("unroll") for(int r=4;r<16;r+=4){a=MX3(a,C0[r],C0[r+1]);b=MX3(b,C0[r+2],C0[r+3]);a=MX3(a,C1[r],C1[r+1]);b=MX3(b,C1[r+2],C1[r+3]);} \
      float rm=__builtin_fmaxf(a,b); { auto rr=__builtin_amdgcn_permlane32_swap(__float_as_uint(rm),__float_as_uint(rm),false,false); rm=__builtin_fmaxf(__uint_as_float(rr[0]),__uint_as_float(rr[1])); } \
      resc=false; \
      if(__builtin_expect(__any(rm>(float)THRL),0)){ const float dl=__builtin_fmaxf(rm,0.f); mhat+=dl; \
        _Pragma("unroll") for(int r=0;r<16;++r){C0[r]-=dl;C1[r]-=dl;} \
        _Pragma("unroll") for(int r=0;r<16;++r)negm[r]=-mhat; asm volatile("":"+v"(negm)); \
        const float f=__builtin_amdgcn_exp2f(-dl); l_reg*=f; if(hi==0)wsf[r32]=f; resc=true; } } \
    SBAR(); \
    GAPB(o[0]=__builtin_amdgcn_mfma_f32_32x32x16_bf16(PAF(0),VFR(0),o[0],0,0,0), C0,0); \
    GAPB(o[1]=__builtin_amdgcn_mfma_f32_32x32x16_bf16(PAF(0),VFR(4),o[1],0,0,0), C0,4); \
    KRD(GL,0); GAPB(o[0]=__builtin_amdgcn_mfma_f32_32x32x16_bf16(PAF(1),VFR(1),o[0],0,0,0), C0,8); \
    KRD(GL,1); GAPB(o[1]=__builtin_amdgcn_mfma_f32_32x32x16_bf16(PAF(1),VFR(5),o[1],0,0,0), C0,12); \
    KRD(GL,2); GAPB(o[0]=__builtin_amdgcn_mfma_f32_32x32x16_bf16(PAF(2),VFR(2),o[0],0,0,0), C1,0); \
    KRD(GL,3); GAPB(o[1]=__builtin_amdgcn_mfma_f32_32x32x16_bf16(PAF(2),VFR(6),o[1],0,0,0), C1,4); \
    GAPB(o[0]=__builtin_amdgcn_mfma_f32_32x32x16_bf16(PAF(3),VFR(3),o[0],0,0,0), C1,8); \
    GAPB(o[1]=__builtin_amdgcn_mfma_f32_32x32x16_bf16(PAF(3),VFR(7),o[1],0,0,0), C1,12); \
    }while(0)
  int t=1;
  #undef CMASK
  #define CMASK(P0,P1,t) do{}while(0)
  for(;t+5<NT;t+=2){
    STEP(pB0,pB1,pA0,pA1,t,true,true,true);     WAIT_BAR(2); RESC(); ROT();
    STEP(pA0,pA1,pB0,pB1,t+1,true,true,true);   WAIT_BAR(2); RESC(); ROT();
  }
  #undef CMASK
  #define CMASK(P0,P1,t) do{}while(0)
  #define ENDW(tt) do{ if((tt)+3<NT){WAIT_BAR(2);} else if((tt)+2<NT){WAIT_BAR(1);} else {WAIT_BAR(0);} }while(0)
  for(;t+1<NT;t+=2){
    STEP(pB0,pB1,pA0,pA1,t,(t+3<NT),(t+1<NT),(t+1<NT));       ENDW(t);   RESC(); ROT();
    STEP(pA0,pA1,pB0,pB1,t+1,(t+4<NT),(t+2<NT),(t+2<NT));     ENDW(t+1); RESC(); ROT();
  }
  STEP(pB0,pB1,pA0,pA1,NT-1,false,false,false); RESC();
  { float sacc=pB0[0]+pB0[1]; _Pragma("unroll") for(int r=2;r<16;++r)sacc+=pB0[r]; _Pragma("unroll") for(int r=0;r<16;++r)sacc+=pB1[r]; l_reg+=sacc;
    pw0=(u32x4){PKW(pB0,0),PKW(pB0,2),PKW(pB0,4),PKW(pB0,6)};pw1=(u32x4){PKW(pB0,8),PKW(pB0,10),PKW(pB0,12),PKW(pB0,14)};pw2=(u32x4){PKW(pB1,0),PKW(pB1,2),PKW(pB1,4),PKW(pB1,6)};pw3=(u32x4){PKW(pB1,8),PKW(pB1,10),PKW(pB1,12),PKW(pB1,14)};
    SBAR(); pv(o,vb0+sl_cur,PAF(0),PAF(1),PAF(2),PAF(3)); }
  #undef PKW
  #undef PAF
  #undef VFR
  #undef PIN
  #undef MX3
  #undef GAPA
  #undef GAPB
  #undef EX
  #undef VRD
  #undef KRD
  #undef STEP
  #undef ENDW
  {auto rr=__builtin_amdgcn_permlane32_swap(__float_as_uint(l_reg),__float_as_uint(l_reg),false,false);l_reg=__uint_as_float(rr[0])+__uint_as_float(rr[1]);}
  if(hi==0)wsf[32+r32]=l_reg;asm volatile("s_waitcnt lgkmcnt(0)":::"memory");
  float rli[16];
  #pragma unroll
  for(int r=0;r<16;++r)rli[r]=__builtin_amdgcn_rcpf(wsf[32+crow(r,hi)]);
  bf16*Ow=O+(rowbase+q0+wid*QBLK)*QP+h*D;
  { bf16*stg=(bf16*)(shm+LDS_OST)+wid*2048;
    #pragma unroll
    for(int r=0;r<16;++r){const int orow=crow(r,hi);
      #pragma unroll
      for(int d0=0;d0<2;++d0)stg[orow*64+d0*32+r32]=(bf16)f2bf(o[d0][r]*rli[r]);}
    asm volatile("s_waitcnt lgkmcnt(0)":::"memory");
    #pragma unroll
    for(int i=0;i<4;++i){const int row=i*8+(lane>>3),ch=lane&7; const u32x4 v=*(const u32x4*)(stg+row*64+ch*8); ATTN_STORE16(Ow+(long)row*QP+ch*8,v);} }
  asm volatile("s_waitcnt lgkmcnt(0)\n\ts_barrier":::"memory");
  #undef DMA_K
  #undef DMA_V
  #undef CMASK
  #undef START
  #undef RESC
  #undef ROT
}
constexpr int ATTN_LDS_BYTES=LDS_BYTES;
#undef SBAR
#undef WAIT_BAR
}
constexpr int NWAVES = 8;
constexpr int RING_OFF = 0, RING_BYTES = 131072;
constexpr int SGU_ROWB = 1040, SGU_TILE_BYTES = 128 * SGU_ROWB;
constexpr int TBL_OFF = 133120;
constexpr int MOE_MAXU = 6;
constexpr int RSTBL_OFF = TBL_OFF + MOE_MAXU * 1024;
constexpr int UREC_OFF = RSTBL_OFF + MOE_MAXU * 1024;
constexpr int MISC_OFF = UREC_OFF + 512;
constexpr int LDS_BYTES = 147456;
static_assert(MISC_OFF + 128 <= LDS_BYTES, "LDS map");
constexpr int NPHASE = 13;

#define GAS __attribute__((address_space(1)))
typedef GAS unsigned gu32;
#define RLX_AGENT __ATOMIC_RELAXED, __HIP_MEMORY_SCOPE_AGENT

#define XB_TMO      128
#define XB_XCNT(j)  (256  + 64 * (j))
#define XB_XSUB(j)  (1280 + 64 * (j))
#define XB_XGEN(j)  (2304 + 64 * (j))
#define XB_TOP      3328
#define XB_TOPGEN   3392
#define XCD_BAR_WORDS 3456
#define XB_SPIN_CAP (1u << 18)
__device__ __forceinline__ unsigned xb_ld(unsigned* p)              { return __hip_atomic_load(p, __ATOMIC_RELAXED, __HIP_MEMORY_SCOPE_AGENT); }
__device__ __forceinline__ unsigned xb_add(unsigned* p, unsigned v) { return __hip_atomic_fetch_add(p, v, __ATOMIC_RELAXED, __HIP_MEMORY_SCOPE_AGENT); }
__device__ __forceinline__ unsigned xb_xcc_id() { return (unsigned)__builtin_amdgcn_s_getreg((3 << 11) | 20) & 0xFu; }
#define XB_SPIN(cond, bar) do { unsigned _sp = 0; while (cond) { __builtin_amdgcn_s_sleep(1); \
    if ((++_sp & 255u) == 0u) { if (xb_ld(&(bar)[XB_TMO])) break; if (_sp > XB_SPIN_CAP) { atomicAdd(&(bar)[XB_TMO], 1u); break; } } } } while (0)
struct XcdBarrier { unsigned* bar; unsigned x; volatile LAS unsigned* st; };
__device__ __forceinline__ XcdBarrier xcd_barrier_post(unsigned* bar, volatile LAS unsigned* st) {
    XcdBarrier b; b.bar = bar; b.x = xb_xcc_id(); b.st = st;
    if (threadIdx.x == 0) (void)xb_add(&bar[XB_XCNT(b.x)], 1u);
    return b;
}
__device__ __forceinline__ void xcd_barrier_complete(unsigned* bar, unsigned x, unsigned& nloc, unsigned& nx) {
    const unsigned G = gridDim.x * gridDim.y * gridDim.z;
    unsigned sum, cnt, mine, sp = 0u;
    for (;;) {
        sum = 0u; cnt = 0u; mine = 0u;
#pragma unroll
        for (unsigned j = 0; j < 16; ++j) { const unsigned c = xb_ld(&bar[XB_XCNT(j)]); sum += c; cnt += (c > 0u) ? 1u : 0u; mine = (j == x) ? c : mine; }
        if (sum == G) break;
        __builtin_amdgcn_s_sleep(1);
        if ((++sp & 255u) == 0u) { if (xb_ld(&bar[XB_TMO])) break; if (sp > XB_SPIN_CAP) { atomicAdd(&bar[XB_TMO], 1u); break; } }
    }
    nloc = mine > 0u ? mine : 1u; nx = cnt > 0u ? cnt : 1u;
}
__device__ __forceinline__ void xcd_barrier(const XcdBarrier& b) {
    asm volatile("s_waitcnt vmcnt(0)" ::: "memory");
    __syncthreads();
    if (threadIdx.x == 0) {
        unsigned* bar = b.bar;
        __builtin_amdgcn_s_waitcnt(0);
        unsigned nloc = b.st[0], nx = b.st[1];
        if (nloc == 0u) { xcd_barrier_complete(bar, b.x, nloc, nx); b.st[0] = nloc; b.st[1] = nx; }
        const unsigned old = xb_add(&bar[XB_XSUB(b.x)], 1u);
        const unsigned gen = old / nloc;
        if (old + 1u == (gen + 1u) * nloc) {
            __builtin_amdgcn_fence(__ATOMIC_RELEASE, "agent");
            asm volatile("s_waitcnt vmcnt(0)" ::: "memory");
            const unsigned og = xb_add(&bar[XB_TOP], 1u);
            const unsigned tg = og / nx;
            if (og + 1u == (tg + 1u) * nx) xb_add(&bar[XB_TOPGEN], 1u);
            else XB_SPIN(xb_ld(&bar[XB_TOPGEN]) == tg, bar);
            __builtin_amdgcn_fence(__ATOMIC_ACQUIRE, "agent");
            xb_add(&bar[XB_XGEN(b.x)], 1u);
            asm volatile("s_waitcnt vmcnt(0)" ::: "memory");
        } else {
            XB_SPIN(xb_ld(&bar[XB_XGEN(b.x)]) == gen, bar);
            __builtin_amdgcn_fence(__ATOMIC_ACQUIRE, "agent");
            asm volatile("s_waitcnt vmcnt(0)" ::: "memory");
        }
    }
    __syncthreads();
}

using pg8::Unit;
struct SchedPlain {
    const char* A; const char* Bt; int nM, nN, G, c, K;
    __device__ __forceinline__ bool next(int i, Unit& u) const { const long L = (long)i * G + c; if (L >= (long)nM * nN) return false; pg8::tile_of((int)L, nM, nN, u.pm, u.pn); u.kind = 0; u.dup = 0; return true; }
    __device__ __forceinline__ const char* a_ptr(const Unit& u) const { return A + (size_t)u.pm * 256 * K * 2; }
    __device__ __forceinline__ const char* b_ptr(const Unit& u) const { return Bt + (size_t)u.pn * 256 * K * 2; }
    __device__ __forceinline__ unsigned goff(int, int) const { return 0u; }
};
template <class B> struct SchedDup { B b;
    __device__ __forceinline__ bool next(int i, Unit& u) const { if (!b.next(i >> 1, u)) return false; u.dup = !(i & 1); return true; }
    __device__ __forceinline__ const char* a_ptr(const Unit& u) const { return b.a_ptr(u); }
    __device__ __forceinline__ const char* b_ptr(const Unit& u) const { return b.b_ptr(u); }
    __device__ __forceinline__ unsigned goff(int, int) const { return 0u; }
    __device__ __forceinline__ int k_of(const Unit& u) const { return b.k_of(u); }
};
struct SchedZ {
    const char* A; const char* Bt; int G, c;
    __device__ __forceinline__ bool next(int i, Unit& u) const { const long L = (long)i * G + c; if (L >= 912) return false;
        if (L < 896) pg8::tile_of((int)L, 128, 7, u.pm, u.pn); else { const int j = (int)L - 896; u.pm = 128 + (j >> 2); u.pn = 15 + (j & 3); } u.kind = 0; u.dup = 0; return true; }
    __device__ __forceinline__ const char* a_ptr(const Unit& u) const { return A + (size_t)u.pm * 256 * 2048; }
    __device__ __forceinline__ const char* b_ptr(const Unit& u) const { return Bt + (size_t)u.pn * 256 * 2048; }
    __device__ __forceinline__ unsigned goff(int, int) const { return 0u; }
};
struct SchedY {
    const char* ws; int G, c;
    __device__ __forceinline__ bool next(int i, Unit& u) const { const long L = (long)(i >> 2) * G + c; if (L >= 512) return false; pg8::tile_of((int)L, 128, 4, u.pm, u.pn); u.kind = i & 3; u.dup = 0; return true; }
    __device__ __forceinline__ int k_of(const Unit& u) const { return 1024 - 512 * (u.kind >> 1); }
    __device__ __forceinline__ const char* a_ptr(const Unit& u) const { const size_t mix = (size_t)(u.kind >> 1), sg = (size_t)(u.kind & 1);
        const size_t off = mix * (WS_ATT + sg * (WS_SG - WS_ATT) + (size_t)u.pm * 256 * 1024) + (1 - mix) * (WS_XN + (size_t)u.pm * 256 * 2048); return ws + off; }
    __device__ __forceinline__ const char* b_ptr(const Unit& u) const { const size_t mix = (size_t)(u.kind >> 1), sg = (size_t)(u.kind & 1);
        const size_t off = mix * (WS_WATT + sg * (WS_WSGU - WS_WATT) + (size_t)u.pn * 256 * 1024) + (1 - mix) * (WS_WZ + (size_t)(ZGA + sg * (ZGB - ZGA) + u.pn * 256) * 2048); return ws + off; }
    __device__ __forceinline__ unsigned goff(int, int) const { return 0u; }
};
struct SchedMoe {
    const LAS int* rec; const LAS unsigned* tbl; const char* A; const char* Bt; size_t a_panel_bytes, b_expert_bytes, b_tile_bytes; bool gather;
    __device__ __forceinline__ bool next(int i, Unit& u) const { if (i >= MOE_MAXU || rec[i * 8] == 0) return false; u.pm = rec[i * 8 + 1]; u.pn = rec[i * 8 + 2]; u.kind = rec[i * 8 + 3]; u.dup = 0; return true; }
    __device__ __forceinline__ const char* a_ptr(const Unit& u) const { return gather ? A : A + (size_t)u.pm * a_panel_bytes; }
    __device__ __forceinline__ const char* b_ptr(const Unit& u) const { return Bt + (size_t)u.kind * b_expert_bytes + (size_t)u.pn * b_tile_bytes; }
    __device__ __forceinline__ unsigned goff(int ui, int row) const { return tbl[ui * 256 + row]; }
};

#ifndef EPI_ST
#define EPI_ST 0
#endif
__device__ __forceinline__ void st16(void* p, u32x4 v) {
#if EPI_ST == 1
    asm volatile("global_store_dwordx4 %0, %1, off nt\n\ts_nop 1" :: "v"(p), "v"(v) : "memory");
#elif EPI_ST == 2
    asm volatile("global_store_dwordx4 %0, %1, off sc1\n\ts_nop 1" :: "v"(p), "v"(v) : "memory");
#else
    *(u32x4*)p = v;
#endif
}
typedef const f32x4 (&AccRef)[2][2][4][2];
typedef float f32x2 __attribute__((ext_vector_type(2)));
struct EpiZ {
    static constexpr bool PERM = true, EDUP = false;
    unsigned char* ws; const float* gq; const float* gk; const float* tab; const float* rs0;
    __device__ __forceinline__ void operator()(AccRef acc, const Unit& u, int, int wr, int wc, int fr, int fq) const {
        const int pn = u.pn;
#define EPIZ_R0(ai_) float r0m[4]; _Pragma("unroll") for (int m_ = 0; m_ < 4; ++m_) r0m[m_] = (X0_BF16 && pn < 15) ? rs0[u.pm * 256 + (ai_) * 128 + wr * 64 + m_ * 16 + fr] : 1.0f
        if (pn <= 2) {
            const bool isv = (pn == 2 && wc >= 2), isq = (pn < 2);
            bf16_t* dst; int ldc;
            if (isq) { dst = (bf16_t*)(ws + WS_Q) + (4 * pn + wc) * 64; ldc = 512; }
            else if (!isv) { dst = (bf16_t*)(ws + WS_K) + wc * 64; ldc = 128; }
            else { dst = (bf16_t*)(ws + WS_V) + (wc - 2) * 64; ldc = 128; }
            const float* g = isq ? gq : gk;
            f32x4 gv[2][2];
#pragma unroll
            for (int bj = 0; bj < 2; ++bj)
#pragma unroll
                for (int n = 0; n < 2; ++n) gv[bj][n] = *(const f32x4*)(g + 32 * bj + 8 * fq + 4 * n);
            const float osc = isq ? C2_SELF : 1.0f;
#pragma unroll
            for (int ai = 0; ai < 2; ++ai) {
                EPIZ_R0(ai);
                const int rid = (4 * u.pm + 2 * ai + wr) & 127;
                f32x4 csr = (f32x4){1.f, 1.f, 1.f, 1.f}, snr = (f32x4){0.f, 0.f, 0.f, 0.f}, csc[4], snc[4];
#pragma unroll
                for (int m = 0; m < 4; ++m) { csc[m] = csr; snc[m] = snr; }
                if (!isv) { const float* tr = tab + rid * 16 + 4 * fq; csr = *(const f32x4*)tr; snr = *(const f32x4*)(tr + 2048);
#pragma unroll
                    for (int m = 0; m < 4; ++m) { const float* tc = tab + 2 * 2048 + (16 * m + fr) * 16 + 4 * fq; csc[m] = *(const f32x4*)tc; snc[m] = *(const f32x4*)(tc + 2048); } }
#pragma unroll
                for (int m = 0; m < 4; ++m) {
                    const int row = u.pm * 256 + ai * 128 + wr * 64 + m * 16 + fr;
                    bf16_t* rowp = dst + (size_t)row * ldc + 8 * fq;
                    if (isv) {
#pragma unroll
                        for (int bj = 0; bj < 2; ++bj) { const f32x4 v0 = acc[ai][bj][m][0] * r0m[m], v1 = acc[ai][bj][m][1] * r0m[m];
                            u32x4 w; w.x = pg8::cvt_pk_bf16(v0[0], v0[1]); w.y = pg8::cvt_pk_bf16(v0[2], v0[3]); w.z = pg8::cvt_pk_bf16(v1[0], v1[1]); w.w = pg8::cvt_pk_bf16(v1[2], v1[3]);
                            st16(rowp + 32 * bj, w); }
                    } else {
                        float ss = 0.f;
#pragma unroll
                        for (int bj = 0; bj < 2; ++bj)
#pragma unroll
                            for (int n = 0; n < 2; ++n) { const f32x4 x = acc[ai][bj][m][n]; ss += (x[0] * x[0] + x[1] * x[1]) + (x[2] * x[2] + x[3] * x[3]); }
                        ss += __shfl_xor(ss, 16); ss += __shfl_xor(ss, 32);
                        const float rq = r0m[m]; const float rs = rq * osc / sqrtf(rq * rq * ss * (1.f / 64.f) + EPS);
#pragma unroll
                        for (int bj = 0; bj < 2; ++bj) {
                            const f32x4 cs = bj ? csc[m] : csr, sn = bj ? snc[m] : snr;
                            float o[8];
#pragma unroll
                            for (int n = 0; n < 2; ++n) { const f32x4 x = acc[ai][bj][m][n], gg = gv[bj][n];
                                const float y0 = x[0] * rs * gg[0], y1 = x[1] * rs * gg[1], y2 = x[2] * rs * gg[2], y3 = x[3] * rs * gg[3];
                                const float c0 = cs[2 * n], s0 = sn[2 * n], c1 = cs[2 * n + 1], s1 = sn[2 * n + 1];
                                o[4 * n + 0] = y0 * c0 - y1 * s0; o[4 * n + 1] = y0 * s0 + y1 * c0; o[4 * n + 2] = y2 * c1 - y3 * s1; o[4 * n + 3] = y2 * s1 + y3 * c1; }
                            u32x4 w; w.x = pg8::cvt_pk_bf16(o[0], o[1]); w.y = pg8::cvt_pk_bf16(o[2], o[3]); w.z = pg8::cvt_pk_bf16(o[4], o[5]); w.w = pg8::cvt_pk_bf16(o[6], o[7]);
                            st16(rowp + 32 * bj, w); }
                    }
                }
            }
        } else {
            bf16_t* dst; int ldc, row0; int act;
            if (pn < 5) { dst = (bf16_t*)(ws + WS_U) + (pn - 3) * 256; ldc = 512; act = 1; row0 = u.pm * 256; }
            else if (pn < 7) { dst = (bf16_t*)(ws + WS_GV) + (pn - 5) * 256; ldc = 512; act = 1; row0 = u.pm * 256; }
            else if (pn < 11) { dst = (bf16_t*)(ws + WS_GA) + (pn - 7) * 256; ldc = 1024; act = 2; row0 = u.pm * 256; }
            else if (pn < 15) { dst = (bf16_t*)(ws + WS_GB) + (pn - 11) * 256; ldc = 1024; act = 2; row0 = u.pm * 256; }
            else { dst = (bf16_t*)(ws + WS_KVC) + (pn - 15) * 256; ldc = 1024; act = 0; row0 = (u.pm - 128) * 256; }
#pragma unroll
            for (int ai = 0; ai < 2; ++ai) { EPIZ_R0(ai);
#pragma unroll
                for (int m = 0; m < 4; ++m) { bf16_t* rowp = dst + (size_t)(row0 + ai * 128 + wr * 64 + m * 16 + fr) * ldc + wc * 32 + 8 * fq;
#pragma unroll
                    for (int bj = 0; bj < 2; ++bj) { f32x2 o[4];
#pragma unroll
                        for (int n = 0; n < 2; ++n)
#pragma unroll
                            for (int hh = 0; hh < 2; ++hh) { const f32x2 x = (f32x2){acc[ai][bj][m][n][2 * hh], acc[ai][bj][m][n][2 * hh + 1]} * r0m[m];
                                if (act == 2) { const f32x2 t = x * (-LOG2E); f32x2 e; e.x = __builtin_amdgcn_exp2f(t.x); e.y = __builtin_amdgcn_exp2f(t.y); const f32x2 d = e + 1.0f;
                                    f32x2 r; r.x = __builtin_amdgcn_rcpf(d.x); r.y = __builtin_amdgcn_rcpf(d.y); o[2 * n + hh] = r; }
                                else if (act == 1) { const f32x2 x2 = x * x, t = (x2 * (-2.0f * LOG2E * 0.7978845608028654f * 0.044715f) + (-2.0f * LOG2E * 0.7978845608028654f)) * x;
                                    f32x2 e; e.x = __builtin_amdgcn_exp2f(t.x); e.y = __builtin_amdgcn_exp2f(t.y); const f32x2 d = e + 1.0f;
                                    f32x2 r; r.x = __builtin_amdgcn_rcpf(d.x); r.y = __builtin_amdgcn_rcpf(d.y); o[2 * n + hh] = x * r; }
                                else o[2 * n + hh] = x; }
                        u32x4 w; w.x = pg8::cvt_pk_bf16(o[0].x, o[0].y); w.y = pg8::cvt_pk_bf16(o[1].x, o[1].y); w.z = pg8::cvt_pk_bf16(o[2].x, o[2].y); w.w = pg8::cvt_pk_bf16(o[3].x, o[3].y);
                        st16(rowp + bj * 128, w); } } }
        }
#undef EPIZ_R0
    }
};
__device__ __forceinline__ void unpack8(const u32x4 g, float (&f)[8]) {
    f[0] = __uint_as_float(g.x << 16); f[1] = __uint_as_float(g.x & 0xffff0000u); f[2] = __uint_as_float(g.y << 16); f[3] = __uint_as_float(g.y & 0xffff0000u);
    f[4] = __uint_as_float(g.z << 16); f[5] = __uint_as_float(g.z & 0xffff0000u); f[6] = __uint_as_float(g.w << 16); f[7] = __uint_as_float(g.w & 0xffff0000u);
}
struct EpiY {
    static constexpr bool PERM = true, EDUP = false;
    bf16_t* GS; bf16_t* MG; const float* rs0;
    __device__ __forceinline__ void operator()(AccRef acc, const Unit& u, int, int wr, int wc, int fr, int fq) const {
#ifdef TEST_TRIV
        if (u.kind >= TEST_TRIV) { GS[(size_t)fr] = (bf16_t)acc[0][0][0][0][0]; return; }
#endif
        int gsl = (wr * 64 + fr) * 256 + wc * 32 + 8 * fq; asm volatile("" : "+v"(gsl));
        static_assert(GATE_U8, "two parked gate tiles need the 8-bit form"); gsl += (u.kind & 1) * 65536;
        if (u.kind < 2) {
            float r0[2][4];
#pragma unroll
            for (int ai = 0; ai < 2; ++ai)
#pragma unroll
                for (int m = 0; m < 4; ++m) r0[ai][m] = X0_BF16 ? rs0[u.pm * 256 + ai * 128 + wr * 64 + m * 16 + fr] : 1.0f;
#pragma unroll
            for (int ai = 0; ai < 2; ++ai)
#pragma unroll
                for (int m = 0; m < 4; ++m) {
#pragma unroll
                    for (int bj = 0; bj < 2; ++bj) { unsigned q[8];
#pragma unroll
                        for (int n = 0; n < 2; ++n)
#pragma unroll
                            for (int hh = 0; hh < 2; ++hh) { const f32x2 x = (f32x2){acc[ai][bj][m][n][2 * hh], acc[ai][bj][m][n][2 * hh + 1]};
                                const f32x2 t = x * (-LOG2E * r0[ai][m]); f32x2 e; e.x = __builtin_amdgcn_exp2f(t.x); e.y = __builtin_amdgcn_exp2f(t.y); const f32x2 d = e + 1.0f;
                                f32x2 r; r.x = __builtin_amdgcn_rcpf(d.x); r.y = __builtin_amdgcn_rcpf(d.y);
#if GATE_U8
                                const f32x2 s = r * 255.0f + 0.5f; q[4 * n + 2 * hh] = (unsigned)s.x; q[4 * n + 2 * hh + 1] = (unsigned)s.y; }
                        u32x2 w; w.x = q[0] | (q[1] << 8) | (q[2] << 16) | (q[3] << 24); w.y = q[4] | (q[5] << 8) | (q[6] << 16) | (q[7] << 24);
                        *(u32x2*)((unsigned char*)GS + gsl + (ai * 128 + m * 16) * 256 + bj * 128) = w; }
#else
                                q[4 * n + 2 * hh] = __float_as_uint(r.x); q[4 * n + 2 * hh + 1] = __float_as_uint(r.y); }
                        u32x4 w; w.x = pg8::cvt_pk_bf16(__uint_as_float(q[0]), __uint_as_float(q[1])); w.y = pg8::cvt_pk_bf16(__uint_as_float(q[2]), __uint_as_float(q[3]));
                        w.z = pg8::cvt_pk_bf16(__uint_as_float(q[4]), __uint_as_float(q[5])); w.w = pg8::cvt_pk_bf16(__uint_as_float(q[6]), __uint_as_float(q[7]));
                        st16(GS + gsl + (ai * 128 + m * 16) * 256 + bj * 128, w); }
#endif
                }
            return;
        }
        const bool add = (u.kind == 3);
        const size_t offb = (size_t)(u.pm * 256 + wr * 64 + fr) * 1024 + u.pn * 256 + wc * 32 + 8 * fq;
        u32x4 pp[2][2];
#if GATE_U8
        u32x2 gg[2][2];
#define EPIY_GLOAD(buf, bj, ai_, m_) gg[buf][bj] = *(const u32x2*)((const unsigned char*)GS + gsl + (ai_ * 128 + m_ * 16) * 256 + bj * 128)
#else
        u32x4 gg[2][2];
#define EPIY_GLOAD(buf, bj, ai_, m_) gg[buf][bj] = *(const u32x4*)(GS + gsl + (ai_ * 128 + m_ * 16) * 256 + bj * 128)
#endif
#define EPIY_LOAD(buf, s) do { const int ai_ = (s) >> 2, m_ = (s) & 3; _Pragma("unroll") for (int bj = 0; bj < 2; ++bj) { \
            EPIY_GLOAD(buf, bj, ai_, m_); \
            pp[buf][bj] = add ? *(const u32x4*)(MG + offb + (size_t)(ai_ * 128 + m_ * 16) * 1024 + bj * 128) : (u32x4){0u, 0u, 0u, 0u}; } } while (0)
        EPIY_LOAD(0, 0);
#pragma unroll
        for (int s = 0; s < 8; ++s) { const int ai = s >> 2, mm = s & 3, cb = s & 1;
            if (s + 1 < 8) { if (cb == 0) EPIY_LOAD(1, s + 1); else EPIY_LOAD(0, s + 1); }
#pragma unroll
            for (int bj = 0; bj < 2; ++bj) { float g[8], p[8]; unpack8(pp[cb][bj], p); float o[8];
#if GATE_U8
                { const unsigned g0 = gg[cb][bj].x, g1 = gg[cb][bj].y;
                  g[0] = (float)(g0 & 0xffu) * (1.f / 255.f); g[1] = (float)((g0 >> 8) & 0xffu) * (1.f / 255.f); g[2] = (float)((g0 >> 16) & 0xffu) * (1.f / 255.f); g[3] = (float)(g0 >> 24) * (1.f / 255.f);
                  g[4] = (float)(g1 & 0xffu) * (1.f / 255.f); g[5] = (float)((g1 >> 8) & 0xffu) * (1.f / 255.f); g[6] = (float)((g1 >> 16) & 0xffu) * (1.f / 255.f); g[7] = (float)(g1 >> 24) * (1.f / 255.f); }
#else
                unpack8(gg[cb][bj], g);
#endif
#pragma unroll
                for (int n = 0; n < 2; ++n)
#pragma unroll
                    for (int j = 0; j < 4; ++j) o[4 * n + j] = p[4 * n + j] + g[4 * n + j] * acc[ai][bj][mm][n][j];
                u32x4 w; w.x = pg8::cvt_pk_bf16(o[0], o[1]); w.y = pg8::cvt_pk_bf16(o[2], o[3]); w.z = pg8::cvt_pk_bf16(o[4], o[5]); w.w = pg8::cvt_pk_bf16(o[6], o[7]);
                st16(MG + offb + (size_t)(ai * 128 + mm * 16) * 1024 + bj * 128, w); } }
#undef EPIY_LOAD
#undef EPIY_GLOAD
    }
};
struct EpiRes {
    static constexpr bool PERM = false, EDUP = false;
    const float* base; float* out;
    __device__ __forceinline__ void operator()(AccRef acc, const Unit& u, int, int wr, int wc, int fr, int fq) const {
#pragma unroll
        for (int ai = 0; ai < 2; ++ai) {
            const size_t off0 = (size_t)(u.pm * 256 + ai * 128 + wr * 64 + fr) * 1024 + u.pn * 256 + wc * 32 + 4 * fq;
            f32x4 bb[4][2][2];
#pragma unroll
            for (int m = 0; m < 4; ++m)
#pragma unroll
                for (int bj = 0; bj < 2; ++bj)
#pragma unroll
                    for (int n = 0; n < 2; ++n) bb[m][bj][n] = *(const f32x4*)(base + off0 + (size_t)m * 16 * 1024 + bj * 128 + n * 16);
#pragma unroll
            for (int m = 0; m < 4; ++m)
#pragma unroll
                for (int bj = 0; bj < 2; ++bj)
#pragma unroll
                    for (int n = 0; n < 2; ++n) *(f32x4*)(out + off0 + (size_t)m * 16 * 1024 + bj * 128 + n * 16) = bb[m][bj][n] + acc[ai][bj][m][n]; }
    }
};
struct EpiBf16s {
    static constexpr bool PERM = true, EDUP = false;
    bf16_t* O; int ldc; float scale;
    __device__ __forceinline__ void operator()(AccRef acc, const Unit& u, int, int wr, int wc, int fr, int fq) const {
#pragma unroll
        for (int ai = 0; ai < 2; ++ai)
#pragma unroll
            for (int m = 0; m < 4; ++m) { bf16_t* rowp = O + (size_t)(u.pm * 256 + ai * 128 + wr * 64 + m * 16 + fr) * ldc + u.pn * 256 + wc * 32 + 8 * fq;
#pragma unroll
                for (int bj = 0; bj < 2; ++bj) { const f32x4 v0 = acc[ai][bj][m][0] * scale, v1 = acc[ai][bj][m][1] * scale;
                    u32x4 w; w.x = pg8::cvt_pk_bf16(v0[0], v0[1]); w.y = pg8::cvt_pk_bf16(v0[2], v0[3]); w.z = pg8::cvt_pk_bf16(v1[0], v1[1]); w.w = pg8::cvt_pk_bf16(v1[2], v1[3]);
                    st16(rowp + bj * 128, w); } }
    }
};
struct EpiMoeA {
    static constexpr bool PERM = true, EDUP = false;
    bf16_t* H; const LAS float* rstbl;
    __device__ __forceinline__ void operator()(AccRef acc, const Unit& u, int ui, int wr, int wc, int fr, int fq) const {
#pragma unroll
        for (int ai = 0; ai < 2; ++ai)
#pragma unroll
            for (int m = 0; m < 4; ++m) { bf16_t* rowp = H + (size_t)(u.pm * 256 + ai * 128 + wr * 64 + m * 16 + fr) * 512 + u.pn * 128 + wc * 32 + 8 * fq; float o[8];
                const float rs = ROUTE_MFMA ? rstbl[ui * 256 + ai * 128 + wr * 64 + m * 16 + fr] : 1.0f;
#pragma unroll
                for (int n = 0; n < 2; ++n)
#pragma unroll
                    for (int j = 0; j < 4; ++j) { const float g = acc[ai][0][m][n][j] * rs, up = acc[ai][1][m][n][j] * rs; o[4 * n + j] = g * __builtin_amdgcn_rcpf(1.0f + __builtin_amdgcn_exp2f(-LOG2E * g)) * up; }
                u32x4 w; w.x = pg8::cvt_pk_bf16(o[0], o[1]); w.y = pg8::cvt_pk_bf16(o[2], o[3]); w.z = pg8::cvt_pk_bf16(o[4], o[5]); w.w = pg8::cvt_pk_bf16(o[6], o[7]);
                st16(rowp, w); }
    }
};
struct EpiMoeB {
    static constexpr bool PERM = true, EDUP = false;
    const LAS int* rec; const int* list; bf16_t* YS;
    __device__ __forceinline__ void operator()(AccRef acc, const Unit& u, int ui, int wr, int wc, int fr, int fq) const {
        const int e = u.kind, r0 = rec[ui * 8 + 4], ne = rec[ui * 8 + 5];
        u32x2 ent[2][4];
#pragma unroll
        for (int ai = 0; ai < 2; ++ai)
#pragma unroll
            for (int m = 0; m < 4; ++m) { const int idx = r0 + ai * 128 + wr * 64 + m * 16 + fr; ent[ai][m] = (u32x2){0u, 0u};
                if (idx < ne) ent[ai][m] = *(const u32x2*)(list + ((size_t)e * LIST_CAP + idx) * 2); }
#pragma unroll
        for (int ai = 0; ai < 2; ++ai)
#pragma unroll
            for (int m = 0; m < 4; ++m) { const int idx = r0 + ai * 128 + wr * 64 + m * 16 + fr;
                if (idx < ne) { const int dest = (int)ent[ai][m].x; const float w = __uint_as_float(ent[ai][m].y);
                    bf16_t* rowp = YS + (size_t)dest * 1024 + u.pn * 256 + wc * 32 + 8 * fq;
#pragma unroll
                    for (int bj = 0; bj < 2; ++bj) { const f32x4 v0 = acc[ai][bj][m][0] * w, v1 = acc[ai][bj][m][1] * w;
                        u32x4 wv; wv.x = pg8::cvt_pk_bf16(v0[0], v0[1]); wv.y = pg8::cvt_pk_bf16(v0[2], v0[3]); wv.z = pg8::cvt_pk_bf16(v1[0], v1[1]); wv.w = pg8::cvt_pk_bf16(v1[2], v1[3]);
                        st16(rowp + bj * 128, wv); } } }
    }
};

struct EpiX1 {
    static constexpr bool PERM = true, EDUP = true;
    const float* x; const bf16_t* XB0; bf16_t* XB; float* ssq;
    __device__ __forceinline__ void operator()(AccRef acc, const Unit& u, int, int wr, int wc, int fr, int fq) const {
        const int rowb = u.pm * 256 + wr * 64 + fr; const size_t offb = (size_t)rowb * 1024 + u.pn * 256 + wc * 32 + 8 * fq;
#if X0_BF16
        u32x4 xq[2][2];
#define EPIX1_LOAD(buf, s) do { const int ai_ = (s) >> 2, m_ = (s) & 3; _Pragma("unroll") for (int bj = 0; bj < 2; ++bj) xq[buf][bj] = *(const u32x4*)(XB0 + offb + (size_t)(ai_ * 128 + m_ * 16) * 1024 + bj * 128); } while (0)
#else
        f32x4 xb[2][2][2];
#define EPIX1_LOAD(buf, s) do { const int ai_ = (s) >> 2, m_ = (s) & 3; _Pragma("unroll") for (int bj = 0; bj < 2; ++bj) _Pragma("unroll") for (int n = 0; n < 2; ++n) \
            xb[buf][bj][n] = *(const f32x4*)(x + offb + (size_t)(ai_ * 128 + m_ * 16) * 1024 + bj * 128 + n * 4); } while (0)
#endif
        EPIX1_LOAD(0, 0);
#pragma unroll
        for (int s = 0; s < 8; ++s) { const int ai = s >> 2, mm = s & 3, cb = s & 1;
            if (s + 1 < 8) { if (cb == 0) EPIX1_LOAD(1, s + 1); else EPIX1_LOAD(0, s + 1); }
            float ss = 0.f;
#pragma unroll
            for (int bj = 0; bj < 2; ++bj) {
#if X0_BF16
                float b[8]; unpack8(xq[cb][bj], b); const f32x4 v0 = (f32x4){b[0], b[1], b[2], b[3]} + acc[ai][bj][mm][0], v1 = (f32x4){b[4], b[5], b[6], b[7]} + acc[ai][bj][mm][1];
#else
                const f32x4 v0 = xb[cb][bj][0] + acc[ai][bj][mm][0], v1 = xb[cb][bj][1] + acc[ai][bj][mm][1];
#endif
                ss += (v0[0] * v0[0] + v0[1] * v0[1]) + (v0[2] * v0[2] + v0[3] * v0[3]) + (v1[0] * v1[0] + v1[1] * v1[1]) + (v1[2] * v1[2] + v1[3] * v1[3]);
                u32x4 w; w.x = pg8::cvt_pk_bf16(v0[0], v0[1]); w.y = pg8::cvt_pk_bf16(v0[2], v0[3]); w.z = pg8::cvt_pk_bf16(v1[0], v1[1]); w.w = pg8::cvt_pk_bf16(v1[2], v1[3]);
                st16(XB + offb + (size_t)(ai * 128 + mm * 16) * 1024 + bj * 128, w); }
            ss += __shfl_xor(ss, 16); ss += __shfl_xor(ss, 32);
            if (fq == 0) ssq[(size_t)(rowb + ai * 128 + mm * 16) * 16 + u.pn * 4 + wc] = ss; }
#undef EPIX1_LOAD
    }
};
struct EpiQC {
    static constexpr bool PERM = true, EDUP = false;
    bf16_t* O; const float* ssq; float scale;
    __device__ __forceinline__ void operator()(AccRef acc, const Unit& u, int, int wr, int wc, int fr, int fq) const {
        f32x4 q[2][4];
#pragma unroll
        for (int ai = 0; ai < 2; ++ai)
#pragma unroll
            for (int m = 0; m < 4; ++m) q[ai][m] = *(const f32x4*)(ssq + (size_t)(u.pm * 256 + ai * 128 + wr * 64 + m * 16 + fr) * 16 + 4 * fq);
#pragma unroll
        for (int ai = 0; ai < 2; ++ai)
#pragma unroll
            for (int m = 0; m < 4; ++m) { float s = (q[ai][m][0] + q[ai][m][1]) + (q[ai][m][2] + q[ai][m][3]); s += __shfl_xor(s, 16); s += __shfl_xor(s, 32);
                const float rs = scale / sqrtf(s * (1.f / 1024.f) + EPS);
                bf16_t* rowp = O + (size_t)(u.pm * 256 + ai * 128 + wr * 64 + m * 16 + fr) * 512 + u.pn * 256 + wc * 32 + 8 * fq;
#pragma unroll
                for (int bj = 0; bj < 2; ++bj) { const f32x4 v0 = acc[ai][bj][m][0] * rs, v1 = acc[ai][bj][m][1] * rs;
                    u32x4 w; w.x = pg8::cvt_pk_bf16(v0[0], v0[1]); w.y = pg8::cvt_pk_bf16(v0[2], v0[3]); w.z = pg8::cvt_pk_bf16(v1[0], v1[1]); w.w = pg8::cvt_pk_bf16(v1[2], v1[3]);
                    st16(rowp + bj * 128, w); } }
    }
};
struct EpiX2 {
    static constexpr bool PERM = true, EDUP = false;
    const bf16_t* XB; float* out; bf16_t* XB2;
    __device__ __forceinline__ void operator()(AccRef acc, const Unit& u, int, int wr, int wc, int fr, int fq) const {
        const size_t offb = (size_t)(u.pm * 256 + wr * 64 + fr) * 1024 + u.pn * 256 + wc * 32 + 8 * fq;
        u32x4 xb[2][2];
#define EPIX2_LOAD(buf, s) do { const int ai_ = (s) >> 2, m_ = (s) & 3; _Pragma("unroll") for (int bj = 0; bj < 2; ++bj) xb[buf][bj] = *(const u32x4*)(XB + offb + (size_t)(ai_ * 128 + m_ * 16) * 1024 + bj * 128); } while (0)
        EPIX2_LOAD(0, 0);
#pragma unroll
        for (int s = 0; s < 8; ++s) { const int ai = s >> 2, mm = s & 3, cb = s & 1;
            if (s + 1 < 8) { if (cb == 0) EPIX2_LOAD(1, s + 1); else EPIX2_LOAD(0, s + 1); }
#pragma unroll
            for (int bj = 0; bj < 2; ++bj) { float b[8]; unpack8(xb[cb][bj], b);
                const f32x4 v0 = (f32x4){b[0], b[1], b[2], b[3]} + acc[ai][bj][mm][0], v1 = (f32x4){b[4], b[5], b[6], b[7]} + acc[ai][bj][mm][1];
                const size_t o_ = offb + (size_t)(ai * 128 + mm * 16) * 1024 + bj * 128;
                if (X2_BF16) { u32x4 w; w.x = pg8::cvt_pk_bf16(v0[0], v0[1]); w.y = pg8::cvt_pk_bf16(v0[2], v0[3]); w.z = pg8::cvt_pk_bf16(v1[0], v1[1]); w.w = pg8::cvt_pk_bf16(v1[2], v1[3]); st16(XB2 + o_, w); }
                else { *(f32x4*)(out + o_) = v0; *(f32x4*)(out + o_ + 4) = v1; } } }
#undef EPIX2_LOAD
    }
};
typedef short v4i16_t __attribute__((ext_vector_type(4)));
typedef short bf16x8_t __attribute__((ext_vector_type(8)));
typedef float f32x16_t __attribute__((ext_vector_type(16)));
__device__ __forceinline__ v4i16_t lds_tr16(LAS unsigned char* p) { return __builtin_amdgcn_ds_read_tr16_b64_v4i16((LAS v4i16_t*)p); }

__device__ __forceinline__ void sgu_unit(LAS unsigned char* lds, unsigned char* ws, const PtrsIn& P, int ch) {
    const int tid = threadIdx.x, lane = tid & 63, wave = __builtin_amdgcn_readfirstlane(tid >> 6), fr = lane & 15, fq = lane >> 4;
    {
        const int row = tid >> 2, q4 = tid & 3;
        const u32x4* src = (const u32x4*)((const bf16_t*)(ws + WS_GV) + ((size_t)ch * 128 + row) * 512 + q4 * 128);
        u32x4 raw[16];
#pragma unroll
        for (int j = 0; j < 16; ++j) raw[j] = src[j];
        float s = 0.f;
#pragma unroll
        for (int j = 0; j < 16; ++j) { float f[8]; unpack8(raw[j], f);
#pragma unroll
            for (int k = 0; k < 8; ++k) s += f[k]; }
        s += __shfl_xor(s, 1); s += __shfl_xor(s, 2);
        const float mean = s * (1.f / 512.f); float q = 0.f;
#pragma unroll
        for (int j = 0; j < 16; ++j) { float f[8]; unpack8(raw[j], f);
#pragma unroll
            for (int k = 0; k < 8; ++k) { const float d = f[k] - mean; q += d * d; } }
        q += __shfl_xor(q, 1); q += __shfl_xor(q, 2);
        const float rstd = 1.0f / sqrtf(q * (1.f / 512.f) + EPS);
        const float* lg = P.in[7] + q4 * 128; const float* lb = P.in[8] + q4 * 128;
        LAS unsigned char* dst = lds + row * SGU_ROWB + q4 * 256;
#pragma unroll
        for (int j = 0; j < 16; ++j) { float f[8]; unpack8(raw[j], f);
            const f32x4 g0 = *(const f32x4*)(lg + 8 * j), g1 = *(const f32x4*)(lg + 8 * j + 4), b0 = *(const f32x4*)(lb + 8 * j), b1 = *(const f32x4*)(lb + 8 * j + 4);
            u32x4 w; w.x = pg8::cvt_pk_bf16((f[0] - mean) * rstd * g0[0] + b0[0], (f[1] - mean) * rstd * g0[1] + b0[1]); w.y = pg8::cvt_pk_bf16((f[2] - mean) * rstd * g0[2] + b0[2], (f[3] - mean) * rstd * g0[3] + b0[3]);
            w.z = pg8::cvt_pk_bf16((f[4] - mean) * rstd * g1[0] + b1[0], (f[5] - mean) * rstd * g1[1] + b1[1]); w.w = pg8::cvt_pk_bf16((f[6] - mean) * rstd * g1[2] + b1[2], (f[7] - mean) * rstd * g1[3] + b1[3]);
            *(LAS u32x4*)(dst + j * 16) = w; }
    }
    __syncthreads();
    const int i16 = lane & 15;
    LAS unsigned char* trb = lds + (8 * fq + (i16 >> 2)) * SGU_ROWB + (i16 & 3) * 8;
    const int p = 16 * wave + fr; const size_t tok = (size_t)ch * 128 + p;
    u32x2 uu[4][8]; float bsv[4];
#pragma unroll
    for (int g = 0; g < 4; ++g) { const bf16_t* U = (const bf16_t*)(ws + WS_U) + tok * 512 + g * 128 + 4 * fq; bsv[g] = P.in[10][g * 128 + p];
#pragma unroll
        for (int nt = 0; nt < 8; ++nt) uu[g][nt] = *(const u32x2*)(U + 16 * nt); }
#pragma unroll
    for (int g = 0; g < 4; ++g) {
        const bf16_t* W = (const bf16_t*)(ws + WS_WSS) + ((size_t)g * 128 + p) * 128 + 8 * fq;
        bf16x8_t af[4];
#pragma unroll
        for (int ks = 0; ks < 4; ++ks) af[ks] = *(const bf16x8_t*)(W + 32 * ks);
        const float bs = bsv[g];
        f32x4 acc[8];
#pragma unroll
        for (int nt = 0; nt < 8; ++nt) { acc[nt] = (f32x4){0.f, 0.f, 0.f, 0.f};
#pragma unroll
            for (int ks = 0; ks < 4; ++ks) { LAS unsigned char* a = trb + ks * 32 * SGU_ROWB + (g * 128 + 16 * nt) * 2;
                const v4i16_t lo = lds_tr16(a), hi = lds_tr16(a + 4 * SGU_ROWB);
                const bf16x8_t bfr = (bf16x8_t){lo[0], lo[1], lo[2], lo[3], hi[0], hi[1], hi[2], hi[3]};
                acc[nt] = __builtin_amdgcn_mfma_f32_16x16x32_bf16(bfr, af[ks], acc[nt], 0, 0, 0); } }
        bf16_t* SG = (bf16_t*)(ws + WS_SG) + tok * 512 + g * 128 + 4 * fq;
#pragma unroll
        for (int nt = 0; nt < 8; ++nt) { const u32x2 u2 = uu[g][nt];
            const float u0 = __uint_as_float(u2.x << 16), u1 = __uint_as_float(u2.x & 0xffff0000u), u2f = __uint_as_float(u2.y << 16), u3 = __uint_as_float(u2.y & 0xffff0000u);
            u32x2 o; o.x = pg8::cvt_pk_bf16(u0 * (acc[nt][0] + bs), u1 * (acc[nt][1] + bs)); o.y = pg8::cvt_pk_bf16(u2f * (acc[nt][2] + bs), u3 * (acc[nt][3] + bs));
            *(u32x2*)(SG + 16 * nt) = o; }
    }
    __syncthreads();
}

__device__ __forceinline__ void phase2_sgu_attn(LAS unsigned char* lds, unsigned char* lds_generic, unsigned char* ws, const PtrsIn& P, int vcu, int G) {
    for (int ch = vcu; ch < M / 128; ch += G) sgu_unit(lds, ws, P, ch);
    const int upc = (1024 + G - 1) / G;
    float cfix; { const int l64 = threadIdx.x & 63; const float mq = wave_max(fabsf(P.in[4][l64])), mk = wave_max(fabsf(P.in[5][l64])); cfix = __int_as_float(__builtin_amdgcn_readfirstlane(__float_as_int(C2_SELF * 64.0f * mq * mk))); }
    const bool fixm = ATT_FIXM && (cfix < 60.0f);
    const int nmoe = IT_TOTAL - IT_P0, per = (nmoe + G - 1) / G, it0 = IT_P0 + vcu * per, it1 = (it0 + per < IT_TOTAL) ? it0 + per : IT_TOTAL, slot = vcu % upc;
    for (int i = 0; i < upc; ++i) { const int U = vcu * upc + i;
        if (U < 1024) { const int bkv = U >> 7, jj = U & 127, hl = jj >> 5, qb = jj & 31, b = bkv >> 1, kvh = bkv & 1;
            if (fixm) attn_body::attn_unit<8, true>(b, kvh * 4 + hl, kvh, qb, (const bf16_t*)(ws + WS_Q), (const bf16_t*)(ws + WS_K), (const bf16_t*)(ws + WS_V), (bf16_t*)(ws + WS_ATT), (char*)lds_generic + RING_OFF, cfix);
            else attn_body::attn_unit<8, false>(b, kvh * 4 + hl, kvh, qb, (const bf16_t*)(ws + WS_Q), (const bf16_t*)(ws + WS_K), (const bf16_t*)(ws + WS_V), (bf16_t*)(ws + WS_ATT), (char*)lds_generic + RING_OFF, 0.f); }
        if (MOE_CONV_IN_P2 && i == slot) {
            int tid2 = threadIdx.x; asm volatile("" : "+v"(tid2));
            const int lane2 = tid2 & 63, wave2 = __builtin_amdgcn_readfirstlane(tid2 >> 6);
            LAS float* scr = (LAS float*)(lds + RING_OFF + wave2 * 16384);
            for (int it = it0 + wave2; it < it1; it += NWAVES) p0_weight_item(P, ws, scr, it, lane2);
            __syncthreads(); } }
}

__device__ __forceinline__ void cross_stage_kv(unsigned lds0, const bf16_t* KVC, int b, int h, int wave, int lane) {
#pragma unroll
    for (int j = 0; j < 8; ++j) { const int c = 2 * wave + (j >> 2), rb = j & 3;
        attn_body::glds16(KVC + (size_t)(b * NMEM + rb * 64 + lane) * 1024 + h * 128 + c * 8, (unsigned)__builtin_amdgcn_readfirstlane(lds0 + c * 4096 + rb * 1024)); }
#pragma unroll
    for (int j = 0; j < 8; ++j) { const int pc = wave * 8 + j, db = pc >> 4, r0 = (pc & 15) * 16;
        attn_body::glds16(KVC + (size_t)(b * NMEM + r0 + (lane >> 2)) * 1024 + 512 + h * 128 + db * 32 + (lane & 3) * 8, (unsigned)__builtin_amdgcn_readfirstlane(lds0 + 65536 + db * 16384 + r0 * 64)); }
}
__device__ __forceinline__ void cross_unit(LAS unsigned char* lds, const bf16_t* QC, bf16_t* OC, int row0, int h) {
    const int tid = threadIdx.x, lane = tid & 63, wave = __builtin_amdgcn_readfirstlane(tid >> 6), r32 = lane & 31, hi = lane >> 5;
    const bf16_t* Qw = QC + (size_t)(row0 + 32 * wave + r32) * 512 + h * 128 + 8 * hi;
    bf16x8_t qr[8];
#pragma unroll
    for (int ds = 0; ds < 8; ++ds) qr[ds] = *(const bf16x8_t*)(Qw + 16 * ds);
    f32x16_t p[8];
    const LAS unsigned char* kb0 = lds + hi * 4096 + r32 * 16;
#pragma unroll
    for (int kb = 0; kb < 8; ++kb) { p[kb] = f32x16_t{};
#pragma unroll
        for (int ds = 0; ds < 8; ++ds) { const bf16x8_t kf = *(const LAS bf16x8_t*)(kb0 + ds * 8192 + kb * 512); p[kb] = __builtin_amdgcn_mfma_f32_32x32x16_bf16(kf, qr[ds], p[kb], 0, 0, 0); }
        __builtin_amdgcn_sched_barrier(0); }
    float mx = -1e30f;
#pragma unroll
    for (int kb = 0; kb < 8; ++kb)
#pragma unroll
        for (int r = 0; r < 16; ++r) mx = fmaxf(mx, p[kb][r]);
    { auto rr = __builtin_amdgcn_permlane32_swap(__float_as_uint(mx), __float_as_uint(mx), false, false); mx = fmaxf(__uint_as_float(rr[0]), __uint_as_float(rr[1])); }
    float l = 0.f;
    u32x4 pw[16];
#pragma unroll
    for (int kb = 0; kb < 8; ++kb) {
#pragma unroll
        for (int r = 0; r < 16; ++r) { p[kb][r] = __builtin_amdgcn_exp2f(p[kb][r] - mx); l += p[kb][r]; }
#pragma unroll
        for (int s = 0; s < 2; ++s) { pw[2 * kb + s].x = pg8::cvt_pk_bf16(p[kb][8 * s + 0], p[kb][8 * s + 1]); pw[2 * kb + s].y = pg8::cvt_pk_bf16(p[kb][8 * s + 2], p[kb][8 * s + 3]);
            pw[2 * kb + s].z = pg8::cvt_pk_bf16(p[kb][8 * s + 4], p[kb][8 * s + 5]); pw[2 * kb + s].w = pg8::cvt_pk_bf16(p[kb][8 * s + 6], p[kb][8 * s + 7]); }
        __builtin_amdgcn_sched_barrier(0); }
    { auto rr = __builtin_amdgcn_permlane32_swap(__float_as_uint(l), __float_as_uint(l), false, false); l = __uint_as_float(rr[0]) + __uint_as_float(rr[1]); }
    const float il = 1.0f / l;
    f32x16_t o[4];
#pragma unroll
    for (int db = 0; db < 4; ++db) o[db] = f32x16_t{};
    const int i16 = lane & 15;
    LAS unsigned char* vb = lds + 65536 + (4 * hi + (i16 >> 2)) * 64 + ((lane >> 4) & 1) * 32 + (i16 & 3) * 8;
#pragma unroll
    for (int ks = 0; ks < 16; ++ks) {
        const bf16x8_t pa = __builtin_bit_cast(bf16x8_t, pw[ks]);
#pragma unroll
        for (int db = 0; db < 4; ++db) { LAS unsigned char* a = vb + db * 16384 + (16 * ks) * 64;
            const v4i16_t lo = lds_tr16(a), hh = lds_tr16(a + 512);
            const bf16x8_t vf = (bf16x8_t){lo[0], lo[1], lo[2], lo[3], hh[0], hh[1], hh[2], hh[3]};
            o[db] = __builtin_amdgcn_mfma_f32_32x32x16_bf16(vf, pa, o[db], 0, 0, 0); }
        __builtin_amdgcn_sched_barrier(0); }
    bf16_t* Ow = OC + (size_t)(row0 + 32 * wave + r32) * 512 + h * 128 + 4 * hi;
#pragma unroll
    for (int db = 0; db < 4; ++db)
#pragma unroll
        for (int rg = 0; rg < 4; ++rg) { u32x2 w; w.x = pg8::cvt_pk_bf16(o[db][4 * rg + 0] * il, o[db][4 * rg + 1] * il); w.y = pg8::cvt_pk_bf16(o[db][4 * rg + 2] * il, o[db][4 * rg + 3] * il);
            *(u32x2*)(Ow + 32 * db + 8 * rg) = w; }
}
__device__ __forceinline__ void cross_after_qc(LAS unsigned char* lds, unsigned char* lds_generic, unsigned char* ws, int pm, int pn) {
    const int tid = threadIdx.x, lane = tid & 63, wave = __builtin_amdgcn_readfirstlane(tid >> 6);
    const unsigned lds0 = (unsigned)(uintptr_t)(lds_generic + RING_OFF);
    for (int hh = 0; hh < 2; ++hh) { const int h = 2 * pn + hh, b = pm >> 5;
        cross_stage_kv(lds0, (const bf16_t*)(ws + WS_KVC), b, h, wave, lane);
        asm volatile("s_waitcnt vmcnt(0)" ::: "memory"); __syncthreads();
        cross_unit(lds, (const bf16_t*)(ws + WS_QC), (bf16_t*)(ws + WS_OC), pm * 256, h);
        __syncthreads(); }
}
__device__ __forceinline__ void phase7_cross(LAS unsigned char* lds, unsigned char* lds_generic, unsigned char* ws, int vcu, int G) {
    const int tid = threadIdx.x, lane = tid & 63, wave = __builtin_amdgcn_readfirstlane(tid >> 6);
    const unsigned lds0 = (unsigned)(uintptr_t)(lds_generic + RING_OFF);
    for (int j = vcu; j < 256; j += G) { const int h = j & 3, pp = j >> 2, b = pp >> 4;
        cross_stage_kv(lds0, (const bf16_t*)(ws + WS_KVC), b, h, wave, lane);
        asm volatile("s_waitcnt vmcnt(0)" ::: "memory"); __syncthreads();
        cross_unit(lds, (const bf16_t*)(ws + WS_QC), (bf16_t*)(ws + WS_OC), (2 * pp) * 256, h);
        cross_unit(lds, (const bf16_t*)(ws + WS_QC), (bf16_t*)(ws + WS_OC), (2 * pp + 1) * 256, h);
        __syncthreads(); }
}
struct Args { PtrsIn P; float* out; unsigned char* ws; int ph_lo, ph_hi; };
static_assert(sizeof(Args) == 27 * 8 + 24, "Args has no holes");

__device__ __forceinline__ void moe_setup(LAS unsigned char* lds, unsigned char* ws, int vcu, int G, bool with_gather) {
    LAS int* rec = (LAS int*)(lds + UREC_OFF); LAS unsigned* tbl = (LAS unsigned*)(lds + TBL_OFF);
    const int tid = threadIdx.x;
    const unsigned* ec = (const unsigned*)(ws + WS_CTL) + CW_ECNT;
    int cnt[16], pb[17]; pb[0] = 0;
#pragma unroll
    for (int e = 0; e < 16; ++e) { cnt[e] = (int)__hip_atomic_load(ec + 64 * e, __ATOMIC_RELAXED, __HIP_MEMORY_SCOPE_AGENT); pb[e + 1] = pb[e] + ((cnt[e] + 255) >> 8); }
    const int NP = pb[16];
    LAS float* rstbl = (LAS float*)(lds + RSTBL_OFF);
    for (int i = 0; i < MOE_MAXU; ++i) {
        const int L = i * G + vcu; const bool valid = (L < 4 * NP);
        int panel = 0, pn = 0, e = 0, r0 = 0, ne = 0;
        if (valid) { panel = L >> 2; pn = L & 3;
#pragma unroll
            for (int j = 1; j < 16; ++j) if (panel >= pb[j]) e = j;
#pragma unroll
            for (int j = 0; j < 16; ++j) if (j == e) { r0 = (panel - pb[j]) * 256; ne = cnt[j]; } }
        if (tid == 0) { rec[i * 8 + 0] = valid ? 1 : 0; rec[i * 8 + 1] = panel; rec[i * 8 + 2] = pn; rec[i * 8 + 3] = e; rec[i * 8 + 4] = r0; rec[i * 8 + 5] = ne; }
        if (with_gather && tid < 256) { unsigned off = 0u; float rsv = 0.f;
            if (valid && r0 + tid < ne) { const int dest = ((const int*)(ws + WS_LIST))[((size_t)e * LIST_CAP + r0 + tid) * 2]; off = (unsigned)(dest >> 1) * 2048u; if (ROUTE_MFMA) rsv = ((const float*)(ws + WS_RSTOK))[dest >> 1]; }
            tbl[i * 256 + tid] = off; rstbl[i * 256 + tid] = rsv; }
    }
    if (tid == 0) rec[MOE_MAXU * 8] = 4 * NP;
    __syncthreads();
}

#ifndef LB_W
#define LB_W 2
#endif
__global__ void __launch_bounds__(NWAVES * 64, LB_W) mega(Args args) {
    extern __shared__ __attribute__((aligned(16))) unsigned char lds_raw[];
    LAS unsigned char* lds = (LAS unsigned char*)lds_raw;
    volatile LAS unsigned* MISC = (volatile LAS unsigned*)(lds + MISC_OFF);
    const int tid = threadIdx.x, lane = tid & 63, wave = __builtin_amdgcn_readfirstlane(tid >> 6);
    const int G = gridDim.x, bx = blockIdx.x, vcu = (G % 8 == 0) ? (bx % 8) * (G / 8) + bx / 8 : bx;
    unsigned char* ws = args.ws; const PtrsIn& P = args.P; float* out = args.out;
    for (int u = tid; u < (LDS_BYTES - MISC_OFF) / 4; u += NWAVES * 64) ((LAS unsigned*)(lds + MISC_OFF))[u] = 0u;
    __syncthreads();
    const int lo = args.ph_lo, hi = args.ph_hi;
    const bool fusedrun = (hi - lo) > 1;
    XcdBarrier bar; bar.bar = (unsigned*)(ws + WS_CTL) + CW_BAR; bar.x = 0; bar.st = nullptr;
    if (fusedrun) bar = xcd_barrier_post((unsigned*)(ws + WS_CTL) + CW_BAR, MISC + 8);
#ifndef TAIL_E0
#define TAIL_E0 16
#endif
#ifndef STAG_Y
#define STAG_Y 0u
#endif
#ifndef STAG_MA
#define STAG_MA 0u
#endif
#ifndef STAG_MB
#define STAG_MB 0u
#endif
#ifndef ALIGN_E
#define ALIGN_E true
#endif
#ifndef PH_EN
#define PH_EN 0x1FFF
#endif
#define IN(k) ((((PH_EN) >> (k)) & 1) && lo <= (k) && (k) < hi)
#define SEAM(k) do { if (IN(k) && IN((k) + 1)) xcd_barrier(bar); } while (0)
#ifndef PH_DUP
#define PH_DUP 0
#endif
#define NREP(k) ((((PH_DUP) >> (k)) & 1) ? 2 : 1)
#define REPSEAM(k) do { if (NREP(k) == 2 && rep_ == 0 && fusedrun) xcd_barrier(bar); } while (0)
    const int gw = vcu * NWAVES + wave, NGW = G * NWAVES;

    if (IN(0)) {
        _Pragma("unroll") for (int rep_ = 0; rep_ < NREP(0); ++rep_) {
        LAS float* scr = (LAS float*)(lds + RING_OFF + wave * 16384);
        const bool tailconv = TAIL_CONV && (G == 256);
        for (int it = gw; it < ((MOE_CONV_IN_P2 || tailconv) ? IT_P0 : IT_TOTAL); it += NGW) p0_weight_item(P, ws, scr, it, lane);
        if (tailconv) for (int j = TAIL_E0 * 512 + gw; j < NE * 512; j += NGW) p0_weight_item(P, ws, scr, IT_P0 + (j >> 9) * 768 + (j & 511), lane);
        { const float* wsrc = P.in[9]; bf16_t* wd = (bf16_t*)(ws + WS_WSS);
          for (int i = bx * 512 + tid; i < 4 * 128 * 128; i += G * 512) wd[i] = (bf16_t)f2bf(wsrc[i]); }
        for (int i = bx * 512 + tid; i < 2048; i += G * 512) rope_table_entry((float*)(ws + WS_TAB), i);
        bf16_t* XN = (bf16_t*)(ws + WS_XN);
        if (X0_BF16) xb0_rows(P.in[0], XN, (float*)(ws + WS_RS0), gw, NGW, M, lane); else rms_rows(P.in[0], P.in[2], XN, gw, NGW, M, lane);
        rms_rows(P.in[1], P.in[14], XN + (size_t)M * D, gw, NGW, MMEM, lane);
            REPSEAM(0); }
    }
    SEAM(0);
    if (IN(1)) {
        _Pragma("unroll") for (int rep_ = 0; rep_ < NREP(1); ++rep_) {
        SchedZ S{(const char*)(ws + WS_XN), (const char*)(ws + WS_WZ), G, bx};
        EpiZ E{ws, P.in[4], P.in[5], (const float*)(ws + WS_TAB), (const float*)(ws + WS_RS0)};
        pg8::gemm_phase<EpiZ, SchedZ, ALIGN_E, false>(lds + RING_OFF, 1024, S, E);
        if (TAIL_CONV && G == 256 && bx >= 144) {
            int tid2 = threadIdx.x; asm volatile("" : "+v"(tid2)); const int lane2 = tid2 & 63, wave2 = __builtin_amdgcn_readfirstlane(tid2 >> 6);
            LAS float* scr = (LAS float*)(lds + RING_OFF + wave2 * 16384);
            for (int j = (bx - 144) * NWAVES + wave2; j < TAIL_E0 * 512; j += 112 * NWAVES) p0_weight_item(P, ws, scr, IT_P0 + (j >> 9) * 768 + (j & 511), lane2); }
            REPSEAM(1); }
    }
    SEAM(1);
    if (IN(2)) {
        _Pragma("unroll") for (int rep_ = 0; rep_ < NREP(2); ++rep_) {
        phase2_sgu_attn(lds, lds_raw, ws, P, vcu, G);
            REPSEAM(2); }
    }
    SEAM(2);
    if (IN(3)) {
        _Pragma("unroll") for (int rep_ = 0; rep_ < NREP(3); ++rep_) {
        SchedY S{(const char*)ws, G, bx};
        EpiY E{(bf16_t*)(ws + WS_GSCR) + (size_t)bx * 65536, (bf16_t*)(ws + WS_MERGED), (const float*)(ws + WS_RS0)};
#ifdef PROBE_KDUP_Y
        SchedDup<SchedY> SD{S}; pg8::gemm_phase<EpiY, SchedDup<SchedY>, ALIGN_E, false, true>(lds + RING_OFF, 1024, SD, E, STAG_Y);
#else
        pg8::gemm_phase<EpiY, SchedY, ALIGN_E, false, true>(lds + RING_OFF, 1024, S, E, STAG_Y);
#endif
            REPSEAM(3); }
    }
    SEAM(3);
    if (IN(4)) {
        _Pragma("unroll") for (int rep_ = 0; rep_ < NREP(4); ++rep_) {
        SchedPlain S{(const char*)(ws + WS_MERGED), (const char*)(ws + WS_WOUT), 128, 4, G, bx, 1024};
#if FOLD_GAINS
        EpiX1 E{P.in[0], (const bf16_t*)(ws + WS_XN), (bf16_t*)(ws + WS_XN1), (float*)(ws + WS_SSQ1)};
#ifdef PROBE_KDUP
        SchedDup<SchedPlain> SD{S}; pg8::gemm_phase<EpiX1, SchedDup<SchedPlain>, ALIGN_E, false>(lds + RING_OFF, 1024, SD, E);
#else
        pg8::gemm_phase<EpiX1, SchedPlain, ALIGN_E, false>(lds + RING_OFF, 1024, S, E);
#endif
#else
        EpiRes E{P.in[0], out};
        pg8::gemm_phase<EpiRes, SchedPlain, ALIGN_E, false>(lds + RING_OFF, 1024, S, E);
#endif
            REPSEAM(4); }
    }
    SEAM(4);
    if (IN(5)) {
        _Pragma("unroll") for (int rep_ = 0; rep_ < NREP(5); ++rep_) {
        bf16_t* XN1 = (bf16_t*)(ws + WS_XN1);
        if (!FOLD_GAINS) rms_rows(out, P.in[13], XN1, gw, NGW, M, lane);
            REPSEAM(5); }
    }
    if (!FOLD_GAINS) SEAM(5);
    if (IN(6)) {
        _Pragma("unroll") for (int rep_ = 0; rep_ < NREP(6); ++rep_) {
        SchedPlain S{(const char*)(ws + WS_XN1), (const char*)(ws + WS_WCQ), 128, 2, G, bx, 1024};
#if FOLD_GAINS
        EpiQC E{(bf16_t*)(ws + WS_QC), (const float*)(ws + WS_SSQ1), C2_CROSS};
        pg8::gemm_phase<EpiQC, SchedPlain, ALIGN_E, false>(lds + RING_OFF, 1024, S, E);
#if MERGE_QC_CROSS
        asm volatile("s_waitcnt vmcnt(0)" ::: "memory"); __syncthreads();
        { Unit u; for (int i = 0; S.next(i, u); ++i) cross_after_qc(lds, lds_raw, ws, u.pm, u.pn); }
#endif
#else
        EpiBf16s E{(bf16_t*)(ws + WS_QC), 512, C2_CROSS};
        pg8::gemm_phase<EpiBf16s, SchedPlain, ALIGN_E, false>(lds + RING_OFF, 1024, S, E);
#endif
            REPSEAM(6); }
    }
    if (!(MERGE_QC_CROSS && FOLD_GAINS)) SEAM(6);
    if (IN(7)) {
        _Pragma("unroll") for (int rep_ = 0; rep_ < NREP(7); ++rep_) {
        if (!(MERGE_QC_CROSS && FOLD_GAINS)) phase7_cross(lds, lds_raw, ws, vcu, G);
            REPSEAM(7); }
    }
    SEAM(7);
    if (IN(8)) {
        SchedPlain S{(const char*)(ws + WS_OC), (const char*)(ws + WS_WCO), 128, 4, G, bx, 512};
#if FOLD_GAINS
        EpiX2 E{(const bf16_t*)(ws + WS_XN1), out, (bf16_t*)(ws + WS_XN3)};
        pg8::gemm_phase<EpiX2, SchedPlain, ALIGN_E, false>(lds + RING_OFF, 512, S, E);
#else
        EpiRes E{out, out};
        pg8::gemm_phase<EpiRes, SchedPlain, ALIGN_E, false>(lds + RING_OFF, 512, S, E);
#endif
        if (!FOLD_GAINS && NREP(8) == 2) { if (fusedrun) xcd_barrier(bar); EpiRes E2{out, (float*)(ws + WS_Q)}; pg8::gemm_phase<EpiRes, SchedPlain, ALIGN_E, false>(lds + RING_OFF, 512, S, E2); }
    }
    SEAM(8);
#if ROUTE_MFMA
    if (IN(9)) {
#if X2_BF16
        LAS bf16_t* WH = (LAS bf16_t*)(lds + RING_OFF);
        LAS bf16_t* WM = WH + 20 * 1032;
        LAS float* PART = (LAS float*)(lds + RING_OFF + 2 * 20 * 1032 * 2);
        LAS float* SSQP = PART + 2 * 4 * 32 * 33;
        LAS int* te = (LAS int*)(SSQP + 2 * 4 * 2 * 32); LAS float* tw = (LAS float*)(te + 256); LAS int* tp = (LAS int*)(tw + 256); LAS int* ebase = tp + 256;
        for (int i = tid; i < 1024 * 20; i += 512) { const int kk = i / 20, o = i % 20; const float w = (o < 4 ? P.in[19][kk * 4 + o] : P.in[21][kk * 16 + (o - 4)]) * P.in[18][kk];
            const unsigned hb = f2bf(w); const float rem = w - __uint_as_float(hb << 16); WH[o * 1032 + kk] = (bf16_t)hb; WM[o * 1032 + kk] = (bf16_t)f2bf(rem); }
        __syncthreads();
        const int tg = wave & 3, kh = wave >> 2, n = lane & 31, hh = lane >> 5;
        bf16_t* XB2 = (bf16_t*)(ws + WS_XN3); float* rstok = (float*)(ws + WS_RSTOK);
        const LAS bf16_t* whr = WH + (n < 20 ? n : 19) * 1032 + kh * 512 + 8 * hh; const LAS bf16_t* wmr = WM + (n < 20 ? n : 19) * 1032 + kh * 512 + 8 * hh;
        for (int tb = vcu; tb < M / 128; tb += G) {
            const int t0 = tb * 128; const size_t eoff = (size_t)(t0 + tg * 32 + n) * 1024 + kh * 512 + 8 * hh;
            f32x16_t acc = f32x16_t{}; float ssq = 0.f;
            for (int jb = 0; jb < 32; jb += 8) { u32x4 xv[8];
#pragma unroll
                for (int j = 0; j < 8; ++j) xv[j] = *(const u32x4*)(XB2 + eoff + 16 * (jb + j));
#pragma unroll
                for (int j = 0; j < 8; ++j) { const bf16x8_t wh = *(const LAS bf16x8_t*)(whr + 16 * (jb + j)), wm = *(const LAS bf16x8_t*)(wmr + 16 * (jb + j));
                    float xf[8]; unpack8(xv[j], xf);
                    ssq += ((xf[0] * xf[0] + xf[1] * xf[1]) + (xf[2] * xf[2] + xf[3] * xf[3])) + ((xf[4] * xf[4] + xf[5] * xf[5]) + (xf[6] * xf[6] + xf[7] * xf[7]));
                    const bf16x8_t xa = __builtin_bit_cast(bf16x8_t, xv[j]);
                    acc = __builtin_amdgcn_mfma_f32_32x32x16_bf16(xa, wh, acc, 0, 0, 0); acc = __builtin_amdgcn_mfma_f32_32x32x16_bf16(xa, wm, acc, 0, 0, 0); } }
#else
        LAS float* WT = (LAS float*)(lds + RING_OFF);
        LAS float* PART = WT + 20 * 1028;
        LAS float* SSQP = PART + 2 * 4 * 32 * 33;
        LAS int* te = (LAS int*)(SSQP + 2 * 4 * 2 * 32); LAS float* tw = (LAS float*)(te + 256); LAS int* tp = (LAS int*)(tw + 256); LAS int* ebase = tp + 256;
        for (int i = tid; i < 1024 * 4; i += 512) { const int kk = i >> 2, o = i & 3; WT[o * 1028 + kk] = P.in[19][i] * P.in[18][kk]; }
        for (int i = tid; i < 1024 * 16; i += 512) { const int kk = i >> 4, o = i & 15; WT[(4 + o) * 1028 + kk] = P.in[21][i] * P.in[18][kk]; }
        __syncthreads();
        const int tg = wave & 3, kh = wave >> 2, n = lane & 31, hh = lane >> 5;
        bf16_t* XB2 = (bf16_t*)(ws + WS_XN3); float* rstok = (float*)(ws + WS_RSTOK);
        const LAS float* wrow = WT + (n < 20 ? n : 19) * 1028 + kh * 512 + 4 * hh;
        for (int tb = vcu; tb < M / 128; tb += G) {
            const int t0 = tb * 128; const size_t eoff = (size_t)(t0 + tg * 32 + n) * 1024 + kh * 512 + 4 * hh;
            f32x16_t acc = f32x16_t{}; float ssq = 0.f;
            for (int jb = 0; jb < 64; jb += 8) { f32x4 xv[8];
#pragma unroll
                for (int j = 0; j < 8; ++j) {
                    if (X2_BF16) { const u32x2 q = *(const u32x2*)(XB2 + eoff + 8 * (jb + j)); xv[j] = (f32x4){__uint_as_float(q.x << 16), __uint_as_float(q.x & 0xffff0000u), __uint_as_float(q.y << 16), __uint_as_float(q.y & 0xffff0000u)}; }
                    else xv[j] = *(const f32x4*)(out + eoff + 8 * (jb + j)); }
#pragma unroll
                for (int j = 0; j < 8; ++j) { const f32x4 wv = *(const LAS f32x4*)(wrow + 8 * (jb + j)); const f32x4 x = xv[j];
                    ssq += (x[0] * x[0] + x[1] * x[1]) + (x[2] * x[2] + x[3] * x[3]);
                    acc = __builtin_amdgcn_mfma_f32_32x32x2f32(x[0], wv[0], acc, 0, 0, 0); acc = __builtin_amdgcn_mfma_f32_32x32x2f32(x[1], wv[1], acc, 0, 0, 0);
                    acc = __builtin_amdgcn_mfma_f32_32x32x2f32(x[2], wv[2], acc, 0, 0, 0); acc = __builtin_amdgcn_mfma_f32_32x32x2f32(x[3], wv[3], acc, 0, 0, 0);
                    if (!X2_BF16) { u32x2 w; w.x = pg8::cvt_pk_bf16(x[0], x[1]); w.y = pg8::cvt_pk_bf16(x[2], x[3]); *(u32x2*)(XB2 + eoff + 8 * (jb + j)) = w; } } }
#endif
#pragma unroll
            for (int r = 0; r < 16; ++r) PART[((kh * 4 + tg) * 32 + ((r & 3) + 8 * (r >> 2) + 4 * hh)) * 33 + n] = acc[r];
            SSQP[((kh * 4 + tg) * 2 + hh) * 32 + n] = ssq;
            __syncthreads();
            if (wave < 4 && lane < 32) { const int tl = wave * 32 + lane, t = t0 + tl;
                const float s = (SSQP[((0 * 4 + wave) * 2 + 0) * 32 + lane] + SSQP[((0 * 4 + wave) * 2 + 1) * 32 + lane]) + (SSQP[((1 * 4 + wave) * 2 + 0) * 32 + lane] + SSQP[((1 * 4 + wave) * 2 + 1) * 32 + lane]);
                const float rs = 1.0f / sqrtf(s * (1.f / 1024.f) + EPS);
                float lg[20];
#pragma unroll
                for (int nn = 0; nn < 20; ++nn) lg[nn] = (PART[((0 * 4 + wave) * 32 + lane) * 33 + nn] + PART[((1 * 4 + wave) * 32 + lane) * 33 + nn]) * rs;
                int e0, e1; float w0, w1; route_decide(lg, P.in[20], P.in[22], e0, e1, w0, w1);
                te[2 * tl] = e0; te[2 * tl + 1] = e1; tw[2 * tl] = w0; tw[2 * tl + 1] = w1; rstok[t] = rs; }
            __syncthreads();
            if (wave == 0) {
                int cnt = 0; int mye[4];
#pragma unroll
                for (int j = 0; j < 4; ++j) mye[j] = te[j * 64 + lane];
                int pos[4] = {0, 0, 0, 0};
                for (int e = 0; e < 16; ++e) { int run = 0;
#pragma unroll
                    for (int j = 0; j < 4; ++j) { const unsigned long long mk = __ballot(mye[j] == e); const int before = __popcll(mk & ((1ull << lane) - 1ull));
                        if (mye[j] == e) pos[j] = run + before; run += __popcll(mk); }
                    if (lane == e) cnt = run; }
#pragma unroll
                for (int j = 0; j < 4; ++j) tp[j * 64 + lane] = pos[j];
                if (lane < 16) { unsigned* ec = (unsigned*)(ws + WS_CTL) + CW_ECNT + 64 * lane; ebase[lane] = (int)atomicAdd(ec, (unsigned)cnt); }
            }
            __syncthreads();
            if (tid < 256) { const int e = te[tid], slot = ebase[e] + tp[tid], dest = (t0 * 2) + tid; const float w = tw[tid];
                int* lst = (int*)(ws + WS_LIST) + ((size_t)e * LIST_CAP + slot) * 2; lst[0] = dest; lst[1] = __float_as_int(w); }
            __syncthreads();
        }
    }
#else
    if (IN(9)) {
        LAS float* rw = (LAS float*)(lds + RING_OFF);
        LAS int* te = (LAS int*)(lds + RING_OFF + 20 * 1024 * 4); LAS float* tw = (LAS float*)(te + 256); LAS int* tp = (LAS int*)(tw + 256); LAS int* ebase = tp + 256;
        for (int i = tid; i < 1024 * 4; i += 512) { const int k = i >> 2, o = i & 3; rw[o * 1024 + k] = P.in[19][i]; }
        for (int i = tid; i < 1024 * 16; i += 512) { const int k = i >> 4, o = i & 15; rw[(4 + o) * 1024 + k] = P.in[21][i]; }
        __syncthreads();
        bf16_t* XN3 = (bf16_t*)(ws + WS_XN3);
        if (NREP(9) == 2) { for (int tb = vcu; tb < M / 128; tb += G) { const int t0 = tb * 128; Row4 rcur = row_load(out + (size_t)(t0 + wave * 16) * D, lane);
            for (int i = 0; i < 16; ++i) { const int tl = wave * 16 + i, t = t0 + tl; int e0, e1; float w0, w1; const Row4 rnxt = row_load(out + (size_t)(t + (i < 15 ? 1 : 0)) * D, lane);
                route_token(rcur, P.in[18], rw, P.in[20], P.in[22], XN3 + (size_t)t * D, lane, e0, e1, w0, w1); rcur = rnxt; if (lane == 0) { te[2 * tl] = e0; tw[2 * tl] = w0 + w1 + (float)e1; } } }
            if (fusedrun) xcd_barrier(bar); }
        for (int tb = vcu; tb < M / 128; tb += G) {
            const int t0 = tb * 128;
            Row4 rcur = row_load(out + (size_t)(t0 + wave * 16) * D, lane);
            for (int i = 0; i < 16; ++i) { const int tl = wave * 16 + i, t = t0 + tl; int e0, e1; float w0, w1;
                const Row4 rnxt = row_load(out + (size_t)(t + (i < 15 ? 1 : 0)) * D, lane);
                route_token(rcur, P.in[18], rw, P.in[20], P.in[22], XN3 + (size_t)t * D, lane, e0, e1, w0, w1); rcur = rnxt;
                if (lane == 0) { te[2 * tl] = e0; te[2 * tl + 1] = e1; tw[2 * tl] = w0; tw[2 * tl + 1] = w1; } }
            __syncthreads();
            if (wave == 0) {
                int cnt = 0; int mye[4];
#pragma unroll
                for (int j = 0; j < 4; ++j) mye[j] = te[j * 64 + lane];
                int pos[4] = {0, 0, 0, 0};
                for (int e = 0; e < 16; ++e) { int run = 0;
#pragma unroll
                    for (int j = 0; j < 4; ++j) { const unsigned long long mk = __ballot(mye[j] == e); const int before = __popcll(mk & ((1ull << lane) - 1ull));
                        if (mye[j] == e) pos[j] = run + before; run += __popcll(mk); }
                    if (lane == e) cnt = run; }
#pragma unroll
                for (int j = 0; j < 4; ++j) tp[j * 64 + lane] = pos[j];
                if (lane < 16) { unsigned* ec = (unsigned*)(ws + WS_CTL) + CW_ECNT + 64 * lane; ebase[lane] = (int)atomicAdd(ec, (unsigned)cnt); }
            }
            __syncthreads();
            if (tid < 256) { const int e = te[tid], slot = ebase[e] + tp[tid], dest = (t0 * 2) + tid; const float w = tw[tid];
                int* lst = (int*)(ws + WS_LIST) + ((size_t)e * LIST_CAP + slot) * 2; lst[0] = dest; lst[1] = __float_as_int(w);
                int* ti = (int*)(ws + WS_TOKINFO) + (size_t)dest * 2; ti[0] = e; ti[1] = __float_as_int(w); }
            __syncthreads();
        }
    }
#endif
    SEAM(9);
    if (IN(10)) {
        _Pragma("unroll") for (int rep_ = 0; rep_ < NREP(10); ++rep_) {
        moe_setup(lds, ws, vcu, G, true);
        SchedMoe S{(const LAS int*)(lds + UREC_OFF), (const LAS unsigned*)(lds + TBL_OFF), (const char*)(ws + WS_XN3), (const char*)(ws + WS_WGU), 0, (size_t)1024 * 1024 * 2, (size_t)256 * 1024 * 2, true};
        EpiMoeA E{(bf16_t*)(ws + WS_H), (const LAS float*)(lds + RSTBL_OFF)};
        pg8::gemm_phase<EpiMoeA, SchedMoe, ALIGN_E, true>(lds + RING_OFF, 1024, S, E, STAG_MA);
        if (TAIL_CONV && G == 256) {
            const LAS int* rec = (const LAS int*)(lds + UREC_OFF); int myu = 0;
            for (int i = 0; i < MOE_MAXU; ++i) myu += rec[i * 8];
            const int nu = rec[MOE_MAXU * 8], rem = nu % G, maxu = (nu + G - 1) / G;
            const bool idle = (rem == 0) || (myu < maxu); const int nidle = (rem == 0) ? G : G - rem, rank = (rem == 0) ? vcu : vcu - rem;
            if (idle) { int tid2 = threadIdx.x; asm volatile("" : "+v"(tid2)); const int lane2 = tid2 & 63, wave2 = __builtin_amdgcn_readfirstlane(tid2 >> 6);
                LAS float* scr = (LAS float*)(lds + RING_OFF + wave2 * 16384);
                for (int j = rank * NWAVES + wave2; j < NE * 256; j += nidle * NWAVES) p0_weight_item(P, ws, scr, IT_P0 + (j >> 8) * 768 + 512 + (j & 255), lane2); } }
            REPSEAM(10); }
    }
    SEAM(10);
    if (IN(11)) {
        _Pragma("unroll") for (int rep_ = 0; rep_ < NREP(11); ++rep_) {
        moe_setup(lds, ws, vcu, G, false);
        SchedMoe S{(const LAS int*)(lds + UREC_OFF), (const LAS unsigned*)(lds + TBL_OFF), (const char*)(ws + WS_H), (const char*)(ws + WS_WD), (size_t)256 * 512 * 2, (size_t)1024 * 512 * 2, (size_t)256 * 512 * 2, false};
        EpiMoeB E{(const LAS int*)(lds + UREC_OFF), (const int*)(ws + WS_LIST), (bf16_t*)(ws + WS_YS)};
        pg8::gemm_phase<EpiMoeB, SchedMoe, ALIGN_E, false>(lds + RING_OFF, 512, S, E, STAG_MB);
            REPSEAM(11); }
    }
    SEAM(11);
    if (IN(12)) {
        const bf16_t* ys = (const bf16_t*)(ws + WS_YS);
        if (NREP(12) == 2) { float* dead = (float*)(ws + WS_H);
            for (int m = gw; m < M; m += NGW) { RowF r = rowf_load(out + (size_t)m * D, ys + (size_t)m * 2048, lane); const f32x4* src = (const f32x4*)(out + (size_t)m * D) + lane; f32x4* dd = (f32x4*)(dead + (size_t)m * D) + lane;
                (void)src; rowf_store(r, dead + (size_t)m * D, P.in[26], lane); (void)dd; }
            if (fusedrun) xcd_barrier(bar); }
        if (X2_BF16) final_rows_b(out, (const bf16_t*)(ws + WS_XN3), ys, P.in[26], gw, NGW, M, lane); else final_rows(out, ys, P.in[26], gw, NGW, M, lane);
    }
#undef IN
#undef SEAM
}
#ifndef OPT_MASK
#define OPT_MASK 0x1FFF
#endif
#ifndef FUSED
#define FUSED 1
#endif
static void launch_mega(const Args& a0, int lo, int hi, int grid, hipStream_t stream) {
    Args a = a0; a.ph_lo = lo; a.ph_hi = hi;
    hipLaunchKernelGGL(mega, dim3(grid), dim3(NWAVES * 64), LDS_BYTES, stream, a);
    const hipError_t le = hipPeekAtLastError();
    if (le != hipSuccess) fprintf(stderr, "kernel_launch: launch [%d,%d) failed: %s\n", lo, hi, hipGetErrorName(le));
}
extern "C" void kernel_launch(void* const* d_in, const int* in_sizes, int n_in, void* d_out, int out_size, void* d_ws, size_t ws_size, hipStream_t stream) {
    static int grid = 0;
    if (grid == 0) {
        if (n_in != 27 || in_sizes[0] != M * D || out_size != M * D || ws_size < WS_END) { fprintf(stderr, "kernel_launch: unexpected problem (n_in %d, in0 %d, out %d, ws %zu)\n", n_in, n_in > 0 ? in_sizes[0] : -1, out_size, ws_size); grid = -1; return; }
        (void)hipFuncSetAttribute((const void*)k_route, hipFuncAttributeMaxDynamicSharedMemorySize, 20 * 1024 * 4 + 4096);
        (void)hipFuncSetAttribute((const void*)nv_sgu, hipFuncAttributeMaxDynamicSharedMemorySize, 128 * 129 * 4 + 1024);
        (void)hipFuncSetAttribute((const void*)nv_attn, hipFuncAttributeMaxDynamicSharedMemorySize, 4 * 64 * 65 * 4);
        (void)hipFuncSetAttribute((const void*)k_prologue, hipFuncAttributeMaxDynamicSharedMemorySize, 8 * 64 * 33 * 4);
        if (hipFuncSetAttribute((const void*)mega, hipFuncAttributeMaxDynamicSharedMemorySize, LDS_BYTES) != hipSuccess) { fprintf(stderr, "kernel_launch: hipFuncSetAttribute(mega) failed\n"); grid = -1; return; }
        int dev = 0, cus = 0, per_cu = 0;
        if (hipGetDevice(&dev) != hipSuccess || hipDeviceGetAttribute(&cus, hipDeviceAttributeMultiprocessorCount, dev) != hipSuccess) { grid = -1; return; }
        if (hipOccupancyMaxActiveBlocksPerMultiprocessor(&per_cu, (const void*)mega, NWAVES * 64, LDS_BYTES) != hipSuccess || per_cu < 1) fprintf(stderr, "kernel_launch: occupancy query says %d blocks per CU\n", per_cu);
        (void)hipGetLastError();
        grid = cus;
    }
    if (grid < 0) return;
    unsigned char* ws = (unsigned char*)d_ws; float* out = (float*)d_out;
    Args a{}; for (int i = 0; i < 27; ++i) a.P.in[i] = (const float*)d_in[i];
    a.out = out; a.ws = ws; a.ph_lo = 0; a.ph_hi = NPHASE;
    const PtrsIn& P = a.P;
    (void)hipMemsetAsync(ws + WS_CTL, 0, CTL_ZERO_BYTES, stream);
#if FUSED
    launch_mega(a, 0, NPHASE, grid, stream);
#else
    float* scr = (float*)(ws + WS_SCR);
    bf16_t* XN = (bf16_t*)(ws + WS_XN);
    for (int ph = 0; ph < NPHASE; ++ph) {
        if ((OPT_MASK >> ph) & 1) { launch_mega(a, ph, ph + 1, grid, stream); continue; }
        switch (ph) {
        case 0: hipLaunchKernelGGL(k_prologue, dim3(256), dim3(512), 8 * 64 * 33 * 4, stream, P, ws); break;
        case 1:
            for (int c = 0; c < M / 4096; ++c) {
                hipLaunchKernelGGL(nv_gemm, dim3(NZ / 64, 4096 / 64), dim3(256), 0, stream, XN + (size_t)c * 4096 * D, D, (const bf16_t*)(ws + WS_WZ), D, D, scr, NZ);
                hipLaunchKernelGGL(nv_z_epi, dim3(4096), dim3(256), 0, stream, (const float*)scr, c * 4096, P, ws); }
            hipLaunchKernelGGL(nv_gemm, dim3(1024 / 64, MMEM / 64), dim3(256), 0, stream, XN + (size_t)M * D, D, (const bf16_t*)(ws + WS_WZ) + (size_t)NZ * D, D, D, scr, 1024);
            hipLaunchKernelGGL(nv_store_bf16, dim3(1024), dim3(256), 0, stream, (const float*)scr, (bf16_t*)(ws + WS_KVC), (size_t)MMEM * 1024, 1.0f);
            break;
        case 2:
            hipLaunchKernelGGL(nv_attn, dim3(SEQ / 64, 8, BATCH), dim3(256), 4 * 64 * 65 * 4, stream, (const bf16_t*)(ws + WS_Q), (const bf16_t*)(ws + WS_K), (const bf16_t*)(ws + WS_V), (bf16_t*)(ws + WS_ATT));
            hipLaunchKernelGGL(nv_sgu, dim3(M / 128, 4), dim3(256), 128 * 129 * 4 + 1024, stream, P, ws);
            break;
        case 3:
            for (int c = 0; c < M / 4096; ++c) { float* c1 = scr; float* c2 = scr + (size_t)4096 * 1024;
                hipLaunchKernelGGL(nv_gemm, dim3(1024 / 64, 64), dim3(256), 0, stream, (const bf16_t*)(ws + WS_ATT) + (size_t)c * 4096 * 512, 512, (const bf16_t*)(ws + WS_WATT), 512, 512, c1, 1024);
                hipLaunchKernelGGL(nv_gemm, dim3(1024 / 64, 64), dim3(256), 0, stream, (const bf16_t*)(ws + WS_SG) + (size_t)c * 4096 * 512, 512, (const bf16_t*)(ws + WS_WSGU), 512, 512, c2, 1024);
                hipLaunchKernelGGL(nv_merge, dim3(2048), dim3(256), 0, stream, (const float*)c1, (const float*)c2, (const bf16_t*)(ws + WS_GA) + (size_t)c * 4096 * 1024, (const bf16_t*)(ws + WS_GB) + (size_t)c * 4096 * 1024,
                                   (bf16_t*)(ws + WS_MERGED) + (size_t)c * 4096 * 1024, (size_t)4096 * 1024); }
            break;
        case 4:
            for (int c = 0; c < M / 4096; ++c) {
                hipLaunchKernelGGL(nv_gemm, dim3(1024 / 64, 64), dim3(256), 0, stream, (const bf16_t*)(ws + WS_MERGED) + (size_t)c * 4096 * 1024, 1024, (const bf16_t*)(ws + WS_WOUT), 1024, 1024, scr, 1024);
                hipLaunchKernelGGL(nv_resid, dim3(2048), dim3(256), 0, stream, P.in[0] + (size_t)c * 4096 * 1024, (const float*)scr, out + (size_t)c * 4096 * 1024, (size_t)4096 * 1024); }
            break;
        case 5: hipLaunchKernelGGL(k_norm_rows, dim3(256), dim3(512), 0, stream, (const float*)out, P.in[13], (bf16_t*)(ws + WS_XN1), M); break;
        case 6:
            for (int c = 0; c < M / 4096; ++c) {
                hipLaunchKernelGGL(nv_gemm, dim3(512 / 64, 64), dim3(256), 0, stream, (const bf16_t*)(ws + WS_XN1) + (size_t)c * 4096 * 1024, 1024, (const bf16_t*)(ws + WS_WCQ), 1024, 1024, scr, 512);
                hipLaunchKernelGGL(nv_store_bf16, dim3(1024), dim3(256), 0, stream, (const float*)scr, (bf16_t*)(ws + WS_QC) + (size_t)c * 4096 * 512, (size_t)4096 * 512, C2_CROSS); }
            break;
        case 7: hipLaunchKernelGGL(nv_cross, dim3(M), dim3(256), 0, stream, (const bf16_t*)(ws + WS_QC), (const bf16_t*)(ws + WS_KVC), (bf16_t*)(ws + WS_OC)); break;
        case 8:
            for (int c = 0; c < M / 4096; ++c) {
                hipLaunchKernelGGL(nv_gemm, dim3(1024 / 64, 64), dim3(256), 0, stream, (const bf16_t*)(ws + WS_OC) + (size_t)c * 4096 * 512, 512, (const bf16_t*)(ws + WS_WCO), 512, 512, scr, 1024);
                hipLaunchKernelGGL(nv_resid, dim3(2048), dim3(256), 0, stream, (const float*)(out + (size_t)c * 4096 * 1024), (const float*)scr, out + (size_t)c * 4096 * 1024, (size_t)4096 * 1024); }
            break;
        case 9: hipLaunchKernelGGL(k_route, dim3(256), dim3(512), 20 * 1024 * 4 + 4096, stream, P, (const float*)out, ws); break;
        case 10: hipLaunchKernelGGL(nv_moe_a, dim3(2 * M), dim3(256), 0, stream, (const bf16_t*)(ws + WS_XN3), ws); break;
        case 11: hipLaunchKernelGGL(nv_moe_b, dim3(2 * M), dim3(256), 0, stream, ws); break;
        case 12: hipLaunchKernelGGL(k_final, dim3(256), dim3(512), 0, stream, out, (const bf16_t*)(ws + WS_YS), P.in[26]); break;
        }
    }
#endif
}
```

```cpp
#include <hip/hip_runtime.h>
#include <cstdio>
#include <cstdint>
#include <cmath>

#ifndef FOLD_GAINS
#define FOLD_GAINS 1
#endif
#ifndef ATT_FIXM
#define ATT_FIXM 1
#endif
#ifndef X0_BF16
#define X0_BF16 1
#endif
#ifndef NT_LOADS
#define NT_LOADS 1
#endif
#ifndef NT2
#define NT2 0
#endif
#ifndef FINAL_NT
#define FINAL_NT 0
#endif
#ifndef GATE_U8
#define GATE_U8 1
#endif
#ifndef MERGE_QC_CROSS
#define MERGE_QC_CROSS 1
#endif
#ifndef TAIL_CONV
#define TAIL_CONV 1
#endif
#ifndef ROUTE_MFMA
#define ROUTE_MFMA 1
#endif
#ifndef FOLD_MOE
#define FOLD_MOE ROUTE_MFMA
#endif
#ifndef X2_BF16
#define X2_BF16 1
#endif
#ifndef MOE_CONV_IN_P2
#define MOE_CONV_IN_P2 0
#endif
typedef unsigned short bf16_t;
typedef float f32x4 __attribute__((ext_vector_type(4)));
typedef unsigned u32x4 __attribute__((ext_vector_type(4)));
typedef unsigned u32x2 __attribute__((ext_vector_type(2)));

constexpr int BATCH = 4, SEQ = 8192, D = 1024, M = BATCH * SEQ;
constexpr int NMEM = 256, MMEM = BATCH * NMEM;
constexpr int NZ = 3840;
constexpr int ZQ = 0, ZK = 512, ZV = 640, ZSU = 768, ZSV = 1280, ZGA = 1792, ZGB = 2816;
constexpr int NE = 16, DE = 512;
constexpr float EPS = 1e-6f;
constexpr float LOG2E = 1.4426950408889634f;
constexpr float C2_SELF = 0.125f * LOG2E;
constexpr float C2_CROSS = 0.08838834764831845f * LOG2E;
constexpr int LIST_CAP = 32768;

constexpr size_t MiB = 1u << 20;
constexpr size_t WS_CTL = 0, CTL_ZERO_BYTES = 64 * 1024;
constexpr size_t WS_TAB = 512 * 1024;
constexpr size_t WS_WZ = 1 * MiB;
constexpr size_t WS_WATT = 11 * MiB, WS_WSGU = 12 * MiB, WS_WOUT = 13 * MiB, WS_WCQ = 15 * MiB, WS_WCO = 16 * MiB, WS_WSS = 17 * MiB;
constexpr size_t WS_WGU = 18 * MiB;
constexpr size_t WS_WD = 50 * MiB;
constexpr size_t WS_XN = 68 * MiB;
constexpr size_t WS_MERGED = 248 * MiB;
constexpr size_t WS_GSCR = 312 * MiB;
constexpr size_t WS_XN3 = 68 * MiB;
constexpr size_t WS_KVC = 134 * MiB;
constexpr size_t WS_Q = 136 * MiB, WS_K = 168 * MiB, WS_V = 176 * MiB, WS_U = 184 * MiB, WS_GV = 216 * MiB, WS_GA = 248 * MiB, WS_GB = 312 * MiB;
constexpr size_t WS_ATT = 376 * MiB, WS_SG = 408 * MiB;
constexpr size_t WS_XN1 = 136 * MiB;
constexpr size_t WS_SSQ1 = 132 * MiB;
constexpr size_t WS_QC = 376 * MiB, WS_OC = 408 * MiB;
constexpr size_t WS_LIST = 200 * MiB;
constexpr size_t WS_RS0 = 66 * MiB;
constexpr size_t WS_RSTOK = 205 * MiB;
constexpr size_t WS_TOKINFO = 204 * MiB;
constexpr size_t WS_YS = 208 * MiB;
constexpr size_t WS_H = 336 * MiB;
constexpr size_t WS_SCR = 440 * MiB;
constexpr size_t WS_END = 504 * MiB;
constexpr int CW_TMO = 0, CW_BAR = 4096, CW_ECNT = 8192;

__host__ __device__ __forceinline__ float bf2f(bf16_t b) { union { unsigned u; float f; } c; c.u = ((unsigned)b) << 16; return c.f; }
__host__ __device__ __forceinline__ unsigned f2bf(float f) { union { unsigned u; float f; } c; c.f = f; unsigned u = c.u; return (u + 0x7fffu + ((u >> 16) & 1u)) >> 16; }
__device__ __forceinline__ unsigned pk2(float lo, float hi) { return f2bf(lo) | (f2bf(hi) << 16); }
__device__ __forceinline__ float wave_sum(float v) {
#pragma unroll
    for (int o = 1; o < 64; o <<= 1) v += __shfl_xor(v, o);
    return v;
}
__device__ __forceinline__ float wave_max(float v) {
#pragma unroll
    for (int o = 1; o < 64; o <<= 1) v = fmaxf(v, __shfl_xor(v, o));
    return v;
}
__device__ __forceinline__ float gelu_tanh(float x) { const float u = 0.7978845608028654f * (x + 0.044715f * x * x * x); return x / (1.0f + __builtin_amdgcn_exp2f(-2.0f * LOG2E * u)); }
__device__ __forceinline__ float sigmoidf_(float x) { return 1.0f / (1.0f + __builtin_amdgcn_exp2f(-LOG2E * x)); }

__host__ __device__ __forceinline__ int z_phys(int c) {
    if (c < 512) { const int h = c >> 6, d = c & 63; return (h >> 2) * 256 + (d >> 5) * 128 + (h & 3) * 32 + (d & 31); }
    if (c < 768) { const int cc = c - 512, w = cc >> 6, d = cc & 63; return 512 + (d >> 5) * 128 + w * 32 + (d & 31); }
    return c;
}

#define LAS __attribute__((address_space(3)))
__device__ __forceinline__ void p0_transpose_item(const float* W, int K, int N, bf16_t* WT, int mode, int row_off, LAS float* scr, int item, int lane, const float* gk = nullptr) {
    const int nblk = N / 32, kb = item / nblk, nb = item % nblk, k0 = 64 * kb, n0 = 32 * nb;
    float tv[32];
#pragma unroll
    for (int i = 0; i < 32; ++i) tv[i] = NT2 ? __builtin_nontemporal_load(&W[(size_t)(k0 + 2 * i + (lane >> 5)) * N + n0 + (lane & 31)]) : W[(size_t)(k0 + 2 * i + (lane >> 5)) * N + n0 + (lane & 31)];
    if (gk) {
#pragma unroll
        for (int i = 0; i < 32; ++i) tv[i] *= gk[k0 + 2 * i + (lane >> 5)]; }
#pragma unroll
    for (int i = 0; i < 32; ++i) scr[(2 * i + (lane >> 5)) * 33 + (lane & 31)] = tv[i];
    __builtin_amdgcn_s_waitcnt(0xC07F); asm volatile("" ::: "memory");
    const int c = lane & 7;
#pragma unroll
    for (int j = 0; j < 4; ++j) { const int n = (lane >> 3) + 8 * j; const LAS float* s = scr + (8 * c) * 33 + n;
        u32x4 o; o.x = pk2(s[0 * 33], s[1 * 33]); o.y = pk2(s[2 * 33], s[3 * 33]); o.z = pk2(s[4 * 33], s[5 * 33]); o.w = pk2(s[6 * 33], s[7 * 33]);
        const int nl = n0 + n; int row;
        if (mode == 0) row = row_off + nl; else if (mode == 1) row = z_phys(nl); else if (mode == 2) row = 256 * (nl >> 7) + (nl & 127); else row = 256 * (nl >> 7) + 128 + (nl & 127);
        *(u32x4*)(WT + (size_t)row * K + k0 + 8 * c) = o; }
    __builtin_amdgcn_s_waitcnt(0xC07F); asm volatile("" ::: "memory");
}
struct PtrsIn { const float* in[27]; };
constexpr int IT_WIN = 16 * 120, IT_CKV = 16 * 32, IT_ATT = 8 * 32, IT_SGU = 8 * 32, IT_OUT = 16 * 32, IT_CQ = 16 * 16, IT_CO = 8 * 32, IT_G = 16 * 16, IT_DN = 8 * 32;
constexpr int IT_P0 = IT_WIN + IT_CKV + IT_ATT + IT_SGU + IT_OUT + IT_CQ + IT_CO;
constexpr int IT_TOTAL = IT_P0 + NE * (2 * IT_G + IT_DN);
__device__ __forceinline__ void p0_weight_item(const PtrsIn& P, unsigned char* ws, LAS float* scr, int it, int lane) {
    int r = it;
    bf16_t* WZ = (bf16_t*)(ws + WS_WZ);
    if (r < IT_WIN) { p0_transpose_item(P.in[3], 1024, NZ, WZ, 1, 0, scr, r, lane, X0_BF16 ? P.in[2] : nullptr); return; } r -= IT_WIN;
    if (r < IT_CKV) { p0_transpose_item(P.in[16], 1024, 1024, WZ, 0, NZ, scr, r, lane); return; } r -= IT_CKV;
    if (r < IT_ATT) { p0_transpose_item(P.in[6], 512, 1024, (bf16_t*)(ws + WS_WATT), 0, 0, scr, r, lane); return; } r -= IT_ATT;
    if (r < IT_SGU) { p0_transpose_item(P.in[11], 512, 1024, (bf16_t*)(ws + WS_WSGU), 0, 0, scr, r, lane); return; } r -= IT_SGU;
    if (r < IT_OUT) { p0_transpose_item(P.in[12], 1024, 1024, (bf16_t*)(ws + WS_WOUT), 0, 0, scr, r, lane); return; } r -= IT_OUT;
    if (r < IT_CQ) { p0_transpose_item(P.in[15], 1024, 512, (bf16_t*)(ws + WS_WCQ), 0, 0, scr, r, lane, FOLD_GAINS ? P.in[13] : nullptr); return; } r -= IT_CQ;
    if (r < IT_CO) { p0_transpose_item(P.in[17], 512, 1024, (bf16_t*)(ws + WS_WCO), 0, 0, scr, r, lane); return; } r -= IT_CO;
    const int per = 2 * IT_G + IT_DN, e = r / per; r -= e * per;
    if (r < IT_G) { p0_transpose_item(P.in[23] + (size_t)e * 1024 * 512, 1024, 512, (bf16_t*)(ws + WS_WGU) + (size_t)e * 1024 * 1024, 2, 0, scr, r, lane, FOLD_MOE ? P.in[18] : nullptr); return; } r -= IT_G;
    if (r < IT_G) { p0_transpose_item(P.in[24] + (size_t)e * 1024 * 512, 1024, 512, (bf16_t*)(ws + WS_WGU) + (size_t)e * 1024 * 1024, 3, 0, scr, r, lane, FOLD_MOE ? P.in[18] : nullptr); return; } r -= IT_G;
    p0_transpose_item(P.in[25] + (size_t)e * 512 * 1024, 512, 1024, (bf16_t*)(ws + WS_WD) + (size_t)e * 1024 * 512, 0, 0, scr, r, lane);
}
struct Row4 { f32x4 v[4]; };
__device__ __forceinline__ Row4 row_load(const float* xrow, int lane) { Row4 r; const f32x4* xr = (const f32x4*)xrow + lane;
#pragma unroll
    for (int j = 0; j < 4; ++j) r.v[j] = NT_LOADS ? __builtin_nontemporal_load(&xr[64 * j]) : xr[64 * j];
    return r; }
__device__ __forceinline__ void rms_row_store(const Row4& r, const float* g, bf16_t* orow, int lane) {
    const f32x4* gr = (const f32x4*)g + lane; float s = 0.f;
#pragma unroll
    for (int j = 0; j < 4; ++j) s += (r.v[j].x * r.v[j].x + r.v[j].y * r.v[j].y) + (r.v[j].z * r.v[j].z + r.v[j].w * r.v[j].w);
    const float rs = 1.0f / sqrtf(wave_sum(s) * (1.f / 1024.f) + EPS);
    unsigned long long* o8 = (unsigned long long*)orow + lane;
#pragma unroll
    for (int j = 0; j < 4; ++j) { const f32x4 gg = gr[64 * j]; o8[64 * j] = (unsigned long long)pk2(r.v[j].x * rs * gg.x, r.v[j].y * rs * gg.y) | ((unsigned long long)pk2(r.v[j].z * rs * gg.z, r.v[j].w * rs * gg.w) << 32); }
}
__device__ __forceinline__ void xb0_row_store(const Row4& r, bf16_t* orow, float* rs_out, int lane) {
    float s = 0.f;
#pragma unroll
    for (int j = 0; j < 4; ++j) s += (r.v[j].x * r.v[j].x + r.v[j].y * r.v[j].y) + (r.v[j].z * r.v[j].z + r.v[j].w * r.v[j].w);
    const float rs = 1.0f / sqrtf(wave_sum(s) * (1.f / 1024.f) + EPS);
    unsigned long long* o8 = (unsigned long long*)orow + lane;
#pragma unroll
    for (int j = 0; j < 4; ++j) o8[64 * j] = (unsigned long long)pk2(r.v[j].x, r.v[j].y) | ((unsigned long long)pk2(r.v[j].z, r.v[j].w) << 32);
    if (lane == 0) *rs_out = rs;
}
__device__ __forceinline__ void xb0_rows(const float* x, bf16_t* o, float* rs0, int first, int step, int rows, int lane) {
    if (first >= rows) return;
    const int last = first + ((rows - 1 - first) / step) * step;
    Row4 r0 = row_load(x + (size_t)first * D, lane);
    Row4 r1 = row_load(x + (size_t)((first + step <= last) ? first + step : last) * D, lane);
    for (int m = first; m < rows; m += step) { const int m2 = (m + 2 * step <= last) ? m + 2 * step : last;
        const Row4 r2 = row_load(x + (size_t)m2 * D, lane);
        xb0_row_store(r0, o + (size_t)m * D, rs0 + m, lane); r0 = r1; r1 = r2; }
}
__device__ __forceinline__ void rms_rows(const float* x, const float* g, bf16_t* o, int first, int step, int rows, int lane) {
    if (first >= rows) return;
    const int last = first + ((rows - 1 - first) / step) * step;
    Row4 r0 = row_load(x + (size_t)first * D, lane);
    Row4 r1 = row_load(x + (size_t)((first + step <= last) ? first + step : last) * D, lane);
    for (int m = first; m < rows; m += step) { const int m2 = (m + 2 * step <= last) ? m + 2 * step : last;
        const Row4 r2 = row_load(x + (size_t)m2 * D, lane);
        rms_row_store(r0, g, o + (size_t)m * D, lane); r0 = r1; r1 = r2; }
}
__device__ __forceinline__ void rms_row_to_bf16(const float* xrow, const float* g, bf16_t* orow, int lane) {
    const f32x4* xr = (const f32x4*)xrow + lane; const f32x4* gr = (const f32x4*)g + lane;
    f32x4 v[4]; float s = 0.f;
#pragma unroll
    for (int j = 0; j < 4; ++j) { v[j] = xr[64 * j]; s += (v[j].x * v[j].x + v[j].y * v[j].y) + (v[j].z * v[j].z + v[j].w * v[j].w); }
    const float rs = 1.0f / sqrtf(wave_sum(s) * (1.f / 1024.f) + EPS);
    unsigned long long* o8 = (unsigned long long*)orow + lane;
#pragma unroll
    for (int j = 0; j < 4; ++j) { const f32x4 gg = gr[64 * j]; o8[64 * j] = (unsigned long long)pk2(v[j].x * rs * gg.x, v[j].y * rs * gg.y) | ((unsigned long long)pk2(v[j].z * rs * gg.z, v[j].w * rs * gg.w) << 32); }
}
__device__ __forceinline__ void rope_table_entry(float* tab, int idx) {
    const int pos = idx >> 4, i = idx & 15;
    const float inv = exp2f(-(float)i * (13.287712379549449f / 16.0f));
    const float ang = (float)pos * inv;
    float s, c; sincosf(ang, &s, &c);
    tab[0 * 2048 + idx] = c; tab[1 * 2048 + idx] = s; tab[2 * 2048 + idx] = c; tab[3 * 2048 + idx] = s;
}

__device__ __forceinline__ void route_decide(const float (&lg)[20], const float* b_rg, const float* b_re, int& e0, int& e1, float& w0, float& w1) {
    float g0 = lg[0] + b_rg[0], g1 = lg[1] + b_rg[1], g2 = lg[2] + b_rg[2], g3 = lg[3] + b_rg[3];
    int gi = 0; float gm = g0; if (g1 > gm) { gm = g1; gi = 1; } if (g2 > gm) { gm = g2; gi = 2; } if (g3 > gm) { gm = g3; gi = 3; }
    const float gval = 1.0f / (expf(g0 - gm) + expf(g1 - gm) + expf(g2 - gm) + expf(g3 - gm));
    float ev[4];
#pragma unroll
    for (int j = 0; j < 4; ++j) { float t = 0.f;
#pragma unroll
        for (int g = 0; g < 4; ++g) t = (gi == g) ? (lg[4 + 4 * g + j] + b_re[4 * g + j]) : t;
        ev[j] = t; }
    int i0 = 0; float m0 = ev[0];
#pragma unroll
    for (int j = 1; j < 4; ++j) if (ev[j] > m0) { m0 = ev[j]; i0 = j; }
    int i1 = -1; float m1 = -INFINITY;
#pragma unroll
    for (int j = 0; j < 4; ++j) if (j != i0 && ev[j] > m1) { m1 = ev[j]; i1 = j; }
    const float p1 = expf(m1 - m0), den = 1.0f / (1.0f + p1);
    e0 = gi * 4 + i0; e1 = gi * 4 + i1; w0 = den * gval; w1 = p1 * den * gval;
}
template <class RW> __device__ __forceinline__ void route_token(const Row4& xin, const float* gmoe, RW rw, const float* b_rg, const float* b_re, bf16_t* orow, int lane, int& e0, int& e1, float& w0, float& w1) {
    const f32x4* gr = (const f32x4*)gmoe + lane;
    f32x4 v[4]; float s = 0.f;
#pragma unroll
    for (int j = 0; j < 4; ++j) { v[j] = xin.v[j]; s += (v[j].x * v[j].x + v[j].y * v[j].y) + (v[j].z * v[j].z + v[j].w * v[j].w); }
    const float rs = 1.0f / sqrtf(wave_sum(s) * (1.f / 1024.f) + EPS);
    unsigned long long* o8 = (unsigned long long*)orow + lane;
#pragma unroll
    for (int j = 0; j < 4; ++j) { const f32x4 gg = gr[64 * j]; v[j].x *= rs * gg.x; v[j].y *= rs * gg.y; v[j].z *= rs * gg.z; v[j].w *= rs * gg.w;
        o8[64 * j] = (unsigned long long)pk2(v[j].x, v[j].y) | ((unsigned long long)pk2(v[j].z, v[j].w) << 32); }
    float lg[20];
#pragma unroll
    for (int o = 0; o < 20; ++o) { auto wr = rw + o * 1024 + 4 * lane; float a = 0.f;
#pragma unroll
        for (int j = 0; j < 4; ++j) { const float w0_ = wr[256 * j], w1_ = wr[256 * j + 1], w2_ = wr[256 * j + 2], w3_ = wr[256 * j + 3]; a += (v[j].x * w0_ + v[j].y * w1_) + (v[j].z * w2_ + v[j].w * w3_); }
        lg[o] = wave_sum(a); }
    route_decide(lg, b_rg, b_re, e0, e1, w0, w1);
}
__device__ __forceinline__ void final_row(float* orow, const bf16_t* ys2, const float* g, int lane) {
    f32x4* xr = (f32x4*)orow + lane; const f32x4* gr = (const f32x4*)g + lane;
    const u32x2* y0 = (const u32x2*)ys2 + lane; const u32x2* y1 = (const u32x2*)(ys2 + 1024) + lane;
    f32x4 v[4]; float s = 0.f;
#pragma unroll
    for (int j = 0; j < 4; ++j) { v[j] = xr[64 * j]; const u32x2 a = y0[64 * j], b = y1[64 * j];
        v[j].x += bf2f((bf16_t)(a.x & 0xffff)) + bf2f((bf16_t)(b.x & 0xffff)); v[j].y += bf2f((bf16_t)(a.x >> 16)) + bf2f((bf16_t)(b.x >> 16));
        v[j].z += bf2f((bf16_t)(a.y & 0xffff)) + bf2f((bf16_t)(b.y & 0xffff)); v[j].w += bf2f((bf16_t)(a.y >> 16)) + bf2f((bf16_t)(b.y >> 16));
        s += (v[j].x * v[j].x + v[j].y * v[j].y) + (v[j].z * v[j].z + v[j].w * v[j].w); }
    const float rs = 1.0f / sqrtf(wave_sum(s) * (1.f / 1024.f) + EPS);
#pragma unroll
    for (int j = 0; j < 4; ++j) { const f32x4 gg = gr[64 * j]; f32x4 o; o.x = v[j].x * rs * gg.x; o.y = v[j].y * rs * gg.y; o.z = v[j].z * rs * gg.z; o.w = v[j].w * rs * gg.w; xr[64 * j] = o; }
}

struct RowF { f32x4 v[4]; u32x2 a[4], b[4]; };
__device__ __forceinline__ RowF rowf_load(const float* orow, const bf16_t* ys2, int lane) { RowF r; const f32x4* xr = (const f32x4*)orow + lane; const u32x2* y0 = (const u32x2*)ys2 + lane; const u32x2* y1 = (const u32x2*)(ys2 + 1024) + lane;
#pragma unroll
    for (int j = 0; j < 4; ++j) { r.v[j] = xr[64 * j]; r.a[j] = y0[64 * j]; r.b[j] = y1[64 * j]; }
    return r; }
__device__ __forceinline__ void rowf_store(const RowF& r, float* orow, const float* g, int lane) {
    f32x4* xr = (f32x4*)orow + lane; const f32x4* gr = (const f32x4*)g + lane; f32x4 v[4]; float s = 0.f;
#pragma unroll
    for (int j = 0; j < 4; ++j) { v[j] = r.v[j]; const u32x2 a = r.a[j], b = r.b[j];
        v[j].x += __uint_as_float(a.x << 16) + __uint_as_float(b.x << 16); v[j].y += __uint_as_float(a.x & 0xffff0000u) + __uint_as_float(b.x & 0xffff0000u);
        v[j].z += __uint_as_float(a.y << 16) + __uint_as_float(b.y << 16); v[j].w += __uint_as_float(a.y & 0xffff0000u) + __uint_as_float(b.y & 0xffff0000u);
        s += (v[j].x * v[j].x + v[j].y * v[j].y) + (v[j].z * v[j].z + v[j].w * v[j].w); }
    const float rs = 1.0f / sqrtf(wave_sum(s) * (1.f / 1024.f) + EPS);
#pragma unroll
    for (int j = 0; j < 4; ++j) { const f32x4 gg = gr[64 * j]; f32x4 o; o.x = v[j].x * rs * gg.x; o.y = v[j].y * rs * gg.y; o.z = v[j].z * rs * gg.z; o.w = v[j].w * rs * gg.w;
#if FINAL_NT
        __builtin_nontemporal_store(o, &xr[64 * j]);
#else
        xr[64 * j] = o;
#endif
    }
}
__device__ __forceinline__ RowF rowf_load_b(const bf16_t* xb, const bf16_t* ys2, int lane) { RowF r; const u32x2* xr = (const u32x2*)xb + lane; const u32x2* y0 = (const u32x2*)ys2 + lane; const u32x2* y1 = (const u32x2*)(ys2 + 1024) + lane;
#pragma unroll
    for (int j = 0; j < 4; ++j) { const u32x2 q = NT_LOADS ? __builtin_nontemporal_load(&xr[64 * j]) : xr[64 * j]; r.v[j] = (f32x4){__uint_as_float(q.x << 16), __uint_as_float(q.x & 0xffff0000u), __uint_as_float(q.y << 16), __uint_as_float(q.y & 0xffff0000u)};
        r.a[j] = NT_LOADS ? __builtin_nontemporal_load(&y0[64 * j]) : y0[64 * j]; r.b[j] = NT_LOADS ? __builtin_nontemporal_load(&y1[64 * j]) : y1[64 * j]; }
    return r; }
__device__ __forceinline__ void final_rows_b(float* out, const bf16_t* xb, const bf16_t* ys, const float* g, int first, int step, int rows, int lane) {
    if (first >= rows) return;
    RowF cur = rowf_load_b(xb + (size_t)first * D, ys + (size_t)first * 2048, lane);
    for (int m = first; m < rows; m += step) { const int mn = (m + step < rows) ? m + step : m;
        const RowF nxt = rowf_load_b(xb + (size_t)mn * D, ys + (size_t)mn * 2048, lane);
        rowf_store(cur, out + (size_t)m * D, g, lane); cur = nxt; }
}
__device__ __forceinline__ void final_rows(float* out, const bf16_t* ys, const float* g, int first, int step, int rows, int lane) {
    if (first >= rows) return;
    RowF cur = rowf_load(out + (size_t)first * D, ys + (size_t)first * 2048, lane);
    for (int m = first; m < rows; m += step) { const int mn = (m + step < rows) ? m + step : m;
        const RowF nxt = rowf_load(out + (size_t)mn * D, ys + (size_t)mn * 2048, lane);
        rowf_store(cur, out + (size_t)m * D, g, lane); cur = nxt; }
}

__global__ void __launch_bounds__(512) k_prologue(PtrsIn P, unsigned char* ws) {
    extern __shared__ __attribute__((aligned(16))) unsigned char dyn[];
    const int tid = threadIdx.x, lane = tid & 63, wave = tid >> 6;
    const int gw = blockIdx.x * 8 + wave, NGW = gridDim.x * 8;
    LAS float* scr = (LAS float*)dyn + wave * 64 * 33;
    for (int it = gw; it < IT_TOTAL; it += NGW) p0_weight_item(P, ws, scr, it, lane);
    { const float* wsrc = P.in[9]; bf16_t* wd = (bf16_t*)(ws + WS_WSS);
      for (int i = blockIdx.x * 512 + tid; i < 4 * 128 * 128; i += gridDim.x * 512) wd[i] = (bf16_t)f2bf(wsrc[i]); }
    for (int i = blockIdx.x * 512 + tid; i < 2048; i += gridDim.x * 512) rope_table_entry((float*)(ws + WS_TAB), i);
    bf16_t* XN = (bf16_t*)(ws + WS_XN);
    for (int m = gw; m < M; m += NGW) rms_row_to_bf16(P.in[0] + (size_t)m * D, P.in[2], XN + (size_t)m * D, lane);
    for (int m = gw; m < MMEM; m += NGW) rms_row_to_bf16(P.in[1] + (size_t)m * D, P.in[14], XN + (size_t)(M + m) * D, lane);
}
__global__ void __launch_bounds__(512) k_norm_rows(const float* x, const float* g, bf16_t* o, int rows) {
    const int lane = threadIdx.x & 63, gw = blockIdx.x * 8 + (threadIdx.x >> 6), NGW = gridDim.x * 8;
    for (int m = gw; m < rows; m += NGW) rms_row_to_bf16(x + (size_t)m * D, g, o + (size_t)m * D, lane);
}
__global__ void __launch_bounds__(512) k_route(PtrsIn P, const float* x2, unsigned char* ws) {
    extern __shared__ __attribute__((aligned(16))) unsigned char dyn[];
    float* rw = (float*)dyn;
    int* te = (int*)(dyn + 20 * 1024 * 4);
    float* tw = (float*)(te + 256);
    int* tp = (int*)(tw + 256);
    int* ebase = tp + 256;
    const int tid = threadIdx.x, lane = tid & 63, wave = tid >> 6;
    for (int i = tid; i < 1024 * 4; i += 512) { const int k = i >> 2, o = i & 3; rw[o * 1024 + k] = P.in[19][i]; }
    for (int i = tid; i < 1024 * 16; i += 512) { const int k = i >> 4, o = i & 15; rw[(4 + o) * 1024 + k] = P.in[21][i]; }
    __syncthreads();
    bf16_t* XN3 = (bf16_t*)(ws + WS_XN3);
    const int t0 = blockIdx.x * 128;
    for (int i = 0; i < 16; ++i) { const int tl = wave * 16 + i, t = t0 + tl; int e0, e1; float w0, w1;
        route_token(row_load(x2 + (size_t)t * D, lane), P.in[18], rw, P.in[20], P.in[22], XN3 + (size_t)t * D, lane, e0, e1, w0, w1);
        if (lane == 0) { te[2 * tl] = e0; te[2 * tl + 1] = e1; tw[2 * tl] = w0; tw[2 * tl + 1] = w1; } }
    __syncthreads();
    if (wave == 0) {
        int cnt = 0;
        int mye[4]; for (int j = 0; j < 4; ++j) mye[j] = te[j * 64 + lane];
        int pos[4] = {0, 0, 0, 0};
        for (int e = 0; e < 16; ++e) { int run = 0;
            for (int j = 0; j < 4; ++j) { const unsigned long long mk = __ballot(mye[j] == e); const int before = __popcll(mk & ((1ull << lane) - 1ull));
                if (mye[j] == e) pos[j] = run + before; run += __popcll(mk); }
            if (lane == e) cnt = run; }
        for (int j = 0; j < 4; ++j) tp[j * 64 + lane] = pos[j];
        if (lane < 16) { unsigned* ec = (unsigned*)(ws + WS_CTL) + CW_ECNT + 64 * lane; ebase[lane] = (int)atomicAdd(ec, (unsigned)cnt); }
    }
    __syncthreads();
    if (tid < 256) { const int e = te[tid], slot = ebase[e] + tp[tid], dest = (t0 * 2) + tid; const float w = tw[tid];
        int* lst = (int*)(ws + WS_LIST) + ((size_t)e * LIST_CAP + slot) * 2; lst[0] = dest; lst[1] = __float_as_int(w);
        int* ti = (int*)(ws + WS_TOKINFO) + (size_t)dest * 2; ti[0] = e; ti[1] = __float_as_int(w); }
}
__global__ void __launch_bounds__(512) k_final(float* out, const bf16_t* ys, const float* g) {
    const int lane = threadIdx.x & 63, gw = blockIdx.x * 8 + (threadIdx.x >> 6), NGW = gridDim.x * 8;
    for (int m = gw; m < M; m += NGW) final_row(out + (size_t)m * D, ys + (size_t)m * 2048, g, lane);
}

__global__ void __launch_bounds__(256) nv_gemm(const bf16_t* A, int lda, const bf16_t* Bt, int ldb, int K, float* C, int ldc) {
    __shared__ __attribute__((aligned(16))) float As[16][68], Bs[16][68];
    const int tid = threadIdx.x, tx = tid & 15, ty = tid >> 4, r0 = blockIdx.y * 64, n0 = blockIdx.x * 64, lr = tid >> 2, lk = (tid & 3) * 4;
    float acc[4][4];
#pragma unroll
    for (int i = 0; i < 4; ++i)
#pragma unroll
        for (int j = 0; j < 4; ++j) acc[i][j] = 0.f;
    for (int k0 = 0; k0 < K; k0 += 16) {
        const u32x2 av = *(const u32x2*)(A + (size_t)(r0 + lr) * lda + k0 + lk), bv = *(const u32x2*)(Bt + (size_t)(n0 + lr) * ldb + k0 + lk);
        As[lk + 0][lr] = bf2f((bf16_t)(av.x & 0xffff)); As[lk + 1][lr] = bf2f((bf16_t)(av.x >> 16)); As[lk + 2][lr] = bf2f((bf16_t)(av.y & 0xffff)); As[lk + 3][lr] = bf2f((bf16_t)(av.y >> 16));
        Bs[lk + 0][lr] = bf2f((bf16_t)(bv.x & 0xffff)); Bs[lk + 1][lr] = bf2f((bf16_t)(bv.x >> 16)); Bs[lk + 2][lr] = bf2f((bf16_t)(bv.y & 0xffff)); Bs[lk + 3][lr] = bf2f((bf16_t)(bv.y >> 16));
        __syncthreads();
#pragma unroll
        for (int kk = 0; kk < 16; ++kk) { const f32x4 a = *(const f32x4*)&As[kk][ty * 4], b = *(const f32x4*)&Bs[kk][tx * 4];
#pragma unroll
            for (int i = 0; i < 4; ++i)
#pragma unroll
                for (int j = 0; j < 4; ++j) acc[i][j] += a[i] * b[j]; }
        __syncthreads();
    }
#pragma unroll
    for (int i = 0; i < 4; ++i) { f32x4 o = {acc[i][0], acc[i][1], acc[i][2], acc[i][3]}; *(f32x4*)(C + (size_t)(r0 + ty * 4 + i) * ldc + n0 + tx * 4) = o; }
}
__global__ void __launch_bounds__(256) nv_z_epi(const float* Cz, int row0, PtrsIn P, unsigned char* ws) {
    const int tid = threadIdx.x, lane = tid & 63, wave = tid >> 6;
    const int rl = blockIdx.x, row = row0 + rl, t = row % SEQ, rid = t >> 6, cid = t & 63;
    const float* z = Cz + (size_t)rl * NZ; const float* tab = (const float*)(ws + WS_TAB);
    if (wave == 0) {
        for (int hh = 0; hh < 10; ++hh) {
            const int c = (hh < 8) ? hh * 64 + lane : 512 + (hh - 8) * 64 + lane;
            const float v = z[z_phys(c)]; const float ss = wave_sum(v * v); const float rs = 1.0f / sqrtf(ss * (1.f / 64.f) + EPS);
            const float g = (hh < 8) ? P.in[4][lane] : P.in[5][lane];
            const float y = v * rs * g, yp = __shfl_xor(y, 1);
            const int i = lane >> 1; const float cs = (i < 16) ? tab[0 * 2048 + rid * 16 + i] : tab[2 * 2048 + cid * 16 + (i - 16)], sn = (i < 16) ? tab[1 * 2048 + rid * 16 + i] : tab[3 * 2048 + cid * 16 + (i - 16)];
            const float o = (lane & 1) ? (yp * sn + y * cs) : (y * cs - yp * sn);
            if (hh < 8) ((bf16_t*)(ws + WS_Q))[(size_t)row * 512 + hh * 64 + lane] = (bf16_t)f2bf(o * C2_SELF);
            else ((bf16_t*)(ws + WS_K))[(size_t)row * 128 + (hh - 8) * 64 + lane] = (bf16_t)f2bf(o);
        }
        for (int c = lane; c < 128; c += 64) ((bf16_t*)(ws + WS_V))[(size_t)row * 128 + c] = (bf16_t)f2bf(z[z_phys(ZV + c)]);
    } else {
        for (int c = tid - 64; c < 512; c += 192) { ((bf16_t*)(ws + WS_U))[(size_t)row * 512 + c] = (bf16_t)f2bf(gelu_tanh(z[ZSU + c])); ((bf16_t*)(ws + WS_GV))[(size_t)row * 512 + c] = (bf16_t)f2bf(gelu_tanh(z[ZSV + c])); }
        for (int c = tid - 64; c < 1024; c += 192) { ((bf16_t*)(ws + WS_GA))[(size_t)row * 1024 + c] = (bf16_t)f2bf(sigmoidf_(z[ZGA + c])); ((bf16_t*)(ws + WS_GB))[(size_t)row * 1024 + c] = (bf16_t)f2bf(sigmoidf_(z[ZGB + c])); }
    }
}
__global__ void __launch_bounds__(256) nv_store_bf16(const float* C, bf16_t* O, size_t n, float scale) {
    for (size_t i = (size_t)blockIdx.x * 256 + threadIdx.x; i < n; i += (size_t)gridDim.x * 256) O[i] = (bf16_t)f2bf(C[i] * scale);
}
__global__ void __launch_bounds__(256) nv_attn(const bf16_t* Q, const bf16_t* Kb, const bf16_t* Vb, bf16_t* O) {
    extern __shared__ __attribute__((aligned(16))) unsigned char dyn[];
    float (*Qs)[65] = (float (*)[65])dyn; float (*Ks)[65] = Qs + 64; float (*Vs)[65] = Ks + 64; float (*Ps)[65] = Vs + 64;
    const int tid = threadIdx.x, tx = tid & 15, ty = tid >> 4, qb = blockIdx.x, h = blockIdx.y, b = blockIdx.z, kvh = h >> 2;
    const int lr = tid >> 2, lc = (tid & 3) * 16;
    { const bf16_t* src = Q + ((size_t)(b * SEQ + qb * 64 + lr)) * 512 + h * 64 + lc;
      for (int j = 0; j < 16; ++j) Qs[lr][lc + j] = bf2f(src[j]); }
    float m[4], l[4], o[4][4];
    for (int i = 0; i < 4; ++i) { m[i] = -1e30f; l[i] = 0.f; for (int j = 0; j < 4; ++j) o[i][j] = 0.f; }
    for (int kt = 0; kt < SEQ / 64; ++kt) {
        __syncthreads();
        { const bf16_t* ks = Kb + ((size_t)(b * SEQ + kt * 64 + lr)) * 128 + kvh * 64 + lc; const bf16_t* vs = Vb + ((size_t)(b * SEQ + kt * 64 + lr)) * 128 + kvh * 64 + lc;
          for (int j = 0; j < 16; ++j) { Ks[lr][lc + j] = bf2f(ks[j]); Vs[lr][lc + j] = bf2f(vs[j]); } }
        __syncthreads();
        float s[4][4];
        for (int i = 0; i < 4; ++i) for (int j = 0; j < 4; ++j) s[i][j] = 0.f;
        for (int d = 0; d < 64; ++d) { float a[4], bb[4];
            for (int i = 0; i < 4; ++i) { a[i] = Qs[ty * 4 + i][d]; bb[i] = Ks[tx * 4 + i][d]; }
            for (int i = 0; i < 4; ++i) for (int j = 0; j < 4; ++j) s[i][j] += a[i] * bb[j]; }
        for (int i = 0; i < 4; ++i) {
            float rm = fmaxf(fmaxf(s[i][0], s[i][1]), fmaxf(s[i][2], s[i][3]));
            for (int x = 1; x < 16; x <<= 1) rm = fmaxf(rm, __shfl_xor(rm, x));
            const float mn = fmaxf(m[i], rm), al = __builtin_amdgcn_exp2f(m[i] - mn);
            float rsum = 0.f;
            for (int j = 0; j < 4; ++j) { const float p = __builtin_amdgcn_exp2f(s[i][j] - mn); Ps[ty * 4 + i][tx * 4 + j] = p; rsum += p; }
            for (int x = 1; x < 16; x <<= 1) rsum += __shfl_xor(rsum, x);
            l[i] = l[i] * al + rsum; m[i] = mn;
            for (int j = 0; j < 4; ++j) o[i][j] *= al;
        }
        __syncthreads();
        for (int c = 0; c < 64; ++c) { float p[4], v[4];
            for (int i = 0; i < 4; ++i) { p[i] = Ps[ty * 4 + i][c]; v[i] = Vs[c][tx * 4 + i]; }
            for (int i = 0; i < 4; ++i) for (int j = 0; j < 4; ++j) o[i][j] += p[i] * v[j]; }
    }
    for (int i = 0; i < 4; ++i) { const float il = 1.0f / l[i]; bf16_t* dst = O + ((size_t)(b * SEQ + qb * 64 + ty * 4 + i)) * 512 + h * 64 + tx * 4;
        for (int j = 0; j < 4; ++j) dst[j] = (bf16_t)f2bf(o[i][j] * il); }
}
__global__ void __launch_bounds__(256) nv_sgu(PtrsIn P, unsigned char* ws) {
    extern __shared__ __attribute__((aligned(16))) unsigned char dyn[];
    float* vn = (float*)dyn;
    float* mu = vn + 128 * 129; float* rstd = mu + 128;
    const int tid = threadIdx.x, lane = tid & 63, wave = tid >> 6, ch = blockIdx.x, g = blockIdx.y;
    const bf16_t* GV = (const bf16_t*)(ws + WS_GV) + (size_t)ch * 128 * 512;
    for (int r = wave * 32; r < wave * 32 + 32; ++r) { float s = 0.f;
        float xv[8]; for (int j = 0; j < 8; ++j) { xv[j] = bf2f(GV[(size_t)r * 512 + j * 64 + lane]); s += xv[j]; }
        const float mean = wave_sum(s) * (1.f / 512.f); float q = 0.f;
        for (int j = 0; j < 8; ++j) { const float d = xv[j] - mean; q += d * d; }
        const float var = wave_sum(q) * (1.f / 512.f);
        if (lane == 0) { mu[r] = mean; rstd[r] = 1.0f / sqrtf(var + EPS); } }
    __syncthreads();
    for (int i = tid; i < 128 * 128; i += 256) { const int q = i >> 7, c = i & 127, cg = g * 128 + c;
        vn[q * 129 + c] = (bf2f(GV[(size_t)q * 512 + cg]) - mu[q]) * rstd[q] * P.in[7][cg] + P.in[8][cg]; }
    __syncthreads();
    const bf16_t* W = (const bf16_t*)(ws + WS_WSS) + (size_t)g * 128 * 128;
    const bf16_t* U = (const bf16_t*)(ws + WS_U) + (size_t)ch * 128 * 512; bf16_t* SG = (bf16_t*)(ws + WS_SG) + (size_t)ch * 128 * 512;
    const int c = tid & 127;
    for (int p = tid >> 7; p < 128; p += 2) { float a = 0.f;
        for (int q = 0; q < 128; ++q) a += bf2f(W[p * 128 + q]) * vn[q * 129 + c];
        a += P.in[10][g * 128 + p];
        SG[(size_t)p * 512 + g * 128 + c] = (bf16_t)f2bf(bf2f(U[(size_t)p * 512 + g * 128 + c]) * a); }
}
__global__ void __launch_bounds__(256) nv_merge(const float* C1, const float* C2, const bf16_t* GA, const bf16_t* GB, bf16_t* Mg, size_t n) {
    for (size_t i = (size_t)blockIdx.x * 256 + threadIdx.x; i < n; i += (size_t)gridDim.x * 256) Mg[i] = (bf16_t)f2bf(bf2f(GA[i]) * C1[i] + bf2f(GB[i]) * C2[i]);
}
__global__ void __launch_bounds__(256) nv_resid(const float* base, const float* C, float* out, size_t n) {
    for (size_t i = (size_t)blockIdx.x * 256 + threadIdx.x; i < n; i += (size_t)gridDim.x * 256) out[i] = base[i] + C[i];
}
__global__ void __launch_bounds__(256) nv_cross(const bf16_t* QC, const bf16_t* KVC, bf16_t* OC) {
    __shared__ float qs[512]; __shared__ float ps[4][256];
    const int tid = threadIdx.x, lane = tid & 63, h = tid >> 6, tok = blockIdx.x, b = tok / SEQ;
    for (int i = tid; i < 512; i += 256) qs[i] = bf2f(QC[(size_t)tok * 512 + i]);
    __syncthreads();
    float sc[4]; float mx = -1e30f;
    for (int j = 0; j < 4; ++j) { const int mrow = b * NMEM + j * 64 + lane; const bf16_t* kr = KVC + (size_t)mrow * 1024 + h * 128; float a = 0.f;
        for (int d = 0; d < 128; ++d) a += qs[h * 128 + d] * bf2f(kr[d]);
        sc[j] = a; mx = fmaxf(mx, a); }
    mx = wave_max(mx); float sum = 0.f;
    for (int j = 0; j < 4; ++j) { const float p = __builtin_amdgcn_exp2f(sc[j] - mx); ps[h][j * 64 + lane] = p; sum += p; }
    sum = wave_sum(sum);
    __syncthreads();
    for (int dd = 0; dd < 2; ++dd) { const int d = dd * 64 + lane; float a = 0.f;
        for (int mm = 0; mm < 256; ++mm) a += ps[h][mm] * bf2f(KVC[(size_t)(b * NMEM + mm) * 1024 + 512 + h * 128 + d]);
        OC[(size_t)tok * 512 + h * 128 + d] = (bf16_t)f2bf(a / sum); }
}
__global__ void __launch_bounds__(256) nv_moe_a(const bf16_t* XN3, unsigned char* ws) {
    __shared__ float xs[1024];
    const int tid = threadIdx.x, dest = blockIdx.x, tok = dest >> 1;
    const int e = ((const int*)(ws + WS_TOKINFO))[(size_t)dest * 2];
    for (int i = tid; i < 1024; i += 256) xs[i] = bf2f(XN3[(size_t)tok * 1024 + i]);
    __syncthreads();
    const bf16_t* W = (const bf16_t*)(ws + WS_WGU) + (size_t)e * 1024 * 1024; bf16_t* Hh = (bf16_t*)(ws + WS_H) + (size_t)dest * 512;
    for (int n = tid; n < 512; n += 256) { const bf16_t* wg = W + (size_t)(256 * (n >> 7) + (n & 127)) * 1024; const bf16_t* wu = wg + 128 * 1024; float a = 0.f, b = 0.f;
        for (int k = 0; k < 1024; k += 8) { const u32x4 g4 = *(const u32x4*)(wg + k), u4 = *(const u32x4*)(wu + k);
            const unsigned gg[4] = {g4.x, g4.y, g4.z, g4.w}, uu[4] = {u4.x, u4.y, u4.z, u4.w};
            for (int j = 0; j < 4; ++j) { a += xs[k + 2 * j] * bf2f((bf16_t)(gg[j] & 0xffff)) + xs[k + 2 * j + 1] * bf2f((bf16_t)(gg[j] >> 16)); b += xs[k + 2 * j] * bf2f((bf16_t)(uu[j] & 0xffff)) + xs[k + 2 * j + 1] * bf2f((bf16_t)(uu[j] >> 16)); } }
        Hh[n] = (bf16_t)f2bf(a * sigmoidf_(a) * b); }
}
__global__ void __launch_bounds__(256) nv_moe_b(unsigned char* ws) {
    __shared__ float hs[512];
    const int tid = threadIdx.x, dest = blockIdx.x;
    const int* ti = (const int*)(ws + WS_TOKINFO) + (size_t)dest * 2; const int e = ti[0]; const float w = __int_as_float(ti[1]);
    const bf16_t* Hh = (const bf16_t*)(ws + WS_H) + (size_t)dest * 512;
    for (int i = tid; i < 512; i += 256) hs[i] = bf2f(Hh[i]);
    __syncthreads();
    const bf16_t* W = (const bf16_t*)(ws + WS_WD) + (size_t)e * 1024 * 512; bf16_t* Y = (bf16_t*)(ws + WS_YS) + (size_t)dest * 1024;
    for (int n = tid; n < 1024; n += 256) { const bf16_t* wr = W + (size_t)n * 512; float a = 0.f;
        for (int k = 0; k < 512; k += 8) { const u32x4 g4 = *(const u32x4*)(wr + k); const unsigned gg[4] = {g4.x, g4.y, g4.z, g4.w};
            for (int j = 0; j < 4; ++j) a += hs[k + 2 * j] * bf2f((bf16_t)(gg[j] & 0xffff)) + hs[k + 2 * j + 1] * bf2f((bf16_t)(gg[j] >> 16)); }
        Y[n] = (bf16_t)f2bf(a * w); }
}

namespace pg8 {
typedef short bf16x8 __attribute__((ext_vector_type(8)));
#ifndef WGM_V
#define WGM_V 8
#endif
constexpr int BM = 256, BK = 64, HALF = 128, HTB = HALF * BK * 2, STAGE_BYTES = 8 * HTB, NXCD = 8, WGM = WGM_V;
__host__ __device__ __forceinline__ int lds_byte(int r, int c) { const int st = (r >> 4) * 2 + (c >> 5), rr = r & 15, cc = c & 31, ob = rr * 64 + cc * 2; return st * 1024 + (ob ^ (((ob >> 9) & 1) << 5)); }
__host__ __device__ __forceinline__ void stage_rc(int b, int& R, int& C) { const int st = b / 1024, sb = b % 1024, swz = sb ^ (((sb >> 9) & 1) << 5); R = (st >> 1) * 16 + swz / 64; C = (st & 1) * 32 + (swz % 64) / 2; }
__host__ __device__ __forceinline__ int perm32(int rho) { const int n = rho >> 4, i = rho & 15; return 8 * (i >> 2) + 4 * n + (i & 3); }
struct Unit { int pm, pn, kind, dup; };
__device__ __forceinline__ void tile_of(int L, int nM, int nN, int& pm, int& pn) {
    const int nwg = nM * nN; int wgid = L; { const int q = nwg / NXCD, r = nwg % NXCD, xcd = wgid % NXCD, off = wgid / NXCD; wgid = (xcd < r ? xcd * (q + 1) : r * (q + 1) + (xcd - r) * q) + off; }
    const int nig = WGM * nN, gid = wgid / nig, fm = gid * WGM, gsz = (nM - fm) < WGM ? (nM - fm) : WGM;
    pm = fm + ((wgid % nig) % gsz); pn = (wgid % nig) / gsz;
}
__device__ __forceinline__ unsigned cvt_pk_bf16(float lo, float hi) { unsigned r; asm volatile("v_cvt_pk_bf16_f32 %0, %1, %2" : "=v"(r) : "v"(lo), "v"(hi)); return r; }

template <class Epi, class Sched, bool ALIGN_EPI, bool GATHER, bool VARK = false>
__device__ __forceinline__ void gemm_phase(LAS unsigned char* lds, const int Kc, const Sched& S, const Epi& E, const unsigned stag_ticks = 0u) {
    static_assert(!(VARK && GATHER), "VARK computes its offsets arithmetically");
    unsigned k2c = (unsigned)Kc * 2u, k2n = (unsigned)Kc * 2u;
    const int tid = threadIdx.x, wid = __builtin_amdgcn_readfirstlane(tid >> 6), lane = tid & 63, wr = wid >> 2, wc = wid & 3, fr = lane & 15, fq = lane >> 4;
    const int K = Kc; int nt = K / BK;
    unsigned voffA[2], voffB[2]; int RA[2], CA2[2], RB[2];
#pragma unroll
    for (int i = 0; i < 2; ++i) { int R, C; stage_rc(tid * 16 + i * 8192, R, C); const int Rb = Epi::PERM ? ((R & ~31) + perm32(R & 31)) : R;
        voffA[i] = (unsigned)(R * K + C) * 2u; voffB[i] = (unsigned)(Rb * K + C) * 2u; RA[i] = R; CA2[i] = C * 2; RB[i] = Rb; }
    const size_t kstep = (size_t)(BK * 2);
    const size_t hstep = (size_t)HALF * K * 2;
    const unsigned ldsw = (unsigned)wid * 1024u;
    const int aoff = lds_byte(wr * 64 + fr, fq * 8), boff = lds_byte(wc * 32 + fr, fq * 8);
    unsigned vA[2][2] = {{0u, 0u}, {0u, 0u}}, vN[2][2] = {{0u, 0u}, {0u, 0u}};
#define PG8_SA(b, h) (((b) * 2 + (h)) * HTB)
#define PG8_SB(b, h) ((4 + (b) * 2 + (h)) * HTB)
#define PG8_STAGE(bufoff, gbase, voff) do { _Pragma("unroll") for (int _i = 0; _i < 2; ++_i) \
        __builtin_amdgcn_global_load_lds((const unsigned*)((const char*)(gbase) + (voff)[_i]), (LAS unsigned*)(lds + (bufoff) + ldsw + _i * 8192), 16, 0, 0); } while (0)
#define PG8_STAGEA(bufoff, gbase, h, nx) do { _Pragma("unroll") for (int _i = 0; _i < 2; ++_i) { \
        const unsigned _o = VARK ? (unsigned)((h) * HALF + RA[_i]) * ((nx) ? k2n : k2c) + (unsigned)CA2[_i] : (GATHER ? ((nx) ? vN[h][_i] : vA[h][_i]) : voffA[_i]); \
        __builtin_amdgcn_global_load_lds((const unsigned*)((const char*)(gbase) + ((GATHER || VARK) ? (size_t)0 : (size_t)(h) * hstep) + _o), (LAS unsigned*)(lds + (bufoff) + ldsw + _i * 8192), 16, 0, 0); } } while (0)
#define PG8_STAGEB(bufoff, gbase, h, nx) do { _Pragma("unroll") for (int _i = 0; _i < 2; ++_i) { \
        const unsigned _o = VARK ? (unsigned)((h) * HALF + RB[_i]) * ((nx) ? k2n : k2c) + (unsigned)CA2[_i] : voffB[_i]; \
        __builtin_amdgcn_global_load_lds((const unsigned*)((const char*)(gbase) + (VARK ? (size_t)0 : (size_t)(h) * hstep) + _o), (LAS unsigned*)(lds + (bufoff) + ldsw + _i * 8192), 16, 0, 0); } } while (0)
#define PG8_LDA(dst, b, h) do { _Pragma("unroll") for (int m = 0; m < 4; ++m) _Pragma("unroll") for (int k = 0; k < 2; ++k) dst[m][k] = *(const LAS bf16x8*)(lds + PG8_SA(b, h) + aoff + m * 2048 + k * 1024); } while (0)
#define PG8_LDB(dst, b, h) do { _Pragma("unroll") for (int n = 0; n < 2; ++n) _Pragma("unroll") for (int k = 0; k < 2; ++k) dst[n][k] = *(const LAS bf16x8*)(lds + PG8_SB(b, h) + boff + n * 2048 + k * 1024); } while (0)
#define PG8_MMA(ai, bj, At, Bt) do { __builtin_amdgcn_s_setprio(1); _Pragma("unroll") for (int m = 0; m < 4; ++m) _Pragma("unroll") for (int n = 0; n < 2; ++n) _Pragma("unroll") for (int k = 0; k < 2; ++k) \
        acc[ai][bj][m][n] = __builtin_amdgcn_mfma_f32_16x16x32_bf16(Bt[n][k], At[m][k], acc[ai][bj][m][n], 0, 0, 0); __builtin_amdgcn_s_setprio(0); } while (0)
#define PG8_WAIT_V(n) asm volatile("s_waitcnt vmcnt(" #n ")" ::: "memory")
#define PG8_WAIT_L(n) asm volatile("s_waitcnt lgkmcnt(" #n ")" ::: "memory")
#define PG8_BAR __builtin_amdgcn_s_barrier()
#define PG8_SCHED __builtin_amdgcn_sched_barrier(0)
#define PG8_GOFF(dst, ui_) do { if (GATHER) { _Pragma("unroll") for (int _h = 0; _h < 2; ++_h) _Pragma("unroll") for (int _i = 0; _i < 2; ++_i) dst[_h][_i] = S.goff((ui_), _h * HALF + RA[_i]) + (unsigned)CA2[_i]; } } while (0)
    Unit cur, nxt; int ui = 0;
    if (!S.next(0, cur)) return;
    if (stag_ticks) { const unsigned long long t0 = __builtin_amdgcn_s_memrealtime(), dl = (unsigned long long)((blockIdx.x >> 3) & 1) * stag_ticks;
      while (__builtin_amdgcn_s_memrealtime() - t0 < dl) __builtin_amdgcn_s_sleep(8); }
    f32x4 acc[2][2][4][2];
#pragma unroll
    for (int a = 0; a < 2; ++a)
#pragma unroll
        for (int b = 0; b < 2; ++b)
#pragma unroll
            for (int m = 0; m < 4; ++m)
#pragma unroll
                for (int n = 0; n < 2; ++n) acc[a][b][m][n] = (f32x4){0.f, 0.f, 0.f, 0.f};
    bf16x8 At[4][2], B0[2][2], B1[2][2];
    const char* cA = S.a_ptr(cur); const char* cB = S.b_ptr(cur);
    PG8_GOFF(vA, 0);
    if constexpr (VARK) { nt = S.k_of(cur) / BK; k2c = (unsigned)S.k_of(cur) * 2u; k2n = k2c; }
    PG8_STAGEB(PG8_SB(0, 0), cB, 0, false); PG8_STAGEB(PG8_SB(0, 1), cB, 1, false); PG8_STAGEA(PG8_SA(0, 0), cA, 0, false); PG8_STAGEA(PG8_SA(0, 1), cA, 1, false);
    if (wr == 1) PG8_BAR;
    PG8_WAIT_V(2); PG8_BAR;
    PG8_STAGEB(PG8_SB(1, 0), cB + kstep, 0, false); PG8_STAGEA(PG8_SA(1, 0), cA + kstep, 0, false); PG8_STAGEB(PG8_SB(1, 1), cB + kstep, 1, false);
    PG8_WAIT_V(6); PG8_BAR;
    for (;;) {
        const bool has_next = S.next(ui + 1, nxt);
        const char* nA = has_next ? S.a_ptr(nxt) : cA; const char* nB = has_next ? S.b_ptr(nxt) : cB;
        for (int t = 0; t < nt; t += 2) {
            const bool last = (t == nt - 2);
            const char* a1 = cA + (size_t)(t + 1) * kstep;
            const char* a2 = last ? nA : cA + (size_t)(t + 2) * kstep; const char* b2 = last ? nB : cB + (size_t)(t + 2) * kstep;
            const char* a3 = a2 + kstep; const char* b3 = b2 + kstep;
            if constexpr (VARK) { if (last) k2n = has_next ? (unsigned)S.k_of(nxt) * 2u : k2c; }
            if (GATHER && last) { if (has_next) { PG8_GOFF(vN, ui + 1); } else {
#pragma unroll
                for (int _h = 0; _h < 2; ++_h)
#pragma unroll
                    for (int _i = 0; _i < 2; ++_i) vN[_h][_i] = vA[_h][_i]; } }
            PG8_LDB(B0, 0, 0); PG8_LDB(B1, 0, 1); PG8_SCHED; PG8_LDA(At, 0, 0); PG8_STAGEA(PG8_SA(1, 1), a1, 1, false);
            PG8_WAIT_V(8); PG8_WAIT_L(0); PG8_BAR; PG8_MMA(0, 0, At, B0); PG8_MMA(0, 1, At, B1); PG8_BAR; PG8_SCHED;
            PG8_LDA(At, 0, 1); PG8_STAGEB(PG8_SB(0, 0), b2, 0, last); PG8_STAGEB(PG8_SB(0, 1), b2, 1, last); PG8_STAGEA(PG8_SA(0, 0), a2, 0, last);
            PG8_WAIT_V(8); PG8_WAIT_L(0); PG8_BAR; PG8_MMA(1, 0, At, B0); PG8_MMA(1, 1, At, B1); PG8_BAR; PG8_SCHED;
            PG8_LDB(B0, 1, 0); PG8_LDB(B1, 1, 1); PG8_SCHED; PG8_LDA(At, 1, 0); PG8_STAGEA(PG8_SA(0, 1), a2, 1, last);
            PG8_WAIT_V(8); PG8_WAIT_L(0); PG8_BAR; PG8_MMA(0, 0, At, B0); PG8_MMA(0, 1, At, B1); PG8_BAR; PG8_SCHED;
            PG8_LDA(At, 1, 1); PG8_STAGEB(PG8_SB(1, 0), b3, 0, last); PG8_STAGEB(PG8_SB(1, 1), b3, 1, last); PG8_STAGEA(PG8_SA(1, 0), a3, 0, last);
            PG8_WAIT_V(8); PG8_WAIT_L(0); PG8_BAR; PG8_MMA(1, 0, At, B0); PG8_MMA(1, 1, At, B1); PG8_BAR; PG8_SCHED;
        }
        if constexpr (ALIGN_EPI) { if (wr == 0) PG8_BAR; }
        if (!cur.dup) E(acc, cur, ui, wr, wc, fr, fq);
#ifdef PROBE_EDUP
        if (Epi::EDUP) { asm volatile("s_waitcnt vmcnt(0)" ::: "memory"); E(acc, cur, ui, wr, wc, fr, fq); }
#endif
        if (!has_next) break;
#pragma unroll
        for (int a = 0; a < 2; ++a)
#pragma unroll
            for (int b = 0; b < 2; ++b)
#pragma unroll
                for (int m = 0; m < 4; ++m)
#pragma unroll
                    for (int n = 0; n < 2; ++n) acc[a][b][m][n] = (f32x4){0.f, 0.f, 0.f, 0.f};
        cur = nxt; cA = nA; cB = nB; ++ui;
        if constexpr (VARK) { nt = S.k_of(cur) / BK; k2c = k2n; }
        if (GATHER) {
#pragma unroll
            for (int _h = 0; _h < 2; ++_h)
#pragma unroll
                for (int _i = 0; _i < 2; ++_i) vA[_h][_i] = vN[_h][_i]; }
        if constexpr (ALIGN_EPI) { if (wr == 1) PG8_BAR; }
    }
    PG8_WAIT_V(0);
    if constexpr (!ALIGN_EPI) { if (wr == 0) PG8_BAR; }
    PG8_BAR;
#undef PG8_SA
#undef PG8_SB
#undef PG8_STAGE
#undef PG8_STAGEA
#undef PG8_STAGEB
#undef PG8_LDA
#undef PG8_LDB
#undef PG8_MMA
#undef PG8_WAIT_V
#undef PG8_WAIT_L
#undef PG8_BAR
#undef PG8_SCHED
#undef PG8_GOFF
}
}
namespace attn_body {
using bf16=unsigned short;
using bf16x8=__attribute__((ext_vector_type(8)))short;
using s16x4=__attribute__((ext_vector_type(4)))short;
using f32x16=__attribute__((ext_vector_type(16)))float;
constexpr int SEQA=8192,D=64,QP=512,KP=128;
constexpr int NW=8,QBLK=32,QB=QBLK*NW,KVBLK=64,NQB=SEQA/QB;
__device__ __forceinline__ int crow(int r,int hi){return (r&3)+8*(r>>2)+4*hi;}
#define SBAR() __builtin_amdgcn_sched_barrier(0)
__device__ __forceinline__ void cmask(f32x16&p0,f32x16&p1,int jb,int qrel,int hi){
  const float NEG=-INFINITY; int kb=64*jb+4*hi;
  #pragma unroll
  for(int r=0;r<16;++r){int kv=kb+(r&3)+8*(r>>2); if(kv>qrel)p0[r]=NEG; if(kv+32>qrel)p1[r]=NEG;}
}

constexpr int NSLOT=3, SLOTB=8192;
constexpr int LDS_K=0, LDS_V=NSLOT*SLOTB, LDS_WS=2*NSLOT*SLOTB, LDS_OST=LDS_WS+NW*64*4, LDS_BYTES=LDS_OST+NW*4096;
constexpr float C2=0.125f*1.4426950408889634f;
__device__ __forceinline__ void glds16(const void*gsrc,unsigned lds_dst){unsigned keep;
  asm volatile("s_mov_b32 %0, m0\n\ts_mov_b32 m0, %2\n\ts_nop 0\n\tglobal_load_lds_dwordx4 %1, off\n\ts_mov_b32 m0, %0":"=&s"(keep):"v"(gsrc),"s"(lds_dst):"memory");}
__device__ __forceinline__ float max3f(float a,float b,float c){float r;asm("v_max3_f32 %0, %1, %2, %3":"=v"(r):"v"(a),"v"(b),"v"(c));return r;}
__device__ __forceinline__ float max2f(float a,float b){float r;asm("v_max_f32_e32 %0, %1, %2":"=v"(r):"v"(a),"v"(b));return r;}
__device__ __forceinline__ float fadd_s(float a,float b){float r;asm("v_add_f32_e32 %0, %1, %2":"=v"(r):"v"(a),"v"(b));return r;}
__device__ __forceinline__ float fsub_s(float a,float b){float r;asm("v_sub_f32_e32 %0, %1, %2":"=v"(r):"v"(a),"v"(b));return r;}
typedef float f32x2_t __attribute__((ext_vector_type(2))); typedef __bf16 bf16x2_t __attribute__((ext_vector_type(2)));
__device__ __forceinline__ unsigned cvtpk_s(float lo,float hi){f32x2_t v={lo,hi};bf16x2_t b=__builtin_convertvector(v,bf16x2_t);return __builtin_bit_cast(unsigned,b);}
#define WAIT_BAR(N) asm volatile("s_waitcnt vmcnt(" #N ") lgkmcnt(0)\n\ts_barrier":::"memory")

__device__ __forceinline__ void qkt(f32x16&p0,f32x16&p1,const char*Kslot,const bf16x8*qr,const f32x16&negm,int r32,int hi){
  const char*kb=Kslot+hi*1024+r32*16;
  #pragma unroll
  for(int d0=0;d0<4;++d0){
    const bf16x8 b0=*reinterpret_cast<const bf16x8*>(kb+d0*2048);
    const bf16x8 b1=*reinterpret_cast<const bf16x8*>(kb+d0*2048+512);
    if(d0==0){p0=__builtin_amdgcn_mfma_f32_32x32x16_bf16(b0,qr[0],negm,0,0,0);p1=__builtin_amdgcn_mfma_f32_32x32x16_bf16(b1,qr[0],negm,0,0,0);}
    else{p0=__builtin_amdgcn_mfma_f32_32x32x16_bf16(b0,qr[d0],p0,0,0,0);p1=__builtin_amdgcn_mfma_f32_32x32x16_bf16(b1,qr[d0],p1,0,0,0);}}
}
typedef __attribute__((address_space(3))) const char* lds_cptr;
typedef short v4i16_t __attribute__((ext_vector_type(4)));
__device__ __forceinline__ void kload8(bf16x8*kf,lds_cptr kp){
  kf[0]=*(const __attribute__((address_space(3))) bf16x8*)(kp);      kf[1]=*(const __attribute__((address_space(3))) bf16x8*)(kp+512);
  kf[2]=*(const __attribute__((address_space(3))) bf16x8*)(kp+2048); kf[3]=*(const __attribute__((address_space(3))) bf16x8*)(kp+2560);
  kf[4]=*(const __attribute__((address_space(3))) bf16x8*)(kp+4096); kf[5]=*(const __attribute__((address_space(3))) bf16x8*)(kp+4608);
  kf[6]=*(const __attribute__((address_space(3))) bf16x8*)(kp+6144); kf[7]=*(const __attribute__((address_space(3))) bf16x8*)(kp+6656);
}
__device__ __forceinline__ void kload2(bf16x8*kf,lds_cptr kp,int j){ kf[2*j]=*(const __attribute__((address_space(3))) bf16x8*)(kp+j*2048); kf[2*j+1]=*(const __attribute__((address_space(3))) bf16x8*)(kp+j*2048+512); }
__device__ __forceinline__ s16x4 vtr(lds_cptr p){ return __builtin_bit_cast(s16x4,__builtin_amdgcn_ds_read_tr16_b64_v4i16((__attribute__((address_space(3))) v4i16_t*)p)); }
__device__ __forceinline__ float rowmax(const f32x16&p0,const f32x16&p1){
  float a=max3f(p0[0],p0[1],p1[0]),b=max3f(p0[2],p0[3],p1[1]);a=max3f(a,p1[2],p1[3]);
  #pragma unroll
  for(int r=4;r<16;r+=4){a=max3f(a,p0[r],p0[r+1]);b=max3f(b,p0[r+2],p0[r+3]);a=max3f(a,p1[r],p1[r+1]);b=max3f(b,p1[r+2],p1[r+3]);}
  const float m=max2f(a,b);
  auto rr=__builtin_amdgcn_permlane32_swap(__float_as_uint(m),__float_as_uint(m),false,false);
  return max2f(__uint_as_float(rr[0]),__uint_as_float(rr[1]));
}
__device__ __forceinline__ void pv(f32x16*o,int vb,bf16x8 pa0,bf16x8 pa1,bf16x8 pa2,bf16x8 pa3){
  #pragma unroll
  for(int d0=0;d0<2;++d0){s16x4 lo[4],hi[4];
    #pragma unroll
    for(int ks=0;ks<4;++ks){
      asm volatile("ds_read_b64_tr_b16 %0,%1 offset:%c2":"=&v"(lo[ks]):"v"(vb),"i"(d0*4096+ks*1024):"memory");
      asm volatile("ds_read_b64_tr_b16 %0,%1 offset:%c2":"=&v"(hi[ks]):"v"(vb),"i"(d0*4096+ks*1024+512):"memory");}
    asm volatile("s_waitcnt lgkmcnt(0)":::"memory");SBAR();
    #define PK(k) (bf16x8){lo[k][0],lo[k][1],lo[k][2],lo[k][3],hi[k][0],hi[k][1],hi[k][2],hi[k][3]}
    o[d0]=__builtin_amdgcn_mfma_f32_32x32x16_bf16(pa0,PK(0),o[d0],0,0,0);
    o[d0]=__builtin_amdgcn_mfma_f32_32x32x16_bf16(pa1,PK(1),o[d0],0,0,0);
    o[d0]=__builtin_amdgcn_mfma_f32_32x32x16_bf16(pa2,PK(2),o[d0],0,0,0);
    o[d0]=__builtin_amdgcn_mfma_f32_32x32x16_bf16(pa3,PK(3),o[d0],0,0,0);
    #undef PK
  }
}

#ifndef ATTN_STORE16
#define ATTN_STORE16(p,v) (*(u32x4*)(p)=(v))
#endif
template<int THRL,bool FIXM> __device__ __forceinline__ void attn_unit(int b,int h,int kvh,int qb,const bf16*Q,const bf16*__restrict__ K,const bf16*__restrict__ V,bf16*O,char*shm,float cfix){
  const int tid=threadIdx.x,lane=tid&63,r32=lane&31,hi=lane>>5; const int wid=__builtin_amdgcn_readfirstlane(tid>>6);
  const long rowbase=(long)b*SEQA; const int q0=qb*QB;
  const bf16*Qw=Q+(rowbase+q0+wid*QBLK)*QP+h*D;
  const bf16*Kh=K+rowbase*KP+kvh*D,*Vh=V+rowbase*KP+kvh*D;
  const unsigned lds0=(unsigned)(uintptr_t)shm;
  float*wsf=(float*)(shm+LDS_WS)+wid*64;
  const bf16*ksrc=Kh+(long)lane*KP+wid*8;
  const bf16*vsrc=Vh+(long)(16*(wid&3)+(lane>>2))*KP+(wid>>2)*32+(lane&3)*8;
  const unsigned kdst=lds0+LDS_K+wid*1024, vdst=lds0+LDS_V+wid*1024;
  #define DMA_K(t,slot) glds16(ksrc+(long)(t)*KVBLK*KP,(unsigned)__builtin_amdgcn_readfirstlane(kdst+(slot)))
  #define DMA_V(t,slot) glds16(vsrc+(long)(t)*KVBLK*KP,(unsigned)__builtin_amdgcn_readfirstlane(vdst+(slot)))
  const int vb0=(int)(lds0+LDS_V)+((lane>>4)&1)*32+(lane&3)*8+(4*hi+((lane&15)>>2))*64;
  const char*Kbase=shm+LDS_K; bf16x8 kf[8];
  const lds_cptr shm3=(lds_cptr)shm; const lds_cptr kp0=shm3+LDS_K+hi*1024+r32*16; const lds_cptr vp0=shm3+LDS_V+((lane>>4)&1)*32+(lane&3)*8+(4*hi+((lane&15)>>2))*64;
  const int NT=SEQA/KVBLK;
  DMA_K(0,0);DMA_V(0,0);DMA_K(1,SLOTB);
  bf16x8 qr[4];
  #pragma unroll
  for(int d0=0;d0<4;++d0)qr[d0]=*reinterpret_cast<const bf16x8*>(&Qw[(long)r32*QP+d0*16+hi*8]);
  float mhat=FIXM?cfix:0.f,l_reg=0.f;f32x16 o[2];o[0]=f32x16{};o[1]=f32x16{};f32x16 negm=f32x16{};
  if(FIXM){
  #pragma unroll
  for(int r=0;r<16;++r)negm[r]=-cfix;}
  asm volatile("":"+v"(negm));
  const int qrel=wid*QBLK+r32;
  #define CMASK(P0,P1,t) do{}while(0)
  bool resc=false;
  #define START(P0,P1) do{ resc=false; \
    if(!FIXM){ const float rm=rowmax(P0,P1); const float dl=rm; mhat=fadd_s(mhat,dl); \
      _Pragma("unroll") for(int r=0;r<16;++r){P0[r]=fsub_s(P0[r],dl);P1[r]=fsub_s(P1[r],dl);} \
      _Pragma("unroll") for(int r=0;r<16;++r)negm[r]=-mhat; asm volatile("":"+v"(negm)); } \
    _Pragma("unroll") for(int r=0;r<16;++r)P0[r]=__builtin_amdgcn_exp2f(P0[r]); }while(0)
  #define RESC() do{ if(!FIXM&&resc){ asm volatile("s_waitcnt lgkmcnt(0)":::"memory"); \
      _Pragma("unroll") for(int d_=0;d_<2;++d_) _Pragma("unroll") for(int r=0;r<16;++r)o[d_][r]*=wsf[crow(r,hi)]; } }while(0)
  f32x16 pA0,pA1,pB0,pB1;
  int sl_prev=0,sl_cur=0,sl_next=SLOTB;
  #define ROT() do{sl_prev=sl_cur;sl_cur=sl_next;sl_next=(sl_next==(NSLOT-1)*SLOTB)?0:sl_next+SLOTB;}while(0)
  DMA_K(2,2*SLOTB);
  WAIT_BAR(3);
  qkt(pA0,pA1,Kbase,qr,negm,r32,hi);asm volatile("s_nop 15\n\ts_nop 7":"+v"(pA0),"+v"(pA1));CMASK(pA0,pA1,0);
  START(pA0,pA1);
  _Pragma("unroll") for(int r=0;r<16;++r)pA1[r]=__builtin_amdgcn_exp2f(pA1[r]);
  WAIT_BAR(0);
  DMA_K(3,0);DMA_V(1,SLOTB);
  ROT();
  kload8(kf,kp0+sl_cur);
  WAIT_BAR(2);
  s16x4 vlo[8],vhi[8]; u32x4 pw0,pw1,pw2,pw3;
  #define PKW(P,B) cvtpk_s(P[B],P[B+1])
  #define PAF(k) __builtin_bit_cast(bf16x8,pw##k)
  #define VFR(i) (bf16x8){vlo[i][0],vlo[i][1],vlo[i][2],vlo[i][3],vhi[i][0],vhi[i][1],vhi[i][2],vhi[i][3]}
  #define PIN(x) asm volatile("":"+v"(x))
  #define MX3(a,b,c) __builtin_fmaxf(__builtin_fmaxf((a),(b)),(c))
  #define GAPA(MF,A0,A1,A2,A3,W0,W1,PW) do{ MF; sacc+=A0; sacc+=A1; sacc+=A2; sacc+=A3; PIN(sacc); W0; W1; PIN(PW); SBAR(); }while(0)
  #define EX(v) __builtin_amdgcn_exp2f(v)
  #define GAPB(MF,X,B) do{ MF; X[B]=EX(X[B]); X[B+1]=EX(X[B+1]); X[B+2]=EX(X[B+2]); X[B+3]=EX(X[B+3]); PIN(X); SBAR(); }while(0)
  #define VRD(i) do{ vlo[i]=vtr(vp_+(((i)>>2)*4096+((i)&3)*1024)); vhi[i]=vtr(vp_+(((i)>>2)*4096+((i)&3)*1024+512)); }while(0)
  #define KRD(G,j) do{ if(G){ kload2(kf,kp0+sl_next,j); SBAR(); } }while(0)
  #define STEP(C0,C1,P0,P1,t,GK,GV,GL) do{ SBAR(); \
    const lds_cptr vp_=vp0+sl_prev; \
    VRD(0); SBAR(); float sacc=(P0[0]+P0[1]); \
    GAPA(C0=__builtin_amdgcn_mfma_f32_32x32x16_bf16(kf[0],qr[0],negm,0,0,0), P0[2],P0[3],P0[4],P0[5],     pw0[0]=PKW(P0,0), pw0[1]=PKW(P0,2), pw0); \
    VRD(4); SBAR(); GAPA(C1=__builtin_amdgcn_mfma_f32_32x32x16_bf16(kf[1],qr[0],negm,0,0,0), P0[6],P0[7],P0[8],P0[9],     pw0[2]=PKW(P0,4), pw0[3]=PKW(P0,6), pw0); \
    VRD(1); SBAR(); GAPA(C0=__builtin_amdgcn_mfma_f32_32x32x16_bf16(kf[2],qr[1],C0,0,0,0),   P0[10],P0[11],P0[12],P0[13], pw1[0]=PKW(P0,8), pw1[1]=PKW(P0,10), pw1); \
    VRD(5); SBAR(); GAPA(C1=__builtin_amdgcn_mfma_f32_32x32x16_bf16(kf[3],qr[1],C1,0,0,0),   P0[14],P0[15],P1[0],P1[1],   pw1[2]=PKW(P0,12),pw1[3]=PKW(P0,14), pw1); \
    VRD(2); SBAR(); GAPA(C0=__builtin_amdgcn_mfma_f32_32x32x16_bf16(kf[4],qr[2],C0,0,0,0),   P1[2],P1[3],P1[4],P1[5],     pw2[0]=PKW(P1,0), pw2[1]=PKW(P1,2), pw2); \
    VRD(6); SBAR(); GAPA(C1=__builtin_amdgcn_mfma_f32_32x32x16_bf16(kf[5],qr[2],C1,0,0,0),   P1[6],P1[7],P1[8],P1[9],     pw2[2]=PKW(P1,4), pw2[3]=PKW(P1,6), pw2); \
    VRD(3); SBAR(); GAPA(C0=__builtin_amdgcn_mfma_f32_32x32x16_bf16(kf[6],qr[3],C0,0,0,0),   P1[10],P1[11],P1[12],P1[13], pw3[0]=PKW(P1,8), pw3[1]=PKW(P1,10), pw3); \
    VRD(7); SBAR(); GAPA(C1=__builtin_amdgcn_mfma_f32_32x32x16_bf16(kf[7],qr[3],C1,0,0,0),   P1[14],P1[15],0.f,0.f,       pw3[2]=PKW(P1,12),pw3[3]=PKW(P1,14), pw3); \
    l_reg+=sacc; \
    if(GK){DMA_K((t)+3,sl_cur);} if(GV){DMA_V((t)+1,sl_next);} \
    CMASK(C0,C1,t); \
    if(!FIXM){ float a=MX3(C0[0],C0[1],C1[0]),b=MX3(C0[2],C0[3],C1[1]); a=MX3(a,C1[2],C1[3]); \
      _Pragma("unroll") for(int r=4;r<16;r+=4){a=MX3(a,C0[r],C0[r+1]);b=MX3(b,C0[r+2],C0[r+3]);a=MX3(a,C1[r],C1[r+1]);b=MX3(b,C1[r+2],C1[r+3]);} \
      float rm=__builtin_fmaxf(a,b); { auto rr=__builtin_amdgcn_permlane32_swap(__float_as_uint(rm),__float_as_uint(rm),false,false); rm=__builtin_fmaxf(__uint_as_float(rr[0]),__uint_as_float(rr[1])); } \
      resc=false; \
      if(__builtin_expect(__any(rm>(float)THRL),0)){ const float dl=__builtin_fmaxf(rm,0.f); mhat+=dl; \
        _Pragma("unroll") for(int r=0;r<16;++r){C0[r]-=dl;C1[r]-=dl;} \
        _Pragma("unroll") for(int r=0;r<16;++r)negm[r]=-mhat; asm volatile("":"+v"(negm)); \
        const float f=__builtin_amdgcn_exp2f(-dl); l_reg*=f; if(hi==0)wsf[r32]=f; resc=true; } } \
    SBAR(); \
    GAPB(o[0]=__builtin_amdgcn_mfma_f32_32x32x16_bf16(PAF(0),VFR(0),o[0],0,0,0), C0,0); \
    GAPB(o[1]=__builtin_amdgcn_mfma_f32_32x32x16_bf16(PAF(0),VFR(4),o[1],0,0,0), C0,4); \
    KRD(GL,0); GAPB(o[0]=__builtin_amdgcn_mfma_f32_32x32x16_bf16(PAF(1),VFR(1),o[0],0,0,0), C0,8); \
    KRD(GL,1); GAPB(o[1]=__builtin_amdgcn_mfma_f32_32x32x16_bf16(PAF(1),VFR(5),o[1],0,0,0), C0,12); \
    KRD(GL,2); GAPB(o[0]=__builtin_amdgcn_mfma_f32_32x32x16_bf16(PAF(2),VFR(2),o[0],0,0,0), C1,0); \
    KRD(GL,3); GAPB(o[1]=__builtin_amdgcn_mfma_f32_32x32x16_bf16(PAF(2),VFR(6),o[1],0,0,0), C1,4); \
    GAPB(o[0]=__builtin_amdgcn_mfma_f32_32x32x16_bf16(PAF(3),VFR(3),o[0],0,0,0), C1,8); \
    GAPB(o[1]=__builtin_amdgcn_mfma_f32_32x32x16_bf16(PAF(3),VFR(7),o[1],0,0,0), C1,12); \
    }while(0)
  int t=1;
  #undef CMASK
  #define CMASK(P0,P1,t) do{}while(0)
  for(;t+5<NT;t+=2){
    STEP(pB0,pB1,pA0,pA1,t,true,true,true);     WAIT_BAR(2); RESC(); ROT();
    STEP(pA0,pA1,pB0,pB1,t+1,true,true,true);   WAIT_BAR(2); RESC(); ROT();
  }
  #undef CMASK
  #define CMASK(P0,P1,t) do{}while(0)
  #define ENDW(tt) do{ if((tt)+3<NT){WAIT_BAR(2);} else if((tt)+2<NT){WAIT_BAR(1);} else {WAIT_BAR(0);} }while(0)
  for(;t+1<NT;t+=2){
    STEP(pB0,pB1,pA0,pA1,t,(t+3<NT),(t+1<NT),(t+1<NT));       ENDW(t);   RESC(); ROT();
    STEP(pA0,pA1,pB0,pB1,t+1,(t+4<NT),(t+2<NT),(t+2<NT));     ENDW(t+1); RESC(); ROT();
  }
  STEP(pB0,pB1,pA0,pA1,NT-1,false,false,false); RESC();
  { float sacc=pB0[0]+pB0[1]; _Pragma("unroll") for(int r=2;r<16;++r)sacc+=pB0[r]; _Pragma("unroll") for(int r=0;r<16;++r)sacc+=pB1[r]; l_reg+=sacc;
    pw0=(u32x4){PKW(pB0,0),PKW(pB0,2),PKW(pB0,4),PKW(pB0,6)};pw1=(u32x4){PKW(pB0,8),PKW(pB0,10),PKW(pB0,12),PKW(pB0,14)};pw2=(u32x4){PKW(pB1,0),PKW(pB1,2),PKW(pB1,4),PKW(pB1,6)};pw3=(u32x4){PKW(pB1,8),PKW(pB1,10),PKW(pB1,12),PKW(pB1,14)};
    SBAR(); pv(o,vb0+sl_cur,PAF(0),PAF(1),PAF(2),PAF(3)); }
  #undef PKW
  #undef PAF
  #undef VFR
  #undef PIN
  #undef MX3
  #undef GAPA
  #undef GAPB
  #undef EX
  #undef VRD
  #undef KRD
  #undef STEP
  #undef ENDW
  {auto rr=__builtin_amdgcn_permlane32_swap(__float_as_uint(l_reg),__float_as_uint(l_reg),false,false);l_reg=__uint_as_float(rr[0])+__uint_as_float(rr[1]);}
  if(hi==0)wsf[32+r32]=l_reg;asm volatile("s_waitcnt lgkmcnt(0)":::"memory");
  float rli[16];
  #pragma unroll
  for(int r=0;r<16;++r)rli[r]=__builtin_amdgcn_rcpf(wsf[32+crow(r,hi)]);
  bf16*Ow=O+(rowbase+q0+wid*QBLK)*QP+h*D;
  { bf16*stg=(bf16*)(shm+LDS_OST)+wid*2048;
    #pragma unroll
    for(int r=0;r<16;++r){const int orow=crow(r,hi);
      #pragma unroll
      for(int d0=0;d0<2;++d0)stg[orow*64+d0*32+r32]=(bf16)f2bf(o[d0][r]*rli[r]);}
    asm volatile("s_waitcnt lgkmcnt(0)":::"memory");
    #pragma unroll
    for(int i=0;i<4;++i){const int row=i*8+(lane>>3),ch=lane&7; const u32x4 v=*(const u32x4*)(stg+row*64+ch*8); ATTN_STORE16(Ow+(long)row*QP+ch*8,v);} }
  asm volatile("s_waitcnt lgkmcnt(0)\n\ts_barrier":::"memory");
  #undef DMA_K
  #undef DMA_V
  #undef CMASK
  #undef START
  #undef RESC
  #undef ROT
}
constexpr int ATTN_LDS_BYTES=LDS_BYTES;
#undef SBAR
#undef WAIT_BAR
}
constexpr int NWAVES = 8;
constexpr int RING_OFF = 0, RING_BYTES = 131072;
constexpr int SGU_ROWB = 1040, SGU_TILE_BYTES = 128 * SGU_ROWB;
constexpr int TBL_OFF = 133120;
constexpr int MOE_MAXU = 6;
constexpr int RSTBL_OFF = TBL_OFF + MOE_MAXU * 1024;
constexpr int UREC_OFF = RSTBL_OFF + MOE_MAXU * 1024;
constexpr int MISC_OFF = UREC_OFF + 512;
constexpr int LDS_BYTES = 147456;
static_assert(MISC_OFF + 128 <= LDS_BYTES, "LDS map");
constexpr int NPHASE = 13;

#define GAS __attribute__((address_space(1)))
typedef GAS unsigned gu32;
#define RLX_AGENT __ATOMIC_RELAXED, __HIP_MEMORY_SCOPE_AGENT

#define XB_TMO      128
#define XB_XCNT(j)  (256  + 64 * (j))
#define XB_XSUB(j)  (1280 + 64 * (j))
#define XB_XGEN(j)  (2304 + 64 * (j))
#define XB_TOP      3328
#define XB_TOPGEN   3392
#define XCD_BAR_WORDS 3456
#define XB_SPIN_CAP (1u << 18)
__device__ __forceinline__ unsigned xb_ld(unsigned* p)              { return __hip_atomic_load(p, __ATOMIC_RELAXED, __HIP_MEMORY_SCOPE_AGENT); }
__device__ __forceinline__ unsigned xb_add(unsigned* p, unsigned v) { return __hip_atomic_fetch_add(p, v, __ATOMIC_RELAXED, __HIP_MEMORY_SCOPE_AGENT); }
__device__ __forceinline__ unsigned xb_xcc_id() { return (unsigned)__builtin_amdgcn_s_getreg((3 << 11) | 20) & 0xFu; }
#define XB_SPIN(cond, bar) do { unsigned _sp = 0; while (cond) { __builtin_amdgcn_s_sleep(1); \
    if ((++_sp & 255u) == 0u) { if (xb_ld(&(bar)[XB_TMO])) break; if (_sp > XB_SPIN_CAP) { atomicAdd(&(bar)[XB_TMO], 1u); break; } } } } while (0)
struct XcdBarrier { unsigned* bar; unsigned x; volatile LAS unsigned* st; };
__device__ __forceinline__ XcdBarrier xcd_barrier_post(unsigned* bar, volatile LAS unsigned* st) {
    XcdBarrier b; b.bar = bar; b.x = xb_xcc_id(); b.st = st;
    if (threadIdx.x == 0) (void)xb_add(&bar[XB_XCNT(b.x)], 1u);
    return b;
}
__device__ __forceinline__ void xcd_barrier_complete(unsigned* bar, unsigned x, unsigned& nloc, unsigned& nx) {
    const unsigned G = gridDim.x * gridDim.y * gridDim.z;
    unsigned sum, cnt, mine, sp = 0u;
    for (;;) {
        sum = 0u; cnt = 0u; mine = 0u;
#pragma unroll
        for (unsigned j = 0; j < 16; ++j) { const unsigned c = xb_ld(&bar[XB_XCNT(j)]); sum += c; cnt += (c > 0u) ? 1u : 0u; mine = (j == x) ? c : mine; }
        if (sum == G) break;
        __builtin_amdgcn_s_sleep(1);
        if ((++sp & 255u) == 0u) { if (xb_ld(&bar[XB_TMO])) break; if (sp > XB_SPIN_CAP) { atomicAdd(&bar[XB_TMO], 1u); break; } }
    }
    nloc = mine > 0u ? mine : 1u; nx = cnt > 0u ? cnt : 1u;
}
__device__ __forceinline__ void xcd_barrier(const XcdBarrier& b) {
    asm volatile("s_waitcnt vmcnt(0)" ::: "memory");
    __syncthreads();
    if (threadIdx.x == 0) {
        unsigned* bar = b.bar;
        __builtin_amdgcn_s_waitcnt(0);
        unsigned nloc = b.st[0], nx = b.st[1];
        if (nloc == 0u) { xcd_barrier_complete(bar, b.x, nloc, nx); b.st[0] = nloc; b.st[1] = nx; }
        const unsigned old = xb_add(&bar[XB_XSUB(b.x)], 1u);
        const unsigned gen = old / nloc;
        if (old + 1u == (gen + 1u) * nloc) {
            __builtin_amdgcn_fence(__ATOMIC_RELEASE, "agent");
            asm volatile("s_waitcnt vmcnt(0)" ::: "memory");
            const unsigned og = xb_add(&bar[XB_TOP], 1u);
            const unsigned tg = og / nx;
            if (og + 1u == (tg + 1u) * nx) xb_add(&bar[XB_TOPGEN], 1u);
            else XB_SPIN(xb_ld(&bar[XB_TOPGEN]) == tg, bar);
            __builtin_amdgcn_fence(__ATOMIC_ACQUIRE, "agent");
            xb_add(&bar[XB_XGEN(b.x)], 1u);
            asm volatile("s_waitcnt vmcnt(0)" ::: "memory");
        } else {
            XB_SPIN(xb_ld(&bar[XB_XGEN(b.x)]) == gen, bar);
            __builtin_amdgcn_fence(__ATOMIC_ACQUIRE, "agent");
            asm volatile("s_waitcnt vmcnt(0)" ::: "memory");
        }
    }
    __syncthreads();
}

using pg8::Unit;
struct SchedPlain {
    const char* A; const char* Bt; int nM, nN, G, c, K;
    __device__ __forceinline__ bool next(int i, Unit& u) const { const long L = (long)i * G + c; if (L >= (long)nM * nN) return false; pg8::tile_of((int)L, nM, nN, u.pm, u.pn); u.kind = 0; u.dup = 0; return true; }
    __device__ __forceinline__ const char* a_ptr(const Unit& u) const { return A + (size_t)u.pm * 256 * K * 2; }
    __device__ __forceinline__ const char* b_ptr(const Unit& u) const { return Bt + (size_t)u.pn * 256 * K * 2; }
    __device__ __forceinline__ unsigned goff(int, int) const { return 0u; }
};
template <class B> struct SchedDup { B b;
    __device__ __forceinline__ bool next(int i, Unit& u) const { if (!b.next(i >> 1, u)) return false; u.dup = !(i & 1); return true; }
    __device__ __forceinline__ const char* a_ptr(const Unit& u) const { return b.a_ptr(u); }
    __device__ __forceinline__ const char* b_ptr(const Unit& u) const { return b.b_ptr(u); }
    __device__ __forceinline__ unsigned goff(int, int) const { return 0u; }
    __device__ __forceinline__ int k_of(const Unit& u) const { return b.k_of(u); }
};
struct SchedZ {
    const char* A; const char* Bt; int G, c;
    __device__ __forceinline__ bool next(int i, Unit& u) const { const long L = (long)i * G + c; if (L >= 912) return false;
        if (L < 896) pg8::tile_of((int)L, 128, 7, u.pm, u.pn); else { const int j = (int)L - 896; u.pm = 128 + (j >> 2); u.pn = 15 + (j & 3); } u.kind = 0; u.dup = 0; return true; }
    __device__ __forceinline__ const char* a_ptr(const Unit& u) const { return A + (size_t)u.pm * 256 * 2048; }
    __device__ __forceinline__ const char* b_ptr(const Unit& u) const { return Bt + (size_t)u.pn * 256 * 2048; }
    __device__ __forceinline__ unsigned goff(int, int) const { return 0u; }
};
struct SchedY {
    const char* ws; int G, c;
    __device__ __forceinline__ bool next(int i, Unit& u) const { const long L = (long)(i >> 2) * G + c; if (L >= 512) return false; pg8::tile_of((int)L, 128, 4, u.pm, u.pn); u.kind = i & 3; u.dup = 0; return true; }
    __device__ __forceinline__ int k_of(const Unit& u) const { return 1024 - 512 * (u.kind >> 1); }
    __device__ __forceinline__ const char* a_ptr(const Unit& u) const { const size_t mix = (size_t)(u.kind >> 1), sg = (size_t)(u.kind & 1);
        const size_t off = mix * (WS_ATT + sg * (WS_SG - WS_ATT) + (size_t)u.pm * 256 * 1024) + (1 - mix) * (WS_XN + (size_t)u.pm * 256 * 2048); return ws + off; }
    __device__ __forceinline__ const char* b_ptr(const Unit& u) const { const size_t mix = (size_t)(u.kind >> 1), sg = (size_t)(u.kind & 1);
        const size_t off = mix * (WS_WATT + sg * (WS_WSGU - WS_WATT) + (size_t)u.pn * 256 * 1024) + (1 - mix) * (WS_WZ + (size_t)(ZGA + sg * (ZGB - ZGA) + u.pn * 256) * 2048); return ws + off; }
    __device__ __forceinline__ unsigned goff(int, int) const { return 0u; }
};
struct SchedMoe {
    const LAS int* rec; const LAS unsigned* tbl; const char* A; const char* Bt; size_t a_panel_bytes, b_expert_bytes, b_tile_bytes; bool gather;
    __device__ __forceinline__ bool next(int i, Unit& u) const { if (i >= MOE_MAXU || rec[i * 8] == 0) return false; u.pm = rec[i * 8 + 1]; u.pn = rec[i * 8 + 2]; u.kind = rec[i * 8 + 3]; u.dup = 0; return true; }
    __device__ __forceinline__ const char* a_ptr(const Unit& u) const { return gather ? A : A + (size_t)u.pm * a_panel_bytes; }
    __device__ __forceinline__ const char* b_ptr(const Unit& u) const { return Bt + (size_t)u.kind * b_expert_bytes + (size_t)u.pn * b_tile_bytes; }
    __device__ __forceinline__ unsigned goff(int ui, int row) const { return tbl[ui * 256 + row]; }
};

#ifndef EPI_ST
#define EPI_ST 0
#endif
__device__ __forceinline__ void st16(void* p, u32x4 v) {
#if EPI_ST == 1
    asm volatile("global_store_dwordx4 %0, %1, off nt\n\ts_nop 1" :: "v"(p), "v"(v) : "memory");
#elif EPI_ST == 2
    asm volatile("global_store_dwordx4 %0, %1, off sc1\n\ts_nop 1" :: "v"(p), "v"(v) : "memory");
#else
    *(u32x4*)p = v;
#endif
}
typedef const f32x4 (&AccRef)[2][2][4][2];
typedef float f32x2 __attribute__((ext_vector_type(2)));
struct EpiZ {
    static constexpr bool PERM = true, EDUP = false;
    unsigned char* ws; const float* gq; const float* gk; const float* tab; const float* rs0;
    __device__ __forceinline__ void operator()(AccRef acc, const Unit& u, int, int wr, int wc, int fr, int fq) const {
        const int pn = u.pn;
#define EPIZ_R0(ai_) float r0m[4]; _Pragma("unroll") for (int m_ = 0; m_ < 4; ++m_) r0m[m_] = (X0_BF16 && pn < 15) ? rs0[u.pm * 256 + (ai_) * 128 + wr * 64 + m_ * 16 + fr] : 1.0f
        if (pn <= 2) {
            const bool isv = (pn == 2 && wc >= 2), isq = (pn < 2);
            bf16_t* dst; int ldc;
            if (isq) { dst = (bf16_t*)(ws + WS_Q) + (4 * pn + wc) * 64; ldc = 512; }
            else if (!isv) { dst = (bf16_t*)(ws + WS_K) + wc * 64; ldc = 128; }
            else { dst = (bf16_t*)(ws + WS_V) + (wc - 2) * 64; ldc = 128; }
            const float* g = isq ? gq : gk;
            f32x4 gv[2][2];
#pragma unroll
            for (int bj = 0; bj < 2; ++bj)
#pragma unroll
                for (int n = 0; n < 2; ++n) gv[bj][n] = *(const f32x4*)(g + 32 * bj + 8 * fq + 4 * n);
            const float osc = isq ? C2_SELF : 1.0f;
#pragma unroll
            for (int ai = 0; ai < 2; ++ai) {
                EPIZ_R0(ai);
                const int rid = (4 * u.pm + 2 * ai + wr) & 127;
                f32x4 csr = (f32x4){1.f, 1.f, 1.f, 1.f}, snr = (f32x4){0.f, 0.f, 0.f, 0.f}, csc[4], snc[4];
#pragma unroll
                for (int m = 0; m < 4; ++m) { csc[m] = csr; snc[m] = snr; }
                if (!isv) { const float* tr = tab + rid * 16 + 4 * fq; csr = *(const f32x4*)tr; snr = *(const f32x4*)(tr + 2048);
#pragma unroll
                    for (int m = 0; m < 4; ++m) { const float* tc = tab + 2 * 2048 + (16 * m + fr) * 16 + 4 * fq; csc[m] = *(const f32x4*)tc; snc[m] = *(const f32x4*)(tc + 2048); } }
#pragma unroll
                for (int m = 0; m < 4; ++m) {
                    const int row = u.pm * 256 + ai * 128 + wr * 64 + m * 16 + fr;
                    bf16_t* rowp = dst + (size_t)row * ldc + 8 * fq;
                    if (isv) {
#pragma unroll
                        for (int bj = 0; bj < 2; ++bj) { const f32x4 v0 = acc[ai][bj][m][0] * r0m[m], v1 = acc[ai][bj][m][1] * r0m[m];
                            u32x4 w; w.x = pg8::cvt_pk_bf16(v0[0], v0[1]); w.y = pg8::cvt_pk_bf16(v0[2], v0[3]); w.z = pg8::cvt_pk_bf16(v1[0], v1[1]); w.w = pg8::cvt_pk_bf16(v1[2], v1[3]);
                            st16(rowp + 32 * bj, w); }
                    } else {
                        float ss = 0.f;
#pragma unroll
                        for (int bj = 0; bj < 2; ++bj)
#pragma unroll
                            for (int n = 0; n < 2; ++n) { const f32x4 x = acc[ai][bj][m][n]; ss += (x[0] * x[0] + x[1] * x[1]) + (x[2] * x[2] + x[3] * x[3]); }
                        ss += __shfl_xor(ss, 16); ss += __shfl_xor(ss, 32);
                        const float rq = r0m[m]; const float rs = rq * osc / sqrtf(rq * rq * ss * (1.f / 64.f) + EPS);
#pragma unroll
                        for (int bj = 0; bj < 2; ++bj) {
                            const f32x4 cs = bj ? csc[m] : csr, sn = bj ? snc[m] : snr;
                            float o[8];
#pragma unroll
                            for (int n = 0; n < 2; ++n) { const f32x4 x = acc[ai][bj][m][n], gg = gv[bj][n];
                                const float y0 = x[0] * rs * gg[0], y1 = x[1] * rs * gg[1], y2 = x[2] * rs * gg[2], y3 = x[3] * rs * gg[3];
                                const float c0 = cs[2 * n], s0 = sn[2 * n], c1 = cs[2 * n + 1], s1 = sn[2 * n + 1];
                                o[4 * n + 0] = y0 * c0 - y1 * s0; o[4 * n + 1] = y0 * s0 + y1 * c0; o[4 * n + 2] = y2 * c1 - y3 * s1; o[4 * n + 3] = y2 * s1 + y3 * c1; }
                            u32x4 w; w.x = pg8::cvt_pk_bf16(o[0], o[1]); w.y = pg8::cvt_pk_bf16(o[2], o[3]); w.z = pg8::cvt_pk_bf16(o[4], o[5]); w.w = pg8::cvt_pk_bf16(o[6], o[7]);
                            st16(rowp + 32 * bj, w); }
                    }
                }
            }
        } else {
            bf16_t* dst; int ldc, row0; int act;
            if (pn < 5) { dst = (bf16_t*)(ws + WS_U) + (pn - 3) * 256; ldc = 512; act = 1; row0 = u.pm * 256; }
            else if (pn < 7) { dst = (bf16_t*)(ws + WS_GV) + (pn - 5) * 256; ldc = 512; act = 1; row0 = u.pm * 256; }
            else if (pn < 11) { dst = (bf16_t*)(ws + WS_GA) + (pn - 7) * 256; ldc = 1024; act = 2; row0 = u.pm * 256; }
            else if (pn < 15) { dst = (bf16_t*)(ws + WS_GB) + (pn - 11) * 256; ldc = 1024; act = 2; row0 = u.pm * 256; }
            else { dst = (bf16_t*)(ws + WS_KVC) + (pn - 15) * 256; ldc = 1024; act = 0; row0 = (u.pm - 128) * 256; }
#pragma unroll
            for (int ai = 0; ai < 2; ++ai) { EPIZ_R0(ai);
#pragma unroll
                for (int m = 0; m < 4; ++m) { bf16_t* rowp = dst + (size_t)(row0 + ai * 128 + wr * 64 + m * 16 + fr) * ldc + wc * 32 + 8 * fq;
#pragma unroll
                    for (int bj = 0; bj < 2; ++bj) { f32x2 o[4];
#pragma unroll
                        for (int n = 0; n < 2; ++n)
#pragma unroll
                            for (int hh = 0; hh < 2; ++hh) { const f32x2 x = (f32x2){acc[ai][bj][m][n][2 * hh], acc[ai][bj][m][n][2 * hh + 1]} * r0m[m];
                                if (act == 2) { const f32x2 t = x * (-LOG2E); f32x2 e; e.x = __builtin_amdgcn_exp2f(t.x); e.y = __builtin_amdgcn_exp2f(t.y); const f32x2 d = e + 1.0f;
                                    f32x2 r; r.x = __builtin_amdgcn_rcpf(d.x); r.y = __builtin_amdgcn_rcpf(d.y); o[2 * n + hh] = r; }
                                else if (act == 1) { const f32x2 x2 = x * x, t = (x2 * (-2.0f * LOG2E * 0.7978845608028654f * 0.044715f) + (-2.0f * LOG2E * 0.7978845608028654f)) * x;
                                    f32x2 e; e.x = __builtin_amdgcn_exp2f(t.x); e.y = __builtin_amdgcn_exp2f(t.y); const f32x2 d = e + 1.0f;
                                    f32x2 r; r.x = __builtin_amdgcn_rcpf(d.x); r.y = __builtin_amdgcn_rcpf(d.y); o[2 * n + hh] = x * r; }
                                else o[2 * n + hh] = x; }
                        u32x4 w; w.x = pg8::cvt_pk_bf16(o[0].x, o[0].y); w.y = pg8::cvt_pk_bf16(o[1].x, o[1].y); w.z = pg8::cvt_pk_bf16(o[2].x, o[2].y); w.w = pg8::cvt_pk_bf16(o[3].x, o[3].y);
                        st16(rowp + bj * 128, w); } } }
        }
#undef EPIZ_R0
    }
};
__device__ __forceinline__ void unpack8(const u32x4 g, float (&f)[8]) {
    f[0] = __uint_as_float(g.x << 16); f[1] = __uint_as_float(g.x & 0xffff0000u); f[2] = __uint_as_float(g.y << 16); f[3] = __uint_as_float(g.y & 0xffff0000u);
    f[4] = __uint_as_float(g.z << 16); f[5] = __uint_as_float(g.z & 0xffff0000u); f[6] = __uint_as_float(g.w << 16); f[7] = __uint_as_float(g.w & 0xffff0000u);
}
struct EpiY {
    static constexpr bool PERM = true, EDUP = false;
    bf16_t* GS; bf16_t* MG; const float* rs0;
    __device__ __forceinline__ void operator()(AccRef acc, const Unit& u, int, int wr, int wc, int fr, int fq) const {
#ifdef TEST_TRIV
        if (u.kind >= TEST_TRIV) { GS[(size_t)fr] = (bf16_t)acc[0][0][0][0][0]; return; }
#endif
        int gsl = (wr * 64 + fr) * 256 + wc * 32 + 8 * fq; asm volatile("" : "+v"(gsl));
        static_assert(GATE_U8, "two parked gate tiles need the 8-bit form"); gsl += (u.kind & 1) * 65536;
        if (u.kind < 2) {
            float r0[2][4];
#pragma unroll
            for (int ai = 0; ai < 2; ++ai)
#pragma unroll
                for (int m = 0; m < 4; ++m) r0[ai][m] = X0_BF16 ? rs0[u.pm * 256 + ai * 128 + wr * 64 + m * 16 + fr] : 1.0f;
#pragma unroll
            for (int ai = 0; ai < 2; ++ai)
#pragma unroll
                for (int m = 0; m < 4; ++m) {
#pragma unroll
                    for (int bj = 0; bj < 2; ++bj) { unsigned q[8];
#pragma unroll
                        for (int n = 0; n < 2; ++n)
#pragma unroll
                            for (int hh = 0; hh < 2; ++hh) { const f32x2 x = (f32x2){acc[ai][bj][m][n][2 * hh], acc[ai][bj][m][n][2 * hh + 1]};
                                const f32x2 t = x * (-LOG2E * r0[ai][m]); f32x2 e; e.x = __builtin_amdgcn_exp2f(t.x); e.y = __builtin_amdgcn_exp2f(t.y); const f32x2 d = e + 1.0f;
                                f32x2 r; r.x = __builtin_amdgcn_rcpf(d.x); r.y = __builtin_amdgcn_rcpf(d.y);
#if GATE_U8
                                const f32x2 s = r * 255.0f + 0.5f; q[4 * n + 2 * hh] = (unsigned)s.x; q[4 * n + 2 * hh + 1] = (unsigned)s.y; }
                        u32x2 w; w.x = q[0] | (q[1] << 8) | (q[2] << 16) | (q[3] << 24); w.y = q[4] | (q[5] << 8) | (q[6] << 16) | (q[7] << 24);
                        *(u32x2*)((unsigned char*)GS + gsl + (ai * 128 + m * 16) * 256 + bj * 128) = w; }
#else
                                q[4 * n + 2 * hh] = __float_as_uint(r.x); q[4 * n + 2 * hh + 1] = __float_as_uint(r.y); }
                        u32x4 w; w.x = pg8::cvt_pk_bf16(__uint_as_float(q[0]), __uint_as_float(q[1])); w.y = pg8::cvt_pk_bf16(__uint_as_float(q[2]), __uint_as_float(q[3]));
                        w.z = pg8::cvt_pk_bf16(__uint_as_float(q[4]), __uint_as_float(q[5])); w.w = pg8::cvt_pk_bf16(__uint_as_float(q[6]), __uint_as_float(q[7]));
                        st16(GS + gsl + (ai * 128 + m * 16) * 256 + bj * 128, w); }
#endif
                }
            return;
        }
        const bool add = (u.kind == 3);
        const size_t offb = (size_t)(u.pm * 256 + wr * 64 + fr) * 1024 + u.pn * 256 + wc * 32 + 8 * fq;
        u32x4 pp[2][2];
#if GATE_U8
        u32x2 gg[2][2];
#define EPIY_GLOAD(buf, bj, ai_, m_) gg[buf][bj] = *(const u32x2*)((const unsigned char*)GS + gsl + (ai_ * 128 + m_ * 16) * 256 + bj * 128)
#else
        u32x4 gg[2][2];
#define EPIY_GLOAD(buf, bj, ai_, m_) gg[buf][bj] = *(const u32x4*)(GS + gsl + (ai_ * 128 + m_ * 16) * 256 + bj * 128)
#endif
#define EPIY_LOAD(buf, s) do { const int ai_ = (s) >> 2, m_ = (s) & 3; _Pragma("unroll") for (int bj = 0; bj < 2; ++bj) { \
            EPIY_GLOAD(buf, bj, ai_, m_); \
            pp[buf][bj] = add ? *(const u32x4*)(MG + offb + (size_t)(ai_ * 128 + m_ * 16) * 1024 + bj * 128) : (u32x4){0u, 0u, 0u, 0u}; } } while (0)
        EPIY_LOAD(0, 0);
#pragma unroll
        for (int s = 0; s < 8; ++s) { const int ai = s >> 2, mm = s & 3, cb = s & 1;
            if (s + 1 < 8) { if (cb == 0) EPIY_LOAD(1, s + 1); else EPIY_LOAD(0, s + 1); }
#pragma unroll
            for (int bj = 0; bj < 2; ++bj) { float g[8], p[8]; unpack8(pp[cb][bj], p); float o[8];
#if GATE_U8
                { const unsigned g0 = gg[cb][bj].x, g1 = gg[cb][bj].y;
                  g[0] = (float)(g0 & 0xffu) * (1.f / 255.f); g[1] = (float)((g0 >> 8) & 0xffu) * (1.f / 255.f); g[2] = (float)((g0 >> 16) & 0xffu) * (1.f / 255.f); g[3] = (float)(g0 >> 24) * (1.f / 255.f);
                  g[4] = (float)(g1 & 0xffu) * (1.f / 255.f); g[5] = (float)((g1 >> 8) & 0xffu) * (1.f / 255.f); g[6] = (float)((g1 >> 16) & 0xffu) * (1.f / 255.f); g[7] = (float)(g1 >> 24) * (1.f / 255.f); }
#else
                unpack8(gg[cb][bj], g);
#endif
#pragma unroll
                for (int n = 0; n < 2; ++n)
#pragma unroll
                    for (int j = 0; j < 4; ++j) o[4 * n + j] = p[4 * n + j] + g[4 * n + j] * acc[ai][bj][mm][n][j];
                u32x4 w; w.x = pg8::cvt_pk_bf16(o[0], o[1]); w.y = pg8::cvt_pk_bf16(o[2], o[3]); w.z = pg8::cvt_pk_bf16(o[4], o[5]); w.w = pg8::cvt_pk_bf16(o[6], o[7]);
                st16(MG + offb + (size_t)(ai * 128 + mm * 16) * 1024 + bj * 128, w); } }
#undef EPIY_LOAD
#undef EPIY_GLOAD
    }
};
struct EpiRes {
    static constexpr bool PERM = false, EDUP = false;
    const float* base; float* out;
    __device__ __forceinline__ void operator()(AccRef acc, const Unit& u, int, int wr, int wc, int fr, int fq) const {
#pragma unroll
        for (int ai = 0; ai < 2; ++ai) {
            const size_t off0 = (size_t)(u.pm * 256 + ai * 128 + wr * 64 + fr) * 1024 + u.pn * 256 + wc * 32 + 4 * fq;
            f32x4 bb[4][2][2];
#pragma unroll
            for (int m = 0; m < 4; ++m)
#pragma unroll
                for (int bj = 0; bj < 2; ++bj)
#pragma unroll
                    for (int n = 0; n < 2; ++n) bb[m][bj][n] = *(const f32x4*)(base + off0 + (size_t)m * 16 * 1024 + bj * 128 + n * 16);
#pragma unroll
            for (int m = 0; m < 4; ++m)
#pragma unroll
                for (int bj = 0; bj < 2; ++bj)
#pragma unroll
                    for (int n = 0; n < 2; ++n) *(f32x4*)(out + off0 + (size_t)m * 16 * 1024 + bj * 128 + n * 16) = bb[m][bj][n] + acc[ai][bj][m][n]; }
    }
};
struct EpiBf16s {
    static constexpr bool PERM = true, EDUP = false;
    bf16_t* O; int ldc; float scale;
    __device__ __forceinline__ void operator()(AccRef acc, const Unit& u, int, int wr, int wc, int fr, int fq) const {
#pragma unroll
        for (int ai = 0; ai < 2; ++ai)
#pragma unroll
            for (int m = 0; m < 4; ++m) { bf16_t* rowp = O + (size_t)(u.pm * 256 + ai * 128 + wr * 64 + m * 16 + fr) * ldc + u.pn * 256 + wc * 32 + 8 * fq;
#pragma unroll
                for (int bj = 0; bj < 2; ++bj) { const f32x4 v0 = acc[ai][bj][m][0] * scale, v1 = acc[ai][bj][m][1] * scale;
                    u32x4 w; w.x = pg8::cvt_pk_bf16(v0[0], v0[1]); w.y = pg8::cvt_pk_bf16(v0[2], v0[3]); w.z = pg8::cvt_pk_bf16(v1[0], v1[1]); w.w = pg8::cvt_pk_bf16(v1[2], v1[3]);
                    st16(rowp + bj * 128, w); } }
    }
};
struct EpiMoeA {
    static constexpr bool PERM = true, EDUP = false;
    bf16_t* H; const LAS float* rstbl;
    __device__ __forceinline__ void operator()(AccRef acc, const Unit& u, int ui, int wr, int wc, int fr, int fq) const {
#pragma unroll
        for (int ai = 0; ai < 2; ++ai)
#pragma unroll
            for (int m = 0; m < 4; ++m) { bf16_t* rowp = H + (size_t)(u.pm * 256 + ai * 128 + wr * 64 + m * 16 + fr) * 512 + u.pn * 128 + wc * 32 + 8 * fq; float o[8];
                const float rs = ROUTE_MFMA ? rstbl[ui * 256 + ai * 128 + wr * 64 + m * 16 + fr] : 1.0f;
#pragma unroll
                for (int n = 0; n < 2; ++n)
#pragma unroll
                    for (int j = 0; j < 4; ++j) { const float g = acc[ai][0][m][n][j] * rs, up = acc[ai][1][m][n][j] * rs; o[4 * n + j] = g * __builtin_amdgcn_rcpf(1.0f + __builtin_amdgcn_exp2f(-LOG2E * g)) * up; }
                u32x4 w; w.x = pg8::cvt_pk_bf16(o[0], o[1]); w.y = pg8::cvt_pk_bf16(o[2], o[3]); w.z = pg8::cvt_pk_bf16(o[4], o[5]); w.w = pg8::cvt_pk_bf16(o[6], o[7]);
                st16(rowp, w); }
    }
};
struct EpiMoeB {
    static constexpr bool PERM = true, EDUP = false;
    const LAS int* rec; const int* list; bf16_t* YS;
    __device__ __forceinline__ void operator()(AccRef acc, const Unit& u, int ui, int wr, int wc, int fr, int fq) const {
        const int e = u.kind, r0 = rec[ui * 8 + 4], ne = rec[ui * 8 + 5];
        u32x2 ent[2][4];
#pragma unroll
        for (int ai = 0; ai < 2; ++ai)
#pragma unroll
            for (int m = 0; m < 4; ++m) { const int idx = r0 + ai * 128 + wr * 64 + m * 16 + fr; ent[ai][m] = (u32x2){0u, 0u};
                if (idx < ne) ent[ai][m] = *(const u32x2*)(list + ((size_t)e * LIST_CAP + idx) * 2); }
#pragma unroll
        for (int ai = 0; ai < 2; ++ai)
#pragma unroll
            for (int m = 0; m < 4; ++m) { const int idx = r0 + ai * 128 + wr * 64 + m * 16 + fr;
                if (idx < ne) { const int dest = (int)ent[ai][m].x; const float w = __uint_as_float(ent[ai][m].y);
                    bf16_t* rowp = YS + (size_t)dest * 1024 + u.pn * 256 + wc * 32 + 8 * fq;
#pragma unroll
                    for (int bj = 0; bj < 2; ++bj) { const f32x4 v0 = acc[ai][bj][m][0] * w, v1 = acc[ai][bj][m][1] * w;
                        u32x4 wv; wv.x = pg8::cvt_pk_bf16(v0[0], v0[1]); wv.y = pg8::cvt_pk_bf16(v0[2], v0[3]); wv.z = pg8::cvt_pk_bf16(v1[0], v1[1]); wv.w = pg8::cvt_pk_bf16(v1[2], v1[3]);
                        st16(rowp + bj * 128, wv); } } }
    }
};

struct EpiX1 {
    static constexpr bool PERM = true, EDUP = true;
    const float* x; const bf16_t* XB0; bf16_t* XB; float* ssq;
    __device__ __forceinline__ void operator()(AccRef acc, const Unit& u, int, int wr, int wc, int fr, int fq) const {
        const int rowb = u.pm * 256 + wr * 64 + fr; const size_t offb = (size_t)rowb * 1024 + u.pn * 256 + wc * 32 + 8 * fq;
#if X0_BF16
        u32x4 xq[2][2];
#define EPIX1_LOAD(buf, s) do { const int ai_ = (s) >> 2, m_ = (s) & 3; _Pragma("unroll") for (int bj = 0; bj < 2; ++bj) xq[buf][bj] = NT2 ? __builtin_nontemporal_load((const u32x4*)(XB0 + offb + (size_t)(ai_ * 128 + m_ * 16) * 1024 + bj * 128)) : *(const u32x4*)(XB0 + offb + (size_t)(ai_ * 128 + m_ * 16) * 1024 + bj * 128); } while (0)
#else
        f32x4 xb[2][2][2];
#define EPIX1_LOAD(buf, s) do { const int ai_ = (s) >> 2, m_ = (s) & 3; _Pragma("unroll") for (int bj = 0; bj < 2; ++bj) _Pragma("unroll") for (int n = 0; n < 2; ++n) \
            xb[buf][bj][n] = *(const f32x4*)(x + offb + (size_t)(ai_ * 128 + m_ * 16) * 1024 + bj * 128 + n * 4); } while (0)
#endif
        EPIX1_LOAD(0, 0);
#pragma unroll
        for (int s = 0; s < 8; ++s) { const int ai = s >> 2, mm = s & 3, cb = s & 1;
            if (s + 1 < 8) { if (cb == 0) EPIX1_LOAD(1, s + 1); else EPIX1_LOAD(0, s + 1); }
            float ss = 0.f;
#pragma unroll
            for (int bj = 0; bj < 2; ++bj) {
#if X0_BF16
                float b[8]; unpack8(xq[cb][bj], b); const f32x4 v0 = (f32x4){b[0], b[1], b[2], b[3]} + acc[ai][bj][mm][0], v1 = (f32x4){b[4], b[5], b[6], b[7]} + acc[ai][bj][mm][1];
#else
                const f32x4 v0 = xb[cb][bj][0] + acc[ai][bj][mm][0], v1 = xb[cb][bj][1] + acc[ai][bj][mm][1];
#endif
                ss += (v0[0] * v0[0] + v0[1] * v0[1]) + (v0[2] * v0[2] + v0[3] * v0[3]) + (v1[0] * v1[0] + v1[1] * v1[1]) + (v1[2] * v1[2] + v1[3] * v1[3]);
                u32x4 w; w.x = pg8::cvt_pk_bf16(v0[0], v0[1]); w.y = pg8::cvt_pk_bf16(v0[2], v0[3]); w.z = pg8::cvt_pk_bf16(v1[0], v1[1]); w.w = pg8::cvt_pk_bf16(v1[2], v1[3]);
                st16(XB + offb + (size_t)(ai * 128 + mm * 16) * 1024 + bj * 128, w); }
            ss += __shfl_xor(ss, 16); ss += __shfl_xor(ss, 32);
            if (fq == 0) ssq[(size_t)(rowb + ai * 128 + mm * 16) * 16 + u.pn * 4 + wc] = ss; }
#undef EPIX1_LOAD
    }
};
struct EpiQC {
    static constexpr bool PERM = true, EDUP = false;
    bf16_t* O; const float* ssq; float scale;
    __device__ __forceinline__ void operator()(AccRef acc, const Unit& u, int, int wr, int wc, int fr, int fq) const {
        f32x4 q[2][4];
#pragma unroll
        for (int ai = 0; ai < 2; ++ai)
#pragma unroll
            for (int m = 0; m < 4; ++m) q[ai][m] = *(const f32x4*)(ssq + (size_t)(u.pm * 256 + ai * 128 + wr * 64 + m * 16 + fr) * 16 + 4 * fq);
#pragma unroll
        for (int ai = 0; ai < 2; ++ai)
#pragma unroll
            for (int m = 0; m < 4; ++m) { float s = (q[ai][m][0] + q[ai][m][1]) + (q[ai][m][2] + q[ai][m][3]); s += __shfl_xor(s, 16); s += __shfl_xor(s, 32);
                const float rs = scale / sqrtf(s * (1.f / 1024.f) + EPS);
                bf16_t* rowp = O + (size_t)(u.pm * 256 + ai * 128 + wr * 64 + m * 16 + fr) * 512 + u.pn * 256 + wc * 32 + 8 * fq;
#pragma unroll
                for (int bj = 0; bj < 2; ++bj) { const f32x4 v0 = acc[ai][bj][m][0] * rs, v1 = acc[ai][bj][m][1] * rs;
                    u32x4 w; w.x = pg8::cvt_pk_bf16(v0[0], v0[1]); w.y = pg8::cvt_pk_bf16(v0[2], v0[3]); w.z = pg8::cvt_pk_bf16(v1[0], v1[1]); w.w = pg8::cvt_pk_bf16(v1[2], v1[3]);
                    st16(rowp + bj * 128, w); } }
    }
};
struct EpiX2 {
    static constexpr bool PERM = true, EDUP = false;
    const bf16_t* XB; float* out; bf16_t* XB2;
    __device__ __forceinline__ void operator()(AccRef acc, const Unit& u, int, int wr, int wc, int fr, int fq) const {
        const size_t offb = (size_t)(u.pm * 256 + wr * 64 + fr) * 1024 + u.pn * 256 + wc * 32 + 8 * fq;
        u32x4 xb[2][2];
#define EPIX2_LOAD(buf, s) do { const int ai_ = (s) >> 2, m_ = (s) & 3; _Pragma("unroll") for (int bj = 0; bj < 2; ++bj) xb[buf][bj] = NT2 ? __builtin_nontemporal_load((const u32x4*)(XB + offb + (size_t)(ai_ * 128 + m_ * 16) * 1024 + bj * 128)) : *(const u32x4*)(XB + offb + (size_t)(ai_ * 128 + m_ * 16) * 1024 + bj * 128); } while (0)
        EPIX2_LOAD(0, 0);
#pragma unroll
        for (int s = 0; s < 8; ++s) { const int ai = s >> 2, mm = s & 3, cb = s & 1;
            if (s + 1 < 8) { if (cb == 0) EPIX2_LOAD(1, s + 1); else EPIX2_LOAD(0, s + 1); }
#pragma unroll
            for (int bj = 0; bj < 2; ++bj) { float b[8]; unpack8(xb[cb][bj], b);
                const f32x4 v0 = (f32x4){b[0], b[1], b[2], b[3]} + acc[ai][bj][mm][0], v1 = (f32x4){b[4], b[5], b[6], b[7]} + acc[ai][bj][mm][1];
                const size_t o_ = offb + (size_t)(ai * 128 + mm * 16) * 1024 + bj * 128;
                if (X2_BF16) { u32x4 w; w.x = pg8::cvt_pk_bf16(v0[0], v0[1]); w.y = pg8::cvt_pk_bf16(v0[2], v0[3]); w.z = pg8::cvt_pk_bf16(v1[0], v1[1]); w.w = pg8::cvt_pk_bf16(v1[2], v1[3]); st16(XB2 + o_, w); }
                else { *(f32x4*)(out + o_) = v0; *(f32x4*)(out + o_ + 4) = v1; } } }
#undef EPIX2_LOAD
    }
};
typedef short v4i16_t __attribute__((ext_vector_type(4)));
typedef short bf16x8_t __attribute__((ext_vector_type(8)));
typedef float f32x16_t __attribute__((ext_vector_type(16)));
__device__ __forceinline__ v4i16_t lds_tr16(LAS unsigned char* p) { return __builtin_amdgcn_ds_read_tr16_b64_v4i16((LAS v4i16_t*)p); }

__device__ __forceinline__ void sgu_unit(LAS unsigned char* lds, unsigned char* ws, const PtrsIn& P, int ch) {
    const int tid = threadIdx.x, lane = tid & 63, wave = __builtin_amdgcn_readfirstlane(tid >> 6), fr = lane & 15, fq = lane >> 4;
    {
        const int row = tid >> 2, q4 = tid & 3;
        const u32x4* src = (const u32x4*)((const bf16_t*)(ws + WS_GV) + ((size_t)ch * 128 + row) * 512 + q4 * 128);
        u32x4 raw[16];
#pragma unroll
        for (int j = 0; j < 16; ++j) raw[j] = NT2 ? __builtin_nontemporal_load(&src[j]) : src[j];
        float s = 0.f;
#pragma unroll
        for (int j = 0; j < 16; ++j) { float f[8]; unpack8(raw[j], f);
#pragma unroll
            for (int k = 0; k < 8; ++k) s += f[k]; }
        s += __shfl_xor(s, 1); s += __shfl_xor(s, 2);
        const float mean = s * (1.f / 512.f); float q = 0.f;
#pragma unroll
        for (int j = 0; j < 16; ++j) { float f[8]; unpack8(raw[j], f);
#pragma unroll
            for (int k = 0; k < 8; ++k) { const float d = f[k] - mean; q += d * d; } }
        q += __shfl_xor(q, 1); q += __shfl_xor(q, 2);
        const float rstd = 1.0f / sqrtf(q * (1.f / 512.f) + EPS);
        const float* lg = P.in[7] + q4 * 128; const float* lb = P.in[8] + q4 * 128;
        LAS unsigned char* dst = lds + row * SGU_ROWB + q4 * 256;
#pragma unroll
        for (int j = 0; j < 16; ++j) { float f[8]; unpack8(raw[j], f);
            const f32x4 g0 = *(const f32x4*)(lg + 8 * j), g1 = *(const f32x4*)(lg + 8 * j + 4), b0 = *(const f32x4*)(lb + 8 * j), b1 = *(const f32x4*)(lb + 8 * j + 4);
            u32x4 w; w.x = pg8::cvt_pk_bf16((f[0] - mean) * rstd * g0[0] + b0[0], (f[1] - mean) * rstd * g0[1] + b0[1]); w.y = pg8::cvt_pk_bf16((f[2] - mean) * rstd * g0[2] + b0[2], (f[3] - mean) * rstd * g0[3] + b0[3]);
            w.z = pg8::cvt_pk_bf16((f[4] - mean) * rstd * g1[0] + b1[0], (f[5] - mean) * rstd * g1[1] + b1[1]); w.w = pg8::cvt_pk_bf16((f[6] - mean) * rstd * g1[2] + b1[2], (f[7] - mean) * rstd * g1[3] + b1[3]);
            *(LAS u32x4*)(dst + j * 16) = w; }
    }
    __syncthreads();
    const int i16 = lane & 15;
    LAS unsigned char* trb = lds + (8 * fq + (i16 >> 2)) * SGU_ROWB + (i16 & 3) * 8;
    const int p = 16 * wave + fr; const size_t tok = (size_t)ch * 128 + p;
    u32x2 uu[4][8]; float bsv[4];
#pragma unroll
    for (int g = 0; g < 4; ++g) { const bf16_t* U = (const bf16_t*)(ws + WS_U) + tok * 512 + g * 128 + 4 * fq; bsv[g] = P.in[10][g * 128 + p];
#pragma unroll
        for (int nt = 0; nt < 8; ++nt) uu[g][nt] = NT2 ? __builtin_nontemporal_load((const u32x2*)(U + 16 * nt)) : *(const u32x2*)(U + 16 * nt); }
#pragma unroll
    for (int g = 0; g < 4; ++g) {
        const bf16_t* W = (const bf16_t*)(ws + WS_WSS) + ((size_t)g * 128 + p) * 128 + 8 * fq;
        bf16x8_t af[4];
#pragma unroll
        for (int ks = 0; ks < 4; ++ks) af[ks] = *(const bf16x8_t*)(W + 32 * ks);
        const float bs = bsv[g];
        f32x4 acc[8];
#pragma unroll
        for (int nt = 0; nt < 8; ++nt) { acc[nt] = (f32x4){0.f, 0.f, 0.f, 0.f};
#pragma unroll
            for (int ks = 0; ks < 4; ++ks) { LAS unsigned char* a = trb + ks * 32 * SGU_ROWB + (g * 128 + 16 * nt) * 2;
                const v4i16_t lo = lds_tr16(a), hi = lds_tr16(a + 4 * SGU_ROWB);
                const bf16x8_t bfr = (bf16x8_t){lo[0], lo[1], lo[2], lo[3], hi[0], hi[1], hi[2], hi[3]};
                acc[nt] = __builtin_amdgcn_mfma_f32_16x16x32_bf16(bfr, af[ks], acc[nt], 0, 0, 0); } }
        bf16_t* SG = (bf16_t*)(ws + WS_SG) + tok * 512 + g * 128 + 4 * fq;
#pragma unroll
        for (int nt = 0; nt < 8; ++nt) { const u32x2 u2 = uu[g][nt];
            const float u0 = __uint_as_float(u2.x << 16), u1 = __uint_as_float(u2.x & 0xffff0000u), u2f = __uint_as_float(u2.y << 16), u3 = __uint_as_float(u2.y & 0xffff0000u);
            u32x2 o; o.x = pg8::cvt_pk_bf16(u0 * (acc[nt][0] + bs), u1 * (acc[nt][1] + bs)); o.y = pg8::cvt_pk_bf16(u2f * (acc[nt][2] + bs), u3 * (acc[nt][3] + bs));
            *(u32x2*)(SG + 16 * nt) = o; }
    }
    __syncthreads();
}

__device__ __forceinline__ void phase2_sgu_attn(LAS unsigned char* lds, unsigned char* lds_generic, unsigned char* ws, const PtrsIn& P, int vcu, int G) {
    for (int ch = vcu; ch < M / 128; ch += G) sgu_unit(lds, ws, P, ch);
    const int upc = (1024 + G - 1) / G;
    float cfix; { const int l64 = threadIdx.x & 63; const float mq = wave_max(fabsf(P.in[4][l64])), mk = wave_max(fabsf(P.in[5][l64])); cfix = __int_as_float(__builtin_amdgcn_readfirstlane(__float_as_int(C2_SELF * 64.0f * mq * mk))); }
    const bool fixm = ATT_FIXM && (cfix < 60.0f);
    const int nmoe = IT_TOTAL - IT_P0, per = (nmoe + G - 1) / G, it0 = IT_P0 + vcu * per, it1 = (it0 + per < IT_TOTAL) ? it0 + per : IT_TOTAL, slot = vcu % upc;
    for (int i = 0; i < upc; ++i) { const int U = vcu * upc + i;
        if (U < 1024) { const int bkv = U >> 7, jj = U & 127, hl = jj >> 5, qb = jj & 31, b = bkv >> 1, kvh = bkv & 1;
            if (fixm) attn_body::attn_unit<8, true>(b, kvh * 4 + hl, kvh, qb, (const bf16_t*)(ws + WS_Q), (const bf16_t*)(ws + WS_K), (const bf16_t*)(ws + WS_V), (bf16_t*)(ws + WS_ATT), (char*)lds_generic + RING_OFF, cfix);
            else attn_body::attn_unit<8, false>(b, kvh * 4 + hl, kvh, qb, (const bf16_t*)(ws + WS_Q), (const bf16_t*)(ws + WS_K), (const bf16_t*)(ws + WS_V), (bf16_t*)(ws + WS_ATT), (char*)lds_generic + RING_OFF, 0.f); }
        if (MOE_CONV_IN_P2 && i == slot) {
            int tid2 = threadIdx.x; asm volatile("" : "+v"(tid2));
            const int lane2 = tid2 & 63, wave2 = __builtin_amdgcn_readfirstlane(tid2 >> 6);
            LAS float* scr = (LAS float*)(lds + RING_OFF + wave2 * 16384);
            for (int it = it0 + wave2; it < it1; it += NWAVES) p0_weight_item(P, ws, scr, it, lane2);
            __syncthreads(); } }
}

__device__ __forceinline__ void cross_stage_kv(unsigned lds0, const bf16_t* KVC, int b, int h, int wave, int lane) {
#pragma unroll
    for (int j = 0; j < 8; ++j) { const int c = 2 * wave + (j >> 2), rb = j & 3;
        attn_body::glds16(KVC + (size_t)(b * NMEM + rb * 64 + lane) * 1024 + h * 128 + c * 8, (unsigned)__builtin_amdgcn_readfirstlane(lds0 + c * 4096 + rb * 1024)); }
#pragma unroll
    for (int j = 0; j < 8; ++j) { const int pc = wave * 8 + j, db = pc >> 4, r0 = (pc & 15) * 16;
        attn_body::glds16(KVC + (size_t)(b * NMEM + r0 + (lane >> 2)) * 1024 + 512 + h * 128 + db * 32 + (lane & 3) * 8, (unsigned)__builtin_amdgcn_readfirstlane(lds0 + 65536 + db * 16384 + r0 * 64)); }
}
__device__ __forceinline__ void cross_unit(LAS unsigned char* lds, const bf16_t* QC, bf16_t* OC, int row0, int h) {
    const int tid = threadIdx.x, lane = tid & 63, wave = __builtin_amdgcn_readfirstlane(tid >> 6), r32 = lane & 31, hi = lane >> 5;
    const bf16_t* Qw = QC + (size_t)(row0 + 32 * wave + r32) * 512 + h * 128 + 8 * hi;
    bf16x8_t qr[8];
#pragma unroll
    for (int ds = 0; ds < 8; ++ds) qr[ds] = *(const bf16x8_t*)(Qw + 16 * ds);
    f32x16_t p[8];
    const LAS unsigned char* kb0 = lds + hi * 4096 + r32 * 16;
#pragma unroll
    for (int kb = 0; kb < 8; ++kb) { p[kb] = f32x16_t{};
#pragma unroll
        for (int ds = 0; ds < 8; ++ds) { const bf16x8_t kf = *(const LAS bf16x8_t*)(kb0 + ds * 8192 + kb * 512); p[kb] = __builtin_amdgcn_mfma_f32_32x32x16_bf16(kf, qr[ds], p[kb], 0, 0, 0); }
        __builtin_amdgcn_sched_barrier(0); }
    float mx = -1e30f;
#pragma unroll
    for (int kb = 0; kb < 8; ++kb)
#pragma unroll
        for (int r = 0; r < 16; ++r) mx = fmaxf(mx, p[kb][r]);
    { auto rr = __builtin_amdgcn_permlane32_swap(__float_as_uint(mx), __float_as_uint(mx), false, false); mx = fmaxf(__uint_as_float(rr[0]), __uint_as_float(rr[1])); }
    float l = 0.f;
    u32x4 pw[16];
#pragma unroll
    for (int kb = 0; kb < 8; ++kb) {
#pragma unroll
        for (int r = 0; r < 16; ++r) { p[kb][r] = __builtin_amdgcn_exp2f(p[kb][r] - mx); l += p[kb][r]; }
#pragma unroll
        for (int s = 0; s < 2; ++s) { pw[2 * kb + s].x = pg8::cvt_pk_bf16(p[kb][8 * s + 0], p[kb][8 * s + 1]); pw[2 * kb + s].y = pg8::cvt_pk_bf16(p[kb][8 * s + 2], p[kb][8 * s + 3]);
            pw[2 * kb + s].z = pg8::cvt_pk_bf16(p[kb][8 * s + 4], p[kb][8 * s + 5]); pw[2 * kb + s].w = pg8::cvt_pk_bf16(p[kb][8 * s + 6], p[kb][8 * s + 7]); }
        __builtin_amdgcn_sched_barrier(0); }
    { auto rr = __builtin_amdgcn_permlane32_swap(__float_as_uint(l), __float_as_uint(l), false, false); l = __uint_as_float(rr[0]) + __uint_as_float(rr[1]); }
    const float il = 1.0f / l;
    f32x16_t o[4];
#pragma unroll
    for (int db = 0; db < 4; ++db) o[db] = f32x16_t{};
    const int i16 = lane & 15;
    LAS unsigned char* vb = lds + 65536 + (4 * hi + (i16 >> 2)) * 64 + ((lane >> 4) & 1) * 32 + (i16 & 3) * 8;
#pragma unroll
    for (int ks = 0; ks < 16; ++ks) {
        const bf16x8_t pa = __builtin_bit_cast(bf16x8_t, pw[ks]);
#pragma unroll
        for (int db = 0; db < 4; ++db) { LAS unsigned char* a = vb + db * 16384 + (16 * ks) * 64;
            const v4i16_t lo = lds_tr16(a), hh = lds_tr16(a + 512);
            const bf16x8_t vf = (bf16x8_t){lo[0], lo[1], lo[2], lo[3], hh[0], hh[1], hh[2], hh[3]};
            o[db] = __builtin_amdgcn_mfma_f32_32x32x16_bf16(vf, pa, o[db], 0, 0, 0); }
        __builtin_amdgcn_sched_barrier(0); }
    bf16_t* Ow = OC + (size_t)(row0 + 32 * wave + r32) * 512 + h * 128 + 4 * hi;
#pragma unroll
    for (int db = 0; db < 4; ++db)
#pragma unroll
        for (int rg = 0; rg < 4; ++rg) { u32x2 w; w.x = pg8::cvt_pk_bf16(o[db][4 * rg + 0] * il, o[db][4 * rg + 1] * il); w.y = pg8::cvt_pk_bf16(o[db][4 * rg + 2] * il, o[db][4 * rg + 3] * il);
            *(u32x2*)(Ow + 32 * db + 8 * rg) = w; }
}
__device__ __forceinline__ void cross_after_qc(LAS unsigned char* lds, unsigned char* lds_generic, unsigned char* ws, int pm, int pn) {
    const int tid = threadIdx.x, lane = tid & 63, wave = __builtin_amdgcn_readfirstlane(tid >> 6);
    const unsigned lds0 = (unsigned)(uintptr_t)(lds_generic + RING_OFF);
    for (int hh = 0; hh < 2; ++hh) { const int h = 2 * pn + hh, b = pm >> 5;
        cross_stage_kv(lds0, (const bf16_t*)(ws + WS_KVC), b, h, wave, lane);
        asm volatile("s_waitcnt vmcnt(0)" ::: "memory"); __syncthreads();
        cross_unit(lds, (const bf16_t*)(ws + WS_QC), (bf16_t*)(ws + WS_OC), pm * 256, h);
        __syncthreads(); }
}
__device__ __forceinline__ void phase7_cross(LAS unsigned char* lds, unsigned char* lds_generic, unsigned char* ws, int vcu, int G) {
    const int tid = threadIdx.x, lane = tid & 63, wave = __builtin_amdgcn_readfirstlane(tid >> 6);
    const unsigned lds0 = (unsigned)(uintptr_t)(lds_generic + RING_OFF);
    for (int j = vcu; j < 256; j += G) { const int h = j & 3, pp = j >> 2, b = pp >> 4;
        cross_stage_kv(lds0, (const bf16_t*)(ws + WS_KVC), b, h, wave, lane);
        asm volatile("s_waitcnt vmcnt(0)" ::: "memory"); __syncthreads();
        cross_unit(lds, (const bf16_t*)(ws + WS_QC), (bf16_t*)(ws + WS_OC), (2 * pp) * 256, h);
        cross_unit(lds, (const bf16_t*)(ws + WS_QC), (bf16_t*)(ws + WS_OC), (2 * pp + 1) * 256, h);
        __syncthreads(); }
}
struct Args { PtrsIn P; float* out; unsigned char* ws; int ph_lo, ph_hi; };
static_assert(sizeof(Args) == 27 * 8 + 24, "Args has no holes");

__device__ __forceinline__ void moe_setup(LAS unsigned char* lds, unsigned char* ws, int vcu, int G, bool with_gather) {
    LAS int* rec = (LAS int*)(lds + UREC_OFF); LAS unsigned* tbl = (LAS unsigned*)(lds + TBL_OFF);
    const int tid = threadIdx.x;
    const unsigned* ec = (const unsigned*)(ws + WS_CTL) + CW_ECNT;
    int cnt[16], pb[17]; pb[0] = 0;
#pragma unroll
    for (int e = 0; e < 16; ++e) { cnt[e] = (int)__hip_atomic_load(ec + 64 * e, __ATOMIC_RELAXED, __HIP_MEMORY_SCOPE_AGENT); pb[e + 1] = pb[e] + ((cnt[e] + 255) >> 8); }
    const int NP = pb[16];
    LAS float* rstbl = (LAS float*)(lds + RSTBL_OFF);
    for (int i = 0; i < MOE_MAXU; ++i) {
        const int L = i * G + vcu; const bool valid = (L < 4 * NP);
        int panel = 0, pn = 0, e = 0, r0 = 0, ne = 0;
        if (valid) { panel = L >> 2; pn = L & 3;
#pragma unroll
            for (int j = 1; j < 16; ++j) if (panel >= pb[j]) e = j;
#pragma unroll
            for (int j = 0; j < 16; ++j) if (j == e) { r0 = (panel - pb[j]) * 256; ne = cnt[j]; } }
        if (tid == 0) { rec[i * 8 + 0] = valid ? 1 : 0; rec[i * 8 + 1] = panel; rec[i * 8 + 2] = pn; rec[i * 8 + 3] = e; rec[i * 8 + 4] = r0; rec[i * 8 + 5] = ne; }
        if (with_gather && tid < 256) { unsigned off = 0u; float rsv = 0.f;
            if (valid && r0 + tid < ne) { const int dest = ((const int*)(ws + WS_LIST))[((size_t)e * LIST_CAP + r0 + tid) * 2]; off = (unsigned)(dest >> 1) * 2048u; if (ROUTE_MFMA) rsv = ((const float*)(ws + WS_RSTOK))[dest >> 1]; }
            tbl[i * 256 + tid] = off; rstbl[i * 256 + tid] = rsv; }
    }
    if (tid == 0) rec[MOE_MAXU * 8] = 4 * NP;
    __syncthreads();
}

#ifndef LB_W
#define LB_W 2
#endif
__global__ void __launch_bounds__(NWAVES * 64, LB_W) mega(Args args) {
    extern __shared__ __attribute__((aligned(16))) unsigned char lds_raw[];
    LAS unsigned char* lds = (LAS unsigned char*)lds_raw;
    volatile LAS unsigned* MISC = (volatile LAS unsigned*)(lds + MISC_OFF);
    const int tid = threadIdx.x, lane = tid & 63, wave = __builtin_amdgcn_readfirstlane(tid >> 6);
    const int G = gridDim.x, bx = blockIdx.x, vcu = (G % 8 == 0) ? (bx % 8) * (G / 8) + bx / 8 : bx;
    unsigned char* ws = args.ws; const PtrsIn& P = args.P; float* out = args.out;
    for (int u = tid; u < (LDS_BYTES - MISC_OFF) / 4; u += NWAVES * 64) ((LAS unsigned*)(lds + MISC_OFF))[u] = 0u;
    __syncthreads();
    const int lo = args.ph_lo, hi = args.ph_hi;
    const bool fusedrun = (hi - lo) > 1;
    XcdBarrier bar; bar.bar = (unsigned*)(ws + WS_CTL) + CW_BAR; bar.x = 0; bar.st = nullptr;
    if (fusedrun) bar = xcd_barrier_post((unsigned*)(ws + WS_CTL) + CW_BAR, MISC + 8);
#ifndef TAIL_E0
#define TAIL_E0 16
#endif
#ifndef STAG_Y
#define STAG_Y 0u
#endif
#ifndef STAG_MA
#define STAG_MA 0u
#endif
#ifndef STAG_MB
#define STAG_MB 0u
#endif
#ifndef ALIGN_E
#define ALIGN_E true
#endif
#ifndef PH_EN
#define PH_EN 0x1FFF
#endif
#define IN(k) ((((PH_EN) >> (k)) & 1) && lo <= (k) && (k) < hi)
#define SEAM(k) do { if (IN(k) && IN((k) + 1)) xcd_barrier(bar); } while (0)
#ifndef PH_DUP
#define PH_DUP 0
#endif
#define NREP(k) ((((PH_DUP) >> (k)) & 1) ? 2 : 1)
#define REPSEAM(k) do { if (NREP(k) == 2 && rep_ == 0 && fusedrun) xcd_barrier(bar); } while (0)
    const int gw = vcu * NWAVES + wave, NGW = G * NWAVES;

    if (IN(0)) {
        _Pragma("unroll") for (int rep_ = 0; rep_ < NREP(0); ++rep_) {
        LAS float* scr = (LAS float*)(lds + RING_OFF + wave * 16384);
        const bool tailconv = TAIL_CONV && (G == 256);
        for (int it = gw; it < ((MOE_CONV_IN_P2 || tailconv) ? IT_P0 : IT_TOTAL); it += NGW) p0_weight_item(P, ws, scr, it, lane);
        if (tailconv) for (int j = TAIL_E0 * 512 + gw; j < NE * 512; j += NGW) p0_weight_item(P, ws, scr, IT_P0 + (j >> 9) * 768 + (j & 511), lane);
        { const float* wsrc = P.in[9]; bf16_t* wd = (bf16_t*)(ws + WS_WSS);
          for (int i = bx * 512 + tid; i < 4 * 128 * 128; i += G * 512) wd[i] = (bf16_t)f2bf(wsrc[i]); }
        for (int i = bx * 512 + tid; i < 2048; i += G * 512) rope_table_entry((float*)(ws + WS_TAB), i);
        bf16_t* XN = (bf16_t*)(ws + WS_XN);
        if (X0_BF16) xb0_rows(P.in[0], XN, (float*)(ws + WS_RS0), gw, NGW, M, lane); else rms_rows(P.in[0], P.in[2], XN, gw, NGW, M, lane);
        rms_rows(P.in[1], P.in[14], XN + (size_t)M * D, gw, NGW, MMEM, lane);
            REPSEAM(0); }
    }
    SEAM(0);
    if (IN(1)) {
        _Pragma("unroll") for (int rep_ = 0; rep_ < NREP(1); ++rep_) {
        SchedZ S{(const char*)(ws + WS_XN), (const char*)(ws + WS_WZ), G, bx};
        EpiZ E{ws, P.in[4], P.in[5], (const float*)(ws + WS_TAB), (const float*)(ws + WS_RS0)};
        pg8::gemm_phase<EpiZ, SchedZ, ALIGN_E, false>(lds + RING_OFF, 1024, S, E);
        if (TAIL_CONV && G == 256 && bx >= 144) {
            int tid2 = threadIdx.x; asm volatile("" : "+v"(tid2)); const int lane2 = tid2 & 63, wave2 = __builtin_amdgcn_readfirstlane(tid2 >> 6);
            LAS float* scr = (LAS float*)(lds + RING_OFF + wave2 * 16384);
            for (int j = (bx - 144) * NWAVES + wave2; j < TAIL_E0 * 512; j += 112 * NWAVES) p0_weight_item(P, ws, scr, IT_P0 + (j >> 9) * 768 + (j & 511), lane2); }
            REPSEAM(1); }
    }
    SEAM(1);
    if (IN(2)) {
        _Pragma("unroll") for (int rep_ = 0; rep_ < NREP(2); ++rep_) {
        phase2_sgu_attn(lds, lds_raw, ws, P, vcu, G);
            REPSEAM(2); }
    }
    SEAM(2);
    if (IN(3)) {
        _Pragma("unroll") for (int rep_ = 0; rep_ < NREP(3); ++rep_) {
        SchedY S{(const char*)ws, G, bx};
        EpiY E{(bf16_t*)(ws + WS_GSCR) + (size_t)bx * 65536, (bf16_t*)(ws + WS_MERGED), (const float*)(ws + WS_RS0)};
#ifdef PROBE_KDUP_Y
        SchedDup<SchedY> SD{S}; pg8::gemm_phase<EpiY, SchedDup<SchedY>, ALIGN_E, false, true>(lds + RING_OFF, 1024, SD, E, STAG_Y);
#else
        pg8::gemm_phase<EpiY, SchedY, ALIGN_E, false, true>(lds + RING_OFF, 1024, S, E, STAG_Y);
#endif
            REPSEAM(3); }
    }
    SEAM(3);
    if (IN(4)) {
        _Pragma("unroll") for (int rep_ = 0; rep_ < NREP(4); ++rep_) {
        SchedPlain S{(const char*)(ws + WS_MERGED), (const char*)(ws + WS_WOUT), 128, 4, G, bx, 1024};
#if FOLD_GAINS
        EpiX1 E{P.in[0], (const bf16_t*)(ws + WS_XN), (bf16_t*)(ws + WS_XN1), (float*)(ws + WS_SSQ1)};
#ifdef PROBE_KDUP
        SchedDup<SchedPlain> SD{S}; pg8::gemm_phase<EpiX1, SchedDup<SchedPlain>, ALIGN_E, false>(lds + RING_OFF, 1024, SD, E);
#else
        pg8::gemm_phase<EpiX1, SchedPlain, ALIGN_E, false>(lds + RING_OFF, 1024, S, E);
#endif
#else
        EpiRes E{P.in[0], out};
        pg8::gemm_phase<EpiRes, SchedPlain, ALIGN_E, false>(lds + RING_OFF, 1024, S, E);
#endif
            REPSEAM(4); }
    }
    SEAM(4);
    if (IN(5)) {
        _Pragma("unroll") for (int rep_ = 0; rep_ < NREP(5); ++rep_) {
        bf16_t* XN1 = (bf16_t*)(ws + WS_XN1);
        if (!FOLD_GAINS) rms_rows(out, P.in[13], XN1, gw, NGW, M, lane);
            REPSEAM(5); }
    }
    if (!FOLD_GAINS) SEAM(5);
    if (IN(6)) {
        _Pragma("unroll") for (int rep_ = 0; rep_ < NREP(6); ++rep_) {
        SchedPlain S{(const char*)(ws + WS_XN1), (const char*)(ws + WS_WCQ), 128, 2, G, bx, 1024};
#if FOLD_GAINS
        EpiQC E{(bf16_t*)(ws + WS_QC), (const float*)(ws + WS_SSQ1), C2_CROSS};
        pg8::gemm_phase<EpiQC, SchedPlain, ALIGN_E, false>(lds + RING_OFF, 1024, S, E);
#if MERGE_QC_CROSS
        asm volatile("s_waitcnt vmcnt(0)" ::: "memory"); __syncthreads();
        { Unit u; for (int i = 0; S.next(i, u); ++i) cross_after_qc(lds, lds_raw, ws, u.pm, u.pn); }
#endif
#else
        EpiBf16s E{(bf16_t*)(ws + WS_QC), 512, C2_CROSS};
        pg8::gemm_phase<EpiBf16s, SchedPlain, ALIGN_E, false>(lds + RING_OFF, 1024, S, E);
#endif
            REPSEAM(6); }
    }
    if (!(MERGE_QC_CROSS && FOLD_GAINS)) SEAM(6);
    if (IN(7)) {
        _Pragma("unroll") for (int rep_ = 0; rep_ < NREP(7); ++rep_) {
        if (!(MERGE_QC_CROSS && FOLD_GAINS)) phase7_cross(lds, lds_raw, ws, vcu, G);
            REPSEAM(7); }
    }
    SEAM(7);
    if (IN(8)) {
        SchedPlain S{(const char*)(ws + WS_OC), (const char*)(ws + WS_WCO), 128, 4, G, bx, 512};
#if FOLD_GAINS
        EpiX2 E{(const bf16_t*)(ws + WS_XN1), out, (bf16_t*)(ws + WS_XN3)};
        pg8::gemm_phase<EpiX2, SchedPlain, ALIGN_E, false>(lds + RING_OFF, 512, S, E);
#else
        EpiRes E{out, out};
        pg8::gemm_phase<EpiRes, SchedPlain, ALIGN_E, false>(lds + RING_OFF, 512, S, E);
#endif
        if (!FOLD_GAINS && NREP(8) == 2) { if (fusedrun) xcd_barrier(bar); EpiRes E2{out, (float*)(ws + WS_Q)}; pg8::gemm_phase<EpiRes, SchedPlain, ALIGN_E, false>(lds + RING_OFF, 512, S, E2); }
    }
    SEAM(8);
#if ROUTE_MFMA
    if (IN(9)) {
#if X2_BF16
        LAS bf16_t* WH = (LAS bf16_t*)(lds + RING_OFF);
        LAS bf16_t* WM = WH + 20 * 1032;
        LAS float* PART = (LAS float*)(lds + RING_OFF + 2 * 20 * 1032 * 2);
        LAS float* SSQP = PART + 2 * 4 * 32 * 33;
        LAS int* te = (LAS int*)(SSQP + 2 * 4 * 2 * 32); LAS float* tw = (LAS float*)(te + 256); LAS int* tp = (LAS int*)(tw + 256); LAS int* ebase = tp + 256;
        for (int i = tid; i < 1024 * 20; i += 512) { const int kk = i / 20, o = i % 20; const float w = (o < 4 ? P.in[19][kk * 4 + o] : P.in[21][kk * 16 + (o - 4)]) * P.in[18][kk];
            const unsigned hb = f2bf(w); const float rem = w - __uint_as_float(hb << 16); WH[o * 1032 + kk] = (bf16_t)hb; WM[o * 1032 + kk] = (bf16_t)f2bf(rem); }
        __syncthreads();
        const int tg = wave & 3, kh = wave >> 2, n = lane & 31, hh = lane >> 5;
        bf16_t* XB2 = (bf16_t*)(ws + WS_XN3); float* rstok = (float*)(ws + WS_RSTOK);
        const LAS bf16_t* whr = WH + (n < 20 ? n : 19) * 1032 + kh * 512 + 8 * hh; const LAS bf16_t* wmr = WM + (n < 20 ? n : 19) * 1032 + kh * 512 + 8 * hh;
        for (int tb = vcu; tb < M / 128; tb += G) {
            const int t0 = tb * 128; const size_t eoff = (size_t)(t0 + tg * 32 + n) * 1024 + kh * 512 + 8 * hh;
            f32x16_t acc = f32x16_t{}; float ssq = 0.f;
            for (int jb = 0; jb < 32; jb += 8) { u32x4 xv[8];
#pragma unroll
                for (int j = 0; j < 8; ++j) xv[j] = *(const u32x4*)(XB2 + eoff + 16 * (jb + j));
#pragma unroll
                for (int j = 0; j < 8; ++j) { const bf16x8_t wh = *(const LAS bf16x8_t*)(whr + 16 * (jb + j)), wm = *(const LAS bf16x8_t*)(wmr + 16 * (jb + j));
                    float xf[8]; unpack8(xv[j], xf);
                    ssq += ((xf[0] * xf[0] + xf[1] * xf[1]) + (xf[2] * xf[2] + xf[3] * xf[3])) + ((xf[4] * xf[4] + xf[5] * xf[5]) + (xf[6] * xf[6] + xf[7] * xf[7]));
                    const bf16x8_t xa = __builtin_bit_cast(bf16x8_t, xv[j]);
                    acc = __builtin_amdgcn_mfma_f32_32x32x16_bf16(xa, wh, acc, 0, 0, 0); acc = __builtin_amdgcn_mfma_f32_32x32x16_bf16(xa, wm, acc, 0, 0, 0); } }
#else
        LAS float* WT = (LAS float*)(lds + RING_OFF);
        LAS float* PART = WT + 20 * 1028;
        LAS float* SSQP = PART + 2 * 4 * 32 * 33;
        LAS int* te = (LAS int*)(SSQP + 2 * 4 * 2 * 32); LAS float* tw = (LAS float*)(te + 256); LAS int* tp = (LAS int*)(tw + 256); LAS int* ebase = tp + 256;
        for (int i = tid; i < 1024 * 4; i += 512) { const int kk = i >> 2, o = i & 3; WT[o * 1028 + kk] = P.in[19][i] * P.in[18][kk]; }
        for (int i = tid; i < 1024 * 16; i += 512) { const int kk = i >> 4, o = i & 15; WT[(4 + o) * 1028 + kk] = P.in[21][i] * P.in[18][kk]; }
        __syncthreads();
        const int tg = wave & 3, kh = wave >> 2, n = lane & 31, hh = lane >> 5;
        bf16_t* XB2 = (bf16_t*)(ws + WS_XN3); float* rstok = (float*)(ws + WS_RSTOK);
        const LAS float* wrow = WT + (n < 20 ? n : 19) * 1028 + kh * 512 + 4 * hh;
        for (int tb = vcu; tb < M / 128; tb += G) {
            const int t0 = tb * 128; const size_t eoff = (size_t)(t0 + tg * 32 + n) * 1024 + kh * 512 + 4 * hh;
            f32x16_t acc = f32x16_t{}; float ssq = 0.f;
            for (int jb = 0; jb < 64; jb += 8) { f32x4 xv[8];
#pragma unroll
                for (int j = 0; j < 8; ++j) {
                    if (X2_BF16) { const u32x2 q = *(const u32x2*)(XB2 + eoff + 8 * (jb + j)); xv[j] = (f32x4){__uint_as_float(q.x << 16), __uint_as_float(q.x & 0xffff0000u), __uint_as_float(q.y << 16), __uint_as_float(q.y & 0xffff0000u)}; }
                    else xv[j] = *(const f32x4*)(out + eoff + 8 * (jb + j)); }
#pragma unroll
                for (int j = 0; j < 8; ++j) { const f32x4 wv = *(const LAS f32x4*)(wrow + 8 * (jb + j)); const f32x4 x = xv[j];
                    ssq += (x[0] * x[0] + x[1] * x[1]) + (x[2] * x[2] + x[3] * x[3]);
                    acc = __builtin_amdgcn_mfma_f32_32x32x2f32(x[0], wv[0], acc, 0, 0, 0); acc = __builtin_amdgcn_mfma_f32_32x32x2f32(x[1], wv[1], acc, 0, 0, 0);
                    acc = __builtin_amdgcn_mfma_f32_32x32x2f32(x[2], wv[2], acc, 0, 0, 0); acc = __builtin_amdgcn_mfma_f32_32x32x2f32(x[3], wv[3], acc, 0, 0, 0);
                    if (!X2_BF16) { u32x2 w; w.x = pg8::cvt_pk_bf16(x[0], x[1]); w.y = pg8::cvt_pk_bf16(x[2], x[3]); *(u32x2*)(XB2 + eoff + 8 * (jb + j)) = w; } } }
#endif
#pragma unroll
            for (int r = 0; r < 16; ++r) PART[((kh * 4 + tg) * 32 + ((r & 3) + 8 * (r >> 2) + 4 * hh)) * 33 + n] = acc[r];
            SSQP[((kh * 4 + tg) * 2 + hh) * 32 + n] = ssq;
            __syncthreads();
            if (wave < 4 && lane < 32) { const int tl = wave * 32 + lane, t = t0 + tl;
                const float s = (SSQP[((0 * 4 + wave) * 2 + 0) * 32 + lane] + SSQP[((0 * 4 + wave) * 2 + 1) * 32 + lane]) + (SSQP[((1 * 4 + wave) * 2 + 0) * 32 + lane] + SSQP[((1 * 4 + wave) * 2 + 1) * 32 + lane]);
                const float rs = 1.0f / sqrtf(s * (1.f / 1024.f) + EPS);
                float lg[20];
#pragma unroll
                for (int nn = 0; nn < 20; ++nn) lg[nn] = (PART[((0 * 4 + wave) * 32 + lane) * 33 + nn] + PART[((1 * 4 + wave) * 32 + lane) * 33 + nn]) * rs;
                int e0, e1; float w0, w1; route_decide(lg, P.in[20], P.in[22], e0, e1, w0, w1);
                te[2 * tl] = e0; te[2 * tl + 1] = e1; tw[2 * tl] = w0; tw[2 * tl + 1] = w1; rstok[t] = rs; }
            __syncthreads();
            if (wave == 0) {
                int cnt = 0; int mye[4];
#pragma unroll
                for (int j = 0; j < 4; ++j) mye[j] = te[j * 64 + lane];
                int pos[4] = {0, 0, 0, 0};
                for (int e = 0; e < 16; ++e) { int run = 0;
#pragma unroll
                    for (int j = 0; j < 4; ++j) { const unsigned long long mk = __ballot(mye[j] == e); const int before = __popcll(mk & ((1ull << lane) - 1ull));
                        if (mye[j] == e) pos[j] = run + before; run += __popcll(mk); }
                    if (lane == e) cnt = run; }
#pragma unroll
                for (int j = 0; j < 4; ++j) tp[j * 64 + lane] = pos[j];
                if (lane < 16) { unsigned* ec = (unsigned*)(ws + WS_CTL) + CW_ECNT + 64 * lane; ebase[lane] = (int)atomicAdd(ec, (unsigned)cnt); }
            }
            __syncthreads();
            if (tid < 256) { const int e = te[tid], slot = ebase[e] + tp[tid], dest = (t0 * 2) + tid; const float w = tw[tid];
                int* lst = (int*)(ws + WS_LIST) + ((size_t)e * LIST_CAP + slot) * 2; lst[0] = dest; lst[1] = __float_as_int(w); }
            __syncthreads();
        }
    }
#else
    if (IN(9)) {
        LAS float* rw = (LAS float*)(lds + RING_OFF);
        LAS int* te = (LAS int*)(lds + RING_OFF + 20 * 1024 * 4); LAS float* tw = (LAS float*)(te + 256); LAS int* tp = (LAS int*)(tw + 256); LAS int* ebase = tp + 256;
        for (int i = tid; i < 1024 * 4; i += 512) { const int k = i >> 2, o = i & 3; rw[o * 1024 + k] = P.in[19][i]; }
        for (int i = tid; i < 1024 * 16; i += 512) { const int k = i >> 4, o = i & 15; rw[(4 + o) * 1024 + k] = P.in[21][i]; }
        __syncthreads();
        bf16_t* XN3 = (bf16_t*)(ws + WS_XN3);
        if (NREP(9) == 2) { for (int tb = vcu; tb < M / 128; tb += G) { const int t0 = tb * 128; Row4 rcur = row_load(out + (size_t)(t0 + wave * 16) * D, lane);
            for (int i = 0; i < 16; ++i) { const int tl = wave * 16 + i, t = t0 + tl; int e0, e1; float w0, w1; const Row4 rnxt = row_load(out + (size_t)(t + (i < 15 ? 1 : 0)) * D, lane);
                route_token(rcur, P.in[18], rw, P.in[20], P.in[22], XN3 + (size_t)t * D, lane, e0, e1, w0, w1); rcur = rnxt; if (lane == 0) { te[2 * tl] = e0; tw[2 * tl] = w0 + w1 + (float)e1; } } }
            if (fusedrun) xcd_barrier(bar); }
        for (int tb = vcu; tb < M / 128; tb += G) {
            const int t0 = tb * 128;
            Row4 rcur = row_load(out + (size_t)(t0 + wave * 16) * D, lane);
            for (int i = 0; i < 16; ++i) { const int tl = wave * 16 + i, t = t0 + tl; int e0, e1; float w0, w1;
                const Row4 rnxt = row_load(out + (size_t)(t + (i < 15 ? 1 : 0)) * D, lane);
                route_token(rcur, P.in[18], rw, P.in[20], P.in[22], XN3 + (size_t)t * D, lane, e0, e1, w0, w1); rcur = rnxt;
                if (lane == 0) { te[2 * tl] = e0; te[2 * tl + 1] = e1; tw[2 * tl] = w0; tw[2 * tl + 1] = w1; } }
            __syncthreads();
            if (wave == 0) {
                int cnt = 0; int mye[4];
#pragma unroll
                for (int j = 0; j < 4; ++j) mye[j] = te[j * 64 + lane];
                int pos[4] = {0, 0, 0, 0};
                for (int e = 0; e < 16; ++e) { int run = 0;
#pragma unroll
                    for (int j = 0; j < 4; ++j) { const unsigned long long mk = __ballot(mye[j] == e); const int before = __popcll(mk & ((1ull << lane) - 1ull));
                        if (mye[j] == e) pos[j] = run + before; run += __popcll(mk); }
                    if (lane == e) cnt = run; }
#pragma unroll
                for (int j = 0; j < 4; ++j) tp[j * 64 + lane] = pos[j];
                if (lane < 16) { unsigned* ec = (unsigned*)(ws + WS_CTL) + CW_ECNT + 64 * lane; ebase[lane] = (int)atomicAdd(ec, (unsigned)cnt); }
            }
            __syncthreads();
            if (tid < 256) { const int e = te[tid], slot = ebase[e] + tp[tid], dest = (t0 * 2) + tid; const float w = tw[tid];
                int* lst = (int*)(ws + WS_LIST) + ((size_t)e * LIST_CAP + slot) * 2; lst[0] = dest; lst[1] = __float_as_int(w);
                int* ti = (int*)(ws + WS_TOKINFO) + (size_t)dest * 2; ti[0] = e; ti[1] = __float_as_int(w); }
            __syncthreads();
        }
    }
#endif
    SEAM(9);
    if (IN(10)) {
        _Pragma("unroll") for (int rep_ = 0; rep_ < NREP(10); ++rep_) {
        moe_setup(lds, ws, vcu, G, true);
        SchedMoe S{(const LAS int*)(lds + UREC_OFF), (const LAS unsigned*)(lds + TBL_OFF), (const char*)(ws + WS_XN3), (const char*)(ws + WS_WGU), 0, (size_t)1024 * 1024 * 2, (size_t)256 * 1024 * 2, true};
        EpiMoeA E{(bf16_t*)(ws + WS_H), (const LAS float*)(lds + RSTBL_OFF)};
        pg8::gemm_phase<EpiMoeA, SchedMoe, ALIGN_E, true>(lds + RING_OFF, 1024, S, E, STAG_MA);
        if (TAIL_CONV && G == 256) {
            const LAS int* rec = (const LAS int*)(lds + UREC_OFF); int myu = 0;
            for (int i = 0; i < MOE_MAXU; ++i) myu += rec[i * 8];
            const int nu = rec[MOE_MAXU * 8], rem = nu % G, maxu = (nu + G - 1) / G;
            const bool idle = (rem == 0) || (myu < maxu); const int nidle = (rem == 0) ? G : G - rem, rank = (rem == 0) ? vcu : vcu - rem;
            if (idle) { int tid2 = threadIdx.x; asm volatile("" : "+v"(tid2)); const int lane2 = tid2 & 63, wave2 = __builtin_amdgcn_readfirstlane(tid2 >> 6);
                LAS float* scr = (LAS float*)(lds + RING_OFF + wave2 * 16384);
                for (int j = rank * NWAVES + wave2; j < NE * 256; j += nidle * NWAVES) p0_weight_item(P, ws, scr, IT_P0 + (j >> 8) * 768 + 512 + (j & 255), lane2); } }
            REPSEAM(10); }
    }
    SEAM(10);
    if (IN(11)) {
        _Pragma("unroll") for (int rep_ = 0; rep_ < NREP(11); ++rep_) {
        moe_setup(lds, ws, vcu, G, false);
        SchedMoe S{(const LAS int*)(lds + UREC_OFF), (const LAS unsigned*)(lds + TBL_OFF), (const char*)(ws + WS_H), (const char*)(ws + WS_WD), (size_t)256 * 512 * 2, (size_t)1024 * 512 * 2, (size_t)256 * 512 * 2, false};
        EpiMoeB E{(const LAS int*)(lds + UREC_OFF), (const int*)(ws + WS_LIST), (bf16_t*)(ws + WS_YS)};
        pg8::gemm_phase<EpiMoeB, SchedMoe, ALIGN_E, false>(lds + RING_OFF, 512, S, E, STAG_MB);
            REPSEAM(11); }
    }
    SEAM(11);
    if (IN(12)) {
        const bf16_t* ys = (const bf16_t*)(ws + WS_YS);
        if (NREP(12) == 2) { float* dead = (float*)(ws + WS_H);
            for (int m = gw; m < M; m += NGW) { RowF r = rowf_load(out + (size_t)m * D, ys + (size_t)m * 2048, lane); const f32x4* src = (const f32x4*)(out + (size_t)m * D) + lane; f32x4* dd = (f32x4*)(dead + (size_t)m * D) + lane;
                (void)src; rowf_store(r, dead + (size_t)m * D, P.in[26], lane); (void)dd; }
            if (fusedrun) xcd_barrier(bar); }
        if (X2_BF16) final_rows_b(out, (const bf16_t*)(ws + WS_XN3), ys, P.in[26], gw, NGW, M, lane); else final_rows(out, ys, P.in[26], gw, NGW, M, lane);
    }
#undef IN
#undef SEAM
}
#ifndef OPT_MASK
#define OPT_MASK 0x1FFF
#endif
#ifndef FUSED
#define FUSED 1
#endif
static void launch_mega(const Args& a0, int lo, int hi, int grid, hipStream_t stream) {
    Args a = a0; a.ph_lo = lo; a.ph_hi = hi;
    hipLaunchKernelGGL(mega, dim3(grid), dim3(NWAVES * 64), LDS_BYTES, stream, a);
    const hipError_t le = hipPeekAtLastError();
    if (le != hipSuccess) fprintf(stderr, "kernel_launch: launch [%d,%d) failed: %s\n", lo, hi, hipGetErrorName(le));
}
extern "C" void kernel_launch(void* const* d_in, const int* in_sizes, int n_in, void* d_out, int out_size, void* d_ws, size_t ws_size, hipStream_t stream) {
    static int grid = 0;
    if (grid == 0) {
        if (n_in != 27 || in_sizes[0] != M * D || out_size != M * D || ws_size < WS_END) { fprintf(stderr, "kernel_launch: unexpected problem (n_in %d, in0 %d, out %d, ws %zu)\n", n_in, n_in > 0 ? in_sizes[0] : -1, out_size, ws_size); grid = -1; return; }
        (void)hipFuncSetAttribute((const void*)k_route, hipFuncAttributeMaxDynamicSharedMemorySize, 20 * 1024 * 4 + 4096);
        (void)hipFuncSetAttribute((const void*)nv_sgu, hipFuncAttributeMaxDynamicSharedMemorySize, 128 * 129 * 4 + 1024);
        (void)hipFuncSetAttribute((const void*)nv_attn, hipFuncAttributeMaxDynamicSharedMemorySize, 4 * 64 * 65 * 4);
        (void)hipFuncSetAttribute((const void*)k_prologue, hipFuncAttributeMaxDynamicSharedMemorySize, 8 * 64 * 33 * 4);
        if (hipFuncSetAttribute((const void*)mega, hipFuncAttributeMaxDynamicSharedMemorySize, LDS_BYTES) != hipSuccess) { fprintf(stderr, "kernel_launch: hipFuncSetAttribute(mega) failed\n"); grid = -1; return; }
        int dev = 0, cus = 0, per_cu = 0;
        if (hipGetDevice(&dev) != hipSuccess || hipDeviceGetAttribute(&cus, hipDeviceAttributeMultiprocessorCount, dev) != hipSuccess) { grid = -1; return; }
        if (hipOccupancyMaxActiveBlocksPerMultiprocessor(&per_cu, (const void*)mega, NWAVES * 64, LDS_BYTES) != hipSuccess || per_cu < 1) fprintf(stderr, "kernel_launch: occupancy query says %d blocks per CU\n", per_cu);
        (void)hipGetLastError();
        grid = cus;
    }
    if (grid < 0) return;
    unsigned char* ws = (unsigned char*)d_ws; float* out = (float*)d_out;
    Args a{}; for (int i = 0; i < 27; ++i) a.P.in[i] = (const float*)d_in[i];
    a.out = out; a.ws = ws; a.ph_lo = 0; a.ph_hi = NPHASE;
    const PtrsIn& P = a.P;
    (void)hipMemsetAsync(ws + WS_CTL, 0, CTL_ZERO_BYTES, stream);
#if FUSED
    launch_mega(a, 0, NPHASE, grid, stream);
#else
    float* scr = (float*)(ws + WS_SCR);
    bf16_t* XN = (bf16_t*)(ws + WS_XN);
    for (int ph = 0; ph < NPHASE; ++ph) {
        if ((OPT_MASK >> ph) & 1) { launch_mega(a, ph, ph + 1, grid, stream); continue; }
        switch (ph) {
        case 0: hipLaunchKernelGGL(k_prologue, dim3(256), dim3(512), 8 * 64 * 33 * 4, stream, P, ws); break;
        case 1:
            for (int c = 0; c < M / 4096; ++c) {
                hipLaunchKernelGGL(nv_gemm, dim3(NZ / 64, 4096 / 64), dim3(256), 0, stream, XN + (size_t)c * 4096 * D, D, (const bf16_t*)(ws + WS_WZ), D, D, scr, NZ);
                hipLaunchKernelGGL(nv_z_epi, dim3(4096), dim3(256), 0, stream, (const float*)scr, c * 4096, P, ws); }
            hipLaunchKernelGGL(nv_gemm, dim3(1024 / 64, MMEM / 64), dim3(256), 0, stream, XN + (size_t)M * D, D, (const bf16_t*)(ws + WS_WZ) + (size_t)NZ * D, D, D, scr, 1024);
            hipLaunchKernelGGL(nv_store_bf16, dim3(1024), dim3(256), 0, stream, (const float*)scr, (bf16_t*)(ws + WS_KVC), (size_t)MMEM * 1024, 1.0f);
            break;
        case 2:
            hipLaunchKernelGGL(nv_attn, dim3(SEQ / 64, 8, BATCH), dim3(256), 4 * 64 * 65 * 4, stream, (const bf16_t*)(ws + WS_Q), (const bf16_t*)(ws + WS_K), (const bf16_t*)(ws + WS_V), (bf16_t*)(ws + WS_ATT));
            hipLaunchKernelGGL(nv_sgu, dim3(M / 128, 4), dim3(256), 128 * 129 * 4 + 1024, stream, P, ws);
            break;
        case 3:
            for (int c = 0; c < M / 4096; ++c) { float* c1 = scr; float* c2 = scr + (size_t)4096 * 1024;
                hipLaunchKernelGGL(nv_gemm, dim3(1024 / 64, 64), dim3(256), 0, stream, (const bf16_t*)(ws + WS_ATT) + (size_t)c * 4096 * 512, 512, (const bf16_t*)(ws + WS_WATT), 512, 512, c1, 1024);
                hipLaunchKernelGGL(nv_gemm, dim3(1024 / 64, 64), dim3(256), 0, stream, (const bf16_t*)(ws + WS_SG) + (size_t)c * 4096 * 512, 512, (const bf16_t*)(ws + WS_WSGU), 512, 512, c2, 1024);
                hipLaunchKernelGGL(nv_merge, dim3(2048), dim3(256), 0, stream, (const float*)c1, (const float*)c2, (const bf16_t*)(ws + WS_GA) + (size_t)c * 4096 * 1024, (const bf16_t*)(ws + WS_GB) + (size_t)c * 4096 * 1024,
                                   (bf16_t*)(ws + WS_MERGED) + (size_t)c * 4096 * 1024, (size_t)4096 * 1024); }
            break;
        case 4:
            for (int c = 0; c < M / 4096; ++c) {
                hipLaunchKernelGGL(nv_gemm, dim3(1024 / 64, 64), dim3(256), 0, stream, (const bf16_t*)(ws + WS_MERGED) + (size_t)c * 4096 * 1024, 1024, (const bf16_t*)(ws + WS_WOUT), 1024, 1024, scr, 1024);
                hipLaunchKernelGGL(nv_resid, dim3(2048), dim3(256), 0, stream, P.in[0] + (size_t)c * 4096 * 1024, (const float*)scr, out + (size_t)c * 4096 * 1024, (size_t)4096 * 1024); }
            break;
        case 5: hipLaunchKernelGGL(k_norm_rows, dim3(256), dim3(512), 0, stream, (const float*)out, P.in[13], (bf16_t*)(ws + WS_XN1), M); break;
        case 6:
            for (int c = 0; c < M / 4096; ++c) {
                hipLaunchKernelGGL(nv_gemm, dim3(512 / 64, 64), dim3(256), 0, stream, (const bf16_t*)(ws + WS_XN1) + (size_t)c * 4096 * 1024, 1024, (const bf16_t*)(ws + WS_WCQ), 1024, 1024, scr, 512);
                hipLaunchKernelGGL(nv_store_bf16, dim3(1024), dim3(256), 0, stream, (const float*)scr, (bf16_t*)(ws + WS_QC) + (size_t)c * 4096 * 512, (size_t)4096 * 512, C2_CROSS); }
            break;
        case 7: hipLaunchKernelGGL(nv_cross, dim3(M), dim3(256), 0, stream, (const bf16_t*)(ws + WS_QC), (const bf16_t*)(ws + WS_KVC), (bf16_t*)(ws + WS_OC)); break;
        case 8:
            for (int c = 0; c < M / 4096; ++c) {
                hipLaunchKernelGGL(nv_gemm, dim3(1024 / 64, 64), dim3(256), 0, stream, (const bf16_t*)(ws + WS_OC) + (size_t)c * 4096 * 512, 512, (const bf16_t*)(ws + WS_WCO), 512, 512, scr, 1024);
                hipLaunchKernelGGL(nv_resid, dim3(2048), dim3(256), 0, stream, (const float*)(out + (size_t)c * 4096 * 1024), (const float*)scr, out + (size_t)c * 4096 * 1024, (size_t)4096 * 1024); }
            break;
        case 9: hipLaunchKernelGGL(k_route, dim3(256), dim3(512), 20 * 1024 * 4 + 4096, stream, P, (const float*)out, ws); break;
        case 10: hipLaunchKernelGGL(nv_moe_a, dim3(2 * M), dim3(256), 0, stream, (const bf16_t*)(ws + WS_XN3), ws); break;
        case 11: hipLaunchKernelGGL(nv_moe_b, dim3(2 * M), dim3(256), 0, stream, ws); break;
        case 12: hipLaunchKernelGGL(k_final, dim3(256), dim3(512), 0, stream, out, (const bf16_t*)(ws + WS_YS), P.in[26]); break;
        }
    }
#endif
}
```

```cpp
#include <hip/hip_runtime.h>
#include <cstdio>
#include <cstdint>
#include <cmath>

#ifndef FOLD_GAINS
#define FOLD_GAINS 1
#endif
#ifndef ATT_FIXM
#define ATT_FIXM 1
#endif
#ifndef X0_BF16
#define X0_BF16 1
#endif
#ifndef NT_LOADS
#define NT_LOADS 1
#endif
#ifndef NT_P0
#define NT_P0 1
#endif
#ifndef NT_P12X
#define NT_P12X 1
#endif
#ifndef NT_P12Y
#define NT_P12Y 1
#endif
#ifndef P0_REVERSE
#define P0_REVERSE 0
#endif
#ifndef NT2
#define NT2 0
#endif
#ifndef NT2W
#define NT2W 0
#endif
#ifndef NT2S
#define NT2S 0
#endif
#ifndef FINAL_NT
#define FINAL_NT 0
#endif
#ifndef GATE_U8
#define GATE_U8 1
#endif
#ifndef MERGE_QC_CROSS
#define MERGE_QC_CROSS 1
#endif
#ifndef TAIL_CONV
#define TAIL_CONV 1
#endif
#ifndef ROUTE_MFMA
#define ROUTE_MFMA 1
#endif
#ifndef FOLD_MOE
#define FOLD_MOE ROUTE_MFMA
#endif
#ifndef X2_BF16
#define X2_BF16 1
#endif
#ifndef MOE_CONV_IN_P2
#define MOE_CONV_IN_P2 0
#endif
typedef unsigned short bf16_t;
typedef float f32x4 __attribute__((ext_vector_type(4)));
typedef unsigned u32x4 __attribute__((ext_vector_type(4)));
typedef unsigned u32x2 __attribute__((ext_vector_type(2)));

constexpr int BATCH = 4, SEQ = 8192, D = 1024, M = BATCH * SEQ;
constexpr int NMEM = 256, MMEM = BATCH * NMEM;
constexpr int NZ = 3840;
constexpr int ZQ = 0, ZK = 512, ZV = 640, ZSU = 768, ZSV = 1280, ZGA = 1792, ZGB = 2816;
constexpr int NE = 16, DE = 512;
constexpr float EPS = 1e-6f;
constexpr float LOG2E = 1.4426950408889634f;
constexpr float C2_SELF = 0.125f * LOG2E;
constexpr float C2_CROSS = 0.08838834764831845f * LOG2E;
constexpr int LIST_CAP = 32768;

constexpr size_t MiB = 1u << 20;
constexpr size_t WS_CTL = 0, CTL_ZERO_BYTES = 64 * 1024;
constexpr size_t WS_TAB = 512 * 1024;
constexpr size_t WS_WZ = 1 * MiB;
constexpr size_t WS_WATT = 11 * MiB, WS_WSGU = 12 * MiB, WS_WOUT = 13 * MiB, WS_WCQ = 15 * MiB, WS_WCO = 16 * MiB, WS_WSS = 17 * MiB;
constexpr size_t WS_WGU = 18 * MiB;
constexpr size_t WS_WD = 50 * MiB;
constexpr size_t WS_XN = 68 * MiB;
constexpr size_t WS_MERGED = 248 * MiB;
constexpr size_t WS_GSCR = 312 * MiB;
constexpr size_t WS_XN3 = 68 * MiB;
constexpr size_t WS_KVC = 134 * MiB;
constexpr size_t WS_Q = 136 * MiB, WS_K = 168 * MiB, WS_V = 176 * MiB, WS_U = 184 * MiB, WS_GV = 216 * MiB, WS_GA = 248 * MiB, WS_GB = 312 * MiB;
constexpr size_t WS_ATT = 376 * MiB, WS_SG = 408 * MiB;
constexpr size_t WS_XN1 = 136 * MiB;
constexpr size_t WS_SSQ1 = 132 * MiB;
constexpr size_t WS_QC = 376 * MiB, WS_OC = 408 * MiB;
constexpr size_t WS_LIST = 200 * MiB;
constexpr size_t WS_RS0 = 66 * MiB;
constexpr size_t WS_RSTOK = 205 * MiB;
constexpr size_t WS_TOKINFO = 204 * MiB;
constexpr size_t WS_YS = 208 * MiB;
constexpr size_t WS_H = 336 * MiB;
constexpr size_t WS_SCR = 440 * MiB;
constexpr size_t WS_END = 504 * MiB;
constexpr int CW_TMO = 0, CW_BAR = 4096, CW_ECNT = 8192;

__host__ __device__ __forceinline__ float bf2f(bf16_t b) { union { unsigned u; float f; } c; c.u = ((unsigned)b) << 16; return c.f; }
__host__ __device__ __forceinline__ unsigned f2bf(float f) { union { unsigned u; float f; } c; c.f = f; unsigned u = c.u; return (u + 0x7fffu + ((u >> 16) & 1u)) >> 16; }
__device__ __forceinline__ unsigned pk2(float lo, float hi) { return f2bf(lo) | (f2bf(hi) << 16); }
__device__ __forceinline__ float wave_sum(float v) {
#pragma unroll
    for (int o = 1; o < 64; o <<= 1) v += __shfl_xor(v, o);
    return v;
}
__device__ __forceinline__ float wave_max(float v) {
#pragma unroll
    for (int o = 1; o < 64; o <<= 1) v = fmaxf(v, __shfl_xor(v, o));
    return v;
}
__device__ __forceinline__ float gelu_tanh(float x) { const float u = 0.7978845608028654f * (x + 0.044715f * x * x * x); return x / (1.0f + __builtin_amdgcn_exp2f(-2.0f * LOG2E * u)); }
__device__ __forceinline__ float sigmoidf_(float x) { return 1.0f / (1.0f + __builtin_amdgcn_exp2f(-LOG2E * x)); }

__host__ __device__ __forceinline__ int z_phys(int c) {
    if (c < 512) { const int h = c >> 6, d = c & 63; return (h >> 2) * 256 + (d >> 5) * 128 + (h & 3) * 32 + (d & 31); }
    if (c < 768) { const int cc = c - 512, w = cc >> 6, d = cc & 63; return 512 + (d >> 5) * 128 + w * 32 + (d & 31); }
    return c;
}

#define LAS __attribute__((address_space(3)))
__device__ __forceinline__ void p0_transpose_item(const float* W, int K, int N, bf16_t* WT, int mode, int row_off, LAS float* scr, int item, int lane, const float* gk = nullptr) {
    const int nblk = N / 32, kb = item / nblk, nb = item % nblk, k0 = 64 * kb, n0 = 32 * nb;
    float tv[32];
#pragma unroll
    for (int i = 0; i < 32; ++i) tv[i] = (NT2 || NT2W) ? __builtin_nontemporal_load(&W[(size_t)(k0 + 2 * i + (lane >> 5)) * N + n0 + (lane & 31)]) : W[(size_t)(k0 + 2 * i + (lane >> 5)) * N + n0 + (lane & 31)];
    if (gk) {
#pragma unroll
        for (int i = 0; i < 32; ++i) tv[i] *= gk[k0 + 2 * i + (lane >> 5)]; }
#pragma unroll
    for (int i = 0; i < 32; ++i) scr[(2 * i + (lane >> 5)) * 33 + (lane & 31)] = tv[i];
    __builtin_amdgcn_s_waitcnt(0xC07F); asm volatile("" ::: "memory");
    const int c = lane & 7;
#pragma unroll
    for (int j = 0; j < 4; ++j) { const int n = (lane >> 3) + 8 * j; const LAS float* s = scr + (8 * c) * 33 + n;
        u32x4 o; o.x = pk2(s[0 * 33], s[1 * 33]); o.y = pk2(s[2 * 33], s[3 * 33]); o.z = pk2(s[4 * 33], s[5 * 33]); o.w = pk2(s[6 * 33], s[7 * 33]);
        const int nl = n0 + n; int row;
        if (mode == 0) row = row_off + nl; else if (mode == 1) row = z_phys(nl); else if (mode == 2) row = 256 * (nl >> 7) + (nl & 127); else row = 256 * (nl >> 7) + 128 + (nl & 127);
        *(u32x4*)(WT + (size_t)row * K + k0 + 8 * c) = o; }
    __builtin_amdgcn_s_waitcnt(0xC07F); asm volatile("" ::: "memory");
}
struct PtrsIn { const float* in[27]; };
constexpr int IT_WIN = 16 * 120, IT_CKV = 16 * 32, IT_ATT = 8 * 32, IT_SGU = 8 * 32, IT_OUT = 16 * 32, IT_CQ = 16 * 16, IT_CO = 8 * 32, IT_G = 16 * 16, IT_DN = 8 * 32;
constexpr int IT_P0 = IT_WIN + IT_CKV + IT_ATT + IT_SGU + IT_OUT + IT_CQ + IT_CO;
constexpr int IT_TOTAL = IT_P0 + NE * (2 * IT_G + IT_DN);
__device__ __forceinline__ void p0_weight_item(const PtrsIn& P, unsigned char* ws, LAS float* scr, int it, int lane) {
    int r = it;
    bf16_t* WZ = (bf16_t*)(ws + WS_WZ);
    if (r < IT_WIN) { p0_transpose_item(P.in[3], 1024, NZ, WZ, 1, 0, scr, r, lane, X0_BF16 ? P.in[2] : nullptr); return; } r -= IT_WIN;
    if (r < IT_CKV) { p0_transpose_item(P.in[16], 1024, 1024, WZ, 0, NZ, scr, r, lane); return; } r -= IT_CKV;
    if (r < IT_ATT) { p0_transpose_item(P.in[6], 512, 1024, (bf16_t*)(ws + WS_WATT), 0, 0, scr, r, lane); return; } r -= IT_ATT;
    if (r < IT_SGU) { p0_transpose_item(P.in[11], 512, 1024, (bf16_t*)(ws + WS_WSGU), 0, 0, scr, r, lane); return; } r -= IT_SGU;
    if (r < IT_OUT) { p0_transpose_item(P.in[12], 1024, 1024, (bf16_t*)(ws + WS_WOUT), 0, 0, scr, r, lane); return; } r -= IT_OUT;
    if (r < IT_CQ) { p0_transpose_item(P.in[15], 1024, 512, (bf16_t*)(ws + WS_WCQ), 0, 0, scr, r, lane, FOLD_GAINS ? P.in[13] : nullptr); return; } r -= IT_CQ;
    if (r < IT_CO) { p0_transpose_item(P.in[17], 512, 1024, (bf16_t*)(ws + WS_WCO), 0, 0, scr, r, lane); return; } r -= IT_CO;
    const int per = 2 * IT_G + IT_DN, e = r / per; r -= e * per;
    if (r < IT_G) { p0_transpose_item(P.in[23] + (size_t)e * 1024 * 512, 1024, 512, (bf16_t*)(ws + WS_WGU) + (size_t)e * 1024 * 1024, 2, 0, scr, r, lane, FOLD_MOE ? P.in[18] : nullptr); return; } r -= IT_G;
    if (r < IT_G) { p0_transpose_item(P.in[24] + (size_t)e * 1024 * 512, 1024, 512, (bf16_t*)(ws + WS_WGU) + (size_t)e * 1024 * 1024, 3, 0, scr, r, lane, FOLD_MOE ? P.in[18] : nullptr); return; } r -= IT_G;
    p0_transpose_item(P.in[25] + (size_t)e * 512 * 1024, 512, 1024, (bf16_t*)(ws + WS_WD) + (size_t)e * 1024 * 512, 0, 0, scr, r, lane);
}
struct Row4 { f32x4 v[4]; };
__device__ __forceinline__ Row4 row_load(const float* xrow, int lane) { Row4 r; const f32x4* xr = (const f32x4*)xrow + lane;
#pragma unroll
    for (int j = 0; j < 4; ++j) r.v[j] = (NT_LOADS && NT_P0) ? __builtin_nontemporal_load(&xr[64 * j]) : xr[64 * j];
    return r; }
__device__ __forceinline__ void rms_row_store(const Row4& r, const float* g, bf16_t* orow, int lane) {
    const f32x4* gr = (const f32x4*)g + lane; float s = 0.f;
#pragma unroll
    for (int j = 0; j < 4; ++j) s += (r.v[j].x * r.v[j].x + r.v[j].y * r.v[j].y) + (r.v[j].z * r.v[j].z + r.v[j].w * r.v[j].w);
    const float rs = 1.0f / sqrtf(wave_sum(s) * (1.f / 1024.f) + EPS);
    unsigned long long* o8 = (unsigned long long*)orow + lane;
#pragma unroll
    for (int j = 0; j < 4; ++j) { const f32x4 gg = gr[64 * j]; o8[64 * j] = (unsigned long long)pk2(r.v[j].x * rs * gg.x, r.v[j].y * rs * gg.y) | ((unsigned long long)pk2(r.v[j].z * rs * gg.z, r.v[j].w * rs * gg.w) << 32); }
}
__device__ __forceinline__ void xb0_row_store(const Row4& r, bf16_t* orow, float* rs_out, int lane) {
    float s = 0.f;
#pragma unroll
    for (int j = 0; j < 4; ++j) s += (r.v[j].x * r.v[j].x + r.v[j].y * r.v[j].y) + (r.v[j].z * r.v[j].z + r.v[j].w * r.v[j].w);
    const float rs = 1.0f / sqrtf(wave_sum(s) * (1.f / 1024.f) + EPS);
    unsigned long long* o8 = (unsigned long long*)orow + lane;
#pragma unroll
    for (int j = 0; j < 4; ++j) o8[64 * j] = (unsigned long long)pk2(r.v[j].x, r.v[j].y) | ((unsigned long long)pk2(r.v[j].z, r.v[j].w) << 32);
    if (lane == 0) *rs_out = rs;
}
__device__ __forceinline__ void xb0_rows(const float* x, bf16_t* o, float* rs0, int first, int step, int rows, int lane) {
    if (first >= rows) return;
    const int last = first + ((rows - 1 - first) / step) * step;
#if P0_REVERSE
    Row4 r0 = row_load(x + (size_t)last * D, lane);
    Row4 r1 = row_load(x + (size_t)((last - step >= first) ? last - step : first) * D, lane);
    for (int m = last; m >= first; m -= step) { const int m2 = (m - 2 * step >= first) ? m - 2 * step : first;
        const Row4 r2 = row_load(x + (size_t)m2 * D, lane);
        xb0_row_store(r0, o + (size_t)m * D, rs0 + m, lane); r0 = r1; r1 = r2; }
#else
    Row4 r0 = row_load(x + (size_t)first * D, lane);
    Row4 r1 = row_load(x + (size_t)((first + step <= last) ? first + step : last) * D, lane);
    for (int m = first; m < rows; m += step) { const int m2 = (m + 2 * step <= last) ? m + 2 * step : last;
        const Row4 r2 = row_load(x + (size_t)m2 * D, lane);
        xb0_row_store(r0, o + (size_t)m * D, rs0 + m, lane); r0 = r1; r1 = r2; }
#endif
}
__device__ __forceinline__ void rms_rows(const float* x, const float* g, bf16_t* o, int first, int step, int rows, int lane) {
    if (first >= rows) return;
    const int last = first + ((rows - 1 - first) / step) * step;
    Row4 r0 = row_load(x + (size_t)first * D, lane);
    Row4 r1 = row_load(x + (size_t)((first + step <= last) ? first + step : last) * D, lane);
    for (int m = first; m < rows; m += step) { const int m2 = (m + 2 * step <= last) ? m + 2 * step : last;
        const Row4 r2 = row_load(x + (size_t)m2 * D, lane);
        rms_row_store(r0, g, o + (size_t)m * D, lane); r0 = r1; r1 = r2; }
}
__device__ __forceinline__ void rms_row_to_bf16(const float* xrow, const float* g, bf16_t* orow, int lane) {
    const f32x4* xr = (const f32x4*)xrow + lane; const f32x4* gr = (const f32x4*)g + lane;
    f32x4 v[4]; float s = 0.f;
#pragma unroll
    for (int j = 0; j < 4; ++j) { v[j] = xr[64 * j]; s += (v[j].x * v[j].x + v[j].y * v[j].y) + (v[j].z * v[j].z + v[j].w * v[j].w); }
    const float rs = 1.0f / sqrtf(wave_sum(s) * (1.f / 1024.f) + EPS);
    unsigned long long* o8 = (unsigned long long*)orow + lane;
#pragma unroll
    for (int j = 0; j < 4; ++j) { const f32x4 gg = gr[64 * j]; o8[64 * j] = (unsigned long long)pk2(v[j].x * rs * gg.x, v[j].y * rs * gg.y) | ((unsigned long long)pk2(v[j].z * rs * gg.z, v[j].w * rs * gg.w) << 32); }
}
__device__ __forceinline__ void rope_table_entry(float* tab, int idx) {
    const int pos = idx >> 4, i = idx & 15;
    const float inv = exp2f(-(float)i * (13.287712379549449f / 16.0f));
    const float ang = (float)pos * inv;
    float s, c; sincosf(ang, &s, &c);
    tab[0 * 2048 + idx] = c; tab[1 * 2048 + idx] = s; tab[2 * 2048 + idx] = c; tab[3 * 2048 + idx] = s;
}

__device__ __forceinline__ void route_decide(const float (&lg)[20], const float* b_rg, const float* b_re, int& e0, int& e1, float& w0, float& w1) {
    float g0 = lg[0] + b_rg[0], g1 = lg[1] + b_rg[1], g2 = lg[2] + b_rg[2], g3 = lg[3] + b_rg[3];
    int gi = 0; float gm = g0; if (g1 > gm) { gm = g1; gi = 1; } if (g2 > gm) { gm = g2; gi = 2; } if (g3 > gm) { gm = g3; gi = 3; }
    const float gval = 1.0f / (expf(g0 - gm) + expf(g1 - gm) + expf(g2 - gm) + expf(g3 - gm));
    float ev[4];
#pragma unroll
    for (int j = 0; j < 4; ++j) { float t = 0.f;
#pragma unroll
        for (int g = 0; g < 4; ++g) t = (gi == g) ? (lg[4 + 4 * g + j] + b_re[4 * g + j]) : t;
        ev[j] = t; }
    int i0 = 0; float m0 = ev[0];
#pragma unroll
    for (int j = 1; j < 4; ++j) if (ev[j] > m0) { m0 = ev[j]; i0 = j; }
    int i1 = -1; float m1 = -INFINITY;
#pragma unroll
    for (int j = 0; j < 4; ++j) if (j != i0 && ev[j] > m1) { m1 = ev[j]; i1 = j; }
    const float p1 = expf(m1 - m0), den = 1.0f / (1.0f + p1);
    e0 = gi * 4 + i0; e1 = gi * 4 + i1; w0 = den * gval; w1 = p1 * den * gval;
}
template <class RW> __device__ __forceinline__ void route_token(const Row4& xin, const float* gmoe, RW rw, const float* b_rg, const float* b_re, bf16_t* orow, int lane, int& e0, int& e1, float& w0, float& w1) {
    const f32x4* gr = (const f32x4*)gmoe + lane;
    f32x4 v[4]; float s = 0.f;
#pragma unroll
    for (int j = 0; j < 4; ++j) { v[j] = xin.v[j]; s += (v[j].x * v[j].x + v[j].y * v[j].y) + (v[j].z * v[j].z + v[j].w * v[j].w); }
    const float rs = 1.0f / sqrtf(wave_sum(s) * (1.f / 1024.f) + EPS);
    unsigned long long* o8 = (unsigned long long*)orow + lane;
#pragma unroll
    for (int j = 0; j < 4; ++j) { const f32x4 gg = gr[64 * j]; v[j].x *= rs * gg.x; v[j].y *= rs * gg.y; v[j].z *= rs * gg.z; v[j].w *= rs * gg.w;
        o8[64 * j] = (unsigned long long)pk2(v[j].x, v[j].y) | ((unsigned long long)pk2(v[j].z, v[j].w) << 32); }
    float lg[20];
#pragma unroll
    for (int o = 0; o < 20; ++o) { auto wr = rw + o * 1024 + 4 * lane; float a = 0.f;
#pragma unroll
        for (int j = 0; j < 4; ++j) { const float w0_ = wr[256 * j], w1_ = wr[256 * j + 1], w2_ = wr[256 * j + 2], w3_ = wr[256 * j + 3]; a += (v[j].x * w0_ + v[j].y * w1_) + (v[j].z * w2_ + v[j].w * w3_); }
        lg[o] = wave_sum(a); }
    route_decide(lg, b_rg, b_re, e0, e1, w0, w1);
}
__device__ __forceinline__ void final_row(float* orow, const bf16_t* ys2, const float* g, int lane) {
    f32x4* xr = (f32x4*)orow + lane; const f32x4* gr = (const f32x4*)g + lane;
    const u32x2* y0 = (const u32x2*)ys2 + lane; const u32x2* y1 = (const u32x2*)(ys2 + 1024) + lane;
    f32x4 v[4]; float s = 0.f;
#pragma unroll
    for (int j = 0; j < 4; ++j) { v[j] = xr[64 * j]; const u32x2 a = y0[64 * j], b = y1[64 * j];
        v[j].x += bf2f((bf16_t)(a.x & 0xffff)) + bf2f((bf16_t)(b.x & 0xffff)); v[j].y += bf2f((bf16_t)(a.x >> 16)) + bf2f((bf16_t)(b.x >> 16));
        v[j].z += bf2f((bf16_t)(a.y & 0xffff)) + bf2f((bf16_t)(b.y & 0xffff)); v[j].w += bf2f((bf16_t)(a.y >> 16)) + bf2f((bf16_t)(b.y >> 16));
        s += (v[j].x * v[j].x + v[j].y * v[j].y) + (v[j].z * v[j].z + v[j].w * v[j].w); }
    const float rs = 1.0f / sqrtf(wave_sum(s) * (1.f / 1024.f) + EPS);
#pragma unroll
    for (int j = 0; j < 4; ++j) { const f32x4 gg = gr[64 * j]; f32x4 o; o.x = v[j].x * rs * gg.x; o.y = v[j].y * rs * gg.y; o.z = v[j].z * rs * gg.z; o.w = v[j].w * rs * gg.w; xr[64 * j] = o; }
}

struct RowF { f32x4 v[4]; u32x2 a[4], b[4]; };
__device__ __forceinline__ RowF rowf_load(const float* orow, const bf16_t* ys2, int lane) { RowF r; const f32x4* xr = (const f32x4*)orow + lane; const u32x2* y0 = (const u32x2*)ys2 + lane; const u32x2* y1 = (const u32x2*)(ys2 + 1024) + lane;
#pragma unroll
    for (int j = 0; j < 4; ++j) { r.v[j] = xr[64 * j]; r.a[j] = y0[64 * j]; r.b[j] = y1[64 * j]; }
    return r; }
__device__ __forceinline__ void rowf_store(const RowF& r, float* orow, const float* g, int lane) {
    f32x4* xr = (f32x4*)orow + lane; const f32x4* gr = (const f32x4*)g + lane; f32x4 v[4]; float s = 0.f;
#pragma unroll
    for (int j = 0; j < 4; ++j) { v[j] = r.v[j]; const u32x2 a = r.a[j], b = r.b[j];
        v[j].x += __uint_as_float(a.x << 16) + __uint_as_float(b.x << 16); v[j].y += __uint_as_float(a.x & 0xffff0000u) + __uint_as_float(b.x & 0xffff0000u);
        v[j].z += __uint_as_float(a.y << 16) + __uint_as_float(b.y << 16); v[j].w += __uint_as_float(a.y & 0xffff0000u) + __uint_as_float(b.y & 0xffff0000u);
        s += (v[j].x * v[j].x + v[j].y * v[j].y) + (v[j].z * v[j].z + v[j].w * v[j].w); }
    const float rs = 1.0f / sqrtf(wave_sum(s) * (1.f / 1024.f) + EPS);
#pragma unroll
    for (int j = 0; j < 4; ++j) { const f32x4 gg = gr[64 * j]; f32x4 o; o.x = v[j].x * rs * gg.x; o.y = v[j].y * rs * gg.y; o.z = v[j].z * rs * gg.z; o.w = v[j].w * rs * gg.w;
#if FINAL_NT
        __builtin_nontemporal_store(o, &xr[64 * j]);
#else
        xr[64 * j] = o;
#endif
    }
}
__device__ __forceinline__ RowF rowf_load_b(const bf16_t* xb, const bf16_t* ys2, int lane) { RowF r; const u32x2* xr = (const u32x2*)xb + lane; const u32x2* y0 = (const u32x2*)ys2 + lane; const u32x2* y1 = (const u32x2*)(ys2 + 1024) + lane;
#pragma unroll
    for (int j = 0; j < 4; ++j) { const u32x2 q = (NT_LOADS && NT_P12X) ? __builtin_nontemporal_load(&xr[64 * j]) : xr[64 * j]; r.v[j] = (f32x4){__uint_as_float(q.x << 16), __uint_as_float(q.x & 0xffff0000u), __uint_as_float(q.y << 16), __uint_as_float(q.y & 0xffff0000u)};
        r.a[j] = (NT_LOADS && NT_P12Y) ? __builtin_nontemporal_load(&y0[64 * j]) : y0[64 * j]; r.b[j] = (NT_LOADS && NT_P12Y) ? __builtin_nontemporal_load(&y1[64 * j]) : y1[64 * j]; }
    return r; }
__device__ __forceinline__ void final_rows_b(float* out, const bf16_t* xb, const bf16_t* ys, const float* g, int first, int step, int rows, int lane) {
    if (first >= rows) return;
    RowF cur = rowf_load_b(xb + (size_t)first * D, ys + (size_t)first * 2048, lane);
    for (int m = first; m < rows; m += step) { const int mn = (m + step < rows) ? m + step : m;
        const RowF nxt = rowf_load_b(xb + (size_t)mn * D, ys + (size_t)mn * 2048, lane);
        rowf_store(cur, out + (size_t)m * D, g, lane); cur = nxt; }
}
__device__ __forceinline__ void final_rows(float* out, const bf16_t* ys, const float* g, int first, int step, int rows, int lane) {
    if (first >= rows) return;
    RowF cur = rowf_load(out + (size_t)first * D, ys + (size_t)first * 2048, lane);
    for (int m = first; m < rows; m += step) { const int mn = (m + step < rows) ? m + step : m;
        const RowF nxt = rowf_load(out + (size_t)mn * D, ys + (size_t)mn * 2048, lane);
        rowf_store(cur, out + (size_t)m * D, g, lane); cur = nxt; }
}

__global__ void __launch_bounds__(512) k_prologue(PtrsIn P, unsigned char* ws) {
    extern __shared__ __attribute__((aligned(16))) unsigned char dyn[];
    const int tid = threadIdx.x, lane = tid & 63, wave = tid >> 6;
    const int gw = blockIdx.x * 8 + wave, NGW = gridDim.x * 8;
    LAS float* scr = (LAS float*)dyn + wave * 64 * 33;
    for (int it = gw; it < IT_TOTAL; it += NGW) p0_weight_item(P, ws, scr, it, lane);
    { const float* wsrc = P.in[9]; bf16_t* wd = (bf16_t*)(ws + WS_WSS);
      for (int i = blockIdx.x * 512 + tid; i < 4 * 128 * 128; i += gridDim.x * 512) wd[i] = (bf16_t)f2bf(wsrc[i]); }
    for (int i = blockIdx.x * 512 + tid; i < 2048; i += gridDim.x * 512) rope_table_entry((float*)(ws + WS_TAB), i);
    bf16_t* XN = (bf16_t*)(ws + WS_XN);
    for (int m = gw; m < M; m += NGW) rms_row_to_bf16(P.in[0] + (size_t)m * D, P.in[2], XN + (size_t)m * D, lane);
    for (int m = gw; m < MMEM; m += NGW) rms_row_to_bf16(P.in[1] + (size_t)m * D, P.in[14], XN + (size_t)(M + m) * D, lane);
}
__global__ void __launch_bounds__(512) k_norm_rows(const float* x, const float* g, bf16_t* o, int rows) {
    const int lane = threadIdx.x & 63, gw = blockIdx.x * 8 + (threadIdx.x >> 6), NGW = gridDim.x * 8;
    for (int m = gw; m < rows; m += NGW) rms_row_to_bf16(x + (size_t)m * D, g, o + (size_t)m * D, lane);
}
__global__ void __launch_bounds__(512) k_route(PtrsIn P, const float* x2, unsigned char* ws) {
    extern __shared__ __attribute__((aligned(16))) unsigned char dyn[];
    float* rw = (float*)dyn;
    int* te = (int*)(dyn + 20 * 1024 * 4);
    float* tw = (float*)(te + 256);
    int* tp = (int*)(tw + 256);
    int* ebase = tp + 256;
    const int tid = threadIdx.x, lane = tid & 63, wave = tid >> 6;
    for (int i = tid; i < 1024 * 4; i += 512) { const int k = i >> 2, o = i & 3; rw[o * 1024 + k] = P.in[19][i]; }
    for (int i = tid; i < 1024 * 16; i += 512) { const int k = i >> 4, o = i & 15; rw[(4 + o) * 1024 + k] = P.in[21][i]; }
    __syncthreads();
    bf16_t* XN3 = (bf16_t*)(ws + WS_XN3);
    const int t0 = blockIdx.x * 128;
    for (int i = 0; i < 16; ++i) { const int tl = wave * 16 + i, t = t0 + tl; int e0, e1; float w0, w1;
        route_token(row_load(x2 + (size_t)t * D, lane), P.in[18], rw, P.in[20], P.in[22], XN3 + (size_t)t * D, lane, e0, e1, w0, w1);
        if (lane == 0) { te[2 * tl] = e0; te[2 * tl + 1] = e1; tw[2 * tl] = w0; tw[2 * tl + 1] = w1; } }
    __syncthreads();
    if (wave == 0) {
        int cnt = 0;
        int mye[4]; for (int j = 0; j < 4; ++j) mye[j] = te[j * 64 + lane];
        int pos[4] = {0, 0, 0, 0};
        for (int e = 0; e < 16; ++e) { int run = 0;
            for (int j = 0; j < 4; ++j) { const unsigned long long mk = __ballot(mye[j] == e); const int before = __popcll(mk & ((1ull << lane) - 1ull));
                if (mye[j] == e) pos[j] = run + before; run += __popcll(mk); }
            if (lane == e) cnt = run; }
        for (int j = 0; j < 4; ++j) tp[j * 64 + lane] = pos[j];
        if (lane < 16) { unsigned* ec = (unsigned*)(ws + WS_CTL) + CW_ECNT + 64 * lane; ebase[lane] = (int)atomicAdd(ec, (unsigned)cnt); }
    }
    __syncthreads();
    if (tid < 256) { const int e = te[tid], slot = ebase[e] + tp[tid], dest = (t0 * 2) + tid; const float w = tw[tid];
        int* lst = (int*)(ws + WS_LIST) + ((size_t)e * LIST_CAP + slot) * 2; lst[0] = dest; lst[1] = __float_as_int(w);
        int* ti = (int*)(ws + WS_TOKINFO) + (size_t)dest * 2; ti[0] = e; ti[1] = __float_as_int(w); }
}
__global__ void __launch_bounds__(512) k_final(float* out, const bf16_t* ys, const float* g) {
    const int lane = threadIdx.x & 63, gw = blockIdx.x * 8 + (threadIdx.x >> 6), NGW = gridDim.x * 8;
    for (int m = gw; m < M; m += NGW) final_row(out + (size_t)m * D, ys + (size_t)m * 2048, g, lane);
}

__global__ void __launch_bounds__(256) nv_gemm(const bf16_t* A, int lda, const bf16_t* Bt, int ldb, int K, float* C, int ldc) {
    __shared__ __attribute__((aligned(16))) float As[16][68], Bs[16][68];
    const int tid = threadIdx.x, tx = tid & 15, ty = tid >> 4, r0 = blockIdx.y * 64, n0 = blockIdx.x * 64, lr = tid >> 2, lk = (tid & 3) * 4;
    float acc[4][4];
#pragma unroll
    for (int i = 0; i < 4; ++i)
#pragma unroll
        for (int j = 0; j < 4; ++j) acc[i][j] = 0.f;
    for (int k0 = 0; k0 < K; k0 += 16) {
        const u32x2 av = *(const u32x2*)(A + (size_t)(r0 + lr) * lda + k0 + lk), bv = *(const u32x2*)(Bt + (size_t)(n0 + lr) * ldb + k0 + lk);
        As[lk + 0][lr] = bf2f((bf16_t)(av.x & 0xffff)); As[lk + 1][lr] = bf2f((bf16_t)(av.x >> 16)); As[lk + 2][lr] = bf2f((bf16_t)(av.y & 0xffff)); As[lk + 3][lr] = bf2f((bf16_t)(av.y >> 16));
        Bs[lk + 0][lr] = bf2f((bf16_t)(bv.x & 0xffff)); Bs[lk + 1][lr] = bf2f((bf16_t)(bv.x >> 16)); Bs[lk + 2][lr] = bf2f((bf16_t)(bv.y & 0xffff)); Bs[lk + 3][lr] = bf2f((bf16_t)(bv.y >> 16));
        __syncthreads();
#pragma unroll
        for (int kk = 0; kk < 16; ++kk) { const f32x4 a = *(const f32x4*)&As[kk][ty * 4], b = *(const f32x4*)&Bs[kk][tx * 4];
#pragma unroll
            for (int i = 0; i < 4; ++i)
#pragma unroll
                for (int j = 0; j < 4; ++j) acc[i][j] += a[i] * b[j]; }
        __syncthreads();
    }
#pragma unroll
    for (int i = 0; i < 4; ++i) { f32x4 o = {acc[i][0], acc[i][1], acc[i][2], acc[i][3]}; *(f32x4*)(C + (size_t)(r0 + ty * 4 + i) * ldc + n0 + tx * 4) = o; }
}
__global__ void __launch_bounds__(256) nv_z_epi(const float* Cz, int row0, PtrsIn P, unsigned char* ws) {
    const int tid = threadIdx.x, lane = tid & 63, wave = tid >> 6;
    const int rl = blockIdx.x, row = row0 + rl, t = row % SEQ, rid = t >> 6, cid = t & 63;
    const float* z = Cz + (size_t)rl * NZ; const float* tab = (const float*)(ws + WS_TAB);
    if (wave == 0) {
        for (int hh = 0; hh < 10; ++hh) {
            const int c = (hh < 8) ? hh * 64 + lane : 512 + (hh - 8) * 64 + lane;
            const float v = z[z_phys(c)]; const float ss = wave_sum(v * v); const float rs = 1.0f / sqrtf(ss * (1.f / 64.f) + EPS);
            const float g = (hh < 8) ? P.in[4][lane] : P.in[5][lane];
            const float y = v * rs * g, yp = __shfl_xor(y, 1);
            const int i = lane >> 1; const float cs = (i < 16) ? tab[0 * 2048 + rid * 16 + i] : tab[2 * 2048 + cid * 16 + (i - 16)], sn = (i < 16) ? tab[1 * 2048 + rid * 16 + i] : tab[3 * 2048 + cid * 16 + (i - 16)];
            const float o = (lane & 1) ? (yp * sn + y * cs) : (y * cs - yp * sn);
            if (hh < 8) ((bf16_t*)(ws + WS_Q))[(size_t)row * 512 + hh * 64 + lane] = (bf16_t)f2bf(o * C2_SELF);
            else ((bf16_t*)(ws + WS_K))[(size_t)row * 128 + (hh - 8) * 64 + lane] = (bf16_t)f2bf(o);
        }
        for (int c = lane; c < 128; c += 64) ((bf16_t*)(ws + WS_V))[(size_t)row * 128 + c] = (bf16_t)f2bf(z[z_phys(ZV + c)]);
    } else {
        for (int c = tid - 64; c < 512; c += 192) { ((bf16_t*)(ws + WS_U))[(size_t)row * 512 + c] = (bf16_t)f2bf(gelu_tanh(z[ZSU + c])); ((bf16_t*)(ws + WS_GV))[(size_t)row * 512 + c] = (bf16_t)f2bf(gelu_tanh(z[ZSV + c])); }
        for (int c = tid - 64; c < 1024; c += 192) { ((bf16_t*)(ws + WS_GA))[(size_t)row * 1024 + c] = (bf16_t)f2bf(sigmoidf_(z[ZGA + c])); ((bf16_t*)(ws + WS_GB))[(size_t)row * 1024 + c] = (bf16_t)f2bf(sigmoidf_(z[ZGB + c])); }
    }
}
__global__ void __launch_bounds__(256) nv_store_bf16(const float* C, bf16_t* O, size_t n, float scale) {
    for (size_t i = (size_t)blockIdx.x * 256 + threadIdx.x; i < n; i += (size_t)gridDim.x * 256) O[i] = (bf16_t)f2bf(C[i] * scale);
}
__global__ void __launch_bounds__(256) nv_attn(const bf16_t* Q, const bf16_t* Kb, const bf16_t* Vb, bf16_t* O) {
    extern __shared__ __attribute__((aligned(16))) unsigned char dyn[];
    float (*Qs)[65] = (float (*)[65])dyn; float (*Ks)[65] = Qs + 64; float (*Vs)[65] = Ks + 64; float (*Ps)[65] = Vs + 64;
    const int tid = threadIdx.x, tx = tid & 15, ty = tid >> 4, qb = blockIdx.x, h = blockIdx.y, b = blockIdx.z, kvh = h >> 2;
    const int lr = tid >> 2, lc = (tid & 3) * 16;
    { const bf16_t* src = Q + ((size_t)(b * SEQ + qb * 64 + lr)) * 512 + h * 64 + lc;
      for (int j = 0; j < 16; ++j) Qs[lr][lc + j] = bf2f(src[j]); }
    float m[4], l[4], o[4][4];
    for (int i = 0; i < 4; ++i) { m[i] = -1e30f; l[i] = 0.f; for (int j = 0; j < 4; ++j) o[i][j] = 0.f; }
    for (int kt = 0; kt < SEQ / 64; ++kt) {
        __syncthreads();
        { const bf16_t* ks = Kb + ((size_t)(b * SEQ + kt * 64 + lr)) * 128 + kvh * 64 + lc; const bf16_t* vs = Vb + ((size_t)(b * SEQ + kt * 64 + lr)) * 128 + kvh * 64 + lc;
          for (int j = 0; j < 16; ++j) { Ks[lr][lc + j] = bf2f(ks[j]); Vs[lr][lc + j] = bf2f(vs[j]); } }
        __syncthreads();
        float s[4][4];
        for (int i = 0; i < 4; ++i) for (int j = 0; j < 4; ++j) s[i][j] = 0.f;
        for (int d = 0; d < 64; ++d) { float a[4], bb[4];
            for (int i = 0; i < 4; ++i) { a[i] = Qs[ty * 4 + i][d]; bb[i] = Ks[tx * 4 + i][d]; }
            for (int i = 0; i < 4; ++i) for (int j = 0; j < 4; ++j) s[i][j] += a[i] * bb[j]; }
        for (int i = 0; i < 4; ++i) {
            float rm = fmaxf(fmaxf(s[i][0], s[i][1]), fmaxf(s[i][2], s[i][3]));
            for (int x = 1; x < 16; x <<= 1) rm = fmaxf(rm, __shfl_xor(rm, x));
            const float mn = fmaxf(m[i], rm), al = __builtin_amdgcn_exp2f(m[i] - mn);
            float rsum = 0.f;
            for (int j = 0; j < 4; ++j) { const float p = __builtin_amdgcn_exp2f(s[i][j] - mn); Ps[ty * 4 + i][tx * 4 + j] = p; rsum += p; }
            for (int x = 1; x < 16; x <<= 1) rsum += __shfl_xor(rsum, x);
            l[i] = l[i] * al + rsum; m[i] = mn;
            for (int j = 0; j < 4; ++j) o[i][j] *= al;
        }
        __syncthreads();
        for (int c = 0; c < 64; ++c) { float p[4], v[4];
            for (int i = 0; i < 4; ++i) { p[i] = Ps[ty * 4 + i][c]; v[i] = Vs[c][tx * 4 + i]; }
            for (int i = 0; i < 4; ++i) for (int j = 0; j < 4; ++j) o[i][j] += p[i] * v[j]; }
    }
    for (int i = 0; i < 4; ++i) { const float il = 1.0f / l[i]; bf16_t* dst = O + ((size_t)(b * SEQ + qb * 64 + ty * 4 + i)) * 512 + h * 64 + tx * 4;
        for (int j = 0; j < 4; ++j) dst[j] = (bf16_t)f2bf(o[i][j] * il); }
}
__global__ void __launch_bounds__(256) nv_sgu(PtrsIn P, unsigned char* ws) {
    extern __shared__ __attribute__((aligned(16))) unsigned char dyn[];
    float* vn = (float*)dyn;
    float* mu = vn + 128 * 129; float* rstd = mu + 128;
    const int tid = threadIdx.x, lane = tid & 63, wave = tid >> 6, ch = blockIdx.x, g = blockIdx.y;
    const bf16_t* GV = (const bf16_t*)(ws + WS_GV) + (size_t)ch * 128 * 512;
    for (int r = wave * 32; r < wave * 32 + 32; ++r) { float s = 0.f;
        float xv[8]; for (int j = 0; j < 8; ++j) { xv[j] = bf2f(GV[(size_t)r * 512 + j * 64 + lane]); s += xv[j]; }
        const float mean = wave_sum(s) * (1.f / 512.f); float q = 0.f;
        for (int j = 0; j < 8; ++j) { const float d = xv[j] - mean; q += d * d; }
        const float var = wave_sum(q) * (1.f / 512.f);
        if (lane == 0) { mu[r] = mean; rstd[r] = 1.0f / sqrtf(var + EPS); } }
    __syncthreads();
    for (int i = tid; i < 128 * 128; i += 256) { const int q = i >> 7, c = i & 127, cg = g * 128 + c;
        vn[q * 129 + c] = (bf2f(GV[(size_t)q * 512 + cg]) - mu[q]) * rstd[q] * P.in[7][cg] + P.in[8][cg]; }
    __syncthreads();
    const bf16_t* W = (const bf16_t*)(ws + WS_WSS) + (size_t)g * 128 * 128;
    const bf16_t* U = (const bf16_t*)(ws + WS_U) + (size_t)ch * 128 * 512; bf16_t* SG = (bf16_t*)(ws + WS_SG) + (size_t)ch * 128 * 512;
    const int c = tid & 127;
    for (int p = tid >> 7; p < 128; p += 2) { float a = 0.f;
        for (int q = 0; q < 128; ++q) a += bf2f(W[p * 128 + q]) * vn[q * 129 + c];
        a += P.in[10][g * 128 + p];
        SG[(size_t)p * 512 + g * 128 + c] = (bf16_t)f2bf(bf2f(U[(size_t)p * 512 + g * 128 + c]) * a); }
}
__global__ void __launch_bounds__(256) nv_merge(const float* C1, const float* C2, const bf16_t* GA, const bf16_t* GB, bf16_t* Mg, size_t n) {
    for (size_t i = (size_t)blockIdx.x * 256 + threadIdx.x; i < n; i += (size_t)gridDim.x * 256) Mg[i] = (bf16_t)f2bf(bf2f(GA[i]) * C1[i] + bf2f(GB[i]) * C2[i]);
}
__global__ void __launch_bounds__(256) nv_resid(const float* base, const float* C, float* out, size_t n) {
    for (size_t i = (size_t)blockIdx.x * 256 + threadIdx.x; i < n; i += (size_t)gridDim.x * 256) out[i] = base[i] + C[i];
}
__global__ void __launch_bounds__(256) nv_cross(const bf16_t* QC, const bf16_t* KVC, bf16_t* OC) {
    __shared__ float qs[512]; __shared__ float ps[4][256];
    const int tid = threadIdx.x, lane = tid & 63, h = tid >> 6, tok = blockIdx.x, b = tok / SEQ;
    for (int i = tid; i < 512; i += 256) qs[i] = bf2f(QC[(size_t)tok * 512 + i]);
    __syncthreads();
    float sc[4]; float mx = -1e30f;
    for (int j = 0; j < 4; ++j) { const int mrow = b * NMEM + j * 64 + lane; const bf16_t* kr = KVC + (size_t)mrow * 1024 + h * 128; float a = 0.f;
        for (int d = 0; d < 128; ++d) a += qs[h * 128 + d] * bf2f(kr[d]);
        sc[j] = a; mx = fmaxf(mx, a); }
    mx = wave_max(mx); float sum = 0.f;
    for (int j = 0; j < 4; ++j) { const float p = __builtin_amdgcn_exp2f(sc[j] - mx); ps[h][j * 64 + lane] = p; sum += p; }
    sum = wave_sum(sum);
    __syncthreads();
    for (int dd = 0; dd < 2; ++dd) { const int d = dd * 64 + lane; float a = 0.f;
        for (int mm = 0; mm < 256; ++mm) a += ps[h][mm] * bf2f(KVC[(size_t)(b * NMEM + mm) * 1024 + 512 + h * 128 + d]);
        OC[(size_t)tok * 512 + h * 128 + d] = (bf16_t)f2bf(a / sum); }
}
__global__ void __launch_bounds__(256) nv_moe_a(const bf16_t* XN3, unsigned char* ws) {
    __shared__ float xs[1024];
    const int tid = threadIdx.x, dest = blockIdx.x, tok = dest >> 1;
    const int e = ((const int*)(ws + WS_TOKINFO))[(size_t)dest * 2];
    for (int i = tid; i < 1024; i += 256) xs[i] = bf2f(XN3[(size_t)tok * 1024 + i]);
    __syncthreads();
    const bf16_t* W = (const bf16_t*)(ws + WS_WGU) + (size_t)e * 1024 * 1024; bf16_t* Hh = (bf16_t*)(ws + WS_H) + (size_t)dest * 512;
    for (int n = tid; n < 512; n += 256) { const bf16_t* wg = W + (size_t)(256 * (n >> 7) + (n & 127)) * 1024; const bf16_t* wu = wg + 128 * 1024; float a = 0.f, b = 0.f;
        for (int k = 0; k < 1024; k += 8) { const u32x4 g4 = *(const u32x4*)(wg + k), u4 = *(const u32x4*)(wu + k);
            const unsigned gg[4] = {g4.x, g4.y, g4.z, g4.w}, uu[4] = {u4.x, u4.y, u4.z, u4.w};
            for (int j = 0; j < 4; ++j) { a += xs[k + 2 * j] * bf2f((bf16_t)(gg[j] & 0xffff)) + xs[k + 2 * j + 1] * bf2f((bf16_t)(gg[j] >> 16)); b += xs[k + 2 * j] * bf2f((bf16_t)(uu[j] & 0xffff)) + xs[k + 2 * j + 1] * bf2f((bf16_t)(uu[j] >> 16)); } }
        Hh[n] = (bf16_t)f2bf(a * sigmoidf_(a) * b); }
}
__global__ void __launch_bounds__(256) nv_moe_b(unsigned char* ws) {
    __shared__ float hs[512];
    const int tid = threadIdx.x, dest = blockIdx.x;
    const int* ti = (const int*)(ws + WS_TOKINFO) + (size_t)dest * 2; const int e = ti[0]; const float w = __int_as_float(ti[1]);
    const bf16_t* Hh = (const bf16_t*)(ws + WS_H) + (size_t)dest * 512;
    for (int i = tid; i < 512; i += 256) hs[i] = bf2f(Hh[i]);
    __syncthreads();
    const bf16_t* W = (const bf16_t*)(ws + WS_WD) + (size_t)e * 1024 * 512; bf16_t* Y = (bf16_t*)(ws + WS_YS) + (size_t)dest * 1024;
    for (int n = tid; n < 1024; n += 256) { const bf16_t* wr = W + (size_t)n * 512; float a = 0.f;
        for (int k = 0; k < 512; k += 8) { const u32x4 g4 = *(const u32x4*)(wr + k); const unsigned gg[4] = {g4.x, g4.y, g4.z, g4.w};
            for (int j = 0; j < 4; ++j) a += hs[k + 2 * j] * bf2f((bf16_t)(gg[j] & 0xffff)) + hs[k + 2 * j + 1] * bf2f((bf16_t)(gg[j] >> 16)); }
        Y[n] = (bf16_t)f2bf(a * w); }
}

namespace pg8 {
typedef short bf16x8 __attribute__((ext_vector_type(8)));
#ifndef WGM_V
#define WGM_V 8
#endif
constexpr int BM = 256, BK = 64, HALF = 128, HTB = HALF * BK * 2, STAGE_BYTES = 8 * HTB, NXCD = 8, WGM = WGM_V;
__host__ __device__ __forceinline__ int lds_byte(int r, int c) { const int st = (r >> 4) * 2 + (c >> 5), rr = r & 15, cc = c & 31, ob = rr * 64 + cc * 2; return st * 1024 + (ob ^ (((ob >> 9) & 1) << 5)); }
__host__ __device__ __forceinline__ void stage_rc(int b, int& R, int& C) { const int st = b / 1024, sb = b % 1024, swz = sb ^ (((sb >> 9) & 1) << 5); R = (st >> 1) * 16 + swz / 64; C = (st & 1) * 32 + (swz % 64) / 2; }
__host__ __device__ __forceinline__ int perm32(int rho) { const int n = rho >> 4, i = rho & 15; return 8 * (i >> 2) + 4 * n + (i & 3); }
struct Unit { int pm, pn, kind, dup; };
__device__ __forceinline__ void tile_of(int L, int nM, int nN, int& pm, int& pn) {
    const int nwg = nM * nN; int wgid = L; { const int q = nwg / NXCD, r = nwg % NXCD, xcd = wgid % NXCD, off = wgid / NXCD; wgid = (xcd < r ? xcd * (q + 1) : r * (q + 1) + (xcd - r) * q) + off; }
    const int nig = WGM * nN, gid = wgid / nig, fm = gid * WGM, gsz = (nM - fm) < WGM ? (nM - fm) : WGM;
    pm = fm + ((wgid % nig) % gsz); pn = (wgid % nig) / gsz;
}
__device__ __forceinline__ unsigned cvt_pk_bf16(float lo, float hi) { unsigned r; asm volatile("v_cvt_pk_bf16_f32 %0, %1, %2" : "=v"(r) : "v"(lo), "v"(hi)); return r; }

template <class Epi, class Sched, bool ALIGN_EPI, bool GATHER, bool VARK = false>
__device__ __forceinline__ void gemm_phase(LAS unsigned char* lds, const int Kc, const Sched& S, const Epi& E, const unsigned stag_ticks = 0u) {
    static_assert(!(VARK && GATHER), "VARK computes its offsets arithmetically");
    unsigned k2c = (unsigned)Kc * 2u, k2n = (unsigned)Kc * 2u;
    const int tid = threadIdx.x, wid = __builtin_amdgcn_readfirstlane(tid >> 6), lane = tid & 63, wr = wid >> 2, wc = wid & 3, fr = lane & 15, fq = lane >> 4;
    const int K = Kc; int nt = K / BK;
    unsigned voffA[2], voffB[2]; int RA[2], CA2[2], RB[2];
#pragma unroll
    for (int i = 0; i < 2; ++i) { int R, C; stage_rc(tid * 16 + i * 8192, R, C); const int Rb = Epi::PERM ? ((R & ~31) + perm32(R & 31)) : R;
        voffA[i] = (unsigned)(R * K + C) * 2u; voffB[i] = (unsigned)(Rb * K + C) * 2u; RA[i] = R; CA2[i] = C * 2; RB[i] = Rb; }
    const size_t kstep = (size_t)(BK * 2);
    const size_t hstep = (size_t)HALF * K * 2;
    const unsigned ldsw = (unsigned)wid * 1024u;
    const int aoff = lds_byte(wr * 64 + fr, fq * 8), boff = lds_byte(wc * 32 + fr, fq * 8);
    unsigned vA[2][2] = {{0u, 0u}, {0u, 0u}}, vN[2][2] = {{0u, 0u}, {0u, 0u}};
#define PG8_SA(b, h) (((b) * 2 + (h)) * HTB)
#define PG8_SB(b, h) ((4 + (b) * 2 + (h)) * HTB)
#define PG8_STAGE(bufoff, gbase, voff) do { _Pragma("unroll") for (int _i = 0; _i < 2; ++_i) \
        __builtin_amdgcn_global_load_lds((const unsigned*)((const char*)(gbase) + (voff)[_i]), (LAS unsigned*)(lds + (bufoff) + ldsw + _i * 8192), 16, 0, 0); } while (0)
#define PG8_STAGEA(bufoff, gbase, h, nx) do { _Pragma("unroll") for (int _i = 0; _i < 2; ++_i) { \
        const unsigned _o = VARK ? (unsigned)((h) * HALF + RA[_i]) * ((nx) ? k2n : k2c) + (unsigned)CA2[_i] : (GATHER ? ((nx) ? vN[h][_i] : vA[h][_i]) : voffA[_i]); \
        __builtin_amdgcn_global_load_lds((const unsigned*)((const char*)(gbase) + ((GATHER || VARK) ? (size_t)0 : (size_t)(h) * hstep) + _o), (LAS unsigned*)(lds + (bufoff) + ldsw + _i * 8192), 16, 0, 0); } } while (0)
#define PG8_STAGEB(bufoff, gbase, h, nx) do { _Pragma("unroll") for (int _i = 0; _i < 2; ++_i) { \
        const unsigned _o = VARK ? (unsigned)((h) * HALF + RB[_i]) * ((nx) ? k2n : k2c) + (unsigned)CA2[_i] : voffB[_i]; \
        __builtin_amdgcn_global_load_lds((const unsigned*)((const char*)(gbase) + (VARK ? (size_t)0 : (size_t)(h) * hstep) + _o), (LAS unsigned*)(lds + (bufoff) + ldsw + _i * 8192), 16, 0, 0); } } while (0)
#define PG8_LDA(dst, b, h) do { _Pragma("unroll") for (int m = 0; m < 4; ++m) _Pragma("unroll") for (int k = 0; k < 2; ++k) dst[m][k] = *(const LAS bf16x8*)(lds + PG8_SA(b, h) + aoff + m * 2048 + k * 1024); } while (0)
#define PG8_LDB(dst, b, h) do { _Pragma("unroll") for (int n = 0; n < 2; ++n) _Pragma("unroll") for (int k = 0; k < 2; ++k) dst[n][k] = *(const LAS bf16x8*)(lds + PG8_SB(b, h) + boff + n * 2048 + k * 1024); } while (0)
#define PG8_MMA(ai, bj, At, Bt) do { __builtin_amdgcn_s_setprio(1); _Pragma("unroll") for (int m = 0; m < 4; ++m) _Pragma("unroll") for (int n = 0; n < 2; ++n) _Pragma("unroll") for (int k = 0; k < 2; ++k) \
        acc[ai][bj][m][n] = __builtin_amdgcn_mfma_f32_16x16x32_bf16(Bt[n][k], At[m][k], acc[ai][bj][m][n], 0, 0, 0); __builtin_amdgcn_s_setprio(0); } while (0)
#define PG8_WAIT_V(n) asm volatile("s_waitcnt vmcnt(" #n ")" ::: "memory")
#define PG8_WAIT_L(n) asm volatile("s_waitcnt lgkmcnt(" #n ")" ::: "memory")
#define PG8_BAR __builtin_amdgcn_s_barrier()
#define PG8_SCHED __builtin_amdgcn_sched_barrier(0)
#define PG8_GOFF(dst, ui_) do { if (GATHER) { _Pragma("unroll") for (int _h = 0; _h < 2; ++_h) _Pragma("unroll") for (int _i = 0; _i < 2; ++_i) dst[_h][_i] = S.goff((ui_), _h * HALF + RA[_i]) + (unsigned)CA2[_i]; } } while (0)
    Unit cur, nxt; int ui = 0;
    if (!S.next(0, cur)) return;
    if (stag_ticks) { const unsigned long long t0 = __builtin_amdgcn_s_memrealtime(), dl = (unsigned long long)((blockIdx.x >> 3) & 1) * stag_ticks;
      while (__builtin_amdgcn_s_memrealtime() - t0 < dl) __builtin_amdgcn_s_sleep(8); }
    f32x4 acc[2][2][4][2];
#pragma unroll
    for (int a = 0; a < 2; ++a)
#pragma unroll
        for (int b = 0; b < 2; ++b)
#pragma unroll
            for (int m = 0; m < 4; ++m)
#pragma unroll
                for (int n = 0; n < 2; ++n) acc[a][b][m][n] = (f32x4){0.f, 0.f, 0.f, 0.f};
    bf16x8 At[4][2], B0[2][2], B1[2][2];
    const char* cA = S.a_ptr(cur); const char* cB = S.b_ptr(cur);
    PG8_GOFF(vA, 0);
    if constexpr (VARK) { nt = S.k_of(cur) / BK; k2c = (unsigned)S.k_of(cur) * 2u; k2n = k2c; }
    PG8_STAGEB(PG8_SB(0, 0), cB, 0, false); PG8_STAGEB(PG8_SB(0, 1), cB, 1, false); PG8_STAGEA(PG8_SA(0, 0), cA, 0, false); PG8_STAGEA(PG8_SA(0, 1), cA, 1, false);
    if (wr == 1) PG8_BAR;
    PG8_WAIT_V(2); PG8_BAR;
    PG8_STAGEB(PG8_SB(1, 0), cB + kstep, 0, false); PG8_STAGEA(PG8_SA(1, 0), cA + kstep, 0, false); PG8_STAGEB(PG8_SB(1, 1), cB + kstep, 1, false);
    PG8_WAIT_V(6); PG8_BAR;
    for (;;) {
        const bool has_next = S.next(ui + 1, nxt);
        const char* nA = has_next ? S.a_ptr(nxt) : cA; const char* nB = has_next ? S.b_ptr(nxt) : cB;
        for (int t = 0; t < nt; t += 2) {
            const bool last = (t == nt - 2);
            const char* a1 = cA + (size_t)(t + 1) * kstep;
            const char* a2 = last ? nA : cA + (size_t)(t + 2) * kstep; const char* b2 = last ? nB : cB + (size_t)(t + 2) * kstep;
            const char* a3 = a2 + kstep; const char* b3 = b2 + kstep;
            if constexpr (VARK) { if (last) k2n = has_next ? (unsigned)S.k_of(nxt) * 2u : k2c; }
            if (GATHER && last) { if (has_next) { PG8_GOFF(vN, ui + 1); } else {
#pragma unroll
                for (int _h = 0; _h < 2; ++_h)
#pragma unroll
                    for (int _i = 0; _i < 2; ++_i) vN[_h][_i] = vA[_h][_i]; } }
            PG8_LDB(B0, 0, 0); PG8_LDB(B1, 0, 1); PG8_SCHED; PG8_LDA(At, 0, 0); PG8_STAGEA(PG8_SA(1, 1), a1, 1, false);
            PG8_WAIT_V(8); PG8_WAIT_L(0); PG8_BAR; PG8_MMA(0, 0, At, B0); PG8_MMA(0, 1, At, B1); PG8_BAR; PG8_SCHED;
            PG8_LDA(At, 0, 1); PG8_STAGEB(PG8_SB(0, 0), b2, 0, last); PG8_STAGEB(PG8_SB(0, 1), b2, 1, last); PG8_STAGEA(PG8_SA(0, 0), a2, 0, last);
            PG8_WAIT_V(8); PG8_WAIT_L(0); PG8_BAR; PG8_MMA(1, 0, At, B0); PG8_MMA(1, 1, At, B1); PG8_BAR; PG8_SCHED;
            PG8_LDB(B0, 1, 0); PG8_LDB(B1, 1, 1); PG8_SCHED; PG8_LDA(At, 1, 0); PG8_STAGEA(PG8_SA(0, 1), a2, 1, last);
            PG8_WAIT_V(8); PG8_WAIT_L(0); PG8_BAR; PG8_MMA(0, 0, At, B0); PG8_MMA(0, 1, At, B1); PG8_BAR; PG8_SCHED;
            PG8_LDA(At, 1, 1); PG8_STAGEB(PG8_SB(1, 0), b3, 0, last); PG8_STAGEB(PG8_SB(1, 1), b3, 1, last); PG8_STAGEA(PG8_SA(1, 0), a3, 0, last);
            PG8_WAIT_V(8); PG8_WAIT_L(0); PG8_BAR; PG8_MMA(1, 0, At, B0); PG8_MMA(1, 1, At, B1); PG8_BAR; PG8_SCHED;
        }
        if constexpr (ALIGN_EPI) { if (wr == 0) PG8_BAR; }
        if (!cur.dup) E(acc, cur, ui, wr, wc, fr, fq);
#ifdef PROBE_EDUP
        if (Epi::EDUP) { asm volatile("s_waitcnt vmcnt(0)" ::: "memory"); E(acc, cur, ui, wr, wc, fr, fq); }
#endif
        if (!has_next) break;
#pragma unroll
        for (int a = 0; a < 2; ++a)
#pragma unroll
            for (int b = 0; b < 2; ++b)
#pragma unroll
                for (int m = 0; m < 4; ++m)
#pragma unroll
                    for (int n = 0; n < 2; ++n) acc[a][b][m][n] = (f32x4){0.f, 0.f, 0.f, 0.f};
        cur = nxt; cA = nA; cB = nB; ++ui;
        if constexpr (VARK) { nt = S.k_of(cur) / BK; k2c = k2n; }
        if (GATHER) {
#pragma unroll
            for (int _h = 0; _h < 2; ++_h)
#pragma unroll
                for (int _i = 0; _i < 2; ++_i) vA[_h][_i] = vN[_h][_i]; }
        if constexpr (ALIGN_EPI) { if (wr == 1) PG8_BAR; }
    }
    PG8_WAIT_V(0);
    if constexpr (!ALIGN_EPI) { if (wr == 0) PG8_BAR; }
    PG8_BAR;
#undef PG8_SA
#undef PG8_SB
#undef PG8_STAGE
#undef PG8_STAGEA
#undef PG8_STAGEB
#undef PG8_LDA
#undef PG8_LDB
#undef PG8_MMA
#undef PG8_WAIT_V
#undef PG8_WAIT_L
#undef PG8_BAR
#undef PG8_SCHED
#undef PG8_GOFF
}
}
namespace attn_body {
using bf16=unsigned short;
using bf16x8=__attribute__((ext_vector_type(8)))short;
using s16x4=__attribute__((ext_vector_type(4)))short;
using f32x16=__attribute__((ext_vector_type(16)))float;
constexpr int SEQA=8192,D=64,QP=512,KP=128;
constexpr int NW=8,QBLK=32,QB=QBLK*NW,KVBLK=64,NQB=SEQA/QB;
__device__ __forceinline__ int crow(int r,int hi){return (r&3)+8*(r>>2)+4*hi;}
#define SBAR() __builtin_amdgcn_sched_barrier(0)
__device__ __forceinline__ void cmask(f32x16&p0,f32x16&p1,int jb,int qrel,int hi){
  const float NEG=-INFINITY; int kb=64*jb+4*hi;
  #pragma unroll
  for(int r=0;r<16;++r){int kv=kb+(r&3)+8*(r>>2); if(kv>qrel)p0[r]=NEG; if(kv+32>qrel)p1[r]=NEG;}
}

constexpr int NSLOT=3, SLOTB=8192;
constexpr int LDS_K=0, LDS_V=NSLOT*SLOTB, LDS_WS=2*NSLOT*SLOTB, LDS_OST=LDS_WS+NW*64*4, LDS_BYTES=LDS_OST+NW*4096;
constexpr float C2=0.125f*1.4426950408889634f;
__device__ __forceinline__ void glds16(const void*gsrc,unsigned lds_dst){unsigned keep;
  asm volatile("s_mov_b32 %0, m0\n\ts_mov_b32 m0, %2\n\ts_nop 0\n\tglobal_load_lds_dwordx4 %1, off\n\ts_mov_b32 m0, %0":"=&s"(keep):"v"(gsrc),"s"(lds_dst):"memory");}
__device__ __forceinline__ float max3f(float a,float b,float c){float r;asm("v_max3_f32 %0, %1, %2, %3":"=v"(r):"v"(a),"v"(b),"v"(c));return r;}
__device__ __forceinline__ float max2f(float a,float b){float r;asm("v_max_f32_e32 %0, %1, %2":"=v"(r):"v"(a),"v"(b));return r;}
__device__ __forceinline__ float fadd_s(float a,float b){float r;asm("v_add_f32_e32 %0, %1, %2":"=v"(r):"v"(a),"v"(b));return r;}
__device__ __forceinline__ float fsub_s(float a,float b){float r;asm("v_sub_f32_e32 %0, %1, %2":"=v"(r):"v"(a),"v"(b));return r;}
typedef float f32x2_t __attribute__((ext_vector_type(2))); typedef __bf16 bf16x2_t __attribute__((ext_vector_type(2)));
__device__ __forceinline__ unsigned cvtpk_s(float lo,float hi){f32x2_t v={lo,hi};bf16x2_t b=__builtin_convertvector(v,bf16x2_t);return __builtin_bit_cast(unsigned,b);}
#define WAIT_BAR(N) asm volatile("s_waitcnt vmcnt(" #N ") lgkmcnt(0)\n\ts_barrier":::"memory")

__device__ __forceinline__ void qkt(f32x16&p0,f32x16&p1,const char*Kslot,const bf16x8*qr,const f32x16&negm,int r32,int hi){
  const char*kb=Kslot+hi*1024+r32*16;
  #pragma unroll
  for(int d0=0;d0<4;++d0){
    const bf16x8 b0=*reinterpret_cast<const bf16x8*>(kb+d0*2048);
    const bf16x8 b1=*reinterpret_cast<const bf16x8*>(kb+d0*2048+512);
    if(d0==0){p0=__builtin_amdgcn_mfma_f32_32x32x16_bf16(b0,qr[0],negm,0,0,0);p1=__builtin_amdgcn_mfma_f32_32x32x16_bf16(b1,qr[0],negm,0,0,0);}
    else{p0=__builtin_amdgcn_mfma_f32_32x32x16_bf16(b0,qr[d0],p0,0,0,0);p1=__builtin_amdgcn_mfma_f32_32x32x16_bf16(b1,qr[d0],p1,0,0,0);}}
}
typedef __attribute__((address_space(3))) const char* lds_cptr;
typedef short v4i16_t __attribute__((ext_vector_type(4)));
__device__ __forceinline__ void kload8(bf16x8*kf,lds_cptr kp){
  kf[0]=*(const __attribute__((address_space(3))) bf16x8*)(kp);      kf[1]=*(const __attribute__((address_space(3))) bf16x8*)(kp+512);
  kf[2]=*(const __attribute__((address_space(3))) bf16x8*)(kp+2048); kf[3]=*(const __attribute__((address_space(3))) bf16x8*)(kp+2560);
  kf[4]=*(const __attribute__((address_space(3))) bf16x8*)(kp+4096); kf[5]=*(const __attribute__((address_space(3))) bf16x8*)(kp+4608);
  kf[6]=*(const __attribute__((address_space(3))) bf16x8*)(kp+6144); kf[7]=*(const __attribute__((address_space(3))) bf16x8*)(kp+6656);
}
__device__ __forceinline__ void kload2(bf16x8*kf,lds_cptr kp,int j){ kf[2*j]=*(const __attribute__((address_space(3))) bf16x8*)(kp+j*2048); kf[2*j+1]=*(const __attribute__((address_space(3))) bf16x8*)(kp+j*2048+512); }
__device__ __forceinline__ s16x4 vtr(lds_cptr p){ return __builtin_bit_cast(s16x4,__builtin_amdgcn_ds_read_tr16_b64_v4i16((__attribute__((address_space(3))) v4i16_t*)p)); }
__device__ __forceinline__ float rowmax(const f32x16&p0,const f32x16&p1){
  float a=max3f(p0[0],p0[1],p1[0]),b=max3f(p0[2],p0[3],p1[1]);a=max3f(a,p1[2],p1[3]);
  #pragma unroll
  for(int r=4;r<16;r+=4){a=max3f(a,p0[r],p0[r+1]);b=max3f(b,p0[r+2],p0[r+3]);a=max3f(a,p1[r],p1[r+1]);b=max3f(b,p1[r+2],p1[r+3]);}
  const float m=max2f(a,b);
  auto rr=__builtin_amdgcn_permlane32_swap(__float_as_uint(m),__float_as_uint(m),false,false);
  return max2f(__uint_as_float(rr[0]),__uint_as_float(rr[1]));
}
__device__ __forceinline__ void pv(f32x16*o,int vb,bf16x8 pa0,bf16x8 pa1,bf16x8 pa2,bf16x8 pa3){
  #pragma unroll
  for(int d0=0;d0<2;++d0){s16x4 lo[4],hi[4];
    #pragma unroll
    for(int ks=0;ks<4;++ks){
      asm volatile("ds_read_b64_tr_b16 %0,%1 offset:%c2":"=&v"(lo[ks]):"v"(vb),"i"(d0*4096+ks*1024):"memory");
      asm volatile("ds_read_b64_tr_b16 %0,%1 offset:%c2":"=&v"(hi[ks]):"v"(vb),"i"(d0*4096+ks*1024+512):"memory");}
    asm volatile("s_waitcnt lgkmcnt(0)":::"memory");SBAR();
    #define PK(k) (bf16x8){lo[k][0],lo[k][1],lo[k][2],lo[k][3],hi[k][0],hi[k][1],hi[k][2],hi[k][3]}
    o[d0]=__builtin_amdgcn_mfma_f32_32x32x16_bf16(pa0,PK(0),o[d0],0,0,0);
    o[d0]=__builtin_amdgcn_mfma_f32_32x32x16_bf16(pa1,PK(1),o[d0],0,0,0);
    o[d0]=__builtin_amdgcn_mfma_f32_32x32x16_bf16(pa2,PK(2),o[d0],0,0,0);
    o[d0]=__builtin_amdgcn_mfma_f32_32x32x16_bf16(pa3,PK(3),o[d0],0,0,0);
    #undef PK
  }
}

#ifndef ATTN_STORE16
#define ATTN_STORE16(p,v) (*(u32x4*)(p)=(v))
#endif
template<int THRL,bool FIXM> __device__ __forceinline__ void attn_unit(int b,int h,int kvh,int qb,const bf16*Q,const bf16*__restrict__ K,const bf16*__restrict__ V,bf16*O,char*shm,float cfix){
  const int tid=threadIdx.x,lane=tid&63,r32=lane&31,hi=lane>>5; const int wid=__builtin_amdgcn_readfirstlane(tid>>6);
  const long rowbase=(long)b*SEQA; const int q0=qb*QB;
  const bf16*Qw=Q+(rowbase+q0+wid*QBLK)*QP+h*D;
  const bf16*Kh=K+rowbase*KP+kvh*D,*Vh=V+rowbase*KP+kvh*D;
  const unsigned lds0=(unsigned)(uintptr_t)shm;
  float*wsf=(float*)(shm+LDS_WS)+wid*64;
  const bf16*ksrc=Kh+(long)lane*KP+wid*8;
  const bf16*vsrc=Vh+(long)(16*(wid&3)+(lane>>2))*KP+(wid>>2)*32+(lane&3)*8;
  const unsigned kdst=lds0+LDS_K+wid*1024, vdst=lds0+LDS_V+wid*1024;
  #define DMA_K(t,slot) glds16(ksrc+(long)(t)*KVBLK*KP,(unsigned)__builtin_amdgcn_readfirstlane(kdst+(slot)))
  #define DMA_V(t,slot) glds16(vsrc+(long)(t)*KVBLK*KP,(unsigned)__builtin_amdgcn_readfirstlane(vdst+(slot)))
  const int vb0=(int)(lds0+LDS_V)+((lane>>4)&1)*32+(lane&3)*8+(4*hi+((lane&15)>>2))*64;
  const char*Kbase=shm+LDS_K; bf16x8 kf[8];
  const lds_cptr shm3=(lds_cptr)shm; const lds_cptr kp0=shm3+LDS_K+hi*1024+r32*16; const lds_cptr vp0=shm3+LDS_V+((lane>>4)&1)*32+(lane&3)*8+(4*hi+((lane&15)>>2))*64;
  const int NT=SEQA/KVBLK;
  DMA_K(0,0);DMA_V(0,0);DMA_K(1,SLOTB);
  bf16x8 qr[4];
  #pragma unroll
  for(int d0=0;d0<4;++d0)qr[d0]=*reinterpret_cast<const bf16x8*>(&Qw[(long)r32*QP+d0*16+hi*8]);
  float mhat=FIXM?cfix:0.f,l_reg=0.f;f32x16 o[2];o[0]=f32x16{};o[1]=f32x16{};f32x16 negm=f32x16{};
  if(FIXM){
  #pragma unroll
  for(int r=0;r<16;++r)negm[r]=-cfix;}
  asm volatile("":"+v"(negm));
  const int qrel=wid*QBLK+r32;
  #define CMASK(P0,P1,t) do{}while(0)
  bool resc=false;
  #define START(P0,P1) do{ resc=false; \
    if(!FIXM){ const float rm=rowmax(P0,P1); const float dl=rm; mhat=fadd_s(mhat,dl); \
      _Pragma("unroll") for(int r=0;r<16;++r){P0[r]=fsub_s(P0[r],dl);P1[r]=fsub_s(P1[r],dl);} \
      _Pragma("unroll") for(int r=0;r<16;++r)negm[r]=-mhat; asm volatile("":"+v"(negm)); } \
    _Pragma("unroll") for(int r=0;r<16;++r)P0[r]=__builtin_amdgcn_exp2f(P0[r]); }while(0)
  #define RESC() do{ if(!FIXM&&resc){ asm volatile("s_waitcnt lgkmcnt(0)":::"memory"); \
      _Pragma("unroll") for(int d_=0;d_<2;++d_) _Pragma("unroll") for(int r=0;r<16;++r)o[d_][r]*=wsf[crow(r,hi)]; } }while(0)
  f32x16 pA0,pA1,pB0,pB1;
  int sl_prev=0,sl_cur=0,sl_next=SLOTB;
  #define ROT() do{sl_prev=sl_cur;sl_cur=sl_next;sl_next=(sl_next==(NSLOT-1)*SLOTB)?0:sl_next+SLOTB;}while(0)
  DMA_K(2,2*SLOTB);
  WAIT_BAR(3);
  qkt(pA0,pA1,Kbase,qr,negm,r32,hi);asm volatile("s_nop 15\n\ts_nop 7":"+v"(pA0),"+v"(pA1));CMASK(pA0,pA1,0);
  START(pA0,pA1);
  _Pragma("unroll") for(int r=0;r<16;++r)pA1[r]=__builtin_amdgcn_exp2f(pA1[r]);
  WAIT_BAR(0);
  DMA_K(3,0);DMA_V(1,SLOTB);
  ROT();
  kload8(kf,kp0+sl_cur);
  WAIT_BAR(2);
  s16x4 vlo[8],vhi[8]; u32x4 pw0,pw1,pw2,pw3;
  #define PKW(P,B) cvtpk_s(P[B],P[B+1])
  #define PAF(k) __builtin_bit_cast(bf16x8,pw##k)
  #define VFR(i) (bf16x8){vlo[i][0],vlo[i][1],vlo[i][2],vlo[i][3],vhi[i][0],vhi[i][1],vhi[i][2],vhi[i][3]}
  #define PIN(x) asm volatile("":"+v"(x))
  #define MX3(a,b,c) __builtin_fmaxf(__builtin_fmaxf((a),(b)),(c))
  #define GAPA(MF,A0,A1,A2,A3,W0,W1,PW) do{ MF; sacc+=A0; sacc+=A1; sacc+=A2; sacc+=A3; PIN(sacc); W0; W1; PIN(PW); SBAR(); }while(0)
  #define EX(v) __builtin_amdgcn_exp2f(v)
  #define GAPB(MF,X,B) do{ MF; X[B]=EX(X[B]); X[B+1]=EX(X[B+1]); X[B+2]=EX(X[B+2]); X[B+3]=EX(X[B+3]); PIN(X); SBAR(); }while(0)
  #define VRD(i) do{ vlo[i]=vtr(vp_+(((i)>>2)*4096+((i)&3)*1024)); vhi[i]=vtr(vp_+(((i)>>2)*4096+((i)&3)*1024+512)); }while(0)
  #define KRD(G,j) do{ if(G){ kload2(kf,kp0+sl_next,j); SBAR(); } }while(0)
  #define STEP(C0,C1,P0,P1,t,GK,GV,GL) do{ SBAR(); \
    const lds_cptr vp_=vp0+sl_prev; \
    VRD(0); SBAR(); float sacc=(P0[0]+P0[1]); \
    GAPA(C0=__builtin_amdgcn_mfma_f32_32x32x16_bf16(kf[0],qr[0],negm,0,0,0), P0[2],P0[3],P0[4],P0[5],     pw0[0]=PKW(P0,0), pw0[1]=PKW(P0,2), pw0); \
    VRD(4); SBAR(); GAPA(C1=__builtin_amdgcn_mfma_f32_32x32x16_bf16(kf[1],qr[0],negm,0,0,0), P0[6],P0[7],P0[8],P0[9],     pw0[2]=PKW(P0,4), pw0[3]=PKW(P0,6), pw0); \
    VRD(1); SBAR(); GAPA(C0=__builtin_amdgcn_mfma_f32_32x32x16_bf16(kf[2],qr[1],C0,0,0,0),   P0[10],P0[11],P0[12],P0[13], pw1[0]=PKW(P0,8), pw1[1]=PKW(P0,10), pw1); \
    VRD(5); SBAR(); GAPA(C1=__builtin_amdgcn_mfma_f32_32x32x16_bf16(kf[3],qr[1],C1,0,0,0),   P0[14],P0[15],P1[0],P1[1],   pw1[2]=PKW(P0,12),pw1[3]=PKW(P0,14), pw1); \
    VRD(2); SBAR(); GAPA(C0=__builtin_amdgcn_mfma_f32_32x32x16_bf16(kf[4],qr[2],C0,0,0,0),   P1[2],P1[3],P1[4],P1[5],     pw2[0]=PKW(P1,0), pw2[1]=PKW(P1,2), pw2); \
    VRD(6); SBAR(); GAPA(C1=__builtin_amdgcn_mfma_f32_32x32x16_bf16(kf[5],qr[2],C1,0,0,0),   P1[6],P1[7],P1[8],P1[9],     pw2[2]=PKW(P1,4), pw2[3]=PKW(P1,6), pw2); \
    VRD(3); SBAR(); GAPA(C0=__builtin_amdgcn_mfma_f32_32x32x16_bf16(kf[6],qr[3],C0,0,0,0),   P1[10],P1[11],P1[12],P1[13], pw3[0]=PKW(P1,8), pw3[1]=PKW(P1,10), pw3); \
    VRD(7); SBAR(); GAPA(C1=__builtin_amdgcn_mfma_f32_32x32x16_bf16(kf[7],qr[3],C1,0,0,0),   P1[14],P1[15],0.f,0.f,       pw3[2]=PKW(P1,12),pw3[3]=PKW(P1,14), pw3); \
    l_reg+=sacc; \
    if(GK){DMA_K((t)+3,sl_cur);} if(GV){DMA_V((t)+1,sl_next);} \
    CMASK(C0,C1,t); \
    if(!FIXM){ float a=MX3(C0[0],C0[1],C1[0]),b=MX3(C0[2],C0[3],C1[1]); a=MX3(a,C1[2],C1[3]); \
      _Pragma("unroll") for(int r=4;r<16;r+=4){a=MX3(a,C0[r],C0[r+1]);b=MX3(b,C0[r+2],C0[r+3]);a=MX3(a,C1[r],C1[r+1]);b=MX3(b,C1[r+2],C1[r+3]);} \
      float rm=__builtin_fmaxf(a,b); { auto rr=__builtin_amdgcn_permlane32_swap(__float_as_uint(rm),__float_as_uint(rm),false,false); rm=__builtin_fmaxf(__uint_as_float(rr[0]),__uint_as_float(rr[1])); } \
      resc=false; \
      if(__builtin_expect(__any(rm>(float)THRL),0)){ const float dl=__builtin_fmaxf(rm,0.f); mhat+=dl; \
        _Pragma("unroll") for(int r=0;r<16;++r){C0[r]-=dl;C1[r]-=dl;} \
        _Pragma("unroll") for(int r=0;r<16;++r)negm[r]=-mhat; asm volatile("":"+v"(negm)); \
        const float f=__builtin_amdgcn_exp2f(-dl); l_reg*=f; if(hi==0)wsf[r32]=f; resc=true; } } \
    SBAR(); \
    GAPB(o[0]=__builtin_amdgcn_mfma_f32_32x32x16_bf16(PAF(0),VFR(0),o[0],0,0,0), C0,0); \
    GAPB(o[1]=__builtin_amdgcn_mfma_f32_32x32x16_bf16(PAF(0),VFR(4),o[1],0,0,0), C0,4); \
    KRD(GL,0); GAPB(o[0]=__builtin_amdgcn_mfma_f32_32x32x16_bf16(PAF(1),VFR(1),o[0],0,0,0), C0,8); \
    KRD(GL,1); GAPB(o[1]=__builtin_amdgcn_mfma_f32_32x32x16_bf16(PAF(1),VFR(5),o[1],0,0,0), C0,12); \
    KRD(GL,2); GAPB(o[0]=__builtin_amdgcn_mfma_f32_32x32x16_bf16(PAF(2),VFR(2),o[0],0,0,0), C1,0); \
    KRD(GL,3); GAPB(o[1]=__builtin_amdgcn_mfma_f32_32x32x16_bf16(PAF(2),VFR(6),o[1],0,0,0), C1,4); \
    GAPB(o[0]=__builtin_amdgcn_mfma_f32_32x32x16_bf16(PAF(3),VFR(3),o[0],0,0,0), C1,8); \
    GAPB(o[1]=__builtin_amdgcn_mfma_f32_32x32x16_bf16(PAF(3),VFR(7),o[1],0,0,0), C1,12); \
    }while(0)
  int t=1;
  #undef CMASK
  #define CMASK(P0,P1,t) do{}while(0)
  for(;t+5<NT;t+=2){
    STEP(pB0,pB1,pA0,pA1,t,true,true,true);     WAIT_BAR(2); RESC(); ROT();
    STEP(pA0,pA1,pB0,pB1,t+1,true,true,true);   WAIT_BAR(2); RESC(); ROT();
  }
  #undef CMASK
  #define CMASK(P0,P1,t) do{}while(0)
  #define ENDW(tt) do{ if((tt)+3<NT){WAIT_BAR(2);} else if((tt)+2<NT){WAIT_BAR(1);} else {WAIT_BAR(0);} }while(0)
  for(;t+1<NT;t+=2){
    STEP(pB0,pB1,pA0,pA1,t,(t+3<NT),(t+1<NT),(t+1<NT));       ENDW(t);   RESC(); ROT();
    STEP(pA0,pA1,pB0,pB1,t+1,(t+4<NT),(t+2<NT),(t+2<NT));     ENDW(t+1); RESC(); ROT();
  }
  STEP(pB0,pB1,pA0,pA1,NT-1,false,false,false); RESC();
  { float sacc=pB0[0]+pB0[1]; _Pragma("unroll") for(int r=2;r<16;++r)sacc+=pB0[r]; _Pragma("unroll") for(int r=0;r<16;++r)sacc+=pB1[r]; l_reg+=sacc;
    pw0=(u32x4){PKW(pB0,0),PKW(pB0,2),PKW(pB0,4),PKW(pB0,6)};pw1=(u32x4){PKW(pB0,8),PKW(pB0,10),PKW(pB0,12),PKW(pB0,14)};pw2=(u32x4){PKW(pB1,0),PKW(pB1,2),PKW(pB1,4),PKW(pB1,6)};pw3=(u32x4){PKW(pB1,8),PKW(pB1,10),PKW(pB1,12),PKW(pB1,14)};
    SBAR(); pv(o,vb0+sl_cur,PAF(0),PAF(1),PAF(2),PAF(3)); }
  #undef PKW
  #undef PAF
  #undef VFR
  #undef PIN
  #undef MX3
  #undef GAPA
  #undef GAPB
  #undef EX
  #undef VRD
  #undef KRD
  #undef STEP
  #undef ENDW
  {auto rr=__builtin_amdgcn_permlane32_swap(__float_as_uint(l_reg),__float_as_uint(l_reg),false,false);l_reg=__uint_as_float(rr[0])+__uint_as_float(rr[1]);}
  if(hi==0)wsf[32+r32]=l_reg;asm volatile("s_waitcnt lgkmcnt(0)":::"memory");
  float rli[16];
  #pragma unroll
  for(int r=0;r<16;++r)rli[r]=__builtin_amdgcn_rcpf(wsf[32+crow(r,hi)]);
  bf16*Ow=O+(rowbase+q0+wid*QBLK)*QP+h*D;
  { bf16*stg=(bf16*)(shm+LDS_OST)+wid*2048;
    #pragma unroll
    for(int r=0;r<16;++r){const int orow=crow(r,hi);
      #pragma unroll
      for(int d0=0;d0<2;++d0)stg[orow*64+d0*32+r32]=(bf16)f2bf(o[d0][r]*rli[r]);}
    asm volatile("s_waitcnt lgkmcnt(0)":::"memory");
    #pragma unroll
    for(int i=0;i<4;++i){const int row=i*8+(lane>>3),ch=lane&7; const u32x4 v=*(const u32x4*)(stg+row*64+ch*8); ATTN_STORE16(Ow+(long)row*QP+ch*8,v);} }
  asm volatile("s_waitcnt lgkmcnt(0)\n\ts_barrier":::"memory");
  #undef DMA_K
  #undef DMA_V
  #undef CMASK
  #undef START
  #undef RESC
  #undef ROT
}
constexpr int ATTN_LDS_BYTES=LDS_BYTES;
#undef SBAR
#undef WAIT_BAR
}
constexpr int NWAVES = 8;
constexpr int RING_OFF = 0, RING_BYTES = 131072;
constexpr int SGU_ROWB = 1040, SGU_TILE_BYTES = 128 * SGU_ROWB;
constexpr int TBL_OFF = 133120;
constexpr int MOE_MAXU = 6;
constexpr int RSTBL_OFF = TBL_OFF + MOE_MAXU * 1024;
constexpr int UREC_OFF = RSTBL_OFF + MOE_MAXU * 1024;
constexpr int MISC_OFF = UREC_OFF + 512;
constexpr int LDS_BYTES = 147456;
static_assert(MISC_OFF + 128 <= LDS_BYTES, "LDS map");
constexpr int NPHASE = 13;

#define GAS __attribute__((address_space(1)))
typedef GAS unsigned gu32;
#define RLX_AGENT __ATOMIC_RELAXED, __HIP_MEMORY_SCOPE_AGENT

#define XB_TMO      128
#define XB_XCNT(j)  (256  + 64 * (j))
#define XB_XSUB(j)  (1280 + 64 * (j))
#define XB_XGEN(j)  (2304 + 64 * (j))
#define XB_TOP      3328
#define XB_TOPGEN   3392
#define XCD_BAR_WORDS 3456
#define XB_SPIN_CAP (1u << 18)
__device__ __forceinline__ unsigned xb_ld(unsigned* p)              { return __hip_atomic_load(p, __ATOMIC_RELAXED, __HIP_MEMORY_SCOPE_AGENT); }
__device__ __forceinline__ unsigned xb_add(unsigned* p, unsigned v) { return __hip_atomic_fetch_add(p, v, __ATOMIC_RELAXED, __HIP_MEMORY_SCOPE_AGENT); }
__device__ __forceinline__ unsigned xb_xcc_id() { return (unsigned)__builtin_amdgcn_s_getreg((3 << 11) | 20) & 0xFu; }
#define XB_SPIN(cond, bar) do { unsigned _sp = 0; while (cond) { __builtin_amdgcn_s_sleep(1); \
    if ((++_sp & 255u) == 0u) { if (xb_ld(&(bar)[XB_TMO])) break; if (_sp > XB_SPIN_CAP) { atomicAdd(&(bar)[XB_TMO], 1u); break; } } } } while (0)
struct XcdBarrier { unsigned* bar; unsigned x; volatile LAS unsigned* st; };
__device__ __forceinline__ XcdBarrier xcd_barrier_post(unsigned* bar, volatile LAS unsigned* st) {
    XcdBarrier b; b.bar = bar; b.x = xb_xcc_id(); b.st = st;
    if (threadIdx.x == 0) (void)xb_add(&bar[XB_XCNT(b.x)], 1u);
    return b;
}
__device__ __forceinline__ void xcd_barrier_complete(unsigned* bar, unsigned x, unsigned& nloc, unsigned& nx) {
    const unsigned G = gridDim.x * gridDim.y * gridDim.z;
    unsigned sum, cnt, mine, sp = 0u;
    for (;;) {
        sum = 0u; cnt = 0u; mine = 0u;
#pragma unroll
        for (unsigned j = 0; j < 16; ++j) { const unsigned c = xb_ld(&bar[XB_XCNT(j)]); sum += c; cnt += (c > 0u) ? 1u : 0u; mine = (j == x) ? c : mine; }
        if (sum == G) break;
        __builtin_amdgcn_s_sleep(1);
        if ((++sp & 255u) == 0u) { if (xb_ld(&bar[XB_TMO])) break; if (sp > XB_SPIN_CAP) { atomicAdd(&bar[XB_TMO], 1u); break; } }
    }
    nloc = mine > 0u ? mine : 1u; nx = cnt > 0u ? cnt : 1u;
}
__device__ __forceinline__ void xcd_barrier(const XcdBarrier& b) {
    asm volatile("s_waitcnt vmcnt(0)" ::: "memory");
    __syncthreads();
    if (threadIdx.x == 0) {
        unsigned* bar = b.bar;
        __builtin_amdgcn_s_waitcnt(0);
        unsigned nloc = b.st[0], nx = b.st[1];
        if (nloc == 0u) { xcd_barrier_complete(bar, b.x, nloc, nx); b.st[0] = nloc; b.st[1] = nx; }
        const unsigned old = xb_add(&bar[XB_XSUB(b.x)], 1u);
        const unsigned gen = old / nloc;
        if (old + 1u == (gen + 1u) * nloc) {
            __builtin_amdgcn_fence(__ATOMIC_RELEASE, "agent");
            asm volatile("s_waitcnt vmcnt(0)" ::: "memory");
            const unsigned og = xb_add(&bar[XB_TOP], 1u);
            const unsigned tg = og / nx;
            if (og + 1u == (tg + 1u) * nx) xb_add(&bar[XB_TOPGEN], 1u);
            else XB_SPIN(xb_ld(&bar[XB_TOPGEN]) == tg, bar);
            __builtin_amdgcn_fence(__ATOMIC_ACQUIRE, "agent");
            xb_add(&bar[XB_XGEN(b.x)], 1u);
            asm volatile("s_waitcnt vmcnt(0)" ::: "memory");
        } else {
            XB_SPIN(xb_ld(&bar[XB_XGEN(b.x)]) == gen, bar);
            __builtin_amdgcn_fence(__ATOMIC_ACQUIRE, "agent");
            asm volatile("s_waitcnt vmcnt(0)" ::: "memory");
        }
    }
    __syncthreads();
}

using pg8::Unit;
struct SchedPlain {
    const char* A; const char* Bt; int nM, nN, G, c, K;
    __device__ __forceinline__ bool next(int i, Unit& u) const { const long L = (long)i * G + c; if (L >= (long)nM * nN) return false; pg8::tile_of((int)L, nM, nN, u.pm, u.pn); u.kind = 0; u.dup = 0; return true; }
    __device__ __forceinline__ const char* a_ptr(const Unit& u) const { return A + (size_t)u.pm * 256 * K * 2; }
    __device__ __forceinline__ const char* b_ptr(const Unit& u) const { return Bt + (size_t)u.pn * 256 * K * 2; }
    __device__ __forceinline__ unsigned goff(int, int) const { return 0u; }
};
template <class B> struct SchedDup { B b;
    __device__ __forceinline__ bool next(int i, Unit& u) const { if (!b.next(i >> 1, u)) return false; u.dup = !(i & 1); return true; }
    __device__ __forceinline__ const char* a_ptr(const Unit& u) const { return b.a_ptr(u); }
    __device__ __forceinline__ const char* b_ptr(const Unit& u) const { return b.b_ptr(u); }
    __device__ __forceinline__ unsigned goff(int, int) const { return 0u; }
    __device__ __forceinline__ int k_of(const Unit& u) const { return b.k_of(u); }
};
struct SchedZ {
    const char* A; const char* Bt; int G, c;
    __device__ __forceinline__ bool next(int i, Unit& u) const { const long L = (long)i * G + c; if (L >= 912) return false;
        if (L < 896) pg8::tile_of((int)L, 128, 7, u.pm, u.pn); else { const int j = (int)L - 896; u.pm = 128 + (j >> 2); u.pn = 15 + (j & 3); } u.kind = 0; u.dup = 0; return true; }
    __device__ __forceinline__ const char* a_ptr(const Unit& u) const { return A + (size_t)u.pm * 256 * 2048; }
    __device__ __forceinline__ const char* b_ptr(const Unit& u) const { return Bt + (size_t)u.pn * 256 * 2048; }
    __device__ __forceinline__ unsigned goff(int, int) const { return 0u; }
};
struct SchedY {
    const char* ws; int G, c;
    __device__ __forceinline__ bool next(int i, Unit& u) const { const long L = (long)(i >> 2) * G + c; if (L >= 512) return false; pg8::tile_of((int)L, 128, 4, u.pm, u.pn); u.kind = i & 3; u.dup = 0; return true; }
    __device__ __forceinline__ int k_of(const Unit& u) const { return 1024 - 512 * (u.kind >> 1); }
    __device__ __forceinline__ const char* a_ptr(const Unit& u) const { const size_t mix = (size_t)(u.kind >> 1), sg = (size_t)(u.kind & 1);
        const size_t off = mix * (WS_ATT + sg * (WS_SG - WS_ATT) + (size_t)u.pm * 256 * 1024) + (1 - mix) * (WS_XN + (size_t)u.pm * 256 * 2048); return ws + off; }
    __device__ __forceinline__ const char* b_ptr(const Unit& u) const { const size_t mix = (size_t)(u.kind >> 1), sg = (size_t)(u.kind & 1);
        const size_t off = mix * (WS_WATT + sg * (WS_WSGU - WS_WATT) + (size_t)u.pn * 256 * 1024) + (1 - mix) * (WS_WZ + (size_t)(ZGA + sg * (ZGB - ZGA) + u.pn * 256) * 2048); return ws + off; }
    __device__ __forceinline__ unsigned goff(int, int) const { return 0u; }
};
struct SchedMoe {
    const LAS int* rec; const LAS unsigned* tbl; const char* A; const char* Bt; size_t a_panel_bytes, b_expert_bytes, b_tile_bytes; bool gather;
    __device__ __forceinline__ bool next(int i, Unit& u) const { if (i >= MOE_MAXU || rec[i * 8] == 0) return false; u.pm = rec[i * 8 + 1]; u.pn = rec[i * 8 + 2]; u.kind = rec[i * 8 + 3]; u.dup = 0; return true; }
    __device__ __forceinline__ const char* a_ptr(const Unit& u) const { return gather ? A : A + (size_t)u.pm * a_panel_bytes; }
    __device__ __forceinline__ const char* b_ptr(const Unit& u) const { return Bt + (size_t)u.kind * b_expert_bytes + (size_t)u.pn * b_tile_bytes; }
    __device__ __forceinline__ unsigned goff(int ui, int row) const { return tbl[ui * 256 + row]; }
};

#ifndef EPI_ST
#define EPI_ST 0
#endif
__device__ __forceinline__ void st16(void* p, u32x4 v) {
#if EPI_ST == 1
    asm volatile("global_store_dwordx4 %0, %1, off nt\n\ts_nop 1" :: "v"(p), "v"(v) : "memory");
#elif EPI_ST == 2
    asm volatile("global_store_dwordx4 %0, %1, off sc1\n\ts_nop 1" :: "v"(p), "v"(v) : "memory");
#else
    *(u32x4*)p = v;
#endif
}
typedef const f32x4 (&AccRef)[2][2][4][2];
typedef float f32x2 __attribute__((ext_vector_type(2)));
struct EpiZ {
    static constexpr bool PERM = true, EDUP = false;
    unsigned char* ws; const float* gq; const float* gk; const float* tab; const float* rs0;
    __device__ __forceinline__ void operator()(AccRef acc, const Unit& u, int, int wr, int wc, int fr, int fq) const {
        const int pn = u.pn;
#define EPIZ_R0(ai_) float r0m[4]; _Pragma("unroll") for (int m_ = 0; m_ < 4; ++m_) r0m[m_] = (X0_BF16 && pn < 15) ? rs0[u.pm * 256 + (ai_) * 128 + wr * 64 + m_ * 16 + fr] : 1.0f
        if (pn <= 2) {
            const bool isv = (pn == 2 && wc >= 2), isq = (pn < 2);
            bf16_t* dst; int ldc;
            if (isq) { dst = (bf16_t*)(ws + WS_Q) + (4 * pn + wc) * 64; ldc = 512; }
            else if (!isv) { dst = (bf16_t*)(ws + WS_K) + wc * 64; ldc = 128; }
            else { dst = (bf16_t*)(ws + WS_V) + (wc - 2) * 64; ldc = 128; }
            const float* g = isq ? gq : gk;
            f32x4 gv[2][2];
#pragma unroll
            for (int bj = 0; bj < 2; ++bj)
#pragma unroll
                for (int n = 0; n < 2; ++n) gv[bj][n] = *(const f32x4*)(g + 32 * bj + 8 * fq + 4 * n);
            const float osc = isq ? C2_SELF : 1.0f;
#pragma unroll
            for (int ai = 0; ai < 2; ++ai) {
                EPIZ_R0(ai);
                const int rid = (4 * u.pm + 2 * ai + wr) & 127;
                f32x4 csr = (f32x4){1.f, 1.f, 1.f, 1.f}, snr = (f32x4){0.f, 0.f, 0.f, 0.f}, csc[4], snc[4];
#pragma unroll
                for (int m = 0; m < 4; ++m) { csc[m] = csr; snc[m] = snr; }
                if (!isv) { const float* tr = tab + rid * 16 + 4 * fq; csr = *(const f32x4*)tr; snr = *(const f32x4*)(tr + 2048);
#pragma unroll
                    for (int m = 0; m < 4; ++m) { const float* tc = tab + 2 * 2048 + (16 * m + fr) * 16 + 4 * fq; csc[m] = *(const f32x4*)tc; snc[m] = *(const f32x4*)(tc + 2048); } }
#pragma unroll
                for (int m = 0; m < 4; ++m) {
                    const int row = u.pm * 256 + ai * 128 + wr * 64 + m * 16 + fr;
                    bf16_t* rowp = dst + (size_t)row * ldc + 8 * fq;
                    if (isv) {
#pragma unroll
                        for (int bj = 0; bj < 2; ++bj) { const f32x4 v0 = acc[ai][bj][m][0] * r0m[m], v1 = acc[ai][bj][m][1] * r0m[m];
                            u32x4 w; w.x = pg8::cvt_pk_bf16(v0[0], v0[1]); w.y = pg8::cvt_pk_bf16(v0[2], v0[3]); w.z = pg8::cvt_pk_bf16(v1[0], v1[1]); w.w = pg8::cvt_pk_bf16(v1[2], v1[3]);
                            st16(rowp + 32 * bj, w); }
                    } else {
                        float ss = 0.f;
#pragma unroll
                        for (int bj = 0; bj < 2; ++bj)
#pragma unroll
                            for (int n = 0; n < 2; ++n) { const f32x4 x = acc[ai][bj][m][n]; ss += (x[0] * x[0] + x[1] * x[1]) + (x[2] * x[2] + x[3] * x[3]); }
                        ss += __shfl_xor(ss, 16); ss += __shfl_xor(ss, 32);
                        const float rq = r0m[m]; const float rs = rq * osc / sqrtf(rq * rq * ss * (1.f / 64.f) + EPS);
#pragma unroll
                        for (int bj = 0; bj < 2; ++bj) {
                            const f32x4 cs = bj ? csc[m] : csr, sn = bj ? snc[m] : snr;
                            float o[8];
#pragma unroll
                            for (int n = 0; n < 2; ++n) { const f32x4 x = acc[ai][bj][m][n], gg = gv[bj][n];
                                const float y0 = x[0] * rs * gg[0], y1 = x[1] * rs * gg[1], y2 = x[2] * rs * gg[2], y3 = x[3] * rs * gg[3];
                                const float c0 = cs[2 * n], s0 = sn[2 * n], c1 = cs[2 * n + 1], s1 = sn[2 * n + 1];
                                o[4 * n + 0] = y0 * c0 - y1 * s0; o[4 * n + 1] = y0 * s0 + y1 * c0; o[4 * n + 2] = y2 * c1 - y3 * s1; o[4 * n + 3] = y2 * s1 + y3 * c1; }
                            u32x4 w; w.x = pg8::cvt_pk_bf16(o[0], o[1]); w.y = pg8::cvt_pk_bf16(o[2], o[3]); w.z = pg8::cvt_pk_bf16(o[4], o[5]); w.w = pg8::cvt_pk_bf16(o[6], o[7]);
                            st16(rowp + 32 * bj, w); }
                    }
                }
            }
        } else {
            bf16_t* dst; int ldc, row0; int act;
            if (pn < 5) { dst = (bf16_t*)(ws + WS_U) + (pn - 3) * 256; ldc = 512; act = 1; row0 = u.pm * 256; }
            else if (pn < 7) { dst = (bf16_t*)(ws + WS_GV) + (pn - 5) * 256; ldc = 512; act = 1; row0 = u.pm * 256; }
            else if (pn < 11) { dst = (bf16_t*)(ws + WS_GA) + (pn - 7) * 256; ldc = 1024; act = 2; row0 = u.pm * 256; }
            else if (pn < 15) { dst = (bf16_t*)(ws + WS_GB) + (pn - 11) * 256; ldc = 1024; act = 2; row0 = u.pm * 256; }
            else { dst = (bf16_t*)(ws + WS_KVC) + (pn - 15) * 256; ldc = 1024; act = 0; row0 = (u.pm - 128) * 256; }
#pragma unroll
            for (int ai = 0; ai < 2; ++ai) { EPIZ_R0(ai);
#pragma unroll
                for (int m = 0; m < 4; ++m) { bf16_t* rowp = dst + (size_t)(row0 + ai * 128 + wr * 64 + m * 16 + fr) * ldc + wc * 32 + 8 * fq;
#pragma unroll
                    for (int bj = 0; bj < 2; ++bj) { f32x2 o[4];
#pragma unroll
                        for (int n = 0; n < 2; ++n)
#pragma unroll
                            for (int hh = 0; hh < 2; ++hh) { const f32x2 x = (f32x2){acc[ai][bj][m][n][2 * hh], acc[ai][bj][m][n][2 * hh + 1]} * r0m[m];
                                if (act == 2) { const f32x2 t = x * (-LOG2E); f32x2 e; e.x = __builtin_amdgcn_exp2f(t.x); e.y = __builtin_amdgcn_exp2f(t.y); const f32x2 d = e + 1.0f;
                                    f32x2 r; r.x = __builtin_amdgcn_rcpf(d.x); r.y = __builtin_amdgcn_rcpf(d.y); o[2 * n + hh] = r; }
                                else if (act == 1) { const f32x2 x2 = x * x, t = (x2 * (-2.0f * LOG2E * 0.7978845608028654f * 0.044715f) + (-2.0f * LOG2E * 0.7978845608028654f)) * x;
                                    f32x2 e; e.x = __builtin_amdgcn_exp2f(t.x); e.y = __builtin_amdgcn_exp2f(t.y); const f32x2 d = e + 1.0f;
                                    f32x2 r; r.x = __builtin_amdgcn_rcpf(d.x); r.y = __builtin_amdgcn_rcpf(d.y); o[2 * n + hh] = x * r; }
                                else o[2 * n + hh] = x; }
                        u32x4 w; w.x = pg8::cvt_pk_bf16(o[0].x, o[0].y); w.y = pg8::cvt_pk_bf16(o[1].x, o[1].y); w.z = pg8::cvt_pk_bf16(o[2].x, o[2].y); w.w = pg8::cvt_pk_bf16(o[3].x, o[3].y);
                        st16(rowp + bj * 128, w); } } }
        }
#undef EPIZ_R0
    }
};
__device__ __forceinline__ void unpack8(const u32x4 g, float (&f)[8]) {
    f[0] = __uint_as_float(g.x << 16); f[1] = __uint_as_float(g.x & 0xffff0000u); f[2] = __uint_as_float(g.y << 16); f[3] = __uint_as_float(g.y & 0xffff0000u);
    f[4] = __uint_as_float(g.z << 16); f[5] = __uint_as_float(g.z & 0xffff0000u); f[6] = __uint_as_float(g.w << 16); f[7] = __uint_as_float(g.w & 0xffff0000u);
}
struct EpiY {
    static constexpr bool PERM = true, EDUP = false;
    bf16_t* GS; bf16_t* MG; const float* rs0;
    __device__ __forceinline__ void operator()(AccRef acc, const Unit& u, int, int wr, int wc, int fr, int fq) const {
#ifdef TEST_TRIV
        if (u.kind >= TEST_TRIV) { GS[(size_t)fr] = (bf16_t)acc[0][0][0][0][0]; return; }
#endif
        int gsl = (wr * 64 + fr) * 256 + wc * 32 + 8 * fq; asm volatile("" : "+v"(gsl));
        static_assert(GATE_U8, "two parked gate tiles need the 8-bit form"); gsl += (u.kind & 1) * 65536;
        if (u.kind < 2) {
            float r0[2][4];
#pragma unroll
            for (int ai = 0; ai < 2; ++ai)
#pragma unroll
                for (int m = 0; m < 4; ++m) r0[ai][m] = X0_BF16 ? rs0[u.pm * 256 + ai * 128 + wr * 64 + m * 16 + fr] : 1.0f;
#pragma unroll
            for (int ai = 0; ai < 2; ++ai)
#pragma unroll
                for (int m = 0; m < 4; ++m) {
#pragma unroll
                    for (int bj = 0; bj < 2; ++bj) { unsigned q[8];
#pragma unroll
                        for (int n = 0; n < 2; ++n)
#pragma unroll
                            for (int hh = 0; hh < 2; ++hh) { const f32x2 x = (f32x2){acc[ai][bj][m][n][2 * hh], acc[ai][bj][m][n][2 * hh + 1]};
                                const f32x2 t = x * (-LOG2E * r0[ai][m]); f32x2 e; e.x = __builtin_amdgcn_exp2f(t.x); e.y = __builtin_amdgcn_exp2f(t.y); const f32x2 d = e + 1.0f;
                                f32x2 r; r.x = __builtin_amdgcn_rcpf(d.x); r.y = __builtin_amdgcn_rcpf(d.y);
#if GATE_U8
                                const f32x2 s = r * 255.0f + 0.5f; q[4 * n + 2 * hh] = (unsigned)s.x; q[4 * n + 2 * hh + 1] = (unsigned)s.y; }
                        u32x2 w; w.x = q[0] | (q[1] << 8) | (q[2] << 16) | (q[3] << 24); w.y = q[4] | (q[5] << 8) | (q[6] << 16) | (q[7] << 24);
                        *(u32x2*)((unsigned char*)GS + gsl + (ai * 128 + m * 16) * 256 + bj * 128) = w; }
#else
                                q[4 * n + 2 * hh] = __float_as_uint(r.x); q[4 * n + 2 * hh + 1] = __float_as_uint(r.y); }
                        u32x4 w; w.x = pg8::cvt_pk_bf16(__uint_as_float(q[0]), __uint_as_float(q[1])); w.y = pg8::cvt_pk_bf16(__uint_as_float(q[2]), __uint_as_float(q[3]));
                        w.z = pg8::cvt_pk_bf16(__uint_as_float(q[4]), __uint_as_float(q[5])); w.w = pg8::cvt_pk_bf16(__uint_as_float(q[6]), __uint_as_float(q[7]));
                        st16(GS + gsl + (ai * 128 + m * 16) * 256 + bj * 128, w); }
#endif
                }
            return;
        }
        const bool add = (u.kind == 3);
        const size_t offb = (size_t)(u.pm * 256 + wr * 64 + fr) * 1024 + u.pn * 256 + wc * 32 + 8 * fq;
        u32x4 pp[2][2];
#if GATE_U8
        u32x2 gg[2][2];
#define EPIY_GLOAD(buf, bj, ai_, m_) gg[buf][bj] = *(const u32x2*)((const unsigned char*)GS + gsl + (ai_ * 128 + m_ * 16) * 256 + bj * 128)
#else
        u32x4 gg[2][2];
#define EPIY_GLOAD(buf, bj, ai_, m_) gg[buf][bj] = *(const u32x4*)(GS + gsl + (ai_ * 128 + m_ * 16) * 256 + bj * 128)
#endif
#define EPIY_LOAD(buf, s) do { const int ai_ = (s) >> 2, m_ = (s) & 3; _Pragma("unroll") for (int bj = 0; bj < 2; ++bj) { \
            EPIY_GLOAD(buf, bj, ai_, m_); \
            pp[buf][bj] = add ? *(const u32x4*)(MG + offb + (size_t)(ai_ * 128 + m_ * 16) * 1024 + bj * 128) : (u32x4){0u, 0u, 0u, 0u}; } } while (0)
        EPIY_LOAD(0, 0);
#pragma unroll
        for (int s = 0; s < 8; ++s) { const int ai = s >> 2, mm = s & 3, cb = s & 1;
            if (s + 1 < 8) { if (cb == 0) EPIY_LOAD(1, s + 1); else EPIY_LOAD(0, s + 1); }
#pragma unroll
            for (int bj = 0; bj < 2; ++bj) { float g[8], p[8]; unpack8(pp[cb][bj], p); float o[8];
#if GATE_U8
                { const unsigned g0 = gg[cb][bj].x, g1 = gg[cb][bj].y;
                  g[0] = (float)(g0 & 0xffu) * (1.f / 255.f); g[1] = (float)((g0 >> 8) & 0xffu) * (1.f / 255.f); g[2] = (float)((g0 >> 16) & 0xffu) * (1.f / 255.f); g[3] = (float)(g0 >> 24) * (1.f / 255.f);
                  g[4] = (float)(g1 & 0xffu) * (1.f / 255.f); g[5] = (float)((g1 >> 8) & 0xffu) * (1.f / 255.f); g[6] = (float)((g1 >> 16) & 0xffu) * (1.f / 255.f); g[7] = (float)(g1 >> 24) * (1.f / 255.f); }
#else
                unpack8(gg[cb][bj], g);
#endif
#pragma unroll
                for (int n = 0; n < 2; ++n)
#pragma unroll
                    for (int j = 0; j < 4; ++j) o[4 * n + j] = p[4 * n + j] + g[4 * n + j] * acc[ai][bj][mm][n][j];
                u32x4 w; w.x = pg8::cvt_pk_bf16(o[0], o[1]); w.y = pg8::cvt_pk_bf16(o[2], o[3]); w.z = pg8::cvt_pk_bf16(o[4], o[5]); w.w = pg8::cvt_pk_bf16(o[6], o[7]);
                st16(MG + offb + (size_t)(ai * 128 + mm * 16) * 1024 + bj * 128, w); } }
#undef EPIY_LOAD
#undef EPIY_GLOAD
    }
};
struct EpiRes {
    static constexpr bool PERM = false, EDUP = false;
    const float* base; float* out;
    __device__ __forceinline__ void operator()(AccRef acc, const Unit& u, int, int wr, int wc, int fr, int fq) const {
#pragma unroll
        for (int ai = 0; ai < 2; ++ai) {
            const size_t off0 = (size_t)(u.pm * 256 + ai * 128 + wr * 64 + fr) * 1024 + u.pn * 256 + wc * 32 + 4 * fq;
            f32x4 bb[4][2][2];
#pragma unroll
            for (int m = 0; m < 4; ++m)
#pragma unroll
                for (int bj = 0; bj < 2; ++bj)
#pragma unroll
                    for (int n = 0; n < 2; ++n) bb[m][bj][n] = *(const f32x4*)(base + off0 + (size_t)m * 16 * 1024 + bj * 128 + n * 16);
#pragma unroll
            for (int m = 0; m < 4; ++m)
#pragma unroll
                for (int bj = 0; bj < 2; ++bj)
#pragma unroll
                    for (int n = 0; n < 2; ++n) *(f32x4*)(out + off0 + (size_t)m * 16 * 1024 + bj * 128 + n * 16) = bb[m][bj][n] + acc[ai][bj][m][n]; }
    }
};
struct EpiBf16s {
    static constexpr bool PERM = true, EDUP = false;
    bf16_t* O; int ldc; float scale;
    __device__ __forceinline__ void operator()(AccRef acc, const Unit& u, int, int wr, int wc, int fr, int fq) const {
#pragma unroll
        for (int ai = 0; ai < 2; ++ai)
#pragma unroll
            for (int m = 0; m < 4; ++m) { bf16_t* rowp = O + (size_t)(u.pm * 256 + ai * 128 + wr * 64 + m * 16 + fr) * ldc + u.pn * 256 + wc * 32 + 8 * fq;
#pragma unroll
                for (int bj = 0; bj < 2; ++bj) { const f32x4 v0 = acc[ai][bj][m][0] * scale, v1 = acc[ai][bj][m][1] * scale;
                    u32x4 w; w.x = pg8::cvt_pk_bf16(v0[0], v0[1]); w.y = pg8::cvt_pk_bf16(v0[2], v0[3]); w.z = pg8::cvt_pk_bf16(v1[0], v1[1]); w.w = pg8::cvt_pk_bf16(v1[2], v1[3]);
                    st16(rowp + bj * 128, w); } }
    }
};
struct EpiMoeA {
    static constexpr bool PERM = true, EDUP = false;
    bf16_t* H; const LAS float* rstbl;
    __device__ __forceinline__ void operator()(AccRef acc, const Unit& u, int ui, int wr, int wc, int fr, int fq) const {
#pragma unroll
        for (int ai = 0; ai < 2; ++ai)
#pragma unroll
            for (int m = 0; m < 4; ++m) { bf16_t* rowp = H + (size_t)(u.pm * 256 + ai * 128 + wr * 64 + m * 16 + fr) * 512 + u.pn * 128 + wc * 32 + 8 * fq; float o[8];
                const float rs = ROUTE_MFMA ? rstbl[ui * 256 + ai * 128 + wr * 64 + m * 16 + fr] : 1.0f;
#pragma unroll
                for (int n = 0; n < 2; ++n)
#pragma unroll
                    for (int j = 0; j < 4; ++j) { const float g = acc[ai][0][m][n][j] * rs, up = acc[ai][1][m][n][j] * rs; o[4 * n + j] = g * __builtin_amdgcn_rcpf(1.0f + __builtin_amdgcn_exp2f(-LOG2E * g)) * up; }
                u32x4 w; w.x = pg8::cvt_pk_bf16(o[0], o[1]); w.y = pg8::cvt_pk_bf16(o[2], o[3]); w.z = pg8::cvt_pk_bf16(o[4], o[5]); w.w = pg8::cvt_pk_bf16(o[6], o[7]);
                st16(rowp, w); }
    }
};
struct EpiMoeB {
    static constexpr bool PERM = true, EDUP = false;
    const LAS int* rec; const int* list; bf16_t* YS;
    __device__ __forceinline__ void operator()(AccRef acc, const Unit& u, int ui, int wr, int wc, int fr, int fq) const {
        const int e = u.kind, r0 = rec[ui * 8 + 4], ne = rec[ui * 8 + 5];
        u32x2 ent[2][4];
#pragma unroll
        for (int ai = 0; ai < 2; ++ai)
#pragma unroll
            for (int m = 0; m < 4; ++m) { const int idx = r0 + ai * 128 + wr * 64 + m * 16 + fr; ent[ai][m] = (u32x2){0u, 0u};
                if (idx < ne) ent[ai][m] = *(const u32x2*)(list + ((size_t)e * LIST_CAP + idx) * 2); }
#pragma unroll
        for (int ai = 0; ai < 2; ++ai)
#pragma unroll
            for (int m = 0; m < 4; ++m) { const int idx = r0 + ai * 128 + wr * 64 + m * 16 + fr;
                if (idx < ne) { const int dest = (int)ent[ai][m].x; const float w = __uint_as_float(ent[ai][m].y);
                    bf16_t* rowp = YS + (size_t)dest * 1024 + u.pn * 256 + wc * 32 + 8 * fq;
#pragma unroll
                    for (int bj = 0; bj < 2; ++bj) { const f32x4 v0 = acc[ai][bj][m][0] * w, v1 = acc[ai][bj][m][1] * w;
                        u32x4 wv; wv.x = pg8::cvt_pk_bf16(v0[0], v0[1]); wv.y = pg8::cvt_pk_bf16(v0[2], v0[3]); wv.z = pg8::cvt_pk_bf16(v1[0], v1[1]); wv.w = pg8::cvt_pk_bf16(v1[2], v1[3]);
                        st16(rowp + bj * 128, wv); } } }
    }
};

struct EpiX1 {
    static constexpr bool PERM = true, EDUP = true;
    const float* x; const bf16_t* XB0; bf16_t* XB; float* ssq;
    __device__ __forceinline__ void operator()(AccRef acc, const Unit& u, int, int wr, int wc, int fr, int fq) const {
        const int rowb = u.pm * 256 + wr * 64 + fr; const size_t offb = (size_t)rowb * 1024 + u.pn * 256 + wc * 32 + 8 * fq;
#if X0_BF16
        u32x4 xq[2][2];
#define EPIX1_LOAD(buf, s) do { const int ai_ = (s) >> 2, m_ = (s) & 3; _Pragma("unroll") for (int bj = 0; bj < 2; ++bj) xq[buf][bj] = NT2 ? __builtin_nontemporal_load((const u32x4*)(XB0 + offb + (size_t)(ai_ * 128 + m_ * 16) * 1024 + bj * 128)) : *(const u32x4*)(XB0 + offb + (size_t)(ai_ * 128 + m_ * 16) * 1024 + bj * 128); } while (0)
#else
        f32x4 xb[2][2][2];
#define EPIX1_LOAD(buf, s) do { const int ai_ = (s) >> 2, m_ = (s) & 3; _Pragma("unroll") for (int bj = 0; bj < 2; ++bj) _Pragma("unroll") for (int n = 0; n < 2; ++n) \
            xb[buf][bj][n] = *(const f32x4*)(x + offb + (size_t)(ai_ * 128 + m_ * 16) * 1024 + bj * 128 + n * 4); } while (0)
#endif
        EPIX1_LOAD(0, 0);
#pragma unroll
        for (int s = 0; s < 8; ++s) { const int ai = s >> 2, mm = s & 3, cb = s & 1;
            if (s + 1 < 8) { if (cb == 0) EPIX1_LOAD(1, s + 1); else EPIX1_LOAD(0, s + 1); }
            float ss = 0.f;
#pragma unroll
            for (int bj = 0; bj < 2; ++bj) {
#if X0_BF16
                float b[8]; unpack8(xq[cb][bj], b); const f32x4 v0 = (f32x4){b[0], b[1], b[2], b[3]} + acc[ai][bj][mm][0], v1 = (f32x4){b[4], b[5], b[6], b[7]} + acc[ai][bj][mm][1];
#else
                const f32x4 v0 = xb[cb][bj][0] + acc[ai][bj][mm][0], v1 = xb[cb][bj][1] + acc[ai][bj][mm][1];
#endif
                ss += (v0[0] * v0[0] + v0[1] * v0[1]) + (v0[2] * v0[2] + v0[3] * v0[3]) + (v1[0] * v1[0] + v1[1] * v1[1]) + (v1[2] * v1[2] + v1[3] * v1[3]);
                u32x4 w; w.x = pg8::cvt_pk_bf16(v0[0], v0[1]); w.y = pg8::cvt_pk_bf16(v0[2], v0[3]); w.z = pg8::cvt_pk_bf16(v1[0], v1[1]); w.w = pg8::cvt_pk_bf16(v1[2], v1[3]);
                st16(XB + offb + (size_t)(ai * 128 + mm * 16) * 1024 + bj * 128, w); }
            ss += __shfl_xor(ss, 16); ss += __shfl_xor(ss, 32);
            if (fq == 0) ssq[(size_t)(rowb + ai * 128 + mm * 16) * 16 + u.pn * 4 + wc] = ss; }
#undef EPIX1_LOAD
    }
};
struct EpiQC {
    static constexpr bool PERM = true, EDUP = false;
    bf16_t* O; const float* ssq; float scale;
    __device__ __forceinline__ void operator()(AccRef acc, const Unit& u, int, int wr, int wc, int fr, int fq) const {
        f32x4 q[2][4];
#pragma unroll
        for (int ai = 0; ai < 2; ++ai)
#pragma unroll
            for (int m = 0; m < 4; ++m) q[ai][m] = *(const f32x4*)(ssq + (size_t)(u.pm * 256 + ai * 128 + wr * 64 + m * 16 + fr) * 16 + 4 * fq);
#pragma unroll
        for (int ai = 0; ai < 2; ++ai)
#pragma unroll
            for (int m = 0; m < 4; ++m) { float s = (q[ai][m][0] + q[ai][m][1]) + (q[ai][m][2] + q[ai][m][3]); s += __shfl_xor(s, 16); s += __shfl_xor(s, 32);
                const float rs = scale / sqrtf(s * (1.f / 1024.f) + EPS);
                bf16_t* rowp = O + (size_t)(u.pm * 256 + ai * 128 + wr * 64 + m * 16 + fr) * 512 + u.pn * 256 + wc * 32 + 8 * fq;
#pragma unroll
                for (int bj = 0; bj < 2; ++bj) { const f32x4 v0 = acc[ai][bj][m][0] * rs, v1 = acc[ai][bj][m][1] * rs;
                    u32x4 w; w.x = pg8::cvt_pk_bf16(v0[0], v0[1]); w.y = pg8::cvt_pk_bf16(v0[2], v0[3]); w.z = pg8::cvt_pk_bf16(v1[0], v1[1]); w.w = pg8::cvt_pk_bf16(v1[2], v1[3]);
                    st16(rowp + bj * 128, w); } }
    }
};
struct EpiX2 {
    static constexpr bool PERM = true, EDUP = false;
    const bf16_t* XB; float* out; bf16_t* XB2;
    __device__ __forceinline__ void operator()(AccRef acc, const Unit& u, int, int wr, int wc, int fr, int fq) const {
        const size_t offb = (size_t)(u.pm * 256 + wr * 64 + fr) * 1024 + u.pn * 256 + wc * 32 + 8 * fq;
        u32x4 xb[2][2];
#define EPIX2_LOAD(buf, s) do { const int ai_ = (s) >> 2, m_ = (s) & 3; _Pragma("unroll") for (int bj = 0; bj < 2; ++bj) xb[buf][bj] = NT2 ? __builtin_nontemporal_load((const u32x4*)(XB + offb + (size_t)(ai_ * 128 + m_ * 16) * 1024 + bj * 128)) : *(const u32x4*)(XB + offb + (size_t)(ai_ * 128 + m_ * 16) * 1024 + bj * 128); } while (0)
        EPIX2_LOAD(0, 0);
#pragma unroll
        for (int s = 0; s < 8; ++s) { const int ai = s >> 2, mm = s & 3, cb = s & 1;
            if (s + 1 < 8) { if (cb == 0) EPIX2_LOAD(1, s + 1); else EPIX2_LOAD(0, s + 1); }
#pragma unroll
            for (int bj = 0; bj < 2; ++bj) { float b[8]; unpack8(xb[cb][bj], b);
                const f32x4 v0 = (f32x4){b[0], b[1], b[2], b[3]} + acc[ai][bj][mm][0], v1 = (f32x4){b[4], b[5], b[6], b[7]} + acc[ai][bj][mm][1];
                const size_t o_ = offb + (size_t)(ai * 128 + mm * 16) * 1024 + bj * 128;
                if (X2_BF16) { u32x4 w; w.x = pg8::cvt_pk_bf16(v0[0], v0[1]); w.y = pg8::cvt_pk_bf16(v0[2], v0[3]); w.z = pg8::cvt_pk_bf16(v1[0], v1[1]); w.w = pg8::cvt_pk_bf16(v1[2], v1[3]); st16(XB2 + o_, w); }
                else { *(f32x4*)(out + o_) = v0; *(f32x4*)(out + o_ + 4) = v1; } } }
#undef EPIX2_LOAD
    }
};
typedef short v4i16_t __attribute__((ext_vector_type(4)));
typedef short bf16x8_t __attribute__((ext_vector_type(8)));
typedef float f32x16_t __attribute__((ext_vector_type(16)));
__device__ __forceinline__ v4i16_t lds_tr16(LAS unsigned char* p) { return __builtin_amdgcn_ds_read_tr16_b64_v4i16((LAS v4i16_t*)p); }

__device__ __forceinline__ void sgu_unit(LAS unsigned char* lds, unsigned char* ws, const PtrsIn& P, int ch) {
    const int tid = threadIdx.x, lane = tid & 63, wave = __builtin_amdgcn_readfirstlane(tid >> 6), fr = lane & 15, fq = lane >> 4;
    {
        const int row = tid >> 2, q4 = tid & 3;
        const u32x4* src = (const u32x4*)((const bf16_t*)(ws + WS_GV) + ((size_t)ch * 128 + row) * 512 + q4 * 128);
        u32x4 raw[16];
#pragma unroll
        for (int j = 0; j < 16; ++j) raw[j] = (NT2 || NT2S) ? __builtin_nontemporal_load(&src[j]) : src[j];
        float s = 0.f;
#pragma unroll
        for (int j = 0; j < 16; ++j) { float f[8]; unpack8(raw[j], f);
#pragma unroll
            for (int k = 0; k < 8; ++k) s += f[k]; }
        s += __shfl_xor(s, 1); s += __shfl_xor(s, 2);
        const float mean = s * (1.f / 512.f); float q = 0.f;
#pragma unroll
        for (int j = 0; j < 16; ++j) { float f[8]; unpack8(raw[j], f);
#pragma unroll
            for (int k = 0; k < 8; ++k) { const float d = f[k] - mean; q += d * d; } }
        q += __shfl_xor(q, 1); q += __shfl_xor(q, 2);
        const float rstd = 1.0f / sqrtf(q * (1.f / 512.f) + EPS);
        const float* lg = P.in[7] + q4 * 128; const float* lb = P.in[8] + q4 * 128;
        LAS unsigned char* dst = lds + row * SGU_ROWB + q4 * 256;
#pragma unroll
        for (int j = 0; j < 16; ++j) { float f[8]; unpack8(raw[j], f);
            const f32x4 g0 = *(const f32x4*)(lg + 8 * j), g1 = *(const f32x4*)(lg + 8 * j + 4), b0 = *(const f32x4*)(lb + 8 * j), b1 = *(const f32x4*)(lb + 8 * j + 4);
            u32x4 w; w.x = pg8::cvt_pk_bf16((f[0] - mean) * rstd * g0[0] + b0[0], (f[1] - mean) * rstd * g0[1] + b0[1]); w.y = pg8::cvt_pk_bf16((f[2] - mean) * rstd * g0[2] + b0[2], (f[3] - mean) * rstd * g0[3] + b0[3]);
            w.z = pg8::cvt_pk_bf16((f[4] - mean) * rstd * g1[0] + b1[0], (f[5] - mean) * rstd * g1[1] + b1[1]); w.w = pg8::cvt_pk_bf16((f[6] - mean) * rstd * g1[2] + b1[2], (f[7] - mean) * rstd * g1[3] + b1[3]);
            *(LAS u32x4*)(dst + j * 16) = w; }
    }
    __syncthreads();
    const int i16 = lane & 15;
    LAS unsigned char* trb = lds + (8 * fq + (i16 >> 2)) * SGU_ROWB + (i16 & 3) * 8;
    const int p = 16 * wave + fr; const size_t tok = (size_t)ch * 128 + p;
    u32x2 uu[4][8]; float bsv[4];
#pragma unroll
    for (int g = 0; g < 4; ++g) { const bf16_t* U = (const bf16_t*)(ws + WS_U) + tok * 512 + g * 128 + 4 * fq; bsv[g] = P.in[10][g * 128 + p];
#pragma unroll
        for (int nt = 0; nt < 8; ++nt) uu[g][nt] = (NT2 || NT2S) ? __builtin_nontemporal_load((const u32x2*)(U + 16 * nt)) : *(const u32x2*)(U + 16 * nt); }
#pragma unroll
    for (int g = 0; g < 4; ++g) {
        const bf16_t* W = (const bf16_t*)(ws + WS_WSS) + ((size_t)g * 128 + p) * 128 + 8 * fq;
        bf16x8_t af[4];
#pragma unroll
        for (int ks = 0; ks < 4; ++ks) af[ks] = *(const bf16x8_t*)(W + 32 * ks);
        const float bs = bsv[g];
        f32x4 acc[8];
#pragma unroll
        for (int nt = 0; nt < 8; ++nt) { acc[nt] = (f32x4){0.f, 0.f, 0.f, 0.f};
#pragma unroll
            for (int ks = 0; ks < 4; ++ks) { LAS unsigned char* a = trb + ks * 32 * SGU_ROWB + (g * 128 + 16 * nt) * 2;
                const v4i16_t lo = lds_tr16(a), hi = lds_tr16(a + 4 * SGU_ROWB);
                const bf16x8_t bfr = (bf16x8_t){lo[0], lo[1], lo[2], lo[3], hi[0], hi[1], hi[2], hi[3]};
                acc[nt] = __builtin_amdgcn_mfma_f32_16x16x32_bf16(bfr, af[ks], acc[nt], 0, 0, 0); } }
        bf16_t* SG = (bf16_t*)(ws + WS_SG) + tok * 512 + g * 128 + 4 * fq;
#pragma unroll
        for (int nt = 0; nt < 8; ++nt) { const u32x2 u2 = uu[g][nt];
            const float u0 = __uint_as_float(u2.x << 16), u1 = __uint_as_float(u2.x & 0xffff0000u), u2f = __uint_as_float(u2.y << 16), u3 = __uint_as_float(u2.y & 0xffff0000u);
            u32x2 o; o.x = pg8::cvt_pk_bf16(u0 * (acc[nt][0] + bs), u1 * (acc[nt][1] + bs)); o.y = pg8::cvt_pk_bf16(u2f * (acc[nt][2] + bs), u3 * (acc[nt][3] + bs));
            *(u32x2*)(SG + 16 * nt) = o; }
    }
    __syncthreads();
}

__device__ __forceinline__ void phase2_sgu_attn(LAS unsigned char* lds, unsigned char* lds_generic, unsigned char* ws, const PtrsIn& P, int vcu, int G) {
    for (int ch = vcu; ch < M / 128; ch += G) sgu_unit(lds, ws, P, ch);
    const int upc = (1024 + G - 1) / G;
    float cfix; { const int l64 = threadIdx.x & 63; const float mq = wave_max(fabsf(P.in[4][l64])), mk = wave_max(fabsf(P.in[5][l64])); cfix = __int_as_float(__builtin_amdgcn_readfirstlane(__float_as_int(C2_SELF * 64.0f * mq * mk))); }
    const bool fixm = ATT_FIXM && (cfix < 60.0f);
    const int nmoe = IT_TOTAL - IT_P0, per = (nmoe + G - 1) / G, it0 = IT_P0 + vcu * per, it1 = (it0 + per < IT_TOTAL) ? it0 + per : IT_TOTAL, slot = vcu % upc;
    for (int i = 0; i < upc; ++i) { const int U = vcu * upc + i;
        if (U < 1024) { const int bkv = U >> 7, jj = U & 127, hl = jj >> 5, qb = jj & 31, b = bkv >> 1, kvh = bkv & 1;
            if (fixm) attn_body::attn_unit<8, true>(b, kvh * 4 + hl, kvh, qb, (const bf16_t*)(ws + WS_Q), (const bf16_t*)(ws + WS_K), (const bf16_t*)(ws + WS_V), (bf16_t*)(ws + WS_ATT), (char*)lds_generic + RING_OFF, cfix);
            else attn_body::attn_unit<8, false>(b, kvh * 4 + hl, kvh, qb, (const bf16_t*)(ws + WS_Q), (const bf16_t*)(ws + WS_K), (const bf16_t*)(ws + WS_V), (bf16_t*)(ws + WS_ATT), (char*)lds_generic + RING_OFF, 0.f); }
        if (MOE_CONV_IN_P2 && i == slot) {
            int tid2 = threadIdx.x; asm volatile("" : "+v"(tid2));
            const int lane2 = tid2 & 63, wave2 = __builtin_amdgcn_readfirstlane(tid2 >> 6);
            LAS float* scr = (LAS float*)(lds + RING_OFF + wave2 * 16384);
            for (int it = it0 + wave2; it < it1; it += NWAVES) p0_weight_item(P, ws, scr, it, lane2);
            __syncthreads(); } }
}

__device__ __forceinline__ void cross_stage_kv(unsigned lds0, const bf16_t* KVC, int b, int h, int wave, int lane) {
#pragma unroll
    for (int j = 0; j < 8; ++j) { const int c = 2 * wave + (j >> 2), rb = j & 3;
        attn_body::glds16(KVC + (size_t)(b * NMEM + rb * 64 + lane) * 1024 + h * 128 + c * 8, (unsigned)__builtin_amdgcn_readfirstlane(lds0 + c * 4096 + rb * 1024)); }
#pragma unroll
    for (int j = 0; j < 8; ++j) { const int pc = wave * 8 + j, db = pc >> 4, r0 = (pc & 15) * 16;
        attn_body::glds16(KVC + (size_t)(b * NMEM + r0 + (lane >> 2)) * 1024 + 512 + h * 128 + db * 32 + (lane & 3) * 8, (unsigned)__builtin_amdgcn_readfirstlane(lds0 + 65536 + db * 16384 + r0 * 64)); }
}
__device__ __forceinline__ void cross_unit(LAS unsigned char* lds, const bf16_t* QC, bf16_t* OC, int row0, int h) {
    const int tid = threadIdx.x, lane = tid & 63, wave = __builtin_amdgcn_readfirstlane(tid >> 6), r32 = lane & 31, hi = lane >> 5;
    const bf16_t* Qw = QC + (size_t)(row0 + 32 * wave + r32) * 512 + h * 128 + 8 * hi;
    bf16x8_t qr[8];
#pragma unroll
    for (int ds = 0; ds < 8; ++ds) qr[ds] = *(const bf16x8_t*)(Qw + 16 * ds);
    f32x16_t p[8];
    const LAS unsigned char* kb0 = lds + hi * 4096 + r32 * 16;
#pragma unroll
    for (int kb = 0; kb < 8; ++kb) { p[kb] = f32x16_t{};
#pragma unroll
        for (int ds = 0; ds < 8; ++ds) { const bf16x8_t kf = *(const LAS bf16x8_t*)(kb0 + ds * 8192 + kb * 512); p[kb] = __builtin_amdgcn_mfma_f32_32x32x16_bf16(kf, qr[ds], p[kb], 0, 0, 0); }
        __builtin_amdgcn_sched_barrier(0); }
    float mx = -1e30f;
#pragma unroll
    for (int kb = 0; kb < 8; ++kb)
#pragma unroll
        for (int r = 0; r < 16; ++r) mx = fmaxf(mx, p[kb][r]);
    { auto rr = __builtin_amdgcn_permlane32_swap(__float_as_uint(mx), __float_as_uint(mx), false, false); mx = fmaxf(__uint_as_float(rr[0]), __uint_as_float(rr[1])); }
    float l = 0.f;
    u32x4 pw[16];
#pragma unroll
    for (int kb = 0; kb < 8; ++kb) {
#pragma unroll
        for (int r = 0; r < 16; ++r) { p[kb][r] = __builtin_amdgcn_exp2f(p[kb][r] - mx); l += p[kb][r]; }
#pragma unroll
        for (int s = 0; s < 2; ++s) { pw[2 * kb + s].x = pg8::cvt_pk_bf16(p[kb][8 * s + 0], p[kb][8 * s + 1]); pw[2 * kb + s].y = pg8::cvt_pk_bf16(p[kb][8 * s + 2], p[kb][8 * s + 3]);
            pw[2 * kb + s].z = pg8::cvt_pk_bf16(p[kb][8 * s + 4], p[kb][8 * s + 5]); pw[2 * kb + s].w = pg8::cvt_pk_bf16(p[kb][8 * s + 6], p[kb][8 * s + 7]); }
        __builtin_amdgcn_sched_barrier(0); }
    { auto rr = __builtin_amdgcn_permlane32_swap(__float_as_uint(l), __float_as_uint(l), false, false); l = __uint_as_float(rr[0]) + __uint_as_float(rr[1]); }
    const float il = 1.0f / l;
    f32x16_t o[4];
#pragma unroll
    for (int db = 0; db < 4; ++db) o[db] = f32x16_t{};
    const int i16 = lane & 15;
    LAS unsigned char* vb = lds + 65536 + (4 * hi + (i16 >> 2)) * 64 + ((lane >> 4) & 1) * 32 + (i16 & 3) * 8;
#pragma unroll
    for (int ks = 0; ks < 16; ++ks) {
        const bf16x8_t pa = __builtin_bit_cast(bf16x8_t, pw[ks]);
#pragma unroll
        for (int db = 0; db < 4; ++db) { LAS unsigned char* a = vb + db * 16384 + (16 * ks) * 64;
            const v4i16_t lo = lds_tr16(a), hh = lds_tr16(a + 512);
            const bf16x8_t vf = (bf16x8_t){lo[0], lo[1], lo[2], lo[3], hh[0], hh[1], hh[2], hh[3]};
            o[db] = __builtin_amdgcn_mfma_f32_32x32x16_bf16(vf, pa, o[db], 0, 0, 0); }
        __builtin_amdgcn_sched_barrier(0); }
    bf16_t* Ow = OC + (size_t)(row0 + 32 * wave + r32) * 512 + h * 128 + 4 * hi;
#pragma unroll
    for (int db = 0; db < 4; ++db)
#pragma unroll
        for (int rg = 0; rg < 4; ++rg) { u32x2 w; w.x = pg8::cvt_pk_bf16(o[db][4 * rg + 0] * il, o[db][4 * rg + 1] * il); w.y = pg8::cvt_pk_bf16(o[db][4 * rg + 2] * il, o[db][4 * rg + 3] * il);
            *(u32x2*)(Ow + 32 * db + 8 * rg) = w; }
}
__device__ __forceinline__ void cross_after_qc(LAS unsigned char* lds, unsigned char* lds_generic, unsigned char* ws, int pm, int pn) {
    const int tid = threadIdx.x, lane = tid & 63, wave = __builtin_amdgcn_readfirstlane(tid >> 6);
    const unsigned lds0 = (unsigned)(uintptr_t)(lds_generic + RING_OFF);
    for (int hh = 0; hh < 2; ++hh) { const int h = 2 * pn + hh, b = pm >> 5;
        cross_stage_kv(lds0, (const bf16_t*)(ws + WS_KVC), b, h, wave, lane);
        asm volatile("s_waitcnt vmcnt(0)" ::: "memory"); __syncthreads();
        cross_unit(lds, (const bf16_t*)(ws + WS_QC), (bf16_t*)(ws + WS_OC), pm * 256, h);
        __syncthreads(); }
}
__device__ __forceinline__ void phase7_cross(LAS unsigned char* lds, unsigned char* lds_generic, unsigned char* ws, int vcu, int G) {
    const int tid = threadIdx.x, lane = tid & 63, wave = __builtin_amdgcn_readfirstlane(tid >> 6);
    const unsigned lds0 = (unsigned)(uintptr_t)(lds_generic + RING_OFF);
    for (int j = vcu; j < 256; j += G) { const int h = j & 3, pp = j >> 2, b = pp >> 4;
        cross_stage_kv(lds0, (const bf16_t*)(ws + WS_KVC), b, h, wave, lane);
        asm volatile("s_waitcnt vmcnt(0)" ::: "memory"); __syncthreads();
        cross_unit(lds, (const bf16_t*)(ws + WS_QC), (bf16_t*)(ws + WS_OC), (2 * pp) * 256, h);
        cross_unit(lds, (const bf16_t*)(ws + WS_QC), (bf16_t*)(ws + WS_OC), (2 * pp + 1) * 256, h);
        __syncthreads(); }
}
struct Args { PtrsIn P; float* out; unsigned char* ws; int ph_lo, ph_hi; };
static_assert(sizeof(Args) == 27 * 8 + 24, "Args has no holes");

__device__ __forceinline__ void moe_setup(LAS unsigned char* lds, unsigned char* ws, int vcu, int G, bool with_gather) {
    LAS int* rec = (LAS int*)(lds + UREC_OFF); LAS unsigned* tbl = (LAS unsigned*)(lds + TBL_OFF);
    const int tid = threadIdx.x;
    const unsigned* ec = (const unsigned*)(ws + WS_CTL) + CW_ECNT;
    int cnt[16], pb[17]; pb[0] = 0;
#pragma unroll
    for (int e = 0; e < 16; ++e) { cnt[e] = (int)__hip_atomic_load(ec + 64 * e, __ATOMIC_RELAXED, __HIP_MEMORY_SCOPE_AGENT); pb[e + 1] = pb[e] + ((cnt[e] + 255) >> 8); }
    const int NP = pb[16];
    LAS float* rstbl = (LAS float*)(lds + RSTBL_OFF);
    for (int i = 0; i < MOE_MAXU; ++i) {
        const int L = i * G + vcu; const bool valid = (L < 4 * NP);
        int panel = 0, pn = 0, e = 0, r0 = 0, ne = 0;
        if (valid) { panel = L >> 2; pn = L & 3;
#pragma unroll
            for (int j = 1; j < 16; ++j) if (panel >= pb[j]) e = j;
#pragma unroll
            for (int j = 0; j < 16; ++j) if (j == e) { r0 = (panel - pb[j]) * 256; ne = cnt[j]; } }
        if (tid == 0) { rec[i * 8 + 0] = valid ? 1 : 0; rec[i * 8 + 1] = panel; rec[i * 8 + 2] = pn; rec[i * 8 + 3] = e; rec[i * 8 + 4] = r0; rec[i * 8 + 5] = ne; }
        if (with_gather && tid < 256) { unsigned off = 0u; float rsv = 0.f;
            if (valid && r0 + tid < ne) { const int dest = ((const int*)(ws + WS_LIST))[((size_t)e * LIST_CAP + r0 + tid) * 2]; off = (unsigned)(dest >> 1) * 2048u; if (ROUTE_MFMA) rsv = ((const float*)(ws + WS_RSTOK))[dest >> 1]; }
            tbl[i * 256 + tid] = off; rstbl[i * 256 + tid] = rsv; }
    }
    if (tid == 0) rec[MOE_MAXU * 8] = 4 * NP;
    __syncthreads();
}

#ifndef LB_W
#define LB_W 2
#endif
__global__ void __launch_bounds__(NWAVES * 64, LB_W) mega(Args args) {
    extern __shared__ __attribute__((aligned(16))) unsigned char lds_raw[];
    LAS unsigned char* lds = (LAS unsigned char*)lds_raw;
    volatile LAS unsigned* MISC = (volatile LAS unsigned*)(lds + MISC_OFF);
    const int tid = threadIdx.x, lane = tid & 63, wave = __builtin_amdgcn_readfirstlane(tid >> 6);
    const int G = gridDim.x, bx = blockIdx.x, vcu = (G % 8 == 0) ? (bx % 8) * (G / 8) + bx / 8 : bx;
    unsigned char* ws = args.ws; const PtrsIn& P = args.P; float* out = args.out;
    for (int u = tid; u < (LDS_BYTES - MISC_OFF) / 4; u += NWAVES * 64) ((LAS unsigned*)(lds + MISC_OFF))[u] = 0u;
    __syncthreads();
    const int lo = args.ph_lo, hi = args.ph_hi;
    const bool fusedrun = (hi - lo) > 1;
    XcdBarrier bar; bar.bar = (unsigned*)(ws + WS_CTL) + CW_BAR; bar.x = 0; bar.st = nullptr;
    if (fusedrun) bar = xcd_barrier_post((unsigned*)(ws + WS_CTL) + CW_BAR, MISC + 8);
#ifndef P0_ROWS_FIRST
#define P0_ROWS_FIRST 1
#endif
#ifndef TAIL_E0
#define TAIL_E0 16
#endif
#ifndef STAG_Y
#define STAG_Y 0u
#endif
#ifndef STAG_MA
#define STAG_MA 0u
#endif
#ifndef STAG_MB
#define STAG_MB 0u
#endif
#ifndef ALIGN_E
#define ALIGN_E true
#endif
#ifndef PH_EN
#define PH_EN 0x1FFF
#endif
#define IN(k) ((((PH_EN) >> (k)) & 1) && lo <= (k) && (k) < hi)
#define SEAM(k) do { if (IN(k) && IN((k) + 1)) xcd_barrier(bar); } while (0)
#ifndef PH_DUP
#define PH_DUP 0
#endif
#define NREP(k) ((((PH_DUP) >> (k)) & 1) ? 2 : 1)
#define REPSEAM(k) do { if (NREP(k) == 2 && rep_ == 0 && fusedrun) xcd_barrier(bar); } while (0)
    const int gw = vcu * NWAVES + wave, NGW = G * NWAVES;

    if (IN(0)) {
        _Pragma("unroll") for (int rep_ = 0; rep_ < NREP(0); ++rep_) {
        LAS float* scr = (LAS float*)(lds + RING_OFF + wave * 16384);
        const bool tailconv = TAIL_CONV && (G == 256);
#if P0_ROWS_FIRST
        bf16_t* XN = (bf16_t*)(ws + WS_XN);
        if (X0_BF16) xb0_rows(P.in[0], XN, (float*)(ws + WS_RS0), gw, NGW, M, lane); else rms_rows(P.in[0], P.in[2], XN, gw, NGW, M, lane);
        rms_rows(P.in[1], P.in[14], XN + (size_t)M * D, gw, NGW, MMEM, lane);
#endif
        for (int it = gw; it < ((MOE_CONV_IN_P2 || tailconv) ? IT_P0 : IT_TOTAL); it += NGW) p0_weight_item(P, ws, scr, it, lane);
        if (tailconv) for (int j = TAIL_E0 * 512 + gw; j < NE * 512; j += NGW) p0_weight_item(P, ws, scr, IT_P0 + (j >> 9) * 768 + (j & 511), lane);
        { const float* wsrc = P.in[9]; bf16_t* wd = (bf16_t*)(ws + WS_WSS);
          for (int i = bx * 512 + tid; i < 4 * 128 * 128; i += G * 512) wd[i] = (bf16_t)f2bf(wsrc[i]); }
        for (int i = bx * 512 + tid; i < 2048; i += G * 512) rope_table_entry((float*)(ws + WS_TAB), i);
#if !P0_ROWS_FIRST
        bf16_t* XN = (bf16_t*)(ws + WS_XN);
        if (X0_BF16) xb0_rows(P.in[0], XN, (float*)(ws + WS_RS0), gw, NGW, M, lane); else rms_rows(P.in[0], P.in[2], XN, gw, NGW, M, lane);
        rms_rows(P.in[1], P.in[14], XN + (size_t)M * D, gw, NGW, MMEM, lane);
#endif
            REPSEAM(0); }
    }
    SEAM(0);
    if (IN(1)) {
        _Pragma("unroll") for (int rep_ = 0; rep_ < NREP(1); ++rep_) {
        SchedZ S{(const char*)(ws + WS_XN), (const char*)(ws + WS_WZ), G, bx};
        EpiZ E{ws, P.in[4], P.in[5], (const float*)(ws + WS_TAB), (const float*)(ws + WS_RS0)};
        pg8::gemm_phase<EpiZ, SchedZ, ALIGN_E, false>(lds + RING_OFF, 1024, S, E);
        if (TAIL_CONV && G == 256 && bx >= 144) {
            int tid2 = threadIdx.x; asm volatile("" : "+v"(tid2)); const int lane2 = tid2 & 63, wave2 = __builtin_amdgcn_readfirstlane(tid2 >> 6);
            LAS float* scr = (LAS float*)(lds + RING_OFF + wave2 * 16384);
            for (int j = (bx - 144) * NWAVES + wave2; j < TAIL_E0 * 512; j += 112 * NWAVES) p0_weight_item(P, ws, scr, IT_P0 + (j >> 9) * 768 + (j & 511), lane2); }
            REPSEAM(1); }
    }
    SEAM(1);
    if (IN(2)) {
        _Pragma("unroll") for (int rep_ = 0; rep_ < NREP(2); ++rep_) {
        phase2_sgu_attn(lds, lds_raw, ws, P, vcu, G);
            REPSEAM(2); }
    }
    SEAM(2);
    if (IN(3)) {
        _Pragma("unroll") for (int rep_ = 0; rep_ < NREP(3); ++rep_) {
        SchedY S{(const char*)ws, G, bx};
        EpiY E{(bf16_t*)(ws + WS_GSCR) + (size_t)bx * 65536, (bf16_t*)(ws + WS_MERGED), (const float*)(ws + WS_RS0)};
#ifdef PROBE_KDUP_Y
        SchedDup<SchedY> SD{S}; pg8::gemm_phase<EpiY, SchedDup<SchedY>, ALIGN_E, false, true>(lds + RING_OFF, 1024, SD, E, STAG_Y);
#else
        pg8::gemm_phase<EpiY, SchedY, ALIGN_E, false, true>(lds + RING_OFF, 1024, S, E, STAG_Y);
#endif
            REPSEAM(3); }
    }
    SEAM(3);
    if (IN(4)) {
        _Pragma("unroll") for (int rep_ = 0; rep_ < NREP(4); ++rep_) {
        SchedPlain S{(const char*)(ws + WS_MERGED), (const char*)(ws + WS_WOUT), 128, 4, G, bx, 1024};
#if FOLD_GAINS
        EpiX1 E{P.in[0], (const bf16_t*)(ws + WS_XN), (bf16_t*)(ws + WS_XN1), (float*)(ws + WS_SSQ1)};
#ifdef PROBE_KDUP
        SchedDup<SchedPlain> SD{S}; pg8::gemm_phase<EpiX1, SchedDup<SchedPlain>, ALIGN_E, false>(lds + RING_OFF, 1024, SD, E);
#else
        pg8::gemm_phase<EpiX1, SchedPlain, ALIGN_E, false>(lds + RING_OFF, 1024, S, E);
#endif
#else
        EpiRes E{P.in[0], out};
        pg8::gemm_phase<EpiRes, SchedPlain, ALIGN_E, false>(lds + RING_OFF, 1024, S, E);
#endif
            REPSEAM(4); }
    }
    SEAM(4);
    if (IN(5)) {
        _Pragma("unroll") for (int rep_ = 0; rep_ < NREP(5); ++rep_) {
        bf16_t* XN1 = (bf16_t*)(ws + WS_XN1);
        if (!FOLD_GAINS) rms_rows(out, P.in[13], XN1, gw, NGW, M, lane);
            REPSEAM(5); }
    }
    if (!FOLD_GAINS) SEAM(5);
    if (IN(6)) {
        _Pragma("unroll") for (int rep_ = 0; rep_ < NREP(6); ++rep_) {
        SchedPlain S{(const char*)(ws + WS_XN1), (const char*)(ws + WS_WCQ), 128, 2, G, bx, 1024};
#if FOLD_GAINS
        EpiQC E{(bf16_t*)(ws + WS_QC), (const float*)(ws + WS_SSQ1), C2_CROSS};
        pg8::gemm_phase<EpiQC, SchedPlain, ALIGN_E, false>(lds + RING_OFF, 1024, S, E);
#if MERGE_QC_CROSS
        asm volatile("s_waitcnt vmcnt(0)" ::: "memory"); __syncthreads();
        { Unit u; for (int i = 0; S.next(i, u); ++i) cross_after_qc(lds, lds_raw, ws, u.pm, u.pn); }
#endif
#else
        EpiBf16s E{(bf16_t*)(ws + WS_QC), 512, C2_CROSS};
        pg8::gemm_phase<EpiBf16s, SchedPlain, ALIGN_E, false>(lds + RING_OFF, 1024, S, E);
#endif
            REPSEAM(6); }
    }
    if (!(MERGE_QC_CROSS && FOLD_GAINS)) SEAM(6);
    if (IN(7)) {
        _Pragma("unroll") for (int rep_ = 0; rep_ < NREP(7); ++rep_) {
        if (!(MERGE_QC_CROSS && FOLD_GAINS)) phase7_cross(lds, lds_raw, ws, vcu, G);
            REPSEAM(7); }
    }
    SEAM(7);
    if (IN(8)) {
        SchedPlain S{(const char*)(ws + WS_OC), (const char*)(ws + WS_WCO), 128, 4, G, bx, 512};
#if FOLD_GAINS
        EpiX2 E{(const bf16_t*)(ws + WS_XN1), out, (bf16_t*)(ws + WS_XN3)};
        pg8::gemm_phase<EpiX2, SchedPlain, ALIGN_E, false>(lds + RING_OFF, 512, S, E);
#else
        EpiRes E{out, out};
        pg8::gemm_phase<EpiRes, SchedPlain, ALIGN_E, false>(lds + RING_OFF, 512, S, E);
#endif
        if (!FOLD_GAINS && NREP(8) == 2) { if (fusedrun) xcd_barrier(bar); EpiRes E2{out, (float*)(ws + WS_Q)}; pg8::gemm_phase<EpiRes, SchedPlain, ALIGN_E, false>(lds + RING_OFF, 512, S, E2); }
    }
    SEAM(8);
#if ROUTE_MFMA
    if (IN(9)) {
#if X2_BF16
        LAS bf16_t* WH = (LAS bf16_t*)(lds + RING_OFF);
        LAS bf16_t* WM = WH + 20 * 1032;
        LAS float* PART = (LAS float*)(lds + RING_OFF + 2 * 20 * 1032 * 2);
        LAS float* SSQP = PART + 2 * 4 * 32 * 33;
        LAS int* te = (LAS int*)(SSQP + 2 * 4 * 2 * 32); LAS float* tw = (LAS float*)(te + 256); LAS int* tp = (LAS int*)(tw + 256); LAS int* ebase = tp + 256;
        for (int i = tid; i < 1024 * 20; i += 512) { const int kk = i / 20, o = i % 20; const float w = (o < 4 ? P.in[19][kk * 4 + o] : P.in[21][kk * 16 + (o - 4)]) * P.in[18][kk];
            const unsigned hb = f2bf(w); const float rem = w - __uint_as_float(hb << 16); WH[o * 1032 + kk] = (bf16_t)hb; WM[o * 1032 + kk] = (bf16_t)f2bf(rem); }
        __syncthreads();
        const int tg = wave & 3, kh = wave >> 2, n = lane & 31, hh = lane >> 5;
        bf16_t* XB2 = (bf16_t*)(ws + WS_XN3); float* rstok = (float*)(ws + WS_RSTOK);
        const LAS bf16_t* whr = WH + (n < 20 ? n : 19) * 1032 + kh * 512 + 8 * hh; const LAS bf16_t* wmr = WM + (n < 20 ? n : 19) * 1032 + kh * 512 + 8 * hh;
        for (int tb = vcu; tb < M / 128; tb += G) {
            const int t0 = tb * 128; const size_t eoff = (size_t)(t0 + tg * 32 + n) * 1024 + kh * 512 + 8 * hh;
            f32x16_t acc = f32x16_t{}; float ssq = 0.f;
            for (int jb = 0; jb < 32; jb += 8) { u32x4 xv[8];
#pragma unroll
                for (int j = 0; j < 8; ++j) xv[j] = *(const u32x4*)(XB2 + eoff + 16 * (jb + j));
#pragma unroll
                for (int j = 0; j < 8; ++j) { const bf16x8_t wh = *(const LAS bf16x8_t*)(whr + 16 * (jb + j)), wm = *(const LAS bf16x8_t*)(wmr + 16 * (jb + j));
                    float xf[8]; unpack8(xv[j], xf);
                    ssq += ((xf[0] * xf[0] + xf[1] * xf[1]) + (xf[2] * xf[2] + xf[3] * xf[3])) + ((xf[4] * xf[4] + xf[5] * xf[5]) + (xf[6] * xf[6] + xf[7] * xf[7]));
                    const bf16x8_t xa = __builtin_bit_cast(bf16x8_t, xv[j]);
                    acc = __builtin_amdgcn_mfma_f32_32x32x16_bf16(xa, wh, acc, 0, 0, 0); acc = __builtin_amdgcn_mfma_f32_32x32x16_bf16(xa, wm, acc, 0, 0, 0); } }
#else
        LAS float* WT = (LAS float*)(lds + RING_OFF);
        LAS float* PART = WT + 20 * 1028;
        LAS float* SSQP = PART + 2 * 4 * 32 * 33;
        LAS int* te = (LAS int*)(SSQP + 2 * 4 * 2 * 32); LAS float* tw = (LAS float*)(te + 256); LAS int* tp = (LAS int*)(tw + 256); LAS int* ebase = tp + 256;
        for (int i = tid; i < 1024 * 4; i += 512) { const int kk = i >> 2, o = i & 3; WT[o * 1028 + kk] = P.in[19][i] * P.in[18][kk]; }
        for (int i = tid; i < 1024 * 16; i += 512) { const int kk = i >> 4, o = i & 15; WT[(4 + o) * 1028 + kk] = P.in[21][i] * P.in[18][kk]; }
        __syncthreads();
        const int tg = wave & 3, kh = wave >> 2, n = lane & 31, hh = lane >> 5;
        bf16_t* XB2 = (bf16_t*)(ws + WS_XN3); float* rstok = (float*)(ws + WS_RSTOK);
        const LAS float* wrow = WT + (n < 20 ? n : 19) * 1028 + kh * 512 + 4 * hh;
        for (int tb = vcu; tb < M / 128; tb += G) {
            const int t0 = tb * 128; const size_t eoff = (size_t)(t0 + tg * 32 + n) * 1024 + kh * 512 + 4 * hh;
            f32x16_t acc = f32x16_t{}; float ssq = 0.f;
            for (int jb = 0; jb < 64; jb += 8) { f32x4 xv[8];
#pragma unroll
                for (int j = 0; j < 8; ++j) {
                    if (X2_BF16) { const u32x2 q = *(const u32x2*)(XB2 + eoff + 8 * (jb + j)); xv[j] = (f32x4){__uint_as_float(q.x << 16), __uint_as_float(q.x & 0xffff0000u), __uint_as_float(q.y << 16), __uint_as_float(q.y & 0xffff0000u)}; }
                    else xv[j] = *(const f32x4*)(out + eoff + 8 * (jb + j)); }
#pragma unroll
                for (int j = 0; j < 8; ++j) { const f32x4 wv = *(const LAS f32x4*)(wrow + 8 * (jb + j)); const f32x4 x = xv[j];
                    ssq += (x[0] * x[0] + x[1] * x[1]) + (x[2] * x[2] + x[3] * x[3]);
                    acc = __builtin_amdgcn_mfma_f32_32x32x2f32(x[0], wv[0], acc, 0, 0, 0); acc = __builtin_amdgcn_mfma_f32_32x32x2f32(x[1], wv[1], acc, 0, 0, 0);
                    acc = __builtin_amdgcn_mfma_f32_32x32x2f32(x[2], wv[2], acc, 0, 0, 0); acc = __builtin_amdgcn_mfma_f32_32x32x2f32(x[3], wv[3], acc, 0, 0, 0);
                    if (!X2_BF16) { u32x2 w; w.x = pg8::cvt_pk_bf16(x[0], x[1]); w.y = pg8::cvt_pk_bf16(x[2], x[3]); *(u32x2*)(XB2 + eoff + 8 * (jb + j)) = w; } } }
#endif
#pragma unroll
            for (int r = 0; r < 16; ++r) PART[((kh * 4 + tg) * 32 + ((r & 3) + 8 * (r >> 2) + 4 * hh)) * 33 + n] = acc[r];
            SSQP[((kh * 4 + tg) * 2 + hh) * 32 + n] = ssq;
            __syncthreads();
            if (wave < 4 && lane < 32) { const int tl = wave * 32 + lane, t = t0 + tl;
                const float s = (SSQP[((0 * 4 + wave) * 2 + 0) * 32 + lane] + SSQP[((0 * 4 + wave) * 2 + 1) * 32 + lane]) + (SSQP[((1 * 4 + wave) * 2 + 0) * 32 + lane] + SSQP[((1 * 4 + wave) * 2 + 1) * 32 + lane]);
                const float rs = 1.0f / sqrtf(s * (1.f / 1024.f) + EPS);
                float lg[20];
#pragma unroll
                for (int nn = 0; nn < 20; ++nn) lg[nn] = (PART[((0 * 4 + wave) * 32 + lane) * 33 + nn] + PART[((1 * 4 + wave) * 32 + lane) * 33 + nn]) * rs;
                int e0, e1; float w0, w1; route_decide(lg, P.in[20], P.in[22], e0, e1, w0, w1);
                te[2 * tl] = e0; te[2 * tl + 1] = e1; tw[2 * tl] = w0; tw[2 * tl + 1] = w1; rstok[t] = rs; }
            __syncthreads();
            if (wave == 0) {
                int cnt = 0; int mye[4];
#pragma unroll
                for (int j = 0; j < 4; ++j) mye[j] = te[j * 64 + lane];
                int pos[4] = {0, 0, 0, 0};
                for (int e = 0; e < 16; ++e) { int run = 0;
#pragma unroll
                    for (int j = 0; j < 4; ++j) { const unsigned long long mk = __ballot(mye[j] == e); const int before = __popcll(mk & ((1ull << lane) - 1ull));
                        if (mye[j] == e) pos[j] = run + before; run += __popcll(mk); }
                    if (lane == e) cnt = run; }
#pragma unroll
                for (int j = 0; j < 4; ++j) tp[j * 64 + lane] = pos[j];
                if (lane < 16) { unsigned* ec = (unsigned*)(ws + WS_CTL) + CW_ECNT + 64 * lane; ebase[lane] = (int)atomicAdd(ec, (unsigned)cnt); }
            }
            __syncthreads();
            if (tid < 256) { const int e = te[tid], slot = ebase[e] + tp[tid], dest = (t0 * 2) + tid; const float w = tw[tid];
                int* lst = (int*)(ws + WS_LIST) + ((size_t)e * LIST_CAP + slot) * 2; lst[0] = dest; lst[1] = __float_as_int(w); }
            __syncthreads();
        }
    }
#else
    if (IN(9)) {
        LAS float* rw = (LAS float*)(lds + RING_OFF);
        LAS int* te = (LAS int*)(lds + RING_OFF + 20 * 1024 * 4); LAS float* tw = (LAS float*)(te + 256); LAS int* tp = (LAS int*)(tw + 256); LAS int* ebase = tp + 256;
        for (int i = tid; i < 1024 * 4; i += 512) { const int k = i >> 2, o = i & 3; rw[o * 1024 + k] = P.in[19][i]; }
        for (int i = tid; i < 1024 * 16; i += 512) { const int k = i >> 4, o = i & 15; rw[(4 + o) * 1024 + k] = P.in[21][i]; }
        __syncthreads();
        bf16_t* XN3 = (bf16_t*)(ws + WS_XN3);
        if (NREP(9) == 2) { for (int tb = vcu; tb < M / 128; tb += G) { const int t0 = tb * 128; Row4 rcur = row_load(out + (size_t)(t0 + wave * 16) * D, lane);
            for (int i = 0; i < 16; ++i) { const int tl = wave * 16 + i, t = t0 + tl; int e0, e1; float w0, w1; const Row4 rnxt = row_load(out + (size_t)(t + (i < 15 ? 1 : 0)) * D, lane);
                route_token(rcur, P.in[18], rw, P.in[20], P.in[22], XN3 + (size_t)t * D, lane, e0, e1, w0, w1); rcur = rnxt; if (lane == 0) { te[2 * tl] = e0; tw[2 * tl] = w0 + w1 + (float)e1; } } }
            if (fusedrun) xcd_barrier(bar); }
        for (int tb = vcu; tb < M / 128; tb += G) {
            const int t0 = tb * 128;
            Row4 rcur = row_load(out + (size_t)(t0 + wave * 16) * D, lane);
            for (int i = 0; i < 16; ++i) { const int tl = wave * 16 + i, t = t0 + tl; int e0, e1; float w0, w1;
                const Row4 rnxt = row_load(out + (size_t)(t + (i < 15 ? 1 : 0)) * D, lane);
                route_token(rcur, P.in[18], rw, P.in[20], P.in[22], XN3 + (size_t)t * D, lane, e0, e1, w0, w1); rcur = rnxt;
                if (lane == 0) { te[2 * tl] = e0; te[2 * tl + 1] = e1; tw[2 * tl] = w0; tw[2 * tl + 1] = w1; } }
            __syncthreads();
            if (wave == 0) {
                int cnt = 0; int mye[4];
#pragma unroll
                for (int j = 0; j < 4; ++j) mye[j] = te[j * 64 + lane];
                int pos[4] = {0, 0, 0, 0};
                for (int e = 0; e < 16; ++e) { int run = 0;
#pragma unroll
                    for (int j = 0; j < 4; ++j) { const unsigned long long mk = __ballot(mye[j] == e); const int before = __popcll(mk & ((1ull << lane) - 1ull));
                        if (mye[j] == e) pos[j] = run + before; run += __popcll(mk); }
                    if (lane == e) cnt = run; }
#pragma unroll
                for (int j = 0; j < 4; ++j) tp[j * 64 + lane] = pos[j];
                if (lane < 16) { unsigned* ec = (unsigned*)(ws + WS_CTL) + CW_ECNT + 64 * lane; ebase[lane] = (int)atomicAdd(ec, (unsigned)cnt); }
            }
            __syncthreads();
            if (tid < 256) { const int e = te[tid], slot = ebase[e] + tp[tid], dest = (t0 * 2) + tid; const float w = tw[tid];
                int* lst = (int*)(ws + WS_LIST) + ((size_t)e * LIST_CAP + slot) * 2; lst[0] = dest; lst[1] = __float_as_int(w);
                int* ti = (int*)(ws + WS_TOKINFO) + (size_t)dest * 2; ti[0] = e; ti[1] = __float_as_int(w); }
            __syncthreads();
        }
    }
#endif
    SEAM(9);
    if (IN(10)) {
        _Pragma("unroll") for (int rep_ = 0; rep_ < NREP(10); ++rep_) {
        moe_setup(lds, ws, vcu, G, true);
        SchedMoe S{(const LAS int*)(lds + UREC_OFF), (const LAS unsigned*)(lds + TBL_OFF), (const char*)(ws + WS_XN3), (const char*)(ws + WS_WGU), 0, (size_t)1024 * 1024 * 2, (size_t)256 * 1024 * 2, true};
        EpiMoeA E{(bf16_t*)(ws + WS_H), (const LAS float*)(lds + RSTBL_OFF)};
        pg8::gemm_phase<EpiMoeA, SchedMoe, ALIGN_E, true>(lds + RING_OFF, 1024, S, E, STAG_MA);
        if (TAIL_CONV && G == 256) {
            const LAS int* rec = (const LAS int*)(lds + UREC_OFF); int myu = 0;
            for (int i = 0; i < MOE_MAXU; ++i) myu += rec[i * 8];
            const int nu = rec[MOE_MAXU * 8], rem = nu % G, maxu = (nu + G - 1) / G;
            const bool idle = (rem == 0) || (myu < maxu); const int nidle = (rem == 0) ? G : G - rem, rank = (rem == 0) ? vcu : vcu - rem;
            if (idle) { int tid2 = threadIdx.x; asm volatile("" : "+v"(tid2)); const int lane2 = tid2 & 63, wave2 = __builtin_amdgcn_readfirstlane(tid2 >> 6);
                LAS float* scr = (LAS float*)(lds + RING_OFF + wave2 * 16384);
                for (int j = rank * NWAVES + wave2; j < NE * 256; j += nidle * NWAVES) p0_weight_item(P, ws, scr, IT_P0 + (j >> 8) * 768 + 512 + (j & 255), lane2); } }
            REPSEAM(10); }
    }
    SEAM(10);
    if (IN(11)) {
        _Pragma("unroll") for (int rep_ = 0; rep_ < NREP(11); ++rep_) {
        moe_setup(lds, ws, vcu, G, false);
        SchedMoe S{(const LAS int*)(lds + UREC_OFF), (const LAS unsigned*)(lds + TBL_OFF), (const char*)(ws + WS_H), (const char*)(ws + WS_WD), (size_t)256 * 512 * 2, (size_t)1024 * 512 * 2, (size_t)256 * 512 * 2, false};
        EpiMoeB E{(const LAS int*)(lds + UREC_OFF), (const int*)(ws + WS_LIST), (bf16_t*)(ws + WS_YS)};
        pg8::gemm_phase<EpiMoeB, SchedMoe, ALIGN_E, false>(lds + RING_OFF, 512, S, E, STAG_MB);
            REPSEAM(11); }
    }
    SEAM(11);
    if (IN(12)) {
        const bf16_t* ys = (const bf16_t*)(ws + WS_YS);
        if (NREP(12) == 2) { float* dead = (float*)(ws + WS_H);
            for (int m = gw; m < M; m += NGW) { RowF r = rowf_load(out + (size_t)m * D, ys + (size_t)m * 2048, lane); const f32x4* src = (const f32x4*)(out + (size_t)m * D) + lane; f32x4* dd = (f32x4*)(dead + (size_t)m * D) + lane;
                (void)src; rowf_store(r, dead + (size_t)m * D, P.in[26], lane); (void)dd; }
            if (fusedrun) xcd_barrier(bar); }
        if (X2_BF16) final_rows_b(out, (const bf16_t*)(ws + WS_XN3), ys, P.in[26], gw, NGW, M, lane); else final_rows(out, ys, P.in[26], gw, NGW, M, lane);
    }
#undef IN
#undef SEAM
}
#ifndef OPT_MASK
#define OPT_MASK 0x1FFF
#endif
#ifndef FUSED
#define FUSED 1
#endif
static void launch_mega(const Args& a0, int lo, int hi, int grid, hipStream_t stream) {
    Args a = a0; a.ph_lo = lo; a.ph_hi = hi;
    hipLaunchKernelGGL(mega, dim3(grid), dim3(NWAVES * 64), LDS_BYTES, stream, a);
    const hipError_t le = hipPeekAtLastError();
    if (le != hipSuccess) fprintf(stderr, "kernel_launch: launch [%d,%d) failed: %s\n", lo, hi, hipGetErrorName(le));
}
extern "C" void kernel_launch(void* const* d_in, const int* in_sizes, int n_in, void* d_out, int out_size, void* d_ws, size_t ws_size, hipStream_t stream) {
    static int grid = 0;
    if (grid == 0) {
        if (n_in != 27 || in_sizes[0] != M * D || out_size != M * D || ws_size < WS_END) { fprintf(stderr, "kernel_launch: unexpected problem (n_in %d, in0 %d, out %d, ws %zu)\n", n_in, n_in > 0 ? in_sizes[0] : -1, out_size, ws_size); grid = -1; return; }
        (void)hipFuncSetAttribute((const void*)k_route, hipFuncAttributeMaxDynamicSharedMemorySize, 20 * 1024 * 4 + 4096);
        (void)hipFuncSetAttribute((const void*)nv_sgu, hipFuncAttributeMaxDynamicSharedMemorySize, 128 * 129 * 4 + 1024);
        (void)hipFuncSetAttribute((const void*)nv_attn, hipFuncAttributeMaxDynamicSharedMemorySize, 4 * 64 * 65 * 4);
        (void)hipFuncSetAttribute((const void*)k_prologue, hipFuncAttributeMaxDynamicSharedMemorySize, 8 * 64 * 33 * 4);
        if (hipFuncSetAttribute((const void*)mega, hipFuncAttributeMaxDynamicSharedMemorySize, LDS_BYTES) != hipSuccess) { fprintf(stderr, "kernel_launch: hipFuncSetAttribute(mega) failed\n"); grid = -1; return; }
        int dev = 0, cus = 0, per_cu = 0;
        if (hipGetDevice(&dev) != hipSuccess || hipDeviceGetAttribute(&cus, hipDeviceAttributeMultiprocessorCount, dev) != hipSuccess) { grid = -1; return; }
        if (hipOccupancyMaxActiveBlocksPerMultiprocessor(&per_cu, (const void*)mega, NWAVES * 64, LDS_BYTES) != hipSuccess || per_cu < 1) fprintf(stderr, "kernel_launch: occupancy query says %d blocks per CU\n", per_cu);
        (void)hipGetLastError();
        grid = cus;
    }
    if (grid < 0) return;
    unsigned char* ws = (unsigned char*)d_ws; float* out = (float*)d_out;
    Args a{}; for (int i = 0; i < 27; ++i) a.P.in[i] = (const float*)d_in[i];
    a.out = out; a.ws = ws; a.ph_lo = 0; a.ph_hi = NPHASE;
    const PtrsIn& P = a.P;
    (void)hipMemsetAsync(ws + WS_CTL, 0, CTL_ZERO_BYTES, stream);
#if FUSED
    launch_mega(a, 0, NPHASE, grid, stream);
#else
    float* scr = (float*)(ws + WS_SCR);
    bf16_t* XN = (bf16_t*)(ws + WS_XN);
    for (int ph = 0; ph < NPHASE; ++ph) {
        if ((OPT_MASK >> ph) & 1) { launch_mega(a, ph, ph + 1, grid, stream); continue; }
        switch (ph) {
        case 0: hipLaunchKernelGGL(k_prologue, dim3(256), dim3(512), 8 * 64 * 33 * 4, stream, P, ws); break;
        case 1:
            for (int c = 0; c < M / 4096; ++c) {
                hipLaunchKernelGGL(nv_gemm, dim3(NZ / 64, 4096 / 64), dim3(256), 0, stream, XN + (size_t)c * 4096 * D, D, (const bf16_t*)(ws + WS_WZ), D, D, scr, NZ);
                hipLaunchKernelGGL(nv_z_epi, dim3(4096), dim3(256), 0, stream, (const float*)scr, c * 4096, P, ws); }
            hipLaunchKernelGGL(nv_gemm, dim3(1024 / 64, MMEM / 64), dim3(256), 0, stream, XN + (size_t)M * D, D, (const bf16_t*)(ws + WS_WZ) + (size_t)NZ * D, D, D, scr, 1024);
            hipLaunchKernelGGL(nv_store_bf16, dim3(1024), dim3(256), 0, stream, (const float*)scr, (bf16_t*)(ws + WS_KVC), (size_t)MMEM * 1024, 1.0f);
            break;
        case 2:
            hipLaunchKernelGGL(nv_attn, dim3(SEQ / 64, 8, BATCH), dim3(256), 4 * 64 * 65 * 4, stream, (const bf16_t*)(ws + WS_Q), (const bf16_t*)(ws + WS_K), (const bf16_t*)(ws + WS_V), (bf16_t*)(ws + WS_ATT));
            hipLaunchKernelGGL(nv_sgu, dim3(M / 128, 4), dim3(256), 128 * 129 * 4 + 1024, stream, P, ws);
            break;
        case 3:
            for (int c = 0; c < M / 4096; ++c) { float* c1 = scr; float* c2 = scr + (size_t)4096 * 1024;
                hipLaunchKernelGGL(nv_gemm, dim3(1024 / 64, 64), dim3(256), 0, stream, (const bf16_t*)(ws + WS_ATT) + (size_t)c * 4096 * 512, 512, (const bf16_t*)(ws + WS_WATT), 512, 512, c1, 1024);
                hipLaunchKernelGGL(nv_gemm, dim3(1024 / 64, 64), dim3(256), 0, stream, (const bf16_t*)(ws + WS_SG) + (size_t)c * 4096 * 512, 512, (const bf16_t*)(ws + WS_WSGU), 512, 512, c2, 1024);
                hipLaunchKernelGGL(nv_merge, dim3(2048), dim3(256), 0, stream, (const float*)c1, (const float*)c2, (const bf16_t*)(ws + WS_GA) + (size_t)c * 4096 * 1024, (const bf16_t*)(ws + WS_GB) + (size_t)c * 4096 * 1024,
                                   (bf16_t*)(ws + WS_MERGED) + (size_t)c * 4096 * 1024, (size_t)4096 * 1024); }
            break;
        case 4:
            for (int c = 0; c < M / 4096; ++c) {
                hipLaunchKernelGGL(nv_gemm, dim3(1024 / 64, 64), dim3(256), 0, stream, (const bf16_t*)(ws + WS_MERGED) + (size_t)c * 4096 * 1024, 1024, (const bf16_t*)(ws + WS_WOUT), 1024, 1024, scr, 1024);
                hipLaunchKernelGGL(nv_resid, dim3(2048), dim3(256), 0, stream, P.in[0] + (size_t)c * 4096 * 1024, (const float*)scr, out + (size_t)c * 4096 * 1024, (size_t)4096 * 1024); }
            break;
        case 5: hipLaunchKernelGGL(k_norm_rows, dim3(256), dim3(512), 0, stream, (const float*)out, P.in[13], (bf16_t*)(ws + WS_XN1), M); break;
        case 6:
            for (int c = 0; c < M / 4096; ++c) {
                hipLaunchKernelGGL(nv_gemm, dim3(512 / 64, 64), dim3(256), 0, stream, (const bf16_t*)(ws + WS_XN1) + (size_t)c * 4096 * 1024, 1024, (const bf16_t*)(ws + WS_WCQ), 1024, 1024, scr, 512);
                hipLaunchKernelGGL(nv_store_bf16, dim3(1024), dim3(256), 0, stream, (const float*)scr, (bf16_t*)(ws + WS_QC) + (size_t)c * 4096 * 512, (size_t)4096 * 512, C2_CROSS); }
            break;
        case 7: hipLaunchKernelGGL(nv_cross, dim3(M), dim3(256), 0, stream, (const bf16_t*)(ws + WS_QC), (const bf16_t*)(ws + WS_KVC), (bf16_t*)(ws + WS_OC)); break;
        case 8:
            for (int c = 0; c < M / 4096; ++c) {
                hipLaunchKernelGGL(nv_gemm, dim3(1024 / 64, 64), dim3(256), 0, stream, (const bf16_t*)(ws + WS_OC) + (size_t)c * 4096 * 512, 512, (const bf16_t*)(ws + WS_WCO), 512, 512, scr, 1024);
                hipLaunchKernelGGL(nv_resid, dim3(2048), dim3(256), 0, stream, (const float*)(out + (size_t)c * 4096 * 1024), (const float*)scr, out + (size_t)c * 4096 * 1024, (size_t)4096 * 1024); }
            break;
        case 9: hipLaunchKernelGGL(k_route, dim3(256), dim3(512), 20 * 1024 * 4 + 4096, stream, P, (const float*)out, ws); break;
        case 10: hipLaunchKernelGGL(nv_moe_a, dim3(2 * M), dim3(256), 0, stream, (const bf16_t*)(ws + WS_XN3), ws); break;
        case 11: hipLaunchKernelGGL(nv_moe_b, dim3(2 * M), dim3(256), 0, stream, ws); break;
        case 12: hipLaunchKernelGGL(k_final, dim3(256), dim3(512), 0, stream, out, (const bf16_t*)(ws + WS_YS), P.in[26]); break;
        }
    }
#endif
}
```
